# Optimizing an MI355X kernel written in HIP

```python
import jax, jax.numpy as jnp
from jax import lax
import numpy as np

D_MODEL = 1024
BATCH = 32
SEQ = 2048
DEPTH = 4

GRID_W = 64
CTX_LEN = 256
Q_BLOCK = 128
ROPE_THETA = 10000.0
NORM_EPS = 1e-6

GQA_HEADS = 8
GQA_KV_HEADS = 2
GQA_HEAD_DIM = 128
MLA_HEADS = 8
MLA_Q_RANK = 768
MLA_KV_RANK = 256
MLA_NOPE_DIM = 128
MLA_ROPE_DIM = 64
MLA_V_DIM = 128
N_EXPERTS = 16
EXPERT_FF = 1024
CAPACITY_FACTOR = 2

N_MIXERS = 2
N_GQA_LAYERS = (DEPTH + 1) // 2
N_MLA_LAYERS = DEPTH // 2
DEEPNORM_ALPHA = (2 * DEPTH) ** 0.25
DEEPNORM_BETA = (8 * DEPTH) ** -0.25
ADA_INIT = 0.5

kernel_name = "hybrid_gqa_mla_ecmoe_diffusion_trunk"


def layer_norm(x, g, b):
    xf = x.astype(jnp.float32)
    mu = jnp.mean(xf, axis=-1, keepdims=True)
    xc = xf - mu
    var = jnp.mean(xc * xc, axis=-1, keepdims=True)
    return (xc * lax.rsqrt(var + NORM_EPS) * g + b).astype(x.dtype)


def rms_norm(x, g):
    xf = x.astype(jnp.float32)
    return (xf * lax.rsqrt(jnp.mean(xf * xf, axis=-1, keepdims=True) + NORM_EPS) * g).astype(x.dtype)


def axial_rope_tables(n, rot_dim, dtype):
    t = jnp.arange(n, dtype=jnp.int32)
    row = (t // GRID_W).astype(jnp.float32)
    col = (t % GRID_W).astype(jnp.float32)
    axis_dim = rot_dim // 2
    freqs = ROPE_THETA ** (-jnp.arange(0, axis_dim, 2, dtype=jnp.float32) / axis_dim)
    ang = jnp.concatenate([row[:, None] * freqs, col[:, None] * freqs], axis=-1)
    return jnp.cos(ang).astype(dtype), jnp.sin(ang).astype(dtype)


def apply_rope(x, cos, sin):
    xp = x.reshape(*x.shape[:-1], -1, 2)
    x0, x1 = xp[..., 0], xp[..., 1]
    return jnp.stack([x0 * cos - x1 * sin, x0 * sin + x1 * cos], axis=-1).reshape(x.shape)


def split_blocks(a):
    b, n = a.shape[:2]
    return a.reshape(b, n // Q_BLOCK, Q_BLOCK, *a.shape[2:]).swapaxes(0, 1)


def merge_blocks(a):
    nb, b, qb = a.shape[:3]
    return a.swapaxes(0, 1).reshape(b, nb * qb, *a.shape[3:])


def modulate(h, shift, scale):
    return h * (1.0 + scale) + shift


def gqa_attention(q, k, v):
    scale = GQA_HEAD_DIM ** -0.5

    def block(qb):
        s = jnp.einsum('bqhgd,bkhd->bhgqk', qb, k).astype(jnp.float32) * scale
        p = jax.nn.softmax(s, axis=-1).astype(v.dtype)
        return jnp.einsum('bhgqk,bkhd->bqhgd', p, v)

    o = merge_blocks(lax.map(block, split_blocks(q)))
    return o.reshape(*o.shape[:2], -1)


def gqa_project(h, w_qkv, q_g, k_g):
    b, n, _ = h.shape
    nq = GQA_HEADS * GQA_HEAD_DIM
    nk = GQA_KV_HEADS * GQA_HEAD_DIM
    qkv = h @ w_qkv
    q = qkv[..., :nq].reshape(b, n, GQA_KV_HEADS, GQA_HEADS // GQA_KV_HEADS, GQA_HEAD_DIM)
    k = qkv[..., nq:nq + nk].reshape(b, n, GQA_KV_HEADS, GQA_HEAD_DIM)
    v = qkv[..., nq + nk:].reshape(b, n, GQA_KV_HEADS, GQA_HEAD_DIM)
    return rms_norm(q, q_g), rms_norm(k, k_g), v


def gqa_mixer(h_lat, h_ctx, w_qkv, q_g, k_g, w_o, with_ctx_out):
    q_l, k_l, v_l = gqa_project(h_lat, w_qkv, q_g, k_g)
    cos, sin = axial_rope_tables(h_lat.shape[1], GQA_HEAD_DIM, h_lat.dtype)
    q_l = apply_rope(q_l, cos[:, None, None, :], sin[:, None, None, :])
    k_l = apply_rope(k_l, cos[:, None, :], sin[:, None, :])
    q_c, k_c, v_c = gqa_project(h_ctx, w_qkv, q_g, k_g)
    k_all = jnp.concatenate([k_c, k_l], axis=1)
    v_all = jnp.concatenate([v_c, v_l], axis=1)
    o_lat = gqa_attention(q_l, k_all, v_all) @ w_o
    o_ctx = gqa_attention(q_c, k_c, v_c) @ w_o if with_ctx_out else None
    return o_lat, o_ctx


def mla_attention(q_nope, q_rope, k_nope, k_rope, v):
    scale = (MLA_NOPE_DIM + MLA_ROPE_DIM) ** -0.5

    def block(qs):
        qn, qr = qs
        s = (jnp.einsum('bqhd,bkhd->bhqk', qn, k_nope)
             + jnp.einsum('bqhr,bkr->bhqk', qr, k_rope)).astype(jnp.float32) * scale
        p = jax.nn.softmax(s, axis=-1).astype(v.dtype)
        return jnp.einsum('bhqk,bkhd->bqhd', p, v)

    o = merge_blocks(lax.map(block, (split_blocks(q_nope), split_blocks(q_rope))))
    return o.reshape(*o.shape[:2], -1)


def mla_project(h, w_dq, q_g, w_uq, w_dkv, kv_g, w_ukv):
    b, n, _ = h.shape
    q = (rms_norm(h @ w_dq, q_g) @ w_uq).reshape(b, n, MLA_HEADS, MLA_NOPE_DIM + MLA_ROPE_DIM)
    q_nope, q_rope = q[..., :MLA_NOPE_DIM], q[..., MLA_NOPE_DIM:]
    ckv = h @ w_dkv
    c_kv, k_rope = ckv[..., :MLA_KV_RANK], ckv[..., MLA_KV_RANK:]
    kv = (rms_norm(c_kv, kv_g) @ w_ukv).reshape(b, n, MLA_HEADS, MLA_NOPE_DIM + MLA_V_DIM)
    k_nope, v = kv[..., :MLA_NOPE_DIM], kv[..., MLA_NOPE_DIM:]
    return q_nope, q_rope, k_nope, k_rope, v


def mla_mixer(h_lat, h_ctx, w_dq, q_g, w_uq, w_dkv, kv_g, w_ukv, w_o, with_ctx_out):
    qn_l, qr_l, kn_l, kr_l, v_l = mla_project(h_lat, w_dq, q_g, w_uq, w_dkv, kv_g, w_ukv)
    cos, sin = axial_rope_tables(h_lat.shape[1], MLA_ROPE_DIM, h_lat.dtype)
    qr_l = apply_rope(qr_l, cos[:, None, :], sin[:, None, :])
    kr_l = apply_rope(kr_l, cos, sin)
    qn_c, qr_c, kn_c, kr_c, v_c = mla_project(h_ctx, w_dq, q_g, w_uq, w_dkv, kv_g, w_ukv)
    kn_all = jnp.concatenate([kn_c, kn_l], axis=1)
    kr_all = jnp.concatenate([kr_c, kr_l], axis=1)
    v_all = jnp.concatenate([v_c, v_l], axis=1)
    o_lat = mla_attention(qn_l, qr_l, kn_all, kr_all, v_all) @ w_o
    o_ctx = mla_attention(qn_c, qr_c, kn_c, kr_c, v_c) @ w_o if with_ctx_out else None
    return o_lat, o_ctx


def ec_moe(h, w_router, w_gate, w_up, w_down):
    b, n, _ = h.shape
    cap = CAPACITY_FACTOR * n // N_EXPERTS
    aff = jax.nn.softmax((h @ w_router).astype(jnp.float32), axis=-1)
    g, idx = lax.top_k(aff.swapaxes(1, 2), cap)
    bidx = jnp.arange(b)[:, None, None]
    xs = h[bidx, idx]
    a = jnp.einsum('becd,edf->becf', xs, w_gate)
    u = jnp.einsum('becd,edf->becf', xs, w_up)
    y = jnp.einsum('becf,efd->becd', jax.nn.silu(a) * u, w_down)
    y = (y * g[..., None].astype(y.dtype)).astype(h.dtype)
    return jnp.zeros_like(h).at[bidx, idx].add(y)


def setup_inputs(seed: int = 0) -> dict:
    key = jax.random.key(seed)
    ks = iter(jax.random.split(key, 32))

    def nrm(shape, scale):
        return jax.random.normal(next(ks), shape, jnp.float32) * scale

    D, L, E, F = D_MODEL, DEPTH, N_EXPERTS, EXPERT_FF
    NG, NM = N_GQA_LAYERS, N_MLA_LAYERS
    gqa_cols = (GQA_HEADS + 2 * GQA_KV_HEADS) * GQA_HEAD_DIM
    return {
        "x": nrm((BATCH, SEQ, D), 1.0),
        "c": nrm((BATCH, D), 1.0),
        "ctx": nrm((BATCH, CTX_LEN, D), 1.0),
        "c_ctx": nrm((D,), 1.0),
        "ada_w": nrm((L, D, 6 * D), ADA_INIT * D ** -0.5),
        "ada_b": nrm((L, 6 * D), 0.02),
        "ln_mix_g": 1.0 + nrm((L, D), 0.02),
        "ln_mix_b": nrm((L, D), 0.02),
        "ln_ffn_g": 1.0 + nrm((L, D), 0.02),
        "ln_ffn_b": nrm((L, D), 0.02),
        "router_w": nrm((L, D, E), D ** -0.5),
        "expert_w_gate": nrm((L, E, D, F), D ** -0.5),
        "expert_w_up": nrm((L, E, D, F), D ** -0.5),
        "expert_w_down": nrm((L, E, F, D), DEEPNORM_BETA * F ** -0.5),
        "gqa_w_qkv": nrm((NG, D, gqa_cols), D ** -0.5),
        "gqa_q_g": 1.0 + nrm((NG, GQA_HEAD_DIM), 0.02),
        "gqa_k_g": 1.0 + nrm((NG, GQA_HEAD_DIM), 0.02),
        "gqa_w_o": nrm((NG, GQA_HEADS * GQA_HEAD_DIM, D), DEEPNORM_BETA * (GQA_HEADS * GQA_HEAD_DIM) ** -0.5),
        "mla_w_dq": nrm((NM, D, MLA_Q_RANK), D ** -0.5),
        "mla_q_g": 1.0 + nrm((NM, MLA_Q_RANK), 0.02),
        "mla_w_uq": nrm((NM, MLA_Q_RANK, MLA_HEADS * (MLA_NOPE_DIM + MLA_ROPE_DIM)), MLA_Q_RANK ** -0.5),
        "mla_w_dkv": nrm((NM, D, MLA_KV_RANK + MLA_ROPE_DIM), D ** -0.5),
        "mla_kv_g": 1.0 + nrm((NM, MLA_KV_RANK), 0.02),
        "mla_w_ukv": nrm((NM, MLA_KV_RANK, MLA_HEADS * (MLA_NOPE_DIM + MLA_V_DIM)), MLA_KV_RANK ** -0.5),
        "mla_w_o": nrm((NM, MLA_HEADS * MLA_V_DIM, D), DEEPNORM_BETA * (MLA_HEADS * MLA_V_DIM) ** -0.5),
    }


def reference(x, c, ctx, c_ctx, ada_w, ada_b, ln_mix_g, ln_mix_b, ln_ffn_g, ln_ffn_b,
              router_w, expert_w_gate, expert_w_up, expert_w_down,
              gqa_w_qkv, gqa_q_g, gqa_k_g, gqa_w_o,
              mla_w_dq, mla_q_g, mla_w_uq, mla_w_dkv, mla_kv_g, mla_w_ukv, mla_w_o):
    silu_c = jax.nn.silu(c)
    silu_cc = jax.nn.silu(c_ctx)
    for i in range(DEPTH):
        last = i == DEPTH - 1
        j = i // N_MIXERS
        mod_l = (silu_c @ ada_w[i] + ada_b[i])[:, None, :]
        mod_c = silu_cc @ ada_w[i] + ada_b[i]
        sh1_l, sc1_l, g1_l, sh2_l, sc2_l, g2_l = jnp.split(mod_l, 6, axis=-1)
        sh1_c, sc1_c, g1_c, sh2_c, sc2_c, g2_c = jnp.split(mod_c, 6, axis=-1)

        h_l = modulate(x, sh1_l, sc1_l)
        h_c = modulate(ctx, sh1_c, sc1_c)
        if i % N_MIXERS == 0:
            o_l, o_c = gqa_mixer(h_l, h_c, gqa_w_qkv[j], gqa_q_g[j], gqa_k_g[j], gqa_w_o[j], not last)
        else:
            o_l, o_c = mla_mixer(h_l, h_c, mla_w_dq[j], mla_q_g[j], mla_w_uq[j], mla_w_dkv[j],
                                 mla_kv_g[j], mla_w_ukv[j], mla_w_o[j], not last)
        x = layer_norm(DEEPNORM_ALPHA * x + g1_l * o_l, ln_mix_g[i], ln_mix_b[i])

        f_l = ec_moe(modulate(x, sh2_l, sc2_l), router_w[i], expert_w_gate[i], expert_w_up[i], expert_w_down[i])
        x = layer_norm(DEEPNORM_ALPHA * x + g2_l * f_l, ln_ffn_g[i], ln_ffn_b[i])

        if not last:
            ctx = layer_norm(DEEPNORM_ALPHA * ctx + g1_c * o_c, ln_mix_g[i], ln_mix_b[i])
            f_c = ec_moe(modulate(ctx, sh2_c, sc2_c), router_w[i], expert_w_gate[i], expert_w_up[i], expert_w_down[i])
            ctx = layer_norm(DEEPNORM_ALPHA * ctx + g2_c * f_c, ln_ffn_g[i], ln_ffn_b[i])
    return x
```

```cpp
#define MK_ONE_LAUNCH 1
#include <hip/hip_runtime.h>
#include <cstdio>
#include <cstdint>

#define LAS __attribute__((address_space(3)))
#define GAS __attribute__((address_space(1)))
typedef unsigned short bf16_t;
typedef short bf16x8 __attribute__((ext_vector_type(8)));
typedef short s16x4 __attribute__((ext_vector_type(4)));
typedef float f32x2 __attribute__((ext_vector_type(2)));
typedef float f32x4 __attribute__((ext_vector_type(4)));
typedef float f32x16 __attribute__((ext_vector_type(16)));
typedef unsigned u32x2 __attribute__((ext_vector_type(2)));
typedef unsigned u32x4 __attribute__((ext_vector_type(4)));

#ifndef MK_ONE_LAUNCH
#define MK_ONE_LAUNCH 1
#endif

constexpr int D = 1024, NB = 32, SEQ = 2048, CTXL = 256, TPS = SEQ + CTXL  , T = NB * TPS  , NL = 4;
constexpr int NE = 16, FF = 1024, CAPL = 256, CAPC = 32;
constexpr int NSLOT_L = NB * NE * CAPL  , NSLOT = NSLOT_L + NB * NE * CAPC  , NPANEL = NSLOT / 256  ;
constexpr float ALPHA = 1.6817928305074292f, LN_EPS = 1e-6f;
constexpr int NWAVES = 8, NTHR = 512;
constexpr int MODSZ = 6 * D;
constexpr int MOD_KC = 16;

constexpr size_t MiB = 1u << 20;
constexpr size_t WS_CTL = 0, CTL_ZERO_BYTES = 64 * 1024;
constexpr size_t WS_MOD = 1 * MiB;
constexpr size_t WS_ROPE = 5 * MiB;
constexpr size_t WS_WQKV = 6 * MiB;
constexpr size_t WS_WOG = 12 * MiB;
constexpr size_t WS_WD = 16 * MiB;
constexpr size_t WS_WUQ = 21 * MiB;
constexpr size_t WS_WUKV = 26 * MiB;
constexpr size_t WS_WOM = 28 * MiB;
constexpr size_t WS_WGU = 32 * MiB;
constexpr size_t WS_WDN = 96 * MiB;
constexpr size_t WS_XC = 128 * MiB;
constexpr size_t WS_H = 160 * MiB;
constexpr size_t WS_AFF = 304 * MiB;
constexpr size_t WS_INV = 309 * MiB;
constexpr size_t WS_GVAL = 314 * MiB;
constexpr size_t WS_STOK = 315 * MiB;
constexpr size_t WS_RS = 316 * MiB;
constexpr size_t WS_KR = 317 * MiB;
constexpr size_t WS_R = 326 * MiB;
constexpr size_t R_QKV = 0, R_AOG = 216 * MiB, R_OG = 0;
constexpr size_t R_CQ = 0, R_Q = 180 * MiB, R_KV = 396 * MiB, R_AOM = 0, R_OM = 180 * MiB;
constexpr size_t R_XS = 0, R_ACT = 288 * MiB;
constexpr size_t R_MODP = 0;
constexpr size_t WS_END = WS_R + 684 * MiB;
static_assert((size_t)T * 2048 * 2 == 288 * MiB && (size_t)NSLOT * 1024 * 2 == 288 * MiB && (size_t)T * 1536 * 2 == 216 * MiB && (size_t)T * 1280 * 2 == 180 * MiB, "sizes");
constexpr int CW_BAR = 4096;

constexpr int RING_BYTES = 131072;
constexpr int MISC_OFF = RING_BYTES + 1024;
constexpr int LDS_BYTES = 147456;

__device__ __forceinline__ float bf2f(unsigned b) { return __uint_as_float(b << 16); }
__device__ __forceinline__ unsigned cvt_pk_bf16(float lo, float hi) { unsigned r; asm volatile("v_cvt_pk_bf16_f32 %0, %1, %2" : "=v"(r) : "v"(lo), "v"(hi)); return r; }
__device__ __forceinline__ float wave_sum(float v) {
#pragma unroll
    for (int o = 1; o < 64; o <<= 1) v += __shfl_xor(v, o);
    return v;
}
#define LDS_WAIT() asm volatile("s_waitcnt lgkmcnt(0)" ::: "memory")
#define VM_WAIT() asm volatile("s_waitcnt vmcnt(0)" ::: "memory")
__device__ __forceinline__ int opaque_v(int x) { asm volatile("" : "+v"(x)); return x; }
__device__ __forceinline__ int opaque_s(int x) { asm volatile("" : "+s"(x)); return x; }
__device__ __forceinline__ const float* in_ptr(int i) {
    const __attribute__((address_space(4))) char* kp = (const __attribute__((address_space(4))) char*)__builtin_amdgcn_kernarg_segment_ptr();
    const int off = opaque_s(i * 8);
    return *(const float* const __attribute__((address_space(4)))*)(kp + off);
}
#ifndef ATT_SD_MLA
#define ATT_SD_MLA 1
#endif
#define XB_TMO      128
#define XB_XCNT(j)  (256  + 64 * (j))
#define XB_XSUB(j)  (1280 + 64 * (j))
#define XB_XGEN(j)  (2304 + 64 * (j))
#define XB_TOP      3328
#define XB_TOPGEN   3392
#define XCD_BAR_WORDS 3456
#define XB_SPIN_CAP (1u << 18)

__device__ __forceinline__ unsigned xb_ld(unsigned* p)              { return __hip_atomic_load(p, __ATOMIC_RELAXED, __HIP_MEMORY_SCOPE_AGENT); }
__device__ __forceinline__ unsigned xb_add(unsigned* p, unsigned v) { return __hip_atomic_fetch_add(p, v, __ATOMIC_RELAXED, __HIP_MEMORY_SCOPE_AGENT); }
__device__ __forceinline__ unsigned xb_xcc_id() { return (unsigned)__builtin_amdgcn_s_getreg((3 << 11) | 20) & 0xFu; }
#define XB_SPIN(cond, bar) do { unsigned _sp = 0; while (cond) { __builtin_amdgcn_s_sleep(1); \
    if ((++_sp & 255u) == 0u) { if (xb_ld(&(bar)[XB_TMO])) break; if (_sp > XB_SPIN_CAP) { atomicAdd(&(bar)[XB_TMO], 1u); break; } } } } while (0)

struct XcdBarrier {
    unsigned* bar; unsigned x;
    volatile LAS unsigned* st;
};

__device__ __forceinline__ XcdBarrier xcd_barrier_post(unsigned* bar, volatile LAS unsigned* st) {
    XcdBarrier b; b.bar = bar; b.x = xb_xcc_id(); b.st = st;
    if (threadIdx.x == 0) (void)xb_add(&bar[XB_XCNT(b.x)], 1u);
    return b;
}
__device__ __forceinline__ void xcd_barrier_complete(unsigned* bar, unsigned x, unsigned& nloc, unsigned& nx) {
    const unsigned G = gridDim.x * gridDim.y * gridDim.z;
    unsigned sum, cnt, mine, sp = 0u;
    for (;;) {
        sum = 0u; cnt = 0u; mine = 0u;
#pragma unroll
        for (unsigned j = 0; j < 16; ++j) { const unsigned c = xb_ld(&bar[XB_XCNT(j)]); sum += c; cnt += (c > 0u) ? 1u : 0u; mine = (j == x) ? c : mine; }
        if (sum == G) break;
        __builtin_amdgcn_s_sleep(1);
        if ((++sp & 255u) == 0u) { if (xb_ld(&bar[XB_TMO])) break; if (sp > XB_SPIN_CAP) { atomicAdd(&bar[XB_TMO], 1u); break; } }
    }
    nloc = mine > 0u ? mine : 1u; nx = cnt > 0u ? cnt : 1u;
}

__device__ __forceinline__ void xcd_barrier(const XcdBarrier& b) {
    asm volatile("s_waitcnt vmcnt(0)" ::: "memory");
    __syncthreads();
    if (threadIdx.x == 0) {
        unsigned* bar = b.bar;
        __builtin_amdgcn_s_waitcnt(0);
        unsigned nloc = b.st[0], nx = b.st[1];
        if (nloc == 0u) { xcd_barrier_complete(bar, b.x, nloc, nx); b.st[0] = nloc; b.st[1] = nx; }
        const unsigned old = xb_add(&bar[XB_XSUB(b.x)], 1u);
        const unsigned gen = old / nloc;
        if (old + 1u == (gen + 1u) * nloc) {
            __builtin_amdgcn_fence(__ATOMIC_RELEASE, "agent");
            asm volatile("s_waitcnt vmcnt(0)" ::: "memory");
            const unsigned og = xb_add(&bar[XB_TOP], 1u);
            const unsigned tg = og / nx;
            if (og + 1u == (tg + 1u) * nx) xb_add(&bar[XB_TOPGEN], 1u);
            else XB_SPIN(xb_ld(&bar[XB_TOPGEN]) == tg, bar);
            __builtin_amdgcn_fence(__ATOMIC_ACQUIRE, "agent");
            xb_add(&bar[XB_XGEN(b.x)], 1u);
            asm volatile("s_waitcnt vmcnt(0)" ::: "memory");
        } else {
            XB_SPIN(xb_ld(&bar[XB_XGEN(b.x)]) == gen, bar);
            __builtin_amdgcn_fence(__ATOMIC_ACQUIRE, "agent");
            asm volatile("s_waitcnt vmcnt(0)" ::: "memory");
        }
    }
    __syncthreads();
}

namespace pg8 {
#define PG8_LAS __attribute__((address_space(3)))
constexpr int BM = 256, BK = 64, HALF = 128, HTB = HALF * BK * 2  , STAGE_BYTES = 8 * HTB, NXCD = 8, WGM = 8;

__host__ __device__ __forceinline__ int lds_byte(int r, int c) { const int st = (r >> 4) * 2 + (c >> 5), rr = r & 15, cc = c & 31, ob = rr * 64 + cc * 2; return st * 1024 + (ob ^ (((ob >> 9) & 1) << 5)); }
__host__ __device__ __forceinline__ void stage_rc(int b, int& R, int& C) { const int st = b / 1024, sb = b % 1024, swz = sb ^ (((sb >> 9) & 1) << 5); R = (st >> 1) * 16 + swz / 64; C = (st & 1) * 32 + (swz % 64) / 2; }
__host__ __device__ __forceinline__ int perm32(int rho) { const int n = rho >> 4, i = rho & 15; return 8 * (i >> 2) + 4 * n + (i & 3); }

struct Unit { int pm, pn; };
struct Gemm { const bf16_t* A; const bf16_t* Bt; int lda, ldb, K; int pad; };

struct StaticOrder {
    int nM, nN, nwg, G, c;
    __host__ __device__ void init(int M, int N, int G_, int c_) { nM = M / BM; nN = N / BM; nwg = nM * nN; G = G_; c = c_; }
    __host__ __device__ bool next(int i, Unit& u) const {
        const long L = (long)i * G + c; if (L >= nwg) return false;
        int wgid = (int)L; { const int q = nwg / NXCD, r = nwg % NXCD, xcd = wgid % NXCD, off = wgid / NXCD; wgid = (xcd < r ? xcd * (q + 1) : r * (q + 1) + (xcd - r) * q) + off; }
        const int nig = WGM * nN, gid = wgid / nig, fm = gid * WGM, gsz = (nM - fm) < WGM ? (nM - fm) : WGM;
        u.pm = fm + ((wgid % nig) % gsz); u.pn = (wgid % nig) / gsz; return true;
    }
    __device__ __forceinline__ void a_ready(const Unit&) const {}
    __device__ __forceinline__ void done(const Unit&) const {}
};
template <class Epi, class Sched, bool STAMP = false>
__device__ __forceinline__ void gemm_phase(PG8_LAS unsigned char* lds, const Gemm g, const Sched& S, const Epi& E, unsigned long long* stamps) {
    const int tid = opaque_v((int)threadIdx.x), wid = __builtin_amdgcn_readfirstlane(tid >> 6), lane = tid & 63, wr = wid >> 2, wc = wid & 3, fr = lane & 15, fq = lane >> 4;
    const int K = g.K, nt = K / BK;
    int ts_lo = 0, ts_hi = 0, nts = 0; const unsigned long long rt_entry = STAMP ? (unsigned long long)wall_clock64() : 0ull;
#define PG8_STAMP() do { if (STAMP && wid == 0 && nts < 64) { const unsigned long long _c = (unsigned long long)clock64(); \
        ts_lo = (lane == nts) ? (int)(unsigned)_c : ts_lo; ts_hi = (lane == nts) ? (int)(unsigned)(_c >> 32) : ts_hi; ++nts; } } while (0)
    PG8_STAMP();
    unsigned voffA[2], voffB[2];
#pragma unroll
    for (int i = 0; i < 2; ++i) { int R, C; stage_rc(tid * 16 + i * 8192, R, C); const int Rb = Epi::PERM ? ((R & ~31) + perm32(R & 31)) : R;
        voffA[i] = (unsigned)(R * g.lda + C) * 2u; voffB[i] = (unsigned)(Rb * g.ldb + C) * 2u; }
    const size_t kstep = (size_t)(BK * 2);
    const size_t hstepA = (size_t)HALF * g.lda * 2, hstepB = (size_t)HALF * g.ldb * 2;
    const size_t tstepA = 2 * hstepA, tstepB = 2 * hstepB;
    const unsigned ldsw = (unsigned)wid * 1024u;
    const int aoff = lds_byte(wr * 64 + fr, fq * 8), boff = lds_byte(wc * 32 + fr, fq * 8);
#define PG8_SA(b, h) (((b) * 2 + (h)) * HTB)
#define PG8_SB(b, h) ((4 + (b) * 2 + (h)) * HTB)
#define PG8_STAGE(bufoff, gbase, voff) do { _Pragma("unroll") for (int _i = 0; _i < 2; ++_i) \
        __builtin_amdgcn_global_load_lds((const unsigned*)((const char*)(gbase) + (voff)[_i]), (PG8_LAS unsigned*)(lds + (bufoff) + ldsw + _i * 8192), 16, 0, 0); } while (0)
#define PG8_LDA(dst, b, h) do { _Pragma("unroll") for (int m = 0; m < 4; ++m) _Pragma("unroll") for (int k = 0; k < 2; ++k) dst[m][k] = *(const PG8_LAS bf16x8*)(lds + PG8_SA(b, h) + aoff + m * 2048 + k * 1024); } while (0)
#define PG8_LDB(dst, b, h) do { _Pragma("unroll") for (int n = 0; n < 2; ++n) _Pragma("unroll") for (int k = 0; k < 2; ++k) dst[n][k] = *(const PG8_LAS bf16x8*)(lds + PG8_SB(b, h) + boff + n * 2048 + k * 1024); } while (0)
#define PG8_MMA(ai, bj, At, Bt) do { __builtin_amdgcn_s_setprio(1); _Pragma("unroll") for (int m = 0; m < 4; ++m) _Pragma("unroll") for (int n = 0; n < 2; ++n) _Pragma("unroll") for (int k = 0; k < 2; ++k) \
        acc[ai][bj][m][n] = __builtin_amdgcn_mfma_f32_16x16x32_bf16(Bt[n][k], At[m][k], acc[ai][bj][m][n], 0, 0, 0); __builtin_amdgcn_s_setprio(0); } while (0)
#define PG8_WAIT_V(n) asm volatile("s_waitcnt vmcnt(" #n ")" ::: "memory")
#define PG8_WAIT_L(n) asm volatile("s_waitcnt lgkmcnt(" #n ")" ::: "memory")
#define PG8_BAR __builtin_amdgcn_s_barrier()
#define PG8_SCHED __builtin_amdgcn_sched_barrier(0)
    Unit cur, nxt; int ui = 0;
    if (!S.next(0, cur)) return;
    f32x4 acc[2][2][4][2];
#pragma unroll
    for (int a = 0; a < 2; ++a)
#pragma unroll
        for (int b = 0; b < 2; ++b)
#pragma unroll
            for (int m = 0; m < 4; ++m)
#pragma unroll
                for (int n = 0; n < 2; ++n) acc[a][b][m][n] = (f32x4){0.f, 0.f, 0.f, 0.f};
    bf16x8 At[4][2], B0[2][2], B1[2][2];
    const char* cA = (const char*)g.A + (size_t)cur.pm * tstepA; const char* cB = (const char*)g.Bt + (size_t)cur.pn * tstepB;
    S.a_ready(cur);
    PG8_STAGE(PG8_SB(0, 0), cB, voffB); PG8_STAGE(PG8_SA(0, 0), cA, voffA); PG8_STAGE(PG8_SB(0, 1), cB + hstepB, voffB); PG8_STAGE(PG8_SA(0, 1), cA + hstepA, voffA);
    if (wr == 1) PG8_BAR;
    PG8_WAIT_V(4); PG8_BAR;
    PG8_STAGE(PG8_SB(1, 0), cB + kstep, voffB); PG8_STAGE(PG8_SA(1, 0), cA + kstep, voffA); PG8_STAGE(PG8_SB(1, 1), cB + hstepB + kstep, voffB);
    PG8_WAIT_V(6); PG8_BAR;
    PG8_STAMP();
    for (;;) {
        const bool has_next = S.next(ui + 1, nxt);
        const char* nA = has_next ? (const char*)g.A + (size_t)nxt.pm * tstepA : cA; const char* nB = has_next ? (const char*)g.Bt + (size_t)nxt.pn * tstepB : cB;
        for (int t = 0; t < nt; t += 2) {
            const bool last = (t == nt - 2);
            const char* a1 = cA + (size_t)(t + 1) * kstep;
            const char* a2 = last ? nA : cA + (size_t)(t + 2) * kstep; const char* b2 = last ? nB : cB + (size_t)(t + 2) * kstep;
            const char* a3 = a2 + kstep; const char* b3 = b2 + kstep;
            if (last && has_next) S.a_ready(nxt);
            PG8_LDB(B0, 0, 0); PG8_SCHED; PG8_LDA(At, 0, 0); PG8_STAGE(PG8_SA(1, 1), a1 + hstepA, voffA);
            PG8_WAIT_L(8); PG8_BAR; PG8_WAIT_L(0); PG8_MMA(0, 0, At, B0); PG8_BAR; PG8_SCHED;
            PG8_LDB(B1, 0, 1); PG8_STAGE(PG8_SB(0, 0), b2, voffB);
            PG8_BAR; PG8_WAIT_L(0); PG8_MMA(0, 1, At, B1); PG8_BAR;
            PG8_LDA(At, 0, 1); PG8_STAGE(PG8_SA(0, 0), a2, voffA);
            PG8_BAR; PG8_WAIT_L(0); PG8_MMA(1, 0, At, B0); PG8_BAR; PG8_SCHED;
            PG8_STAGE(PG8_SB(0, 1), b2 + hstepB, voffB);
            PG8_WAIT_V(6); PG8_BAR; PG8_MMA(1, 1, At, B1); PG8_BAR;
            PG8_LDB(B0, 1, 0); PG8_SCHED; PG8_LDA(At, 1, 0); PG8_STAGE(PG8_SA(0, 1), a2 + hstepA, voffA);
            PG8_WAIT_L(8); PG8_BAR; PG8_WAIT_L(0); PG8_MMA(0, 0, At, B0); PG8_BAR; PG8_SCHED;
            PG8_LDB(B1, 1, 1); PG8_STAGE(PG8_SB(1, 0), b3, voffB);
            PG8_BAR; PG8_WAIT_L(0); PG8_MMA(0, 1, At, B1); PG8_BAR;
            PG8_LDA(At, 1, 1); PG8_STAGE(PG8_SA(1, 0), a3, voffA);
            PG8_BAR; PG8_WAIT_L(0); PG8_MMA(1, 0, At, B0); PG8_BAR; PG8_SCHED;
            PG8_STAGE(PG8_SB(1, 1), b3 + hstepB, voffB);
            PG8_WAIT_V(6); PG8_BAR; PG8_MMA(1, 1, At, B1); PG8_BAR;
        }
        PG8_STAMP();
        if constexpr (!Epi::AFTER_DRAIN) { E(acc, cur, wr, wc, fr, fq); S.done(cur); }
        PG8_STAMP();
        if (!has_next) break;
#pragma unroll
        for (int a = 0; a < 2; ++a)
#pragma unroll
            for (int b = 0; b < 2; ++b)
#pragma unroll
                for (int m = 0; m < 4; ++m)
#pragma unroll
                    for (int n = 0; n < 2; ++n) acc[a][b][m][n] = (f32x4){0.f, 0.f, 0.f, 0.f};
        cur = nxt; cA = nA; cB = nB; ++ui;
    }
    PG8_WAIT_V(0);
    if (wr == 0) PG8_BAR;
    PG8_BAR;
    if constexpr (Epi::AFTER_DRAIN) { E.fused(acc, cur, wr, wc, fr, fq, lds, wid, lane); S.done(cur); }
    PG8_STAMP();
    if (STAMP && wid == 0) { stamps[lane] = lane < nts ? (((unsigned long long)(unsigned)ts_hi << 32) | (unsigned)ts_lo) : 0ull;
        if (lane == 62) stamps[62] = rt_entry; if (lane == 63) stamps[63] = (unsigned long long)wall_clock64(); }
#undef PG8_STAMP
#undef PG8_SA
#undef PG8_SB
#undef PG8_STAGE
#undef PG8_LDA
#undef PG8_LDB
#undef PG8_MMA
#undef PG8_WAIT_V
#undef PG8_WAIT_L
#undef PG8_BAR
#undef PG8_SCHED
}
}
namespace pg8 {
struct MoeOrder {
    int NT, G, c, nunits;
    __device__ void init(int NT_, int G_, int c_) { NT = NT_; G = G_; c = c_; nunits = NPANEL * NT_; }
    __device__ bool next(int i, Unit& u) const {
        const long L = (long)i * G + c; if (L >= nunits) return false;
        const int pr = (int)L / NT, pnl = (int)L % NT; int pm, e;
        if (pr < 512) { e = pr >> 5; pm = (pr & 31) * 16 + e; } else { pm = pr; e = (pr - 512) >> 2; }
        u.pm = pm; u.pn = e * NT + pnl; return true;
    }
    __device__ __forceinline__ void a_ready(const Unit&) const {}
    __device__ __forceinline__ void done(const Unit&) const {}
};

__device__ __forceinline__ u32x4 pack8(const f32x4 a, const f32x4 b) { u32x4 w; w.x = cvt_pk_bf16(a[0], a[1]); w.y = cvt_pk_bf16(a[2], a[3]); w.z = cvt_pk_bf16(b[0], b[1]); w.w = cvt_pk_bf16(b[2], b[3]); return w; }

struct EpiStore {
    static constexpr bool PERM = true, AFTER_DRAIN = false;
    bf16_t* O; int ldc;
    __device__ __forceinline__ void operator()(const f32x4 (&acc)[2][2][4][2], const Unit& u, int wr, int wc, int fr, int fq) const {
        const int row0 = u.pm * BM + wr * 64 + fr, col0 = u.pn * BM + wc * 32 + 8 * fq;
#pragma unroll
        for (int ai = 0; ai < 2; ++ai)
#pragma unroll
            for (int m = 0; m < 4; ++m) { const int row = row0 + ai * HALF + m * 16; bf16_t* rowp = O + (size_t)row * ldc + col0;
#pragma unroll
                for (int bj = 0; bj < 2; ++bj) *(u32x4*)(rowp + bj * HALF) = pack8(acc[ai][bj][m][0], acc[ai][bj][m][1]); }
    }
};
struct EpiUq {
    static constexpr bool PERM = true, AFTER_DRAIN = false;
    bf16_t* O; const float* rcos; const float* rsin;
    __device__ __forceinline__ void operator()(const f32x4 (&acc)[2][2][4][2], const Unit& u, int wr, int wc, int fr, int fq) const {
        const int row0 = u.pm * BM + wr * 64 + fr, col0 = u.pn * BM + wc * 32 + 8 * fq;
        const int bsmp = u.pm / 9, ptile = u.pm - bsmp * 9; const bool latent = ptile != 0;
        int j0[2]; bool inr[2];
#pragma unroll
        for (int bj = 0; bj < 2; ++bj) { const int c = col0 + bj * HALF, hd = c / 192, off = c - hd * 192; inr[bj] = latent && off >= 128; j0[bj] = (off - 128) >> 1; }
#pragma unroll
        for (int ai = 0; ai < 2; ++ai)
#pragma unroll
            for (int m = 0; m < 4; ++m) { const int row = row0 + ai * HALF + m * 16; bf16_t* rowp = O + (size_t)row * 1536 + col0;
                const int t = row - bsmp * TPS - CTXL, trow = (t >> 6) & 31, tcol = t & 63;
#pragma unroll
                for (int bj = 0; bj < 2; ++bj) { f32x4 a = acc[ai][bj][m][0], b = acc[ai][bj][m][1];
                    if (inr[bj]) { const int pos = j0[bj] < 16 ? trow : tcol, ti = pos * 16 + (j0[bj] & 15);
                        const f32x4 cs = *(const f32x4*)(rcos + ti), sn = *(const f32x4*)(rsin + ti);
                        const f32x4 a2 = {a[0] * cs[0] - a[1] * sn[0], a[0] * sn[0] + a[1] * cs[0], a[2] * cs[1] - a[3] * sn[1], a[2] * sn[1] + a[3] * cs[1]};
                        const f32x4 b2 = {b[0] * cs[2] - b[1] * sn[2], b[0] * sn[2] + b[1] * cs[2], b[2] * cs[3] - b[3] * sn[3], b[2] * sn[3] + b[3] * cs[3]};
                        a = a2; b = b2; }
                    *(u32x4*)(rowp + bj * HALF) = pack8(a, b); } }
    }
};
struct EpiSwiGlu {
    static constexpr bool PERM = true, AFTER_DRAIN = false;
    bf16_t* O;
    __device__ __forceinline__ void operator()(const f32x4 (&acc)[2][2][4][2], const Unit& u, int wr, int wc, int fr, int fq) const {
        const int row0 = u.pm * BM + wr * 64 + fr, col0 = (u.pn & 7) * HALF + wc * 32 + 8 * fq;
#pragma unroll
        for (int ai = 0; ai < 2; ++ai)
#pragma unroll
            for (int m = 0; m < 4; ++m) { bf16_t* rowp = O + (size_t)(row0 + ai * HALF + m * 16) * FF + col0; f32x4 r[2];
#pragma unroll
                for (int n = 0; n < 2; ++n) { const f32x4 g = acc[ai][0][m][n], up = acc[ai][1][m][n];
#pragma unroll
                    for (int j = 0; j < 4; ++j) r[n][j] = g[j] * __builtin_amdgcn_rcpf(1.0f + __builtin_amdgcn_exp2f(-1.4426950408889634f * g[j])) * up[j]; }
                *(u32x4*)rowp = pack8(r[0], r[1]); }
    }
};
struct EpiDown {
    static constexpr bool PERM = true, AFTER_DRAIN = false;
    bf16_t* O; const float* gv;
    __device__ __forceinline__ void operator()(const f32x4 (&acc)[2][2][4][2], const Unit& u, int wr, int wc, int fr, int fq) const {
        const int row0 = u.pm * BM + wr * 64 + fr, col0 = (u.pn & 3) * BM + wc * 32 + 8 * fq;
#pragma unroll
        for (int ai = 0; ai < 2; ++ai)
#pragma unroll
            for (int m = 0; m < 4; ++m) { const int row = row0 + ai * HALF + m * 16; const float s = gv[row]; bf16_t* rowp = O + (size_t)row * D + col0;
#pragma unroll
                for (int bj = 0; bj < 2; ++bj) *(u32x4*)(rowp + bj * HALF) = pack8(acc[ai][bj][m][0] * s, acc[ai][bj][m][1] * s); }
    }
};
}
namespace att {
constexpr int NW = 8, QBLK = 32, KVBLK = 64, DV = 128;
constexpr float THR = 8.f;
#define SBAR() __builtin_amdgcn_sched_barrier(0)
__device__ __forceinline__ int crow(int r, int hi) { return (r & 3) + 8 * (r >> 2) + 4 * hi; }
__device__ __forceinline__ unsigned cvtpk(float lo, float hi) { unsigned r; asm volatile("v_cvt_pk_bf16_f32 %0, %1, %2" : "=v"(r) : "v"(lo), "v"(hi)); return r; }

template <int DQK> struct Cfg {
    static constexpr float SCALE = DQK == 128 ? 0.088388347648318440f : 0.072168783648703220f;
    static constexpr float C = SCALE * 1.4426950408889634f;
    static constexpr int ROWB = DQK * 2;
    static constexpr int SHM_K = KVBLK * DQK * 2, SHM_V = KVBLK * DV * 2;
    static constexpr int SHM_ATTN = 2 * SHM_V + 2 * SHM_K + NW * 64 * 4 + (DQK > 128 ? NW * 4096 : 0);
};
#define KSWZ(row, colB) ((row) * ROWB + ((colB) ^ (((row) & 7) << 4)))

template <int DQK>
__device__ __forceinline__ void partialSM(f32x16& p0, f32x16& p1, float& m_reg, float& mn, float& alpha) {
  constexpr float C = Cfg<DQK>::C, SCALE = Cfg<DQK>::SCALE;
  float pmax = p0[0];
#pragma unroll
  for (int r = 1; r < 16; ++r) pmax = fmaxf(pmax, p0[r]);
#pragma unroll
  for (int r = 0; r < 16; ++r) pmax = fmaxf(pmax, p1[r]);
  { auto rr = __builtin_amdgcn_permlane32_swap(__float_as_uint(pmax), __float_as_uint(pmax), false, false);
    pmax = fmaxf(__uint_as_float(rr[0]), __uint_as_float(rr[1])); }
  if (__builtin_expect(__all(pmax - m_reg <= THR / SCALE), 1)) { mn = m_reg; alpha = 1.f; }
  else { mn = fmaxf(m_reg, pmax); alpha = __builtin_amdgcn_exp2f((m_reg - mn) * C); m_reg = mn; }
  float mnC = -mn * C;
#pragma unroll
  for (int r = 0; r < 16; ++r) p0[r] = fmaf(p0[r], C, mnC);
#pragma unroll
  for (int r = 0; r < 16; ++r) p1[r] = fmaf(p1[r], C, mnC);
#pragma unroll
  for (int r = 0; r < 16; ++r) p0[r] = __builtin_amdgcn_exp2f(p0[r]);
}
__device__ __forceinline__ void finishSM(f32x16& p0, f32x16& p1, float alpha, float& l_reg, bf16x8& pa0, bf16x8& pa1, bf16x8& pa2, bf16x8& pa3) {
#pragma unroll
  for (int r = 0; r < 16; ++r) p1[r] = __builtin_amdgcn_exp2f(p1[r]);
  float ps = 0;
#pragma unroll
  for (int r = 0; r < 16; ++r) ps += p0[r];
#pragma unroll
  for (int r = 0; r < 16; ++r) ps += p1[r];
  { auto rr = __builtin_amdgcn_permlane32_swap(__float_as_uint(ps), __float_as_uint(ps), false, false);
    ps = __uint_as_float(rr[0]) + __uint_as_float(rr[1]); }
  l_reg = l_reg * alpha + ps;
#define PK4(P, BASE, OUT) do { unsigned a0 = cvtpk(P[BASE + 0], P[BASE + 1]), a1 = cvtpk(P[BASE + 2], P[BASE + 3]);   \
    unsigned b0 = cvtpk(P[BASE + 4], P[BASE + 5]), b1 = cvtpk(P[BASE + 6], P[BASE + 7]);                              \
    auto r0 = __builtin_amdgcn_permlane32_swap(a0, b0, false, false); auto r1 = __builtin_amdgcn_permlane32_swap(a1, b1, false, false); \
    u32x4 w = {r0[0], r1[0], r0[1], r1[1]}; OUT = *reinterpret_cast<bf16x8*>(&w); } while (0)
  PK4(p0, 0, pa0); PK4(p0, 8, pa1); PK4(p1, 0, pa2); PK4(p1, 8, pa3);
#undef PK4
}
template <int DQK>
__device__ __forceinline__ void qkt(f32x16& p0, f32x16& p1, const char* Ks, const bf16x8* qr, const char* qx, int r32, int hi) {
  constexpr int ROWB = Cfg<DQK>::ROWB;
  p0 = f32x16{}; p1 = f32x16{};
#pragma unroll
  for (int d0 = 0; d0 < DQK / 16; ++d0) { int cb = (d0 * 16 + hi * 8) * 2;
    bf16x8 b0 = *reinterpret_cast<const bf16x8*>(Ks + KSWZ(r32, cb));
    bf16x8 b1 = *reinterpret_cast<const bf16x8*>(Ks + KSWZ(32 + r32, cb));
    bf16x8 q; if (d0 < 8) q = qr[d0]; else q = *reinterpret_cast<const bf16x8*>(qx + (d0 - 8) * 1024);
    p0 = __builtin_amdgcn_mfma_f32_32x32x16_bf16(b0, q, p0, 0, 0, 0);
    p1 = __builtin_amdgcn_mfma_f32_32x32x16_bf16(b1, q, p1, 0, 0, 0); }
}
__device__ __forceinline__ int v_st(int k, int c) { const int kk = (k & ~0xC) | ((k & 4) << 1) | ((k & 8) >> 1); return ((kk >> 3) * 4 + (c >> 5)) * 512 + ((kk & 7) * 32 + (c & 31)) * 2; }
__device__ __forceinline__ int v_rd_base(int lane) { return ((lane & 3) << 3) | (((lane >> 2) & 3) << 6) | (((lane >> 4) & 1) << 5) | (((lane >> 5) & 1) << 8); }
constexpr int v_rd_off(int d0, int ks, int half) { return d0 * 512 + ks * 4096 + half * 2048; }
template <int OFF> __device__ __forceinline__ s16x4 tr_read(int vb) {
  s16x4 r; asm volatile("ds_read_b64_tr_b16 %0, %1 offset:%2" : "=&v"(r) : "v"(vb), "i"(OFF) : "memory"); return r;
}
template <int D0> __device__ __forceinline__ void pv_one(f32x16& od, int vb, bf16x8 pa0, bf16x8 pa1, bf16x8 pa2, bf16x8 pa3) {
  const s16x4 l0 = tr_read<v_rd_off(D0, 0, 0)>(vb), h0 = tr_read<v_rd_off(D0, 0, 1)>(vb), l1 = tr_read<v_rd_off(D0, 1, 0)>(vb), h1 = tr_read<v_rd_off(D0, 1, 1)>(vb);
  const s16x4 l2 = tr_read<v_rd_off(D0, 2, 0)>(vb), h2 = tr_read<v_rd_off(D0, 2, 1)>(vb), l3 = tr_read<v_rd_off(D0, 3, 0)>(vb), h3 = tr_read<v_rd_off(D0, 3, 1)>(vb);
  asm volatile("s_waitcnt lgkmcnt(0)" ::: "memory"); SBAR();
#define PK(L, H) (bf16x8){L[0], L[1], L[2], L[3], H[0], H[1], H[2], H[3]}
  od = __builtin_amdgcn_mfma_f32_32x32x16_bf16(pa0, PK(l0, h0), od, 0, 0, 0);
  od = __builtin_amdgcn_mfma_f32_32x32x16_bf16(pa1, PK(l1, h1), od, 0, 0, 0);
  od = __builtin_amdgcn_mfma_f32_32x32x16_bf16(pa2, PK(l2, h2), od, 0, 0, 0);
  od = __builtin_amdgcn_mfma_f32_32x32x16_bf16(pa3, PK(l3, h3), od, 0, 0, 0);
#undef PK
}
__device__ __forceinline__ void pv_d0(f32x16* o, int vb, bf16x8 pa0, bf16x8 pa1, bf16x8 pa2, bf16x8 pa3) {
  pv_one<0>(o[0], vb, pa0, pa1, pa2, pa3); pv_one<1>(o[1], vb, pa0, pa1, pa2, pa3); pv_one<2>(o[2], vb, pa0, pa1, pa2, pa3); pv_one<3>(o[3], vb, pa0, pa1, pa2, pa3);
}

template <int DQK, int SDEPTH, int ldq, int ldk, int ldkr, int ldv, int ldo>
__device__ __forceinline__ void attn_body(const bf16_t* __restrict__ Qb, const bf16_t* __restrict__ Kh, const bf16_t* __restrict__ Kr,
                                          const bf16_t* __restrict__ Vh, bf16_t* __restrict__ Ob, int seq, char* lds) {
  constexpr int ROWB = Cfg<DQK>::ROWB, SHM_K = Cfg<DQK>::SHM_K, SHM_V = Cfg<DQK>::SHM_V;
  constexpr bool X = DQK == 192;
  const int tid = opaque_v((int)threadIdx.x), wid = tid >> 6, lane = tid & 63, r32 = lane & 31, hi = lane >> 5;
  char* V_lds = lds; char* K_lds = lds + 2 * SHM_V;
  float* ws = (float*)(lds + 2 * SHM_V + 2 * SHM_K) + wid * 64; float* li_l = ws; float* al_l = ws + 32;
  float m_reg = -1e30f, l_reg = 0; f32x16 o[4] = {}; bf16x8 qr[8];
  const bf16_t* Qw = Qb + (long)(wid * QBLK + r32) * ldq + hi * 8;
  char* qx = lds + 2 * SHM_V + 2 * SHM_K + NW * 64 * 4 + wid * 4096 + lane * 16;
#pragma unroll
  for (int d0 = 0; d0 < 8; ++d0) qr[d0] = *reinterpret_cast<const bf16x8*>(Qw + d0 * 16);
  if constexpr (X) {
#pragma unroll
    for (int d0 = 8; d0 < 12; ++d0) *reinterpret_cast<bf16x8*>(qx + (d0 - 8) * 1024) = *reinterpret_cast<const bf16x8*>(Qw + d0 * 16);
  }
  const int sr = tid >> 4, sc = (tid & 15) * 8, vst0 = v_st(sr, sc), vst1 = v_st(32 + sr, sc);
  const int xr = tid >> 3, xc = (tid & 7) * 8;
  const int vb0 = (int)(uintptr_t)V_lds + v_rd_base(lane);
  struct { bf16x8 vs0, vs1, ks0, ks1, kx; } sr_[SDEPTH];
#define LD8(p) (*reinterpret_cast<const bf16x8*>(p))
#define SLOAD(i, k0) do { sr_[i].vs0 = LD8(&Vh[(long)((k0) + sr) * ldv + sc]); sr_[i].vs1 = LD8(&Vh[(long)((k0) + 32 + sr) * ldv + sc]); \
    sr_[i].ks0 = LD8(&Kh[(long)((k0) + sr) * ldk + sc]); sr_[i].ks1 = LD8(&Kh[(long)((k0) + 32 + sr) * ldk + sc]); \
    if constexpr (X) sr_[i].kx = LD8(&Kr[(long)((k0) + xr) * ldkr + xc]); } while (0)
#define SWRITE(b, i) do { *(bf16x8*)(V_lds + (b) * SHM_V + vst0) = sr_[i].vs0;          \
    *(bf16x8*)(V_lds + (b) * SHM_V + vst1) = sr_[i].vs1; int kc = sc * 2;               \
    *(bf16x8*)(K_lds + (b) * SHM_K + KSWZ(sr, kc)) = sr_[i].ks0;                       \
    *(bf16x8*)(K_lds + (b) * SHM_K + KSWZ(32 + sr, kc)) = sr_[i].ks1;                  \
    if constexpr (X) { int kx_ = 256 + xc * 2; *(bf16x8*)(K_lds + (b) * SHM_K + KSWZ(xr, kx_)) = sr_[i].kx; } } while (0)
#define SWAIT() do { if constexpr (SDEPTH == 2) { if constexpr (X) asm volatile("s_waitcnt vmcnt(5)" ::: "memory"); else asm volatile("s_waitcnt vmcnt(4)" ::: "memory"); } else asm volatile("s_waitcnt vmcnt(0)" ::: "memory"); } while (0)
#define RESC(a) do { if (__any((a) < 1.f)) { if (hi == 0) al_l[r32] = (a); asm volatile("s_waitcnt lgkmcnt(0)" ::: "memory"); \
    _Pragma("unroll") for (int d = 0; d < 4; ++d) _Pragma("unroll") for (int r = 0; r < 16; ++r) o[d][r] *= al_l[crow(r, hi)]; } } while (0)
  f32x16 pA0, pA1, pB0, pB1; float mnA, mnB, alA, alB; bf16x8 pa0, pa1, pa2, pa3; const int NT = seq / KVBLK;
  constexpr int SE = 0, SO = SDEPTH - 1;
  SLOAD(SE, 0); asm volatile("s_waitcnt vmcnt(0)" ::: "memory"); SWRITE(0, SE); __syncthreads();
  qkt<DQK>(pA0, pA1, K_lds, qr, qx, r32, hi); partialSM<DQK>(pA0, pA1, m_reg, mnA, alA);
  SLOAD(SO, KVBLK); if constexpr (SDEPTH == 2) { if (2 < NT) SLOAD(SE, 2 * KVBLK); }
  SWAIT(); SWRITE(1, SO); __syncthreads();
  for (int j = 1; j + 1 < NT; j += 2) {
    SBAR(); qkt<DQK>(pB0, pB1, K_lds + SHM_K, qr, qx, r32, hi);
    finishSM(pA0, pA1, alA, l_reg, pa0, pa1, pa2, pa3); SBAR();
    SLOAD(SO, (j + SDEPTH) * KVBLK); SBAR();
    pv_d0(o, vb0, pa0, pa1, pa2, pa3); partialSM<DQK>(pB0, pB1, m_reg, mnB, alB);
    __syncthreads(); SWAIT(); SWRITE(0, SE);
    RESC(alB); __syncthreads();
    SBAR(); qkt<DQK>(pA0, pA1, K_lds, qr, qx, r32, hi);
    finishSM(pB0, pB1, alB, l_reg, pa0, pa1, pa2, pa3); SBAR();
    if (SDEPTH == 1 || j + 3 < NT) SLOAD(SE, (j + 1 + SDEPTH) * KVBLK); SBAR();
    pv_d0(o, vb0 + (int)SHM_V, pa0, pa1, pa2, pa3); partialSM<DQK>(pA0, pA1, m_reg, mnA, alA);
    __syncthreads(); SWAIT(); SWRITE(1, SO);
    RESC(alA); __syncthreads();
  }
  SBAR(); qkt<DQK>(pB0, pB1, K_lds + SHM_K, qr, qx, r32, hi);
  finishSM(pA0, pA1, alA, l_reg, pa0, pa1, pa2, pa3); SBAR();
  pv_d0(o, vb0, pa0, pa1, pa2, pa3); partialSM<DQK>(pB0, pB1, m_reg, mnB, alB);
  __syncthreads(); RESC(alB);
  finishSM(pB0, pB1, alB, l_reg, pa0, pa1, pa2, pa3); SBAR();
  pv_d0(o, vb0 + (int)SHM_V, pa0, pa1, pa2, pa3);
  if (hi == 0) li_l[r32] = l_reg; asm volatile("s_waitcnt lgkmcnt(0)" ::: "memory");
  float rli[16];
#pragma unroll
  for (int r = 0; r < 16; ++r) rli[r] = __builtin_amdgcn_rcpf(li_l[crow(r, hi)]);
  bf16_t* Ow = Ob + (long)(wid * QBLK) * ldo;
#pragma unroll
  for (int r = 0; r < 16; ++r) { int orow = crow(r, hi);
#pragma unroll
    for (int d0 = 0; d0 < 4; ++d0) { const unsigned w = cvtpk(o[d0][r] * rli[r], 0.f); Ow[(long)orow * ldo + d0 * 32 + r32] = (bf16_t)(w & 0xffffu); } }
#undef LD8
#undef SLOAD
#undef SWRITE
#undef SWAIT
#undef RESC
}
#undef KSWZ
}
struct Frame {
    LAS unsigned char* lds;
    int tid, lane, wave, vcu, G, gw, ngw;
    float* out;
    unsigned char* ws;
};
enum { I_X = 0, I_C, I_CTX, I_CCTX, I_ADAW, I_ADAB, I_LMG, I_LMB, I_LFG, I_LFB, I_RW, I_WG, I_WU, I_WDN, I_GQKV, I_GQG, I_GKG, I_GWO, I_MDQ, I_MQG, I_MUQ, I_MDKV, I_MKVG, I_MUKV, I_MWO };

__device__ __forceinline__ u32x2 pack4(const f32x4 v) { u32x2 w; w.x = cvt_pk_bf16(v[0], v[1]); w.y = cvt_pk_bf16(v[2], v[3]); return w; }
__device__ __forceinline__ f32x4 unpack4(const u32x2 w) { return (f32x4){__uint_as_float(w.x << 16), __uint_as_float(w.x & 0xffff0000u), __uint_as_float(w.y << 16), __uint_as_float(w.y & 0xffff0000u)}; }
__device__ __forceinline__ float silu_f(float x) { return x / (1.0f + __expf(-x)); }

__device__ __forceinline__ void transpose_item(const float* W, int N, const float* g, bf16_t* dst, int ldd, int row_off, int il, LAS float* scr, int item, int lane) {
    const int nblk = N / 32, kb = item / nblk, nb = item % nblk, k0 = 64 * kb, n0 = 32 * nb;
#pragma unroll 8
    for (int i = 0; i < 32; ++i) { const int kk = 2 * i + (lane >> 5); float v = W[(size_t)(k0 + kk) * N + n0 + (lane & 31)]; if (g) v *= g[k0 + kk]; scr[kk * 33 + (lane & 31)] = v; }
    LDS_WAIT(); asm volatile("" ::: "memory");
    const int c = lane & 7;
#pragma unroll
    for (int j = 0; j < 4; ++j) { const int n = (lane >> 3) + 8 * j; const LAS float* s = scr + (8 * c) * 33 + n;
        u32x4 o; o.x = cvt_pk_bf16(s[0 * 33], s[1 * 33]); o.y = cvt_pk_bf16(s[2 * 33], s[3 * 33]); o.z = cvt_pk_bf16(s[4 * 33], s[5 * 33]); o.w = cvt_pk_bf16(s[6 * 33], s[7 * 33]);
        const int nn = n0 + n, dr = row_off + (il ? ((nn >> 7) << 8) + (nn & 127) : nn);
        *(u32x4*)(dst + (size_t)dr * ldd + k0 + 8 * c) = o; }
    LDS_WAIT(); asm volatile("" ::: "memory");
}

__device__ __forceinline__ void phase_p0a(Frame& F) {
    LAS float* scr = (LAS float*)(F.lds + F.wave * 9216);
    constexpr int I_QKV = 16 * 48, I_WO = 16 * 32, I_DQ = 16 * 24, I_DKV = 16 * 10, I_UQ = 12 * 48, I_UKV = 4 * 64;
    constexpr int PERJ = I_QKV + I_WO + I_DQ + I_DKV + I_UQ + I_UKV + I_WO;
    for (int it = F.gw; it < 2 * PERJ; it += F.ngw) {
        const int j = it / PERJ; int r = it - j * PERJ;
        if (r < I_QKV) { transpose_item(in_ptr(I_GQKV) + (size_t)j * 1024 * 1536, 1536, nullptr, (bf16_t*)(F.ws + WS_WQKV) + (size_t)j * 1536 * 1024, 1024, 0, 0, scr, r, F.lane); continue; } r -= I_QKV;
        if (r < I_WO) { transpose_item(in_ptr(I_GWO) + (size_t)j * 1024 * 1024, 1024, nullptr, (bf16_t*)(F.ws + WS_WOG) + (size_t)j * 1024 * 1024, 1024, 0, 0, scr, r, F.lane); continue; } r -= I_WO;
        if (r < I_DQ) { transpose_item(in_ptr(I_MDQ) + (size_t)j * 1024 * 768, 768, nullptr, (bf16_t*)(F.ws + WS_WD) + (size_t)j * 1280 * 1024, 1024, 0, 0, scr, r, F.lane); continue; } r -= I_DQ;
        if (r < I_DKV) { transpose_item(in_ptr(I_MDKV) + (size_t)j * 1024 * 320, 320, nullptr, (bf16_t*)(F.ws + WS_WD) + (size_t)j * 1280 * 1024, 1024, 768, 0, scr, r, F.lane); continue; } r -= I_DKV;
        if (r < I_UQ) { transpose_item(in_ptr(I_MUQ) + (size_t)j * 768 * 1536, 1536, in_ptr(I_MQG) + j * 768, (bf16_t*)(F.ws + WS_WUQ) + (size_t)j * 1536 * 768, 768, 0, 0, scr, r, F.lane); continue; } r -= I_UQ;
        if (r < I_UKV) { transpose_item(in_ptr(I_MUKV) + (size_t)j * 256 * 2048, 2048, in_ptr(I_MKVG) + j * 256, (bf16_t*)(F.ws + WS_WUKV) + (size_t)j * 2048 * 256, 256, 0, 0, scr, r, F.lane); continue; } r -= I_UKV;
        transpose_item(in_ptr(I_MWO) + (size_t)j * 1024 * 1024, 1024, nullptr, (bf16_t*)(F.ws + WS_WOM) + (size_t)j * 1024 * 1024, 1024, 0, 0, scr, r, F.lane);
    }
    for (int i = blockIdx.x * NTHR + F.tid; i < 2 * 24576; i += F.G * NTHR) { const int j = i / 24576, q = i - j * 24576;
        *((u32x4*)((bf16_t*)(F.ws + WS_WD) + (size_t)j * 1280 * 1024 + (size_t)1088 * 1024) + q) = (u32x4){0u, 0u, 0u, 0u}; }
    { float* rt = (float*)(F.ws + WS_ROPE); const int i = blockIdx.x * NTHR + F.tid;
        if (i < 2048) { const int pos = i >> 5, m = i & 31; const float fr = powf(10000.0f, -(float)(2 * m) / 64.0f), a = (float)pos * fr; rt[i] = cosf(a); rt[2048 + i] = sinf(a); }
        else if (i < 3072) { const int q = i - 2048, pos = q >> 4, m = q & 15; const float fr = powf(10000.0f, -(float)(2 * m) / 32.0f), a = (float)pos * fr; rt[4096 + q] = cosf(a); rt[5120 + q] = sinf(a); } }
    { float* modp = (float*)(F.ws + WS_R + R_MODP); LAS float* s = (LAS float*)(F.lds + F.wave * 9216);
        for (int it = F.gw; it < NL * 96 * MOD_KC; it += F.ngw) {
            const int kc = it % MOD_KC, cg = (it / MOD_KC) % 96, li = it / (MOD_KC * 96);
            for (int q = F.lane; q < 33 * 64; q += 64) { const int b = q >> 6, kk = q & 63; const float cv = b < 32 ? in_ptr(I_C)[b * D + kc * 64 + kk] : in_ptr(I_CCTX)[kc * 64 + kk]; s[kk * 36 + b] = silu_f(cv); }
            LDS_WAIT(); asm volatile("" ::: "memory");
            float acc[33];
#pragma unroll
            for (int b = 0; b < 33; ++b) acc[b] = 0.f;
            const float* wp = in_ptr(I_ADAW) + ((size_t)li * D + kc * 64) * MODSZ + cg * 64 + F.lane;
#pragma unroll 4
            for (int kk = 0; kk < 64; ++kk) { const float w = wp[(size_t)kk * MODSZ];
#pragma unroll
                for (int b4 = 0; b4 < 8; ++b4) { const f32x4 sv = *(const LAS f32x4*)(s + kk * 36 + b4 * 4); acc[b4 * 4 + 0] += sv[0] * w; acc[b4 * 4 + 1] += sv[1] * w; acc[b4 * 4 + 2] += sv[2] * w; acc[b4 * 4 + 3] += sv[3] * w; }
                acc[32] += s[kk * 36 + 32] * w; }
            float* op = modp + ((size_t)(kc * NL + li) * 33) * MODSZ + cg * 64 + F.lane;
#pragma unroll
            for (int b = 0; b < 33; ++b) op[(size_t)b * MODSZ] = acc[b];
            LDS_WAIT(); asm volatile("" ::: "memory");
        } }
}
__device__ __forceinline__ void phase_p0b(Frame& F) {
    const float* modp = (const float*)(F.ws + WS_R + R_MODP); float* mod = (float*)(F.ws + WS_MOD);
    for (int i = blockIdx.x * NTHR + F.tid; i < NL * 33 * MODSZ; i += F.G * NTHR) { const int n = i % MODSZ, li = i / (33 * MODSZ); float a = in_ptr(I_ADAB)[li * MODSZ + n];
#pragma unroll
        for (int kc = 0; kc < MOD_KC; ++kc) a += modp[(size_t)kc * NL * 33 * MODSZ + i];
        mod[i] = a; }
}
__device__ __forceinline__ const float* xrow_in(const float* xl, const float* xc, int b, int p) { return p < CTXL ? xc + ((size_t)b * CTXL + p) * D : xl + ((size_t)b * SEQ + (p - CTXL)) * D; }

__device__ __forceinline__ void phase_p0c(Frame& F) {
    const float* mod = (const float*)(F.ws + WS_MOD); bf16_t* H = (bf16_t*)(F.ws + WS_H);
    for (int r = F.gw; r < T; r += F.ngw) { const int b = r / TPS, p = r - b * TPS; const float* mv = mod + (size_t)(p < CTXL ? 32 : b) * MODSZ;
        const f32x4* xr = (const f32x4*)xrow_in(in_ptr(I_X), in_ptr(I_CTX), b, p) + F.lane; u32x2* hr = (u32x2*)(H + (size_t)r * D) + F.lane;
#pragma unroll
        for (int j = 0; j < 4; ++j) { const f32x4 x = xr[64 * j], sh = *((const f32x4*)mv + F.lane + 64 * j), sc = *((const f32x4*)(mv + D) + F.lane + 64 * j); hr[64 * j] = pack4(x * (1.0f + sc) + sh); } }
}

__device__ __forceinline__ void phase_qknorm(Frame& F, int j) {
    bf16_t* QKV = (bf16_t*)(F.ws + WS_R + R_QKV); const float* rt = (const float*)(F.ws + WS_ROPE);
    const float* qg = in_ptr(I_GQG) + j * 128; const float* kg = in_ptr(I_GKG) + j * 128;
    const int l16 = F.lane & 15, hq = F.lane >> 4;
    const f32x4 gq0 = *(const f32x4*)(qg + l16 * 8), gq1 = *(const f32x4*)(qg + l16 * 8 + 4), gk0 = *(const f32x4*)(kg + l16 * 8), gk1 = *(const f32x4*)(kg + l16 * 8 + 4);
    for (int r = F.gw; r < T; r += F.ngw) { const int b = r / TPS, p = r - b * TPS; const bool latent = p >= CTXL; const int t = p - CTXL, trow = (t >> 6) & 31, tcol = t & 63;
        const int j0 = l16 * 4, pos = j0 < 32 ? trow : tcol, ti = pos * 32 + (j0 & 31);
        f32x4 cs = {1.f, 1.f, 1.f, 1.f}, sn = {0.f, 0.f, 0.f, 0.f};
        if (latent) { cs = *(const f32x4*)(rt + ti); sn = *(const f32x4*)(rt + 2048 + ti); }
#pragma unroll
        for (int ps = 0; ps < 3; ++ps) { const int hd = ps * 4 + hq; if (hd < 10) { u32x4* ptr = (u32x4*)(QKV + (size_t)r * 1536 + hd * 128 + l16 * 8); const u32x4 w = *ptr;
                f32x4 a = {__uint_as_float(w.x << 16), __uint_as_float(w.x & 0xffff0000u), __uint_as_float(w.y << 16), __uint_as_float(w.y & 0xffff0000u)};
                f32x4 c = {__uint_as_float(w.z << 16), __uint_as_float(w.z & 0xffff0000u), __uint_as_float(w.w << 16), __uint_as_float(w.w & 0xffff0000u)};
                float ss = (a[0] * a[0] + a[1] * a[1]) + (a[2] * a[2] + a[3] * a[3]) + (c[0] * c[0] + c[1] * c[1]) + (c[2] * c[2] + c[3] * c[3]);
                ss += __shfl_xor(ss, 1); ss += __shfl_xor(ss, 2); ss += __shfl_xor(ss, 4); ss += __shfl_xor(ss, 8);
                const float rstd = 1.0f / sqrtf(ss * (1.0f / 128.0f) + LN_EPS);
                a = a * rstd * (hd < 8 ? gq0 : gk0); c = c * rstd * (hd < 8 ? gq1 : gk1);
                const f32x4 a2 = {a[0] * cs[0] - a[1] * sn[0], a[0] * sn[0] + a[1] * cs[0], a[2] * cs[1] - a[3] * sn[1], a[2] * sn[1] + a[3] * cs[1]};
                const f32x4 c2 = {c[0] * cs[2] - c[1] * sn[2], c[0] * sn[2] + c[1] * cs[2], c[2] * cs[3] - c[3] * sn[3], c[2] * sn[3] + c[3] * cs[3]};
                u32x4 o; o.x = cvt_pk_bf16(a2[0], a2[1]); o.y = cvt_pk_bf16(a2[2], a2[3]); o.z = cvt_pk_bf16(c2[0], c2[1]); o.w = cvt_pk_bf16(c2[2], c2[3]); *ptr = o; } } }
}
__device__ __forceinline__ void phase_mla_stats(Frame& F) {
    bf16_t* CQ = (bf16_t*)(F.ws + WS_R + R_CQ); bf16_t* KR = (bf16_t*)(F.ws + WS_KR); const float* rt = (const float*)(F.ws + WS_ROPE) + 4096;
    for (int r = F.gw; r < T; r += F.ngw) { const int b = r / TPS, p = r - b * TPS; const bool latent = p >= CTXL; const int t = p - CTXL, trow = (t >> 6) & 31, tcol = t & 63;
        bf16_t* row = CQ + (size_t)r * 1280; const u32x4 w0 = *(const u32x4*)(row + F.lane * 8), w1 = *(const u32x4*)(row + 512 + F.lane * 8);
        float s0 = 0.f, s1 = 0.f;
#pragma unroll
        for (int q = 0; q < 4; ++q) { const float a = __uint_as_float(w0[q] << 16), c = __uint_as_float(w0[q] & 0xffff0000u); s0 += a * a + c * c; const float a1 = __uint_as_float(w1[q] << 16), c1 = __uint_as_float(w1[q] & 0xffff0000u); s1 += a1 * a1 + c1 * c1; }
        const float sq = wave_sum(s0 + (F.lane < 32 ? s1 : 0.f)), skv = wave_sum(F.lane >= 32 ? s1 : 0.f);
        const float rq = 1.0f / sqrtf(sq * (1.0f / 768.0f) + LN_EPS), rkv = 1.0f / sqrtf(skv * (1.0f / 256.0f) + LN_EPS), r1 = F.lane < 32 ? rq : rkv;
        u32x4 o0, o1;
#pragma unroll
        for (int q = 0; q < 4; ++q) { o0[q] = cvt_pk_bf16(__uint_as_float(w0[q] << 16) * rq, __uint_as_float(w0[q] & 0xffff0000u) * rq); o1[q] = cvt_pk_bf16(__uint_as_float(w1[q] << 16) * r1, __uint_as_float(w1[q] & 0xffff0000u) * r1); }
        *(u32x4*)(row + F.lane * 8) = o0; *(u32x4*)(row + 512 + F.lane * 8) = o1;
        if (F.lane < 8) { const u32x4 w = *(const u32x4*)(row + 1024 + F.lane * 8); u32x4 o = w;
            if (latent) { const int j0 = F.lane * 4, pos = j0 < 16 ? trow : tcol, ti = pos * 16 + (j0 & 15); const f32x4 cs = *(const f32x4*)(rt + ti), sn = *(const f32x4*)(rt + 1024 + ti);
#pragma unroll
                for (int q = 0; q < 4; ++q) { const float x0 = __uint_as_float(w[q] << 16), x1 = __uint_as_float(w[q] & 0xffff0000u); o[q] = cvt_pk_bf16(x0 * cs[q] - x1 * sn[q], x0 * sn[q] + x1 * cs[q]); } }
            *(u32x4*)(KR + (size_t)r * 64 + F.lane * 8) = o; } }
}

__device__ __forceinline__ void phase_ln1(Frame& F, int li, const float* xin_l, const float* xin_c, const bf16_t* O) {
    LAS float* Wt = (LAS float*)F.lds;
    { const float* rw = in_ptr(I_RW) + (size_t)li * D * NE; for (int i = F.tid; i < D * NE; i += NTHR) Wt[(i & 15) * D + (i >> 4)] = rw[i]; }
    __syncthreads();
    const float* mod = (const float*)(F.ws + WS_MOD) + (size_t)li * 33 * MODSZ; bf16_t* H = (bf16_t*)(F.ws + WS_H); float* AFF = (float*)(F.ws + WS_AFF); int* INV = (int*)(F.ws + WS_INV);
    float* Xl = F.out; float* Xc = (float*)(F.ws + WS_XC);
    f32x4 lg[4], lb[4], g1[4], sh2[4], sc2[4];
#pragma unroll
    for (int j = 0; j < 4; ++j) { lg[j] = *((const f32x4*)(in_ptr(I_LMG) + li * D) + F.lane + 64 * j); lb[j] = *((const f32x4*)(in_ptr(I_LMB) + li * D) + F.lane + 64 * j); }
    for (int wv = F.gw; wv < 2048; wv += F.ngw) {
    const int b = wv >> 6; int cur = -1;
    for (int k = 0; k < 36; ++k) { const int p = (wv & 63) * 36 + k, r = b * TPS + p; const int isc = p < CTXL ? 1 : 0;
        if (isc != cur) { cur = isc; const float* mv = mod + (size_t)(isc ? 32 : b) * MODSZ;
#pragma unroll
            for (int j = 0; j < 4; ++j) { g1[j] = *((const f32x4*)(mv + 2 * D) + F.lane + 64 * j); sh2[j] = *((const f32x4*)(mv + 3 * D) + F.lane + 64 * j); sc2[j] = *((const f32x4*)(mv + 4 * D) + F.lane + 64 * j); } }
        const f32x4* xr = (const f32x4*)xrow_in(xin_l, xin_c, b, p) + F.lane; const u32x2* orow = (const u32x2*)(O + (size_t)r * D) + F.lane;
        f32x4 v[4]; float s = 0.f;
#pragma unroll
        for (int j = 0; j < 4; ++j) { v[j] = xr[64 * j] * ALPHA + g1[j] * unpack4(orow[64 * j]); s += (v[j][0] + v[j][1]) + (v[j][2] + v[j][3]); }
        const float mean = wave_sum(s) * (1.0f / D); float s2 = 0.f;
#pragma unroll
        for (int j = 0; j < 4; ++j) { v[j] = v[j] - mean; s2 += (v[j][0] * v[j][0] + v[j][1] * v[j][1]) + (v[j][2] * v[j][2] + v[j][3] * v[j][3]); }
        const float rstd = 1.0f / sqrtf(wave_sum(s2) * (1.0f / D) + LN_EPS);
        f32x4* xw = (f32x4*)(isc ? Xc + ((size_t)b * CTXL + p) * D : Xl + ((size_t)b * SEQ + (p - CTXL)) * D) + F.lane; u32x2* hr = (u32x2*)(H + (size_t)r * D) + F.lane;
#pragma unroll
        for (int j = 0; j < 4; ++j) { v[j] = v[j] * rstd * lg[j] + lb[j]; xw[64 * j] = v[j]; v[j] = v[j] * (1.0f + sc2[j]) + sh2[j]; hr[64 * j] = pack4(v[j]); }
        float acc[16];
#pragma unroll
        for (int e = 0; e < 16; ++e) { float a = 0.f;
#pragma unroll
            for (int j = 0; j < 4; ++j) { const f32x4 w = *(const LAS f32x4*)(Wt + e * D + 4 * F.lane + 256 * j); a += (v[j][0] * w[0] + v[j][1] * w[1]) + (v[j][2] * w[2] + v[j][3] * w[3]); }
            acc[e] = a; }
#pragma unroll
        for (int e = 0; e < 8; ++e) { const bool up = (F.lane & 32) != 0; const float send = up ? acc[e] : acc[e + 8], keep = up ? acc[e + 8] : acc[e]; acc[e] = keep + __shfl_xor(send, 32); }
#pragma unroll
        for (int e = 0; e < 4; ++e) { const bool up = (F.lane & 16) != 0; const float send = up ? acc[e] : acc[e + 4], keep = up ? acc[e + 4] : acc[e]; acc[e] = keep + __shfl_xor(send, 16); }
#pragma unroll
        for (int e = 0; e < 2; ++e) { const bool up = (F.lane & 8) != 0; const float send = up ? acc[e] : acc[e + 2], keep = up ? acc[e + 2] : acc[e]; acc[e] = keep + __shfl_xor(send, 8); }
        { const bool up = (F.lane & 4) != 0; const float send = up ? acc[0] : acc[1], keep = up ? acc[1] : acc[0]; acc[0] = keep + __shfl_xor(send, 4); }
        float lg_e = acc[0]; lg_e += __shfl_xor(lg_e, 1); lg_e += __shfl_xor(lg_e, 2);
        float mx = lg_e; mx = fmaxf(mx, __shfl_xor(mx, 4)); mx = fmaxf(mx, __shfl_xor(mx, 8)); mx = fmaxf(mx, __shfl_xor(mx, 16)); mx = fmaxf(mx, __shfl_xor(mx, 32));
        const float ex = __expf(lg_e - mx); float se = ex; se += __shfl_xor(se, 4); se += __shfl_xor(se, 8); se += __shfl_xor(se, 16); se += __shfl_xor(se, 32);
        if ((F.lane & 3) == 0) { AFF[(size_t)r * NE + (F.lane >> 2)] = ex / se; INV[(size_t)r * NE + (F.lane >> 2)] = -1; }
    }
    }
}

__device__ __forceinline__ void topk_item(Frame& F, LAS unsigned* keys, LAS unsigned* hist, int e, int row0  , int n, int cap, int slot0) {
    const float* AFF = (const float*)(F.ws + WS_AFF); int* INV = (int*)(F.ws + WS_INV); float* GVAL = (float*)(F.ws + WS_GVAL); int* STOK = (int*)(F.ws + WS_STOK);
    const int nk = n >> 6;
#pragma unroll 4
    for (int k = 0; k < nk; ++k) keys[F.lane + 64 * k] = __float_as_uint(AFF[(size_t)(row0 + F.lane + 64 * k) * NE + e]);
    LDS_WAIT(); asm volatile("" ::: "memory");
    unsigned prefix = 0u, mask = 0u; int krem = cap;
#pragma unroll 1
    for (int pass = 0; pass < 4; ++pass) { const int shift = 24 - 8 * pass;
        *(LAS u32x4*)(hist + 4 * F.lane) = (u32x4){0u, 0u, 0u, 0u};
        LDS_WAIT(); asm volatile("" ::: "memory");
#pragma unroll 4
        for (int k = 0; k < nk; ++k) { const unsigned key = keys[F.lane + 64 * k]; if ((key & mask) == prefix) __hip_atomic_fetch_add(hist + ((key >> shift) & 255u), 1u, __ATOMIC_RELAXED, __HIP_MEMORY_SCOPE_WORKGROUP); }
        LDS_WAIT(); asm volatile("" ::: "memory");
        const u32x4 c = *(const LAS u32x4*)(hist + 4 * F.lane);
        const int s = (int)(c[0] + c[1] + c[2] + c[3]);
        int suf = s;
#pragma unroll
        for (int o = 1; o < 64; o <<= 1) { const int t = __shfl_down(suf, o); if (F.lane + o < 64) suf += t; }
        int cum = suf - s;
        int fbin = -1, fk = 0;
#pragma unroll
        for (int q = 3; q >= 0; --q) { const int cq = (int)c[q]; if (fbin < 0 && cum < krem && cum + cq >= krem) { fbin = 4 * F.lane + q; fk = krem - cum; } cum += cq; }
        const unsigned long long bal = __ballot(fbin >= 0); const int src = bal ? __ffsll((long long)bal) - 1 : 0;
        const int bin = __shfl(fbin, src), nkk = __shfl(fk, src);
        prefix |= (unsigned)bin << shift; mask |= 0xffu << shift; krem = nkk;
        asm volatile("" ::: "memory");
    }
    int nsel = 0, neq = 0;
    const unsigned long long lt = (1ull << F.lane) - 1ull;
#pragma unroll 2
    for (int k = 0; k < nk; ++k) { const unsigned key = keys[F.lane + 64 * k]; const bool gt = key > prefix, eq = key == prefix;
        const unsigned long long be = __ballot(eq); const int eqb = neq + __popcll(be & lt); const bool sel = gt || (eq && eqb < krem);
        const unsigned long long bs = __ballot(sel); const int pos = nsel + __popcll(bs & lt);
        if (sel && pos < cap) { const int row = row0 + F.lane + 64 * k, slot = slot0 + pos; STOK[slot] = row; GVAL[slot] = __uint_as_float(key); INV[(size_t)row * NE + e] = slot; }
        nsel += __popcll(bs); neq += __popcll(be); }
    LDS_WAIT(); asm volatile("" ::: "memory");
}
__device__ __forceinline__ void phase_topk_conv(Frame& F, int li) {
    LAS unsigned* hist = (LAS unsigned*)(F.lds + 8 * 9216 + F.wave * 1024);
    for (int it = F.gw; it < 1024; it += F.ngw) { const int set = it >> 9, b = (it >> 4) & 31, e = it & 15; LAS unsigned* keys = (LAS unsigned*)(F.lds + F.wave * 9216);
        if (set == 0) topk_item(F, keys, hist, e, b * TPS + CTXL, SEQ, CAPL, (b * NE + e) * CAPL);
        else topk_item(F, keys, hist, e, b * TPS, CTXL, CAPC, NSLOT_L + (e * 4 + (b >> 3)) * 256 + (b & 7) * CAPC); }
    LAS float* scr = (LAS float*)(F.lds + F.wave * 9216);
    for (int it = F.gw; it < 3 * NE * 512; it += F.ngw) { const int which = it / (NE * 512), rem = it - which * (NE * 512), e = rem >> 9, item = rem & 511;
        const size_t eoff = ((size_t)li * NE + e) * D * FF;
        if (which == 0) transpose_item(in_ptr(I_WG) + eoff, FF, nullptr, (bf16_t*)(F.ws + WS_WGU) + (size_t)e * 2048 * D, D, 0, 1, scr, item, F.lane);
        else if (which == 1) transpose_item(in_ptr(I_WU) + eoff, FF, nullptr, (bf16_t*)(F.ws + WS_WGU) + (size_t)e * 2048 * D, D, 128, 1, scr, item, F.lane);
        else transpose_item(in_ptr(I_WDN) + eoff, D, nullptr, (bf16_t*)(F.ws + WS_WDN) + (size_t)e * D * FF, FF, 0, 0, scr, item, F.lane); }
}
__device__ __forceinline__ void phase_gather(Frame& F) {
    const bf16_t* H = (const bf16_t*)(F.ws + WS_H); bf16_t* XS = (bf16_t*)(F.ws + WS_R + R_XS); const int* STOK = (const int*)(F.ws + WS_STOK);
    for (int s0 = F.gw * 4; s0 < NSLOT; s0 += F.ngw * 4) { u32x4 v[4][2];
#pragma unroll
        for (int q = 0; q < 4; ++q) { int row = STOK[s0 + q]; row = row < 0 ? 0 : (row >= T ? T - 1 : row); const u32x4* src = (const u32x4*)(H + (size_t)row * D) + F.lane; v[q][0] = src[0]; v[q][1] = src[64]; }
#pragma unroll
        for (int q = 0; q < 4; ++q) { u32x4* dst = (u32x4*)(XS + (size_t)(s0 + q) * D) + F.lane; dst[0] = v[q][0]; dst[64] = v[q][1]; } }
}
__device__ __forceinline__ void phase_ln2(Frame& F, int li) {
    const float* mod = (const float*)(F.ws + WS_MOD) + (size_t)li * 33 * MODSZ; const float* modn = mod + (size_t)33 * MODSZ; const bool has_next = li + 1 < NL;
    bf16_t* H = (bf16_t*)(F.ws + WS_H); const int* INV = (const int*)(F.ws + WS_INV); const bf16_t* Y = (const bf16_t*)(F.ws + WS_R + R_XS);
    float* Xl = F.out; float* Xc = (float*)(F.ws + WS_XC);
    f32x4 lg[4], lb[4], g2[4], sh1[4], sc1[4];
#pragma unroll
    for (int j = 0; j < 4; ++j) { lg[j] = *((const f32x4*)(in_ptr(I_LFG) + li * D) + F.lane + 64 * j); lb[j] = *((const f32x4*)(in_ptr(I_LFB) + li * D) + F.lane + 64 * j); sh1[j] = (f32x4){0.f, 0.f, 0.f, 0.f}; sc1[j] = sh1[j]; }
    for (int wv = F.gw; wv < 2048; wv += F.ngw) {
    const int b = wv >> 6; int cur = -1;
    for (int k = 0; k < 36; ++k) { const int p = (wv & 63) * 36 + k, r = b * TPS + p; const int isc = p < CTXL ? 1 : 0;
        if (isc != cur) { cur = isc; const float* mv = mod + (size_t)(isc ? 32 : b) * MODSZ; const float* mn = modn + (size_t)(isc ? 32 : b) * MODSZ;
#pragma unroll
            for (int j = 0; j < 4; ++j) { g2[j] = *((const f32x4*)(mv + 5 * D) + F.lane + 64 * j); if (has_next) { sh1[j] = *((const f32x4*)mn + F.lane + 64 * j); sc1[j] = *((const f32x4*)(mn + D) + F.lane + 64 * j); } } }
        f32x4* xw = (f32x4*)(isc ? Xc + ((size_t)b * CTXL + p) * D : Xl + ((size_t)b * SEQ + (p - CTXL)) * D) + F.lane;
        const int myinv = INV[(size_t)r * NE + (F.lane & 15)];
        f32x4 f[4];
#pragma unroll
        for (int j = 0; j < 4; ++j) f[j] = (f32x4){0.f, 0.f, 0.f, 0.f};
#pragma unroll
        for (int e = 0; e < NE; ++e) { const int slot = __builtin_amdgcn_readlane(myinv, e);
            if (slot >= 0) { const u32x2* yr = (const u32x2*)(Y + (size_t)slot * D) + F.lane;
#pragma unroll
                for (int j = 0; j < 4; ++j) f[j] += unpack4(yr[64 * j]); } }
        f32x4 v[4]; float s = 0.f;
#pragma unroll
        for (int j = 0; j < 4; ++j) { v[j] = xw[64 * j] * ALPHA + g2[j] * f[j]; s += (v[j][0] + v[j][1]) + (v[j][2] + v[j][3]); }
        const float mean = wave_sum(s) * (1.0f / D); float s2 = 0.f;
#pragma unroll
        for (int j = 0; j < 4; ++j) { v[j] = v[j] - mean; s2 += (v[j][0] * v[j][0] + v[j][1] * v[j][1]) + (v[j][2] * v[j][2] + v[j][3] * v[j][3]); }
        const float rstd = 1.0f / sqrtf(wave_sum(s2) * (1.0f / D) + LN_EPS);
        u32x2* hr = (u32x2*)(H + (size_t)r * D) + F.lane;
#pragma unroll
        for (int j = 0; j < 4; ++j) { v[j] = v[j] * rstd * lg[j] + lb[j]; xw[64 * j] = v[j]; if (has_next) hr[64 * j] = pack4(v[j] * (1.0f + sc1[j]) + sh1[j]); }
    }
    }
}
template <int DQK, int SD>
__device__ __forceinline__ void phase_attn(Frame& F) {
    char* lds = (char*)F.lds;
    for (int u = F.vcu; u < 2048 + 256; u += F.G) {
        int b, h, prow, seq;
        if (u < 2048) { b = u >> 6; h = (u >> 3) & 7; prow = CTXL + (u & 7) * 256; seq = TPS; } else { const int q = u - 2048; b = q >> 3; h = q & 7; prow = 0; seq = CTXL; }
        const size_t row0 = (size_t)b * TPS;
        if constexpr (DQK == 128) {
            const bf16_t* QKV = (const bf16_t*)(F.ws + WS_R + R_QKV); bf16_t* AO = (bf16_t*)(F.ws + WS_R + R_AOG);
            const bf16_t* K = QKV + row0 * 1536 + 1024 + (h >> 2) * 128;
            att::attn_body<128, SD, 1536, 1536, 64, 1536, D>(QKV + (row0 + prow) * 1536 + h * 128, K, nullptr, K + 256, AO + (row0 + prow) * D + h * 128, seq, lds);
        } else {
            const bf16_t* Q = (const bf16_t*)(F.ws + WS_R + R_Q); const bf16_t* KV = (const bf16_t*)(F.ws + WS_R + R_KV); const bf16_t* KR = (const bf16_t*)(F.ws + WS_KR); bf16_t* AO = (bf16_t*)(F.ws + WS_R + R_AOM);
            const bf16_t* K = KV + row0 * 2048 + h * 256;
            att::attn_body<192, SD, 1536, 2048, 64, 2048, D>(Q + (row0 + prow) * 1536 + h * 192, K, KR + row0 * 64, K + 128, AO + (row0 + prow) * D + h * 128, seq, lds);
        }
        __syncthreads();
    }
}

#ifndef EN_ALL
#define EN_ALL 1
#endif
#ifndef EN_ATTN_MLA
#define EN_ATTN_MLA 1
#endif
#ifndef EN_ATTN_GQA
#define EN_ATTN_GQA 1
#endif
#ifndef ATT_SD_GQA
#define ATT_SD_GQA 2
#endif
#ifndef EN_UQ
#define EN_UQ 1
#endif
#ifndef EN_UKV
#define EN_UKV 1
#endif
#ifndef EN_P0A
#define EN_P0A EN_ALL
#endif
#ifndef EN_P0B
#define EN_P0B EN_ALL
#endif
#ifndef EN_P0C
#define EN_P0C EN_ALL
#endif
#ifndef EN_PROJ
#define EN_PROJ EN_ALL
#endif
#ifndef EN_THIN1
#define EN_THIN1 EN_ALL
#endif
#ifndef EN_UQKV
#define EN_UQKV EN_ALL
#endif
#ifndef EN_ATTN
#define EN_ATTN EN_ALL
#endif
#ifndef EN_OPROJ
#define EN_OPROJ EN_ALL
#endif
#ifndef EN_LN1
#define EN_LN1 EN_ALL
#endif
#ifndef EN_TOPK
#define EN_TOPK EN_ALL
#endif
#ifndef EN_GATHER
#define EN_GATHER EN_ALL
#endif
#ifndef EN_GU
#define EN_GU EN_ALL
#endif
#ifndef EN_DN
#define EN_DN EN_ALL
#endif
#ifndef EN_LN2
#define EN_LN2 EN_ALL
#endif
constexpr int NPH = 3 + NL * 11;
struct Args { const float* in[25]; float* out; unsigned char* ws; int ph_lo, ph_hi; };
__global__ void __launch_bounds__(NTHR, 2) mk_fwd(Args args) {
    extern __shared__ __attribute__((aligned(16))) unsigned char lds_raw[];
    Frame F;
    F.lds = (LAS unsigned char*)lds_raw;
    F.tid = threadIdx.x; F.lane = F.tid & 63; F.wave = __builtin_amdgcn_readfirstlane(F.tid >> 6);
    F.G = gridDim.x; { const int bx = blockIdx.x; F.vcu = (F.G % 8 == 0) ? (bx % 8) * (F.G / 8) + bx / 8 : bx; }
    F.gw = F.vcu * NWAVES + F.wave; F.ngw = F.G * NWAVES;
    F.out = args.out; F.ws = args.ws;
    volatile LAS unsigned* MISC = (volatile LAS unsigned*)(F.lds + MISC_OFF);
    if (F.tid < 4) MISC[F.tid] = 0u;
    __syncthreads();
    const int lo = args.ph_lo, hi = args.ph_hi;
    XcdBarrier bar; bar.bar = (unsigned*)(F.ws + WS_CTL) + CW_BAR; bar.x = 0; bar.st = MISC;
    if (hi - lo > 1) bar = xcd_barrier_post((unsigned*)(F.ws + WS_CTL) + CW_BAR, MISC);
#define IN(k) (lo <= (k) && (k) < hi)
#define SEAM(k) do { if ((k) + 1 < hi) xcd_barrier(bar); } while (0)
#define PB() do { F.lane = opaque_v(F.lane); F.tid = opaque_v(F.tid); F.gw = opaque_s(F.gw); F.wave = opaque_s(F.wave); F.vcu = opaque_s(F.vcu); } while (0)

#if EN_P0A
    if (IN(0)) { PB(); phase_p0a(F); SEAM(0); }
#endif
#if EN_P0B
    if (IN(1)) { PB(); phase_p0b(F); SEAM(1); }
#endif
#if EN_P0C
    if (IN(2)) { PB(); phase_p0c(F); SEAM(2); }
#endif

#pragma unroll 1
    for (int li = 0; li < NL; ++li) {
        const int pb = 3 + li * 11, j = li >> 1; const bool mla = (li & 1) != 0;
#if EN_PROJ
        if (IN(pb + 0)) { PB();
            const int N = mla ? 1280 : 1536;
            pg8::Gemm g{(const bf16_t*)(F.ws + WS_H), mla ? (const bf16_t*)(F.ws + WS_WD) + (size_t)j * 1280 * 1024 : (const bf16_t*)(F.ws + WS_WQKV) + (size_t)j * 1536 * 1024, D, D, D, 0};
            pg8::StaticOrder S; S.init(T, N, F.G, (int)blockIdx.x);
            pg8::EpiStore E{(bf16_t*)(F.ws + WS_R), N};
            pg8::gemm_phase<pg8::EpiStore, pg8::StaticOrder>(F.lds, g, S, E, nullptr);
            SEAM(pb + 0);
        }
#endif
#if EN_THIN1
        if (IN(pb + 1)) { PB(); if (mla) phase_mla_stats(F); else phase_qknorm(F, j); SEAM(pb + 1); }
#endif
#if EN_UQKV
        if (mla && IN(pb + 2)) { PB();
#if EN_UQ
            { pg8::Gemm g{(const bf16_t*)(F.ws + WS_R + R_CQ), (const bf16_t*)(F.ws + WS_WUQ) + (size_t)j * 1536 * 768, 1280, 768, 768, 0};
              pg8::StaticOrder S; S.init(T, 1536, F.G, (int)blockIdx.x);
              const float* rt = (const float*)(F.ws + WS_ROPE);
              pg8::EpiUq E{(bf16_t*)(F.ws + WS_R + R_Q), rt + 4096, rt + 5120};
              pg8::gemm_phase<pg8::EpiUq, pg8::StaticOrder>(F.lds, g, S, E, nullptr); }
#endif
#if EN_UKV
            { pg8::Gemm g{(const bf16_t*)(F.ws + WS_R + R_CQ) + 768, (const bf16_t*)(F.ws + WS_WUKV) + (size_t)j * 2048 * 256, 1280, 256, 256, 0};
              pg8::StaticOrder S; S.init(T, 2048, F.G, (int)blockIdx.x);
              pg8::EpiStore E{(bf16_t*)(F.ws + WS_R + R_KV), 2048};
              pg8::gemm_phase<pg8::EpiStore, pg8::StaticOrder>(F.lds, g, S, E, nullptr); }
#endif
            SEAM(pb + 2);
        }
#endif
#if EN_ATTN
        if (IN(pb + 3)) { PB();
#if EN_ATTN_MLA
            if (mla) phase_attn<192, ATT_SD_MLA>(F);
#endif
#if EN_ATTN_GQA
            if (!mla) phase_attn<128, ATT_SD_GQA>(F);
#endif
            SEAM(pb + 3); }
#endif
#if EN_OPROJ
        if (IN(pb + 4)) { PB();
            pg8::Gemm g{(const bf16_t*)(F.ws + WS_R + (mla ? R_AOM : R_AOG)), (const bf16_t*)(F.ws + (mla ? WS_WOM : WS_WOG)) + (size_t)j * 1024 * 1024, D, D, D, 0};
            pg8::StaticOrder S; S.init(T, D, F.G, (int)blockIdx.x);
            pg8::EpiStore E{(bf16_t*)(F.ws + WS_R + (mla ? R_OM : R_OG)), D};
            pg8::gemm_phase<pg8::EpiStore, pg8::StaticOrder>(F.lds, g, S, E, nullptr);
            SEAM(pb + 4);
        }
#endif
#if EN_LN1
        if (IN(pb + 5)) { PB(); phase_ln1(F, li, li == 0 ? in_ptr(I_X) : F.out, li == 0 ? in_ptr(I_CTX) : (const float*)(F.ws + WS_XC), (const bf16_t*)(F.ws + WS_R + (mla ? R_OM : R_OG))); SEAM(pb + 5); }
#endif
#if EN_TOPK
        if (IN(pb + 6)) { PB(); phase_topk_conv(F, li); SEAM(pb + 6); }
#endif
#if EN_GATHER
        if (IN(pb + 7)) { PB(); phase_gather(F); SEAM(pb + 7); }
#endif
#if EN_GU
        if (IN(pb + 8)) { PB();
            pg8::Gemm g{(const bf16_t*)(F.ws + WS_R + R_XS), (const bf16_t*)(F.ws + WS_WGU), D, D, D, 0};
            pg8::MoeOrder S; S.init(8, F.G, (int)blockIdx.x);
            pg8::EpiSwiGlu E{(bf16_t*)(F.ws + WS_R + R_ACT)};
            pg8::gemm_phase<pg8::EpiSwiGlu, pg8::MoeOrder>(F.lds, g, S, E, nullptr);
            SEAM(pb + 8);
        }
#endif
#if EN_DN
        if (IN(pb + 9)) { PB();
            pg8::Gemm g{(const bf16_t*)(F.ws + WS_R + R_ACT), (const bf16_t*)(F.ws + WS_WDN), FF, FF, FF, 0};
            pg8::MoeOrder S; S.init(4, F.G, (int)blockIdx.x);
            pg8::EpiDown E{(bf16_t*)(F.ws + WS_R + R_XS), (const float*)(F.ws + WS_GVAL)};
            pg8::gemm_phase<pg8::EpiDown, pg8::MoeOrder>(F.lds, g, S, E, nullptr);
            SEAM(pb + 9);
        }
#endif
#if EN_LN2
        if (IN(pb + 10)) { PB(); phase_ln2(F, li); SEAM(pb + 10); }
#endif
    }
#undef IN
#undef SEAM
}

extern "C" void kernel_launch(void* const* d_in, const int* in_sizes, int n_in, void* d_out, int out_size, void* d_ws, size_t ws_size, hipStream_t stream) {
    static int grid = 0;
    if (grid == 0) {
        if (n_in != 25 || out_size != NB * SEQ * D || ws_size < WS_END) { fprintf(stderr, "kernel_launch: shape/workspace mismatch (n_in %d out %d ws %zu need %zu); nothing launched\n", n_in, out_size, ws_size, (size_t)WS_END); grid = -1; return; }
        int dev = 0, cus = 0, per_cu = 0;
        if (hipGetDevice(&dev) != hipSuccess || hipDeviceGetAttribute(&cus, hipDeviceAttributeMultiprocessorCount, dev) != hipSuccess) { grid = -1; return; }
        if (hipFuncSetAttribute((const void*)mk_fwd, hipFuncAttributeMaxDynamicSharedMemorySize, LDS_BYTES) != hipSuccess) { fprintf(stderr, "kernel_launch: hipFuncSetAttribute failed\n"); grid = -1; return; }
        if (hipOccupancyMaxActiveBlocksPerMultiprocessor(&per_cu, (const void*)mk_fwd, NTHR, LDS_BYTES) != hipSuccess || per_cu < 1) { fprintf(stderr, "kernel_launch: occupancy query says %d\n", per_cu); (void)hipGetLastError(); grid = -1; return; }
        grid = cus < 256 ? cus : 256;
    }
    if (grid < 0) return;
    (void)hipMemsetAsync((char*)d_ws + WS_CTL, 0, CTL_ZERO_BYTES, stream);
    Args a{};
    for (int i = 0; i < 25; ++i) a.in[i] = (const float*)d_in[i];
    a.out = (float*)d_out; a.ws = (unsigned char*)d_ws;
#if MK_ONE_LAUNCH
    a.ph_lo = 0; a.ph_hi = NPH;
    hipLaunchKernelGGL(mk_fwd, dim3(grid), dim3(NTHR), LDS_BYTES, stream, a);
#else
    for (int p = 0; p < NPH; ++p) {
        if (p >= 3 && ((p - 3) % 11) == 2 && (((p - 3) / 11) & 1) == 0) continue;
        a.ph_lo = p; a.ph_hi = p + 1;
        hipLaunchKernelGGL(mk_fwd, dim3(grid), dim3(NTHR), LDS_BYTES, stream, a);
    }
#endif
    const hipError_t le = hipPeekAtLastError();
    if (le != hipSuccess) fprintf(stderr, "kernel_launch: launch failed: %s\n", hipGetErrorName(le));
}
```

```cpp
#define MK_ONE_LAUNCH 1
#define ATT_V2 1
#include <hip/hip_runtime.h>
#include <cstdio>
#include <cstdint>

#define LAS __attribute__((address_space(3)))
#define GAS __attribute__((address_space(1)))
typedef unsigned short bf16_t;
typedef short bf16x8 __attribute__((ext_vector_type(8)));
typedef short s16x4 __attribute__((ext_vector_type(4)));
typedef float f32x2 __attribute__((ext_vector_type(2)));
typedef float f32x4 __attribute__((ext_vector_type(4)));
typedef float f32x16 __attribute__((ext_vector_type(16)));
typedef unsigned u32x2 __attribute__((ext_vector_type(2)));
typedef unsigned u32x4 __attribute__((ext_vector_type(4)));

#ifndef REP_LN1
#define REP_LN1 1
#endif
#ifndef MK_ONE_LAUNCH
#define MK_ONE_LAUNCH 1
#endif

constexpr int D = 1024, NB = 32, SEQ = 2048, CTXL = 256, TPS = SEQ + CTXL  , T = NB * TPS  , NL = 4;
constexpr int NE = 16, FF = 1024, CAPL = 256, CAPC = 32;
constexpr int NSLOT_L = NB * NE * CAPL  , NSLOT = NSLOT_L + NB * NE * CAPC  , NPANEL = NSLOT / 256  ;
constexpr float ALPHA = 1.6817928305074292f, LN_EPS = 1e-6f;
constexpr int NWAVES = 8, NTHR = 512;
constexpr int MODSZ = 6 * D;
constexpr int MOD_KC = 16;

constexpr size_t MiB = 1u << 20;
constexpr size_t WS_CTL = 0, CTL_ZERO_BYTES = 64 * 1024;
constexpr size_t WS_MOD = 1 * MiB;
constexpr size_t WS_ROPE = 5 * MiB;
constexpr size_t WS_WQKV = 6 * MiB;
constexpr size_t WS_WOG = 12 * MiB;
constexpr size_t WS_WD = 16 * MiB;
constexpr size_t WS_WUQ = 21 * MiB;
constexpr size_t WS_WUKV = 26 * MiB;
constexpr size_t WS_WOM = 28 * MiB;
constexpr size_t WS_WGU = 32 * MiB;
constexpr size_t WS_WDN = 96 * MiB;
constexpr size_t WS_XC = 128 * MiB;
constexpr size_t WS_H = 160 * MiB;
constexpr size_t WS_CQ8 = WS_H + 72 * MiB;
constexpr size_t WS_AFF = 304 * MiB;
constexpr size_t WS_INV = 309 * MiB;
constexpr size_t WS_GVAL = 314 * MiB;
constexpr size_t WS_STOK = 315 * MiB;
constexpr size_t WS_RS = 316 * MiB;
constexpr size_t WS_KR = 317 * MiB;
constexpr size_t WS_R = 326 * MiB;
constexpr size_t R_QKV = 0, R_AOG = 216 * MiB, R_OG = 0;
constexpr size_t R_CQ = 0, R_Q = 180 * MiB, R_KV = 396 * MiB, R_AOM = 0, R_OM = 180 * MiB;
constexpr size_t R_XS = 0, R_ACT = 288 * MiB;
constexpr size_t R_MODP = 0;
constexpr size_t WS_END = WS_R + 684 * MiB;
static_assert((size_t)T * 2048 * 2 == 288 * MiB && (size_t)NSLOT * 1024 * 2 == 288 * MiB && (size_t)T * 1536 * 2 == 216 * MiB && (size_t)T * 1280 * 2 == 180 * MiB, "sizes");
constexpr int CW_BAR = 4096;

constexpr int RING_BYTES = 131072;
constexpr int LDS_BYTES = 163840;
constexpr int MISC_OFF = LDS_BYTES - 256;

__device__ __forceinline__ float bf2f(unsigned b) { return __uint_as_float(b << 16); }
__device__ __forceinline__ unsigned cvt_pk_bf16(float lo, float hi) { unsigned r; asm volatile("v_cvt_pk_bf16_f32 %0, %1, %2" : "=v"(r) : "v"(lo), "v"(hi)); return r; }
#define DPP_MOV(v, ctrl) __builtin_bit_cast(float, __builtin_amdgcn_update_dpp(0, __builtin_bit_cast(int, (float)(v)), (ctrl), 0xf, 0xf, true))
__device__ __forceinline__ float lane_xor16(float v) { return __builtin_bit_cast(float, __builtin_amdgcn_ds_swizzle(__builtin_bit_cast(int, v), 0x401F)); }
__device__ __forceinline__ float wave_sum(float v) {
    v += DPP_MOV(v, 0xB1);
    v += DPP_MOV(v, 0x4E);
    v += DPP_MOV(v, 0x141);
    v += DPP_MOV(v, 0x140);
    v += lane_xor16(v);
    { auto rr = __builtin_amdgcn_permlane32_swap(__float_as_uint(v), __float_as_uint(v), false, false); v = __uint_as_float(rr[0]) + __uint_as_float(rr[1]); }
    return v;
}
#define LDS_WAIT() asm volatile("s_waitcnt lgkmcnt(0)" ::: "memory")
#define VM_WAIT() asm volatile("s_waitcnt vmcnt(0)" ::: "memory")
__device__ __forceinline__ int opaque_v(int x) { asm volatile("" : "+v"(x)); return x; }
__device__ __forceinline__ int opaque_s(int x) { asm volatile("" : "+s"(x)); return x; }
__device__ __forceinline__ const float* in_ptr(int i) {
    const __attribute__((address_space(4))) char* kp = (const __attribute__((address_space(4))) char*)__builtin_amdgcn_kernarg_segment_ptr();
    const int off = opaque_s(i * 8);
    return *(const float* const __attribute__((address_space(4)))*)(kp + off);
}
__device__ __forceinline__ unsigned cvt4_fp8(float a, float b, float c, float d) {
    a = __builtin_fminf(__builtin_fmaxf(a, -448.f), 448.f); b = __builtin_fminf(__builtin_fmaxf(b, -448.f), 448.f); c = __builtin_fminf(__builtin_fmaxf(c, -448.f), 448.f); d = __builtin_fminf(__builtin_fmaxf(d, -448.f), 448.f);
    int w = 0; w = __builtin_amdgcn_cvt_pk_fp8_f32(a, b, w, false); w = __builtin_amdgcn_cvt_pk_fp8_f32(c, d, w, true); return (unsigned)w;
}
constexpr float WGU_SCALE = 32.f, WDN_SCALE = 64.f, WP_SCALE = 32.f, WO_SCALE = 64.f, AO_SCALE = 16.f;
#ifndef ATT_SD_MLA
#define ATT_SD_MLA 1
#endif
#define XB_TMO      128
#define XB_XCNT(j)  (256  + 64 * (j))
#define XB_XSUB(j)  (1280 + 64 * (j))
#define XB_XGEN(j)  (2304 + 64 * (j))
#define XB_TOP      3328
#define XB_TOPGEN   3392
#define XCD_BAR_WORDS 3456
#define XB_SPIN_CAP (1u << 18)

__device__ __forceinline__ unsigned xb_ld(unsigned* p)              { return __hip_atomic_load(p, __ATOMIC_RELAXED, __HIP_MEMORY_SCOPE_AGENT); }
__device__ __forceinline__ unsigned xb_add(unsigned* p, unsigned v) { return __hip_atomic_fetch_add(p, v, __ATOMIC_RELAXED, __HIP_MEMORY_SCOPE_AGENT); }
__device__ __forceinline__ unsigned xb_xcc_id() { return (unsigned)__builtin_amdgcn_s_getreg((3 << 11) | 20) & 0xFu; }
#define XB_SPIN(cond, bar) do { unsigned _sp = 0; while (cond) { __builtin_amdgcn_s_sleep(1); \
    if ((++_sp & 255u) == 0u) { if (xb_ld(&(bar)[XB_TMO])) break; if (_sp > XB_SPIN_CAP) { atomicAdd(&(bar)[XB_TMO], 1u); break; } } } } while (0)

struct XcdBarrier {
    unsigned* bar; unsigned x;
    volatile LAS unsigned* st;
};

__device__ __forceinline__ XcdBarrier xcd_barrier_post(unsigned* bar, volatile LAS unsigned* st) {
    XcdBarrier b; b.bar = bar; b.x = xb_xcc_id(); b.st = st;
    if (threadIdx.x == 0) (void)xb_add(&bar[XB_XCNT(b.x)], 1u);
    return b;
}
__device__ __forceinline__ void xcd_barrier_complete(unsigned* bar, unsigned x, unsigned& nloc, unsigned& nx) {
    const unsigned G = gridDim.x * gridDim.y * gridDim.z;
    unsigned sum, cnt, mine, sp = 0u;
    for (;;) {
        sum = 0u; cnt = 0u; mine = 0u;
#pragma unroll
        for (unsigned j = 0; j < 16; ++j) { const unsigned c = xb_ld(&bar[XB_XCNT(j)]); sum += c; cnt += (c > 0u) ? 1u : 0u; mine = (j == x) ? c : mine; }
        if (sum == G) break;
        __builtin_amdgcn_s_sleep(1);
        if ((++sp & 255u) == 0u) { if (xb_ld(&bar[XB_TMO])) break; if (sp > XB_SPIN_CAP) { atomicAdd(&bar[XB_TMO], 1u); break; } }
    }
    nloc = mine > 0u ? mine : 1u; nx = cnt > 0u ? cnt : 1u;
}

__device__ __forceinline__ void xcd_barrier(const XcdBarrier& b) {
    asm volatile("s_waitcnt vmcnt(0)" ::: "memory");
    __syncthreads();
    if (threadIdx.x == 0) {
        unsigned* bar = b.bar;
        __builtin_amdgcn_s_waitcnt(0);
        unsigned nloc = b.st[0], nx = b.st[1];
        if (nloc == 0u) { xcd_barrier_complete(bar, b.x, nloc, nx); b.st[0] = nloc; b.st[1] = nx; }
        const unsigned old = xb_add(&bar[XB_XSUB(b.x)], 1u);
        const unsigned gen = old / nloc;
        if (old + 1u == (gen + 1u) * nloc) {
            __builtin_amdgcn_fence(__ATOMIC_RELEASE, "agent");
            asm volatile("s_waitcnt vmcnt(0)" ::: "memory");
            const unsigned og = xb_add(&bar[XB_TOP], 1u);
            const unsigned tg = og / nx;
            if (og + 1u == (tg + 1u) * nx) xb_add(&bar[XB_TOPGEN], 1u);
            else XB_SPIN(xb_ld(&bar[XB_TOPGEN]) == tg, bar);
            __builtin_amdgcn_fence(__ATOMIC_ACQUIRE, "agent");
            xb_add(&bar[XB_XGEN(b.x)], 1u);
            asm volatile("s_waitcnt vmcnt(0)" ::: "memory");
        } else {
            XB_SPIN(xb_ld(&bar[XB_XGEN(b.x)]) == gen, bar);
            __builtin_amdgcn_fence(__ATOMIC_ACQUIRE, "agent");
            asm volatile("s_waitcnt vmcnt(0)" ::: "memory");
        }
    }
    __syncthreads();
}

namespace pg8 {
#define PG8_LAS __attribute__((address_space(3)))
constexpr int BM = 256, BK = 64, HALF = 128, HTB = HALF * BK * 2  , STAGE_BYTES = 8 * HTB, NXCD = 8, WGM = 8;

__host__ __device__ __forceinline__ int lds_byte(int r, int c) { const int st = (r >> 4) * 2 + (c >> 5), rr = r & 15, cc = c & 31, ob = rr * 64 + cc * 2; return st * 1024 + (ob ^ (((ob >> 9) & 1) << 5)); }
__host__ __device__ __forceinline__ void stage_rc(int b, int& R, int& C) { const int st = b / 1024, sb = b % 1024, swz = sb ^ (((sb >> 9) & 1) << 5); R = (st >> 1) * 16 + swz / 64; C = (st & 1) * 32 + (swz % 64) / 2; }
__host__ __device__ __forceinline__ int perm32(int rho) { const int n = rho >> 4, i = rho & 15; return 8 * (i >> 2) + 4 * n + (i & 3); }

struct Unit { int pm, pn; };
struct Gemm { const bf16_t* A; const bf16_t* Bt; int lda, ldb, K; int pad; const int* ridx = nullptr; };

struct StaticOrder {
    int nM, nN, nwg, G, c, rep; bool skipctx;
    __host__ __device__ void init(int M, int N, int G_, int c_) { nM = M / BM; nN = N / BM; nwg = nM * nN; G = G_; c = c_; rep = 1; skipctx = false; }
    __host__ __device__ bool next(int i, Unit& u) const {
        const long L = (long)(i / rep) * G + c; if (L >= nwg) return false;
        int wgid = (int)L; { const int q = nwg / NXCD, r = nwg % NXCD, xcd = wgid % NXCD, off = wgid / NXCD; wgid = (xcd < r ? xcd * (q + 1) : r * (q + 1) + (xcd - r) * q) + off; }
        const int nig = WGM * nN, gid = wgid / nig, fm = gid * WGM, gsz = (nM - fm) < WGM ? (nM - fm) : WGM;
        u.pm = fm + ((wgid % nig) % gsz); u.pn = (wgid % nig) / gsz; if (skipctx) u.pm = (u.pm >> 3) * 9 + 1 + (u.pm & 7); return true;
    }
    __device__ __forceinline__ void a_ready(const Unit&) const {}
    __device__ __forceinline__ void done(const Unit&) const {}
};
typedef int pg8_v8i __attribute__((ext_vector_type(8)));
#ifdef PROBE_CLK
#define PG8_PROBE_NOW() (__builtin_amdgcn_s_memtime() / 20ull)
#else
#define PG8_PROBE_NOW() __builtin_amdgcn_s_memrealtime()
#endif
#ifndef PG8_DMAMMA
#define PG8_DMAMMA 1
#endif
#ifndef PG8_BUF
#define PG8_BUF 0
#endif
__device__ __forceinline__ __amdgpu_buffer_rsrc_t pg8_rsrc(const void* p) {
    const unsigned long long v = (unsigned long long)(size_t)p; const unsigned lo = __builtin_amdgcn_readfirstlane((unsigned)v), hi = __builtin_amdgcn_readfirstlane((unsigned)(v >> 32));
    return __builtin_amdgcn_make_buffer_rsrc((void*)(size_t)(((unsigned long long)hi << 32) | lo), 0, -1, 0x00020000);
}
template <class Epi, class Sched, bool STAMP, bool GATHER, bool FP8, bool PRB>
__device__ __forceinline__ void gemm_phase_x(PG8_LAS unsigned char* lds, const Gemm g, const Sched& S, const Epi& E, unsigned long long* stamps, unsigned long long& pk, unsigned long long& pe);
template <class Epi, class Sched, bool STAMP = false, bool GATHER = false, bool FP8 = false>
__device__ __forceinline__ void gemm_phase(PG8_LAS unsigned char* lds, const Gemm g, const Sched& S, const Epi& E, unsigned long long* stamps) { unsigned long long a_ = 0, b_ = 0; gemm_phase_x<Epi, Sched, STAMP, GATHER, FP8, false>(lds, g, S, E, stamps, a_, b_); }
template <class Epi, class Sched, bool STAMP, bool GATHER, bool FP8, bool PRB>
__device__ __forceinline__ void gemm_phase_x(PG8_LAS unsigned char* lds, const Gemm g, const Sched& S, const Epi& E, unsigned long long* stamps, unsigned long long& pk, unsigned long long& pe) {
    unsigned long long pt_ = 0;
    const int tid = opaque_v((int)threadIdx.x), wid = __builtin_amdgcn_readfirstlane(tid >> 6), lane = tid & 63, wr = wid >> 2, wc = wid & 3, fr = lane & 15, fq = lane >> 4;
    const int K = g.K, nt = K / BK;
    const int wscale = g.pad;
    int ts_lo = 0, ts_hi = 0, nts = 0; const unsigned long long rt_entry = STAMP ? (unsigned long long)wall_clock64() : 0ull;
#define PG8_STAMP() do { if (STAMP && wid == 0 && nts < 64) { const unsigned long long _c = (unsigned long long)clock64(); \
        ts_lo = (lane == nts) ? (int)(unsigned)_c : ts_lo; ts_hi = (lane == nts) ? (int)(unsigned)(_c >> 32) : ts_hi; ++nts; } } while (0)
    PG8_STAMP();
    unsigned voffA[2], voffB[2];
#pragma unroll
    for (int i = 0; i < 2; ++i) { int R, C; stage_rc(tid * 16 + i * 8192, R, C); const int Rb = Epi::PERM ? ((R & ~31) + perm32(R & 31)) : R;
        voffA[i] = GATHER ? (unsigned)C * 2u : (unsigned)(R * g.lda + C) * 2u; voffB[i] = (unsigned)(Rb * g.ldb + C) * 2u; }
    unsigned vs[2][2];
#define PG8_LDRAW(pm_) do { if (wid < 4) __builtin_amdgcn_global_load_lds((const unsigned*)(g.ridx + ((pm_) * BM + wid * 64 + lane)), (PG8_LAS unsigned*)(lds + STAGE_BYTES + wid * 256), 4, 0, 0); } while (0)
#define PG8_CONV(vo) do { _Pragma("unroll") for (int _h = 0; _h < 2; ++_h) _Pragma("unroll") for (int _i = 0; _i < 2; ++_i) { int _R, _C; stage_rc(tid * 16 + _i * 8192, _R, _C); \
        int _v = *(const PG8_LAS int*)(lds + STAGE_BYTES + (_h * HALF + _R) * 4); _v = _v < 0 ? 0 : _v; (vo)[_h][_i] = (unsigned)_v * (unsigned)(g.lda * 2) + voffA[_i]; } } while (0)
    const size_t kstep = (size_t)(BK * 2);
    const size_t hstepA = (size_t)HALF * g.lda * 2, hstepB = (size_t)HALF * g.ldb * 2;
    const size_t tstepA = GATHER ? 0 : 2 * hstepA, tstepB = 2 * hstepB;
    const unsigned ldsw = (unsigned)wid * 1024u;
    const int aoff = lds_byte(wr * 64 + fr, fq * 8), boff = lds_byte(wc * 32 + fr, fq * 8);
#define PG8_SA(b, h) (((b) * 2 + (h)) * HTB)
#define PG8_SB(b, h) ((4 + (b) * 2 + (h)) * HTB)
#if PG8_BUF
    const __amdgpu_buffer_rsrc_t rsA = pg8_rsrc(g.A), rsB = pg8_rsrc(g.Bt);
#define PG8_STAGE_R(rs, base0, bufoff, gbase, voff) do { const int _so = __builtin_amdgcn_readfirstlane((int)(unsigned)((const char*)(gbase) - (const char*)(base0))); _Pragma("unroll") for (int _i = 0; _i < 2; ++_i) \
        __builtin_amdgcn_raw_ptr_buffer_load_lds(rs, (PG8_LAS void*)(lds + (bufoff) + ldsw + _i * 8192), 16, (int)(voff)[_i], _so, 0, 0); } while (0)
#define PG8_STAGE(bufoff, gbase, voff) PG8_STAGE_R(rsB, g.Bt, bufoff, gbase, voff)
#define PG8_STAGEA(bufoff, base, half, vsel) do { if constexpr (GATHER) PG8_STAGE_R(rsA, g.A, bufoff, base, vsel[half]); else PG8_STAGE_R(rsA, g.A, bufoff, (base) + (half) * hstepA, voffA); } while (0)
#else
#define PG8_STAGE(bufoff, gbase, voff) do { _Pragma("unroll") for (int _i = 0; _i < 2; ++_i) \
        __builtin_amdgcn_global_load_lds((const unsigned*)((const char*)(gbase) + (voff)[_i]), (PG8_LAS unsigned*)(lds + (bufoff) + ldsw + _i * 8192), 16, 0, 0); } while (0)
#define PG8_STAGEA(bufoff, base, half, vsel) do { if constexpr (GATHER) PG8_STAGE(bufoff, base, vsel[half]); else PG8_STAGE(bufoff, (base) + (half) * hstepA, voffA); } while (0)
#endif
#define PG8_LDA(dst, b, h) do { if constexpr (FP8) { _Pragma("unroll") for (int m = 0; m < 4; ++m) { const u32x4 lo_ = *(const PG8_LAS u32x4*)(lds + PG8_SA(b, h) + aoff + m * 2048), hi_ = *(const PG8_LAS u32x4*)(lds + PG8_SA(b, h) + aoff + m * 2048 + 1024); \
        dst##8[m] = __builtin_bit_cast(pg8_v8i, __builtin_shufflevector(lo_, hi_, 0, 1, 2, 3, 4, 5, 6, 7)); } } \
    else { _Pragma("unroll") for (int m = 0; m < 4; ++m) _Pragma("unroll") for (int k = 0; k < 2; ++k) dst[m][k] = *(const PG8_LAS bf16x8*)(lds + PG8_SA(b, h) + aoff + m * 2048 + k * 1024); } } while (0)
#define PG8_LDB(dst, b, h) do { if constexpr (FP8) { _Pragma("unroll") for (int n = 0; n < 2; ++n) { const u32x4 lo_ = *(const PG8_LAS u32x4*)(lds + PG8_SB(b, h) + boff + n * 2048), hi_ = *(const PG8_LAS u32x4*)(lds + PG8_SB(b, h) + boff + n * 2048 + 1024); \
        dst##8[n] = __builtin_bit_cast(pg8_v8i, __builtin_shufflevector(lo_, hi_, 0, 1, 2, 3, 4, 5, 6, 7)); } } \
    else { _Pragma("unroll") for (int n = 0; n < 2; ++n) _Pragma("unroll") for (int k = 0; k < 2; ++k) dst[n][k] = *(const PG8_LAS bf16x8*)(lds + PG8_SB(b, h) + boff + n * 2048 + k * 1024); } } while (0)
#define PG8_MMA(ai, bj, At, Bt) do { __builtin_amdgcn_s_setprio(1); _Pragma("unroll") for (int m = 0; m < 4; ++m) _Pragma("unroll") for (int n = 0; n < 2; ++n) _Pragma("unroll") for (int k = 0; k < 2; ++k) \
        acc[ai][bj][m][n] = __builtin_amdgcn_mfma_f32_16x16x32_bf16(Bt[n][k], At[m][k], acc[ai][bj][m][n], 0, 0, 0); __builtin_amdgcn_s_setprio(0); } while (0)
#define PG8_MMA8(ai, bj, At, Bt) do { __builtin_amdgcn_s_setprio(1); _Pragma("unroll") for (int m = 0; m < 4; ++m) _Pragma("unroll") for (int n = 0; n < 2; ++n) \
        acc[ai][bj][m][n] = __builtin_amdgcn_mfma_scale_f32_16x16x128_f8f6f4(Bt##8[n], At##8[m], acc[ai][bj][m][n], 0, 0, 0, wscale, 0, 0x7f7f7f7f); \
        __builtin_amdgcn_s_setprio(0); } while (0)
#define PG8_MMX(ai, bj, At, Bt) do { if constexpr (FP8) PG8_MMA8(ai, bj, At, Bt); else PG8_MMA(ai, bj, At, Bt); } while (0)
#define PG8_PIECE(bufoff, gbase, voff, i) __builtin_amdgcn_global_load_lds((const unsigned*)((const char*)(gbase) + (voff)[i]), (PG8_LAS unsigned*)(lds + (bufoff) + ldsw + (i) * 8192), 16, 0, 0)
#define PG8_PIECEB(bufoff, gbase, i) PG8_PIECE(bufoff, gbase, voffB, i)
#define PG8_PIECEA(bufoff, base, half, i) do { if constexpr (GATHER) PG8_PIECE(bufoff, base, vs[half], i); else PG8_PIECE(bufoff, (base) + (half) * hstepA, voffA, i); } while (0)
#define PG8_MF8(ai, bj, At, Bt, m, n) acc[ai][bj][m][n] = __builtin_amdgcn_mfma_scale_f32_16x16x128_f8f6f4(Bt##8[n], At##8[m], acc[ai][bj][m][n], 0, 0, 0, wscale, 0, 0x7f7f7f7f)
#define PG8_MF16(ai, bj, At, Bt, m, n) do { acc[ai][bj][m][n] = __builtin_amdgcn_mfma_f32_16x16x32_bf16(Bt[n][0], At[m][0], acc[ai][bj][m][n], 0, 0, 0); acc[ai][bj][m][n] = __builtin_amdgcn_mfma_f32_16x16x32_bf16(Bt[n][1], At[m][1], acc[ai][bj][m][n], 0, 0, 0); } while (0)
#define PG8_MF(ai, bj, At, Bt, m, n) do { if constexpr (FP8) PG8_MF8(ai, bj, At, Bt, m, n); else PG8_MF16(ai, bj, At, Bt, m, n); } while (0)
#define PG8_MMXS(ai, bj, At, Bt, S0, S1) do { __builtin_amdgcn_s_setprio(1); PG8_MF(ai, bj, At, Bt, 0, 0); PG8_MF(ai, bj, At, Bt, 0, 1); PG8_SCHED; S0; PG8_SCHED; \
        PG8_MF(ai, bj, At, Bt, 1, 0); PG8_MF(ai, bj, At, Bt, 1, 1); PG8_MF(ai, bj, At, Bt, 2, 0); PG8_SCHED; S1; PG8_SCHED; PG8_MF(ai, bj, At, Bt, 2, 1); PG8_MF(ai, bj, At, Bt, 3, 0); PG8_MF(ai, bj, At, Bt, 3, 1); \
        __builtin_amdgcn_s_setprio(0); } while (0)
#define PG8_WAIT_V(n) asm volatile("s_waitcnt vmcnt(" #n ")" ::: "memory")
#define PG8_WAIT_L(n) asm volatile("s_waitcnt lgkmcnt(" #n ")" ::: "memory")
#define PG8_BAR __builtin_amdgcn_s_barrier()
#define PG8_SCHED __builtin_amdgcn_sched_barrier(0)
    Unit cur, nxt; int ui = 0;
    if (!S.next(0, cur)) return;
    f32x4 acc[2][2][4][2];
#pragma unroll
    for (int a = 0; a < 2; ++a)
#pragma unroll
        for (int b = 0; b < 2; ++b)
#pragma unroll
            for (int m = 0; m < 4; ++m)
#pragma unroll
                for (int n = 0; n < 2; ++n) acc[a][b][m][n] = (f32x4){0.f, 0.f, 0.f, 0.f};
    bf16x8 At[4][2], B0[2][2], B1[2][2]; pg8_v8i At8[4], B08[2], B18[2];
    const char* cA = (const char*)g.A + (size_t)cur.pm * tstepA; const char* cB = (const char*)g.Bt + (size_t)cur.pn * tstepB;
    S.a_ready(cur);
    if constexpr (GATHER) { PG8_LDRAW(cur.pm); asm volatile("s_waitcnt vmcnt(0)" ::: "memory"); __builtin_amdgcn_s_barrier(); asm volatile("" ::: "memory"); PG8_CONV(vs); asm volatile("s_waitcnt lgkmcnt(0)" ::: "memory"); __builtin_amdgcn_s_barrier(); }
    PG8_STAGE(PG8_SB(0, 0), cB, voffB); PG8_STAGEA(PG8_SA(0, 0), cA, 0, vs); PG8_STAGE(PG8_SB(0, 1), cB + hstepB, voffB); PG8_STAGEA(PG8_SA(0, 1), cA, 1, vs);
    if (wr == 1) PG8_BAR;
    PG8_WAIT_V(4); PG8_BAR;
    PG8_STAGE(PG8_SB(1, 0), cB + kstep, voffB); PG8_STAGEA(PG8_SA(1, 0), cA + kstep, 0, vs); PG8_STAGE(PG8_SB(1, 1), cB + hstepB + kstep, voffB);
    PG8_WAIT_V(6); PG8_BAR;
    PG8_STAMP();
    for (;;) {
        if constexpr (PRB) { if (wid == 0) pt_ = PG8_PROBE_NOW(); }
        const bool has_next = S.next(ui + 1, nxt);
        if constexpr (GATHER) { if (has_next) PG8_LDRAW(nxt.pm); }
        const char* nA = has_next ? (const char*)g.A + (size_t)nxt.pm * tstepA : cA; const char* nB = has_next ? (const char*)g.Bt + (size_t)nxt.pn * tstepB : cB;
#pragma unroll 1
        for (int t = 0; t < nt; t += 2) {
            const bool last = (t == nt - 2);
            const char* a1 = cA + (size_t)(t + 1) * kstep;
            const char* a2 = last ? nA : cA + (size_t)(t + 2) * kstep; const char* b2 = last ? nB : cB + (size_t)(t + 2) * kstep;
            const char* a3 = a2 + kstep; const char* b3 = b2 + kstep;
            if (last && has_next) S.a_ready(nxt);
#if PG8_DMAMMA
            PG8_LDB(B0, 0, 0); PG8_SCHED; PG8_LDA(At, 0, 0);
            PG8_WAIT_L(8); PG8_BAR; PG8_WAIT_L(0); PG8_MMXS(0, 0, At, B0, PG8_PIECEA(PG8_SA(1, 1), a1, 1, 0), PG8_PIECEA(PG8_SA(1, 1), a1, 1, 1)); PG8_BAR; PG8_SCHED;
            PG8_LDB(B1, 0, 1);
            if constexpr (GATHER) { if (last && has_next) { PG8_CONV(vs); asm volatile("" : "+v"(vs[0][0]), "+v"(vs[0][1]), "+v"(vs[1][0]), "+v"(vs[1][1])); } }
            PG8_BAR; PG8_WAIT_L(0); PG8_MMXS(0, 1, At, B1, PG8_PIECEB(PG8_SB(0, 0), b2, 0), PG8_PIECEB(PG8_SB(0, 0), b2, 1)); PG8_BAR;
            PG8_LDA(At, 0, 1);
            PG8_BAR; PG8_WAIT_L(0); PG8_MMXS(1, 0, At, B0, PG8_PIECEA(PG8_SA(0, 0), a2, 0, 0), PG8_PIECEA(PG8_SA(0, 0), a2, 0, 1)); PG8_BAR; PG8_SCHED;
            PG8_WAIT_V(4); PG8_BAR; PG8_MMXS(1, 1, At, B1, PG8_PIECEB(PG8_SB(0, 1), b2 + hstepB, 0), PG8_PIECEB(PG8_SB(0, 1), b2 + hstepB, 1)); PG8_BAR;
            PG8_LDB(B0, 1, 0); PG8_SCHED; PG8_LDA(At, 1, 0);
            PG8_WAIT_L(8); PG8_BAR; PG8_WAIT_L(0); PG8_MMXS(0, 0, At, B0, PG8_PIECEA(PG8_SA(0, 1), a2, 1, 0), PG8_PIECEA(PG8_SA(0, 1), a2, 1, 1)); PG8_BAR; PG8_SCHED;
            PG8_LDB(B1, 1, 1);
            PG8_BAR; PG8_WAIT_L(0); PG8_MMXS(0, 1, At, B1, PG8_PIECEB(PG8_SB(1, 0), b3, 0), PG8_PIECEB(PG8_SB(1, 0), b3, 1)); PG8_BAR;
            PG8_LDA(At, 1, 1);
            PG8_BAR; PG8_WAIT_L(0); PG8_MMXS(1, 0, At, B0, PG8_PIECEA(PG8_SA(1, 0), a3, 0, 0), PG8_PIECEA(PG8_SA(1, 0), a3, 0, 1)); PG8_BAR; PG8_SCHED;
            PG8_WAIT_V(4); PG8_BAR; PG8_MMXS(1, 1, At, B1, PG8_PIECEB(PG8_SB(1, 1), b3 + hstepB, 0), PG8_PIECEB(PG8_SB(1, 1), b3 + hstepB, 1)); PG8_BAR;
#else
            PG8_LDB(B0, 0, 0); PG8_SCHED; PG8_LDA(At, 0, 0); PG8_STAGEA(PG8_SA(1, 1), a1, 1, vs);
            if constexpr (GATHER) { if (last && has_next) { PG8_CONV(vs); asm volatile("" : "+v"(vs[0][0]), "+v"(vs[0][1]), "+v"(vs[1][0]), "+v"(vs[1][1])); } }
            PG8_WAIT_L(8); PG8_BAR; PG8_WAIT_L(0); PG8_MMX(0, 0, At, B0); PG8_BAR; PG8_SCHED;
            PG8_LDB(B1, 0, 1); PG8_STAGE(PG8_SB(0, 0), b2, voffB);
            PG8_BAR; PG8_WAIT_L(0); PG8_MMX(0, 1, At, B1); PG8_BAR;
            PG8_LDA(At, 0, 1); PG8_STAGEA(PG8_SA(0, 0), a2, 0, vs);
            PG8_BAR; PG8_WAIT_L(0); PG8_MMX(1, 0, At, B0); PG8_BAR; PG8_SCHED;
            PG8_STAGE(PG8_SB(0, 1), b2 + hstepB, voffB);
            PG8_WAIT_V(6); PG8_BAR; PG8_MMX(1, 1, At, B1); PG8_BAR;
            PG8_LDB(B0, 1, 0); PG8_SCHED; PG8_LDA(At, 1, 0); PG8_STAGEA(PG8_SA(0, 1), a2, 1, vs);
            PG8_WAIT_L(8); PG8_BAR; PG8_WAIT_L(0); PG8_MMX(0, 0, At, B0); PG8_BAR; PG8_SCHED;
            PG8_LDB(B1, 1, 1); PG8_STAGE(PG8_SB(1, 0), b3, voffB);
            PG8_BAR; PG8_WAIT_L(0); PG8_MMX(0, 1, At, B1); PG8_BAR;
            PG8_LDA(At, 1, 1); PG8_STAGEA(PG8_SA(1, 0), a3, 0, vs);
            PG8_BAR; PG8_WAIT_L(0); PG8_MMX(1, 0, At, B0); PG8_BAR; PG8_SCHED;
            PG8_STAGE(PG8_SB(1, 1), b3 + hstepB, voffB);
            PG8_WAIT_V(6); PG8_BAR; PG8_MMX(1, 1, At, B1); PG8_BAR;
#endif
        }
        PG8_STAMP();
        if constexpr (PRB) { if (wid == 0) { const unsigned long long n_ = PG8_PROBE_NOW(); pk += n_ - pt_; pt_ = n_; } }
        if constexpr (!Epi::AFTER_DRAIN) { E(acc, cur, wr, wc, fr, fq); S.done(cur); }
        if constexpr (PRB) { if (wid == 0) { const unsigned long long n_ = PG8_PROBE_NOW(); pe += n_ - pt_; } }
        PG8_STAMP();
        if (!has_next) break;
#pragma unroll
        for (int a = 0; a < 2; ++a)
#pragma unroll
            for (int b = 0; b < 2; ++b)
#pragma unroll
                for (int m = 0; m < 4; ++m)
#pragma unroll
                    for (int n = 0; n < 2; ++n) acc[a][b][m][n] = (f32x4){0.f, 0.f, 0.f, 0.f};
        cur = nxt; cA = nA; cB = nB; ++ui;
    }
    PG8_WAIT_V(0);
    if (wr == 0) PG8_BAR;
    PG8_BAR;
    if constexpr (Epi::AFTER_DRAIN) { E.fused(acc, cur, wr, wc, fr, fq, lds, wid, lane); S.done(cur); }
    PG8_STAMP();
    if (STAMP && wid == 0) { stamps[lane] = lane < nts ? (((unsigned long long)(unsigned)ts_hi << 32) | (unsigned)ts_lo) : 0ull;
        if (lane == 62) stamps[62] = rt_entry; if (lane == 63) stamps[63] = (unsigned long long)wall_clock64(); }
#undef PG8_STAMP
#undef PG8_SA
#undef PG8_SB
#undef PG8_STAGE
#undef PG8_STAGEA
#undef PG8_LDRAW
#undef PG8_CONV
#undef PG8_LDA
#undef PG8_LDB
#undef PG8_MMA
#undef PG8_MMA8
#undef PG8_MMX
#undef PG8_WAIT_V
#undef PG8_WAIT_L
#undef PG8_BAR
#undef PG8_SCHED
}
}
namespace pg8 {
struct MoeOrder {
    int NT, G, c, nunits, rep;
    __device__ void init(int NT_, int G_, int c_) { NT = NT_; G = G_; c = c_; nunits = NPANEL * NT_; rep = 1; }
    __device__ bool next(int i, Unit& u) const {
        const long L0 = (long)(i / rep) * G + c; if (L0 >= nunits) return false;
        int pr, pnl;
        if (G == 256) { const int x = c & 7, jj = c >> 3, PX = 32 / NT; pr = (i / rep) * (256 / NT) + x * PX + jj / NT; pnl = jj % NT; }
        else { pr = (int)L0 / NT; pnl = (int)L0 % NT; }
        int pm, e;
        if (pr < 512) { e = pr >> 5; pm = (pr & 31) * 16 + e; } else { pm = pr; e = (pr - 512) >> 2; }
        u.pm = pm; u.pn = e * NT + pnl; return true;
    }
    __device__ __forceinline__ void a_ready(const Unit&) const {}
    __device__ __forceinline__ void done(const Unit&) const {}
};

__device__ __forceinline__ u32x4 pack8(const f32x4 a, const f32x4 b) { u32x4 w; w.x = cvt_pk_bf16(a[0], a[1]); w.y = cvt_pk_bf16(a[2], a[3]); w.z = cvt_pk_bf16(b[0], b[1]); w.w = cvt_pk_bf16(b[2], b[3]); return w; }

struct EpiStore {
    static constexpr bool PERM = true, AFTER_DRAIN = false;
    bf16_t* O; int ldc; int pnmask;
    __device__ __forceinline__ void operator()(const f32x4 (&acc)[2][2][4][2], const Unit& u, int wr, int wc, int fr, int fq) const {
        const int row0 = u.pm * BM + wr * 64 + fr, col0 = (u.pn & pnmask) * BM + wc * 32 + 8 * fq;
#pragma unroll
        for (int ai = 0; ai < 2; ++ai)
#pragma unroll
            for (int m = 0; m < 4; ++m) { const int row = row0 + ai * HALF + m * 16; bf16_t* rowp = O + (size_t)row * ldc + col0;
#pragma unroll
                for (int bj = 0; bj < 2; ++bj) *(u32x4*)(rowp + bj * HALF) = pack8(acc[ai][bj][m][0], acc[ai][bj][m][1]);
                __builtin_amdgcn_sched_barrier(0); }
    }
};
struct EpiUq {
    static constexpr bool PERM = true, AFTER_DRAIN = false;
    bf16_t* O; const float* rcos; const float* rsin;
    __device__ __forceinline__ void operator()(const f32x4 (&acc)[2][2][4][2], const Unit& u, int wr, int wc, int fr, int fq) const {
        const int row0 = u.pm * BM + wr * 64 + fr, col0 = u.pn * BM + wc * 32 + 8 * fq;
        const int bsmp = u.pm / 9, ptile = u.pm - bsmp * 9; const bool latent = ptile != 0;
        int j0[2]; bool inr[2];
#pragma unroll
        for (int bj = 0; bj < 2; ++bj) { const int c = col0 + bj * HALF, hd = c / 192, off = c - hd * 192; inr[bj] = latent && off >= 128; j0[bj] = (off - 128) >> 1; }
#pragma unroll
        for (int ai = 0; ai < 2; ++ai)
#pragma unroll
            for (int m = 0; m < 4; ++m) { const int row = row0 + ai * HALF + m * 16; bf16_t* rowp = O + (size_t)row * 1536 + col0;
                const int t = row - bsmp * TPS - CTXL, trow = (t >> 6) & 31, tcol = t & 63;
#pragma unroll
                for (int bj = 0; bj < 2; ++bj) { f32x4 a = acc[ai][bj][m][0], b = acc[ai][bj][m][1];
                    if (inr[bj]) { const int pos = j0[bj] < 16 ? trow : tcol, ti = pos * 16 + (j0[bj] & 15);
                        const f32x4 cs = *(const f32x4*)(rcos + ti), sn = *(const f32x4*)(rsin + ti);
                        const f32x4 a2 = {a[0] * cs[0] - a[1] * sn[0], a[0] * sn[0] + a[1] * cs[0], a[2] * cs[1] - a[3] * sn[1], a[2] * sn[1] + a[3] * cs[1]};
                        const f32x4 b2 = {b[0] * cs[2] - b[1] * sn[2], b[0] * sn[2] + b[1] * cs[2], b[2] * cs[3] - b[3] * sn[3], b[2] * sn[3] + b[3] * cs[3]};
                        a = a2; b = b2; }
                    *(u32x4*)(rowp + bj * HALF) = pack8(a, b); } }
    }
};
struct EpiSwiGlu {
    static constexpr bool PERM = true, AFTER_DRAIN = false;
    unsigned char* O;
    __device__ __forceinline__ void operator()(const f32x4 (&acc)[2][2][4][2], const Unit& u, int wr, int wc, int fr, int fq) const {
        const int row0 = u.pm * BM + wr * 64 + fr, col0 = (u.pn & 7) * HALF + wc * 32 + 8 * fq;
#pragma unroll
        for (int ai = 0; ai < 2; ++ai)
#pragma unroll
            for (int m = 0; m < 4; ++m) { unsigned char* rowp = O + (size_t)(row0 + ai * HALF + m * 16) * FF + col0; f32x4 r[2];
#pragma unroll
                for (int n = 0; n < 2; ++n) { const f32x4 g = acc[ai][0][m][n], up = acc[ai][1][m][n];
#pragma unroll
                    for (int j = 0; j < 4; ++j) r[n][j] = g[j] * __builtin_amdgcn_rcpf(1.0f + __builtin_amdgcn_exp2f(-1.4426950408889634f * g[j])) * up[j]; }
                u32x2 w; w.x = cvt4_fp8(r[0][0], r[0][1], r[0][2], r[0][3]); w.y = cvt4_fp8(r[1][0], r[1][1], r[1][2], r[1][3]);
                *(u32x2*)rowp = w; __builtin_amdgcn_sched_barrier(0); }
    }
};
struct EpiDown {
    static constexpr bool PERM = true, AFTER_DRAIN = false;
    bf16_t* O; const float* gv;
    __device__ __forceinline__ void operator()(const f32x4 (&acc)[2][2][4][2], const Unit& u, int wr, int wc, int fr, int fq) const {
        const int row0 = u.pm * BM + wr * 64 + fr, col0 = (u.pn & 3) * BM + wc * 32 + 8 * fq;
#pragma unroll
        for (int ai = 0; ai < 2; ++ai)
#pragma unroll
            for (int m = 0; m < 4; ++m) { const int row = row0 + ai * HALF + m * 16; const float s = gv[row]; bf16_t* rowp = O + (size_t)row * D + col0;
#pragma unroll
                for (int bj = 0; bj < 2; ++bj) *(u32x4*)(rowp + bj * HALF) = pack8(acc[ai][bj][m][0] * s, acc[ai][bj][m][1] * s); }
    }
};
}
namespace att {
constexpr int NW = 8, QBLK = 32, KVBLK = 64, DV = 128;
constexpr float THR = 8.f;
#ifndef ATT_QKPIPE_GQA
#define ATT_QKPIPE_GQA 0
#endif
#ifndef ATT_QKPIPE_MLA
#define ATT_QKPIPE_MLA 0
#endif
#ifndef MLA_QREG
#define MLA_QREG 4
#endif
#define SBAR() __builtin_amdgcn_sched_barrier(0)
__device__ __forceinline__ int crow(int r, int hi) { return (r & 3) + 8 * (r >> 2) + 4 * hi; }
__device__ __forceinline__ unsigned cvtpk(float lo, float hi) { unsigned r; asm volatile("v_cvt_pk_bf16_f32 %0, %1, %2" : "=v"(r) : "v"(lo), "v"(hi)); return r; }

template <int DQK> struct Cfg {
    static constexpr float SCALE = DQK == 128 ? 0.088388347648318440f : 0.072168783648703220f;
    static constexpr float C = SCALE * 1.4426950408889634f;
    static constexpr int ROWB = DQK * 2;
    static constexpr int SHM_K = KVBLK * DQK * 2, SHM_V = KVBLK * DV * 2;
    static constexpr int QREG = DQK == 128 ? 8 : MLA_QREG;
    static constexpr int SHM_ATTN = 2 * SHM_V + 2 * SHM_K + NW * 64 * 4 + NW * (DQK / 16 - QREG) * 1024;
};
#define KSWZ(row, colB) ((row) * ROWB + ((colB) ^ ((((colB) < 256) ? ((row) & 15) : ((row) & 7)) << 4)))

template <int DQK>
__device__ __forceinline__ void partialSM(f32x16& p0, f32x16& p1, float& m_reg, float& mn, float& alpha) {
  constexpr float C = Cfg<DQK>::C, SCALE = Cfg<DQK>::SCALE;
  float pmax = p0[0];
#pragma unroll
  for (int r = 1; r < 16; ++r) pmax = fmaxf(pmax, p0[r]);
#pragma unroll
  for (int r = 0; r < 16; ++r) pmax = fmaxf(pmax, p1[r]);
  { auto rr = __builtin_amdgcn_permlane32_swap(__float_as_uint(pmax), __float_as_uint(pmax), false, false);
    pmax = fmaxf(__uint_as_float(rr[0]), __uint_as_float(rr[1])); }
  if (__builtin_expect(__all(pmax - m_reg <= THR / SCALE), 1)) { mn = m_reg; alpha = 1.f; }
  else { mn = fmaxf(m_reg, pmax); alpha = __builtin_amdgcn_exp2f((m_reg - mn) * C); m_reg = mn; }
  float mnC = -mn * C;
#pragma unroll
  for (int r = 0; r < 16; ++r) p0[r] = fmaf(p0[r], C, mnC);
#pragma unroll
  for (int r = 0; r < 16; ++r) p1[r] = fmaf(p1[r], C, mnC);
#pragma unroll
  for (int r = 0; r < 16; ++r) p0[r] = __builtin_amdgcn_exp2f(p0[r]);
}
__device__ __forceinline__ void finishSM(f32x16& p0, f32x16& p1, float alpha, float& l_reg, bf16x8& pa0, bf16x8& pa1, bf16x8& pa2, bf16x8& pa3) {
#pragma unroll
  for (int r = 0; r < 16; ++r) p1[r] = __builtin_amdgcn_exp2f(p1[r]);
  float ps = 0;
#pragma unroll
  for (int r = 0; r < 16; ++r) ps += p0[r];
#pragma unroll
  for (int r = 0; r < 16; ++r) ps += p1[r];
  { auto rr = __builtin_amdgcn_permlane32_swap(__float_as_uint(ps), __float_as_uint(ps), false, false);
    ps = __uint_as_float(rr[0]) + __uint_as_float(rr[1]); }
  l_reg = l_reg * alpha + ps;
#define PK4(P, BASE, OUT) do { unsigned a0 = cvtpk(P[BASE + 0], P[BASE + 1]), a1 = cvtpk(P[BASE + 2], P[BASE + 3]);   \
    unsigned b0 = cvtpk(P[BASE + 4], P[BASE + 5]), b1 = cvtpk(P[BASE + 6], P[BASE + 7]);                              \
    auto r0 = __builtin_amdgcn_permlane32_swap(a0, b0, false, false); auto r1 = __builtin_amdgcn_permlane32_swap(a1, b1, false, false); \
    u32x4 w = {r0[0], r1[0], r0[1], r1[1]}; OUT = *reinterpret_cast<bf16x8*>(&w); } while (0)
  PK4(p0, 0, pa0); PK4(p0, 8, pa1); PK4(p1, 0, pa2); PK4(p1, 8, pa3);
#undef PK4
}
template <int DQK, int QREG>
__device__ __forceinline__ void qkt_plain(f32x16& p0, f32x16& p1, const char* Ks, const bf16x8* qr, const char* qx, int r32, int hi) {
  constexpr int ROWB = Cfg<DQK>::ROWB;
  p0 = f32x16{}; p1 = f32x16{};
#pragma unroll
  for (int d0 = 0; d0 < DQK / 16; ++d0) { int cb = (d0 * 16 + hi * 8) * 2;
    bf16x8 b0 = *reinterpret_cast<const bf16x8*>(Ks + KSWZ(r32, cb));
    bf16x8 b1 = *reinterpret_cast<const bf16x8*>(Ks + KSWZ(32 + r32, cb));
    bf16x8 q; if (d0 < QREG) q = qr[d0]; else q = *reinterpret_cast<const bf16x8*>(qx + (d0 - QREG) * 1024);
    p0 = __builtin_amdgcn_mfma_f32_32x32x16_bf16(b0, q, p0, 0, 0, 0);
    p1 = __builtin_amdgcn_mfma_f32_32x32x16_bf16(b1, q, p1, 0, 0, 0); }
}
template <int DQK, int QREG, int D0>
__device__ __forceinline__ void qk_issue(bf16x8 (&kl)[3], bf16x8 (&kh)[3], bf16x8 (&qf)[3], int kb, int s4, int s3, int hi16, int qxa) {
  constexpr int ROWB = Cfg<DQK>::ROWB;
  const int ad = kb + ((D0 * 32 + hi16) ^ (D0 < 8 ? s4 : s3));
  asm volatile("ds_read_b128 %0, %1" : "=v"(kl[D0 % 3]) : "v"(ad) : "memory");
  asm volatile("ds_read_b128 %0, %1 offset:%2" : "=v"(kh[D0 % 3]) : "v"(ad), "n"(32 * ROWB) : "memory");
  if constexpr (D0 >= QREG) asm volatile("ds_read_b128 %0, %1 offset:%2" : "=v"(qf[D0 % 3]) : "v"(qxa), "n"((D0 - QREG) * 1024) : "memory");
}
template <int DQK, int QREG, int D0>
__device__ __forceinline__ void qk_steps(f32x16& p0, f32x16& p1, bf16x8 (&kl)[3], bf16x8 (&kh)[3], bf16x8 (&qf)[3], const bf16x8* qr, int kb, int s4, int s3, int hi16, int qxa) {
  constexpr int ND = DQK / 16;
  if constexpr (D0 < ND) {
    constexpr int R1 = D0 + 1 < ND ? 2 + (D0 + 1 >= QREG ? 1 : 0) : 0, R2 = D0 + 2 < ND ? 2 + (D0 + 2 >= QREG ? 1 : 0) : 0;
    if constexpr (D0 >= QREG) asm volatile("s_waitcnt lgkmcnt(%3)" : "+v"(kl[D0 % 3]), "+v"(kh[D0 % 3]), "+v"(qf[D0 % 3]) : "n"(R1 + R2));
    else asm volatile("s_waitcnt lgkmcnt(%2)" : "+v"(kl[D0 % 3]), "+v"(kh[D0 % 3]) : "n"(R1 + R2));
    bf16x8 q; if constexpr (D0 < QREG) q = qr[D0]; else q = qf[D0 % 3];
    if constexpr (D0 == 0) { p0 = __builtin_amdgcn_mfma_f32_32x32x16_bf16(kl[0], q, f32x16{}, 0, 0, 0); p1 = __builtin_amdgcn_mfma_f32_32x32x16_bf16(kh[0], q, f32x16{}, 0, 0, 0); }
    else { p0 = __builtin_amdgcn_mfma_f32_32x32x16_bf16(kl[D0 % 3], q, p0, 0, 0, 0); p1 = __builtin_amdgcn_mfma_f32_32x32x16_bf16(kh[D0 % 3], q, p1, 0, 0, 0); }
    if constexpr (D0 + 3 < ND) qk_issue<DQK, QREG, D0 + 3>(kl, kh, qf, kb, s4, s3, hi16, qxa);
    qk_steps<DQK, QREG, D0 + 1>(p0, p1, kl, kh, qf, qr, kb, s4, s3, hi16, qxa);
  }
}
template <int DQK, int QREG>
__device__ __forceinline__ void qkt(f32x16& p0, f32x16& p1, const char* Ks, const bf16x8* qr, const char* qx, int r32, int hi) {
  constexpr int ROWB = Cfg<DQK>::ROWB;
  if constexpr ((DQK == 128 && !ATT_QKPIPE_GQA) || (DQK == 192 && !ATT_QKPIPE_MLA)) { qkt_plain<DQK, QREG>(p0, p1, Ks, qr, qx, r32, hi); return; }
  const int kb = (int)(unsigned)(uintptr_t)Ks + r32 * ROWB, s4 = (r32 & 15) << 4, s3 = (r32 & 7) << 4, hi16 = hi * 16, qxa = (int)(unsigned)(uintptr_t)qx;
  bf16x8 kl[3], kh[3], qf[3];
  qk_issue<DQK, QREG, 0>(kl, kh, qf, kb, s4, s3, hi16, qxa); qk_issue<DQK, QREG, 1>(kl, kh, qf, kb, s4, s3, hi16, qxa); qk_issue<DQK, QREG, 2>(kl, kh, qf, kb, s4, s3, hi16, qxa);
  qk_steps<DQK, QREG, 0>(p0, p1, kl, kh, qf, qr, kb, s4, s3, hi16, qxa);
}
__device__ __forceinline__ int v_st(int k, int c) { const int kk = (k & ~0xC) | ((k & 4) << 1) | ((k & 8) >> 1); return ((kk >> 3) * 4 + (c >> 5)) * 512 + ((kk & 7) * 32 + (c & 31)) * 2; }
__device__ __forceinline__ int v_rd_base(int lane) { return ((lane & 3) << 3) | (((lane >> 2) & 3) << 6) | (((lane >> 4) & 1) << 5) | (((lane >> 5) & 1) << 8); }
constexpr int v_rd_off(int d0, int ks, int half) { return d0 * 512 + ks * 4096 + half * 2048; }
template <int OFF> __device__ __forceinline__ s16x4 tr_read(int vb) {
  s16x4 r; asm volatile("ds_read_b64_tr_b16 %0, %1 offset:%2" : "=&v"(r) : "v"(vb), "i"(OFF) : "memory"); return r;
}
template <int D0> __device__ __forceinline__ void pv_one(f32x16& od, int vb, bf16x8 pa0, bf16x8 pa1, bf16x8 pa2, bf16x8 pa3) {
  const s16x4 l0 = tr_read<v_rd_off(D0, 0, 0)>(vb), h0 = tr_read<v_rd_off(D0, 0, 1)>(vb), l1 = tr_read<v_rd_off(D0, 1, 0)>(vb), h1 = tr_read<v_rd_off(D0, 1, 1)>(vb);
  const s16x4 l2 = tr_read<v_rd_off(D0, 2, 0)>(vb), h2 = tr_read<v_rd_off(D0, 2, 1)>(vb), l3 = tr_read<v_rd_off(D0, 3, 0)>(vb), h3 = tr_read<v_rd_off(D0, 3, 1)>(vb);
  asm volatile("s_waitcnt lgkmcnt(0)" ::: "memory"); SBAR();
#define PK(L, H) (bf16x8){L[0], L[1], L[2], L[3], H[0], H[1], H[2], H[3]}
  od = __builtin_amdgcn_mfma_f32_32x32x16_bf16(pa0, PK(l0, h0), od, 0, 0, 0);
  od = __builtin_amdgcn_mfma_f32_32x32x16_bf16(pa1, PK(l1, h1), od, 0, 0, 0);
  od = __builtin_amdgcn_mfma_f32_32x32x16_bf16(pa2, PK(l2, h2), od, 0, 0, 0);
  od = __builtin_amdgcn_mfma_f32_32x32x16_bf16(pa3, PK(l3, h3), od, 0, 0, 0);
#undef PK
}
__device__ __forceinline__ void pv_d0(f32x16* o, int vb, bf16x8 pa0, bf16x8 pa1, bf16x8 pa2, bf16x8 pa3) {
  pv_one<0>(o[0], vb, pa0, pa1, pa2, pa3); pv_one<1>(o[1], vb, pa0, pa1, pa2, pa3); pv_one<2>(o[2], vb, pa0, pa1, pa2, pa3); pv_one<3>(o[3], vb, pa0, pa1, pa2, pa3);
}

template <int DQK, int SDEPTH, int ldq, int ldk, int ldkr, int ldv, int ldo>
__device__ __forceinline__ void attn_body(const bf16_t* __restrict__ Qb, const bf16_t* __restrict__ Kh, const bf16_t* __restrict__ Kr,
                                          const bf16_t* __restrict__ Vh, unsigned char* __restrict__ Ob, int seq, char* lds, int qt0, const float* __restrict__ rt, const float* __restrict__ qg) {
  constexpr int ROWB = Cfg<DQK>::ROWB, SHM_K = Cfg<DQK>::SHM_K, SHM_V = Cfg<DQK>::SHM_V;
  constexpr bool X = DQK == 192; constexpr int QREG = Cfg<DQK>::QREG, QLDS = DQK / 16 - QREG;
  const int tid = opaque_v((int)threadIdx.x), wid = tid >> 6, lane = tid & 63, r32 = lane & 31, hi = lane >> 5;
  char* V_lds = lds; char* K_lds = lds + 2 * SHM_V;
  float* ws = (float*)(lds + 2 * SHM_V + 2 * SHM_K) + wid * 64; float* li_l = ws; float* al_l = ws + 32;
  float m_reg = -1e30f, l_reg = 0; f32x16 o[4] = {}; bf16x8 qr[QREG];
  const bf16_t* Qw = Qb + (long)(wid * QBLK + r32) * ldq + hi * 8;
  char* qx = lds + 2 * SHM_V + 2 * SHM_K + NW * 64 * 4 + wid * (QLDS * 1024) + lane * 16;
#pragma unroll
  for (int d0 = 0; d0 < QREG; ++d0) qr[d0] = *reinterpret_cast<const bf16x8*>(Qw + d0 * 16);
  if constexpr (X) {
#pragma unroll
    for (int d0 = QREG; d0 < 8; ++d0) *reinterpret_cast<bf16x8*>(qx + (d0 - QREG) * 1024) = *reinterpret_cast<const bf16x8*>(Qw + d0 * 16);
  }
  if constexpr (!X) {
    float ss = 0.f;
#pragma unroll
    for (int d0 = 0; d0 < 8; ++d0) { const u32x4 w = *reinterpret_cast<const u32x4*>(&qr[d0]);
#pragma unroll
      for (int q = 0; q < 4; ++q) { const float x0 = __uint_as_float(w[q] << 16), x1 = __uint_as_float(w[q] & 0xffff0000u); ss += x0 * x0 + x1 * x1; } }
    ss += __shfl_xor(ss, 32);
    const float rstd = 1.0f / sqrtf(ss * (1.0f / 128.0f) + 1e-6f);
    const int t = qt0 >= 0 ? qt0 + wid * QBLK + r32 : 0;
#pragma unroll
    for (int d0 = 0; d0 < 8; ++d0) { u32x4 w = *reinterpret_cast<const u32x4*>(&qr[d0]);
      const f32x4 g0 = *reinterpret_cast<const f32x4*>(qg + d0 * 16 + hi * 8), g1 = *reinterpret_cast<const f32x4*>(qg + d0 * 16 + hi * 8 + 4);
      const int pos = d0 < 4 ? (t >> 6) : (t & 63), ti = pos * 32 + (d0 & 3) * 8 + hi * 4; const f32x4 cs = *reinterpret_cast<const f32x4*>(rt + ti), sn = *reinterpret_cast<const f32x4*>(rt + 2048 + ti);
      const float gg[8] = {g0[0], g0[1], g0[2], g0[3], g1[0], g1[1], g1[2], g1[3]};
#pragma unroll
      for (int q = 0; q < 4; ++q) { const float x0 = __uint_as_float(w[q] << 16) * rstd * gg[2 * q], x1 = __uint_as_float(w[q] & 0xffff0000u) * rstd * gg[2 * q + 1]; w[q] = cvtpk(x0 * cs[q] - x1 * sn[q], x0 * sn[q] + x1 * cs[q]); }
      qr[d0] = *reinterpret_cast<const bf16x8*>(&w); }
  }
  if constexpr (X) {
#pragma unroll
    for (int d0 = 8; d0 < 12; ++d0) {
      u32x4 w = *reinterpret_cast<const u32x4*>(Qw + d0 * 16);
      { const int t = qt0 >= 0 ? qt0 + wid * QBLK + r32 : 0, j0 = (d0 - 8) * 8 + hi * 4, pos = d0 < 10 ? (t >> 6) : (t & 63), ti = pos * 16 + (j0 & 15);
        const f32x4 cs = *reinterpret_cast<const f32x4*>(rt + ti), sn = *reinterpret_cast<const f32x4*>(rt + 1024 + ti);
#pragma unroll
        for (int q = 0; q < 4; ++q) { const float x0 = __uint_as_float(w[q] << 16), x1 = __uint_as_float(w[q] & 0xffff0000u); w[q] = cvtpk(x0 * cs[q] - x1 * sn[q], x0 * sn[q] + x1 * cs[q]); } }
      *reinterpret_cast<u32x4*>(qx + (d0 - QREG) * 1024) = w; }
  }
  const int sr = tid >> 4, sc = (tid & 15) * 8, vst0 = v_st(sr, sc), vst1 = v_st(32 + sr, sc);
  const int xr = tid >> 3, xc = (tid & 7) * 8;
  const int vb0 = (int)(uintptr_t)V_lds + v_rd_base(lane);
  struct { bf16x8 vs0, vs1, ks0, ks1, kx; } sr_[SDEPTH];
#define LD8(p) (*reinterpret_cast<const bf16x8*>(p))
#define SLOAD(i, k0) do { sr_[i].vs0 = LD8(&Vh[(long)((k0) + sr) * ldv + sc]); sr_[i].vs1 = LD8(&Vh[(long)((k0) + 32 + sr) * ldv + sc]); \
    sr_[i].ks0 = LD8(&Kh[(long)((k0) + sr) * ldk + sc]); sr_[i].ks1 = LD8(&Kh[(long)((k0) + 32 + sr) * ldk + sc]); \
    if constexpr (X) sr_[i].kx = LD8(&Kr[(long)((k0) + xr) * ldkr + xc]); } while (0)
#define SWRITE(b, i) do { *(bf16x8*)(V_lds + (b) * SHM_V + vst0) = sr_[i].vs0;          \
    *(bf16x8*)(V_lds + (b) * SHM_V + vst1) = sr_[i].vs1; int kc = sc * 2;               \
    *(bf16x8*)(K_lds + (b) * SHM_K + KSWZ(sr, kc)) = sr_[i].ks0;                       \
    *(bf16x8*)(K_lds + (b) * SHM_K + KSWZ(32 + sr, kc)) = sr_[i].ks1;                  \
    if constexpr (X) { int kx_ = 256 + xc * 2; *(bf16x8*)(K_lds + (b) * SHM_K + KSWZ(xr, kx_)) = sr_[i].kx; } } while (0)
#define SWAIT() do { if constexpr (SDEPTH == 2) { if constexpr (X) asm volatile("s_waitcnt vmcnt(5)" ::: "memory"); else asm volatile("s_waitcnt vmcnt(4)" ::: "memory"); } else asm volatile("s_waitcnt vmcnt(0)" ::: "memory"); } while (0)
#define RESC(a) do { if (__any((a) < 1.f)) { if (hi == 0) al_l[r32] = (a); asm volatile("s_waitcnt lgkmcnt(0)" ::: "memory"); \
    _Pragma("unroll") for (int d = 0; d < 4; ++d) _Pragma("unroll") for (int r = 0; r < 16; ++r) o[d][r] *= al_l[crow(r, hi)]; } } while (0)
  f32x16 pA0, pA1, pB0, pB1; float mnA, mnB, alA, alB; bf16x8 pa0, pa1, pa2, pa3; const int NT = seq / KVBLK;
  constexpr int SE = 0, SO = SDEPTH - 1;
  SLOAD(SE, 0); asm volatile("s_waitcnt vmcnt(0)" ::: "memory"); SWRITE(0, SE); __syncthreads();
  qkt<DQK, QREG>(pA0, pA1, K_lds, qr, qx, r32, hi); partialSM<DQK>(pA0, pA1, m_reg, mnA, alA);
  SLOAD(SO, KVBLK); if constexpr (SDEPTH == 2) { if (2 < NT) SLOAD(SE, 2 * KVBLK); }
  SWAIT(); SWRITE(1, SO); __syncthreads();
  for (int j = 1; j + 1 < NT; j += 2) {
    SBAR(); qkt<DQK, QREG>(pB0, pB1, K_lds + SHM_K, qr, qx, r32, hi);
    finishSM(pA0, pA1, alA, l_reg, pa0, pa1, pa2, pa3); SBAR();
    SLOAD(SO, (j + SDEPTH) * KVBLK); SBAR();
    pv_d0(o, vb0, pa0, pa1, pa2, pa3); partialSM<DQK>(pB0, pB1, m_reg, mnB, alB);
    __syncthreads(); SWAIT(); SWRITE(0, SE);
    RESC(alB); __syncthreads();
    SBAR(); qkt<DQK, QREG>(pA0, pA1, K_lds, qr, qx, r32, hi);
    finishSM(pB0, pB1, alB, l_reg, pa0, pa1, pa2, pa3); SBAR();
    if (SDEPTH == 1 || j + 3 < NT) SLOAD(SE, (j + 1 + SDEPTH) * KVBLK); SBAR();
    pv_d0(o, vb0 + (int)SHM_V, pa0, pa1, pa2, pa3); partialSM<DQK>(pA0, pA1, m_reg, mnA, alA);
    __syncthreads(); SWAIT(); SWRITE(1, SO);
    RESC(alA); __syncthreads();
  }
  SBAR(); qkt<DQK, QREG>(pB0, pB1, K_lds + SHM_K, qr, qx, r32, hi);
  finishSM(pA0, pA1, alA, l_reg, pa0, pa1, pa2, pa3); SBAR();
  pv_d0(o, vb0, pa0, pa1, pa2, pa3); partialSM<DQK>(pB0, pB1, m_reg, mnB, alB);
  __syncthreads(); RESC(alB);
  finishSM(pB0, pB1, alB, l_reg, pa0, pa1, pa2, pa3); SBAR();
  pv_d0(o, vb0 + (int)SHM_V, pa0, pa1, pa2, pa3);
  if (hi == 0) li_l[r32] = l_reg; asm volatile("s_waitcnt lgkmcnt(0)" ::: "memory");
  float rli[16];
#pragma unroll
  for (int r = 0; r < 16; ++r) rli[r] = __builtin_amdgcn_rcpf(li_l[crow(r, hi)]);
  unsigned char* Ow = Ob + (long)(wid * QBLK) * ldo;
#pragma unroll
  for (int r = 0; r < 16; ++r) { int orow = crow(r, hi);
#pragma unroll
    for (int d0 = 0; d0 < 4; ++d0) { const float ov = __builtin_fminf(__builtin_fmaxf(o[d0][r] * rli[r] * AO_SCALE, -448.f), 448.f); Ow[(long)orow * ldo + d0 * 32 + r32] = (unsigned char)(__builtin_amdgcn_cvt_pk_fp8_f32(ov, 0.f, 0, false) & 0xff); } }
#undef LD8
#undef SLOAD
#undef SWRITE
#undef SWAIT
#undef RESC
}
#undef KSWZ
}
#ifndef A2_RS_GQA
#define A2_RS_GQA 0
#endif
#ifndef A2_SPREAD
#define A2_SPREAD 0
#endif
#ifndef A2_PKSM
#define A2_PKSM 0
#endif
#ifndef A2_BUF
#define A2_BUF 1
#endif
#ifndef A2_RS_MLA
#define A2_RS_MLA 0
#endif
namespace att2 {
#if defined(PROBE_SEL) && PROBE_SEL >= 50 && PROBE_SEL <= 59
#define A2_T(n) do { if (wid == 0) { const unsigned long long t_ = __builtin_amdgcn_s_memrealtime(); if ((n) == PROBE_SEL - 49) pacc += t_ - a2_t; a2_t = t_; } } while (0)
#define A2_TDECL unsigned long long a2_t = 0ull;
#if PROBE_SEL == 54
#define A2_TQ() do { __builtin_amdgcn_sched_barrier(0); if (wid == 0) { pacc += __builtin_amdgcn_s_memrealtime() - a2_t; } } while (0)
#else
#define A2_TQ() do { } while (0)
#endif
#if PROBE_SEL >= 56
#define A2_TX(n) A2_T(n)
#define A2_T3() A2_T(9)
#else
#define A2_TX(n) do { } while (0)
#define A2_T3() A2_T(3)
#endif
#else
#define A2_TX(n) do { } while (0)
#define A2_T3() do { } while (0)
#define A2_TQ() do { } while (0)
#define A2_T(n) do { } while (0)
#define A2_TDECL
#endif
using att::Cfg; using att::crow; using att::cvtpk; using att::v_rd_base; using att::pv_d0;
typedef LAS char LASc; typedef LAS bf16x8 LASv;
constexpr int NW = 8, QBLK = 32, KVBLK = 64;
constexpr float THR = 8.f;
#define KSWZ2(row, colB) ((row) * ROWB + ((colB) ^ (((row) & 7) << 4)))
#define A2_BAR() do { asm volatile("" ::: "memory"); __builtin_amdgcn_sched_barrier(0); __builtin_amdgcn_s_barrier(); __builtin_amdgcn_sched_barrier(0); asm volatile("" ::: "memory"); } while (0)

template <int DQK>
__device__ __forceinline__ void qk_tile(f32x16& p0, f32x16& p1, const LASc* Ks, const bf16x8* qr, int r32, int hi) {
  constexpr int ROWB = Cfg<DQK>::ROWB;
  const int kb = (int)(unsigned)(size_t)Ks + r32 * ROWB, s3 = (r32 & 7) << 4, hi16 = hi * 16;
  bf16x8 kl[3], kh[3], qf[3];
  att::qk_issue<DQK, DQK / 16, 0>(kl, kh, qf, kb, s3, s3, hi16, 0); att::qk_issue<DQK, DQK / 16, 1>(kl, kh, qf, kb, s3, s3, hi16, 0); att::qk_issue<DQK, DQK / 16, 2>(kl, kh, qf, kb, s3, s3, hi16, 0);
  att::qk_steps<DQK, DQK / 16, 0>(p0, p1, kl, kh, qf, qr, kb, s3, s3, hi16, 0);
}
template <int DQK, class HOOK>
__device__ __forceinline__ void softmax_tile(f32x16& p0, f32x16& p1, float& m_reg, float& l_reg, float& alpha, bf16x8& pa0, bf16x8& pa1, bf16x8& pa2, bf16x8& pa3, HOOK&& hook) {
  constexpr float C = Cfg<DQK>::C, SCALE = Cfg<DQK>::SCALE;
  float pmax = p0[0];
#pragma unroll
  for (int r = 1; r < 16; ++r) pmax = fmaxf(pmax, p0[r]);
#pragma unroll
  for (int r = 0; r < 16; ++r) pmax = fmaxf(pmax, p1[r]);
  { auto rr = __builtin_amdgcn_permlane32_swap(__float_as_uint(pmax), __float_as_uint(pmax), false, false);
    pmax = fmaxf(__uint_as_float(rr[0]), __uint_as_float(rr[1])); }
  float mn;
  if (__builtin_expect(__all(pmax - m_reg <= THR / SCALE), 1)) { mn = m_reg; alpha = 1.f; }
  else { mn = fmaxf(m_reg, pmax); alpha = __builtin_amdgcn_exp2f((m_reg - mn) * C); m_reg = mn; }
  const float mnC = -mn * C;
#if A2_PKSM
  const f32x2 Cv = {C, C}, Mv = {mnC, mnC}; f32x2 ps2 = {0.f, 0.f};
#pragma unroll
  for (int r = 0; r < 16; r += 2) { f32x2 t = {p0[r], p0[r + 1]}; t = __builtin_elementwise_fma(t, Cv, Mv); p0[r] = __builtin_amdgcn_exp2f(t[0]); p0[r + 1] = __builtin_amdgcn_exp2f(t[1]); }
#pragma unroll
  for (int r = 0; r < 16; r += 2) { f32x2 t = {p1[r], p1[r + 1]}; t = __builtin_elementwise_fma(t, Cv, Mv); p1[r] = __builtin_amdgcn_exp2f(t[0]); p1[r + 1] = __builtin_amdgcn_exp2f(t[1]); }
#pragma unroll
  for (int r = 0; r < 16; r += 2) { const f32x2 t = {p0[r], p0[r + 1]}; ps2 += t; }
#pragma unroll
  for (int r = 0; r < 16; r += 2) { const f32x2 t = {p1[r], p1[r + 1]}; ps2 += t; }
  float ps = ps2[0] + ps2[1];
#else
  hook(0);
#pragma unroll
  for (int r = 0; r < 8; ++r) p0[r] = __builtin_amdgcn_exp2f(fmaf(p0[r], C, mnC));
  hook(1);
#pragma unroll
  for (int r = 8; r < 16; ++r) p0[r] = __builtin_amdgcn_exp2f(fmaf(p0[r], C, mnC));
  hook(2);
#pragma unroll
  for (int r = 0; r < 8; ++r) p1[r] = __builtin_amdgcn_exp2f(fmaf(p1[r], C, mnC));
  hook(3);
#pragma unroll
  for (int r = 8; r < 16; ++r) p1[r] = __builtin_amdgcn_exp2f(fmaf(p1[r], C, mnC));
  hook(4);
  float ps = 0;
#pragma unroll
  for (int r = 0; r < 16; ++r) ps += p0[r];
#pragma unroll
  for (int r = 0; r < 16; ++r) ps += p1[r];
#endif
  { auto rr = __builtin_amdgcn_permlane32_swap(__float_as_uint(ps), __float_as_uint(ps), false, false);
    ps = __uint_as_float(rr[0]) + __uint_as_float(rr[1]); }
  l_reg = l_reg * alpha + ps;
#define PK4(P, BASE, OUT) do { unsigned a0 = cvtpk(P[BASE + 0], P[BASE + 1]), a1 = cvtpk(P[BASE + 2], P[BASE + 3]);   \
    unsigned b0 = cvtpk(P[BASE + 4], P[BASE + 5]), b1 = cvtpk(P[BASE + 6], P[BASE + 7]);                              \
    auto r0 = __builtin_amdgcn_permlane32_swap(a0, b0, false, false); auto r1 = __builtin_amdgcn_permlane32_swap(a1, b1, false, false); \
    u32x4 w = {r0[0], r1[0], r0[1], r1[1]}; OUT = *reinterpret_cast<bf16x8*>(&w); } while (0)
  PK4(p0, 0, pa0); PK4(p0, 8, pa1); PK4(p1, 0, pa2); PK4(p1, 8, pa3);
#undef PK4
}

struct VFrag { s16x4 l0, h0, l1, h1, l2, h2, l3, h3; };
template <int D0> __device__ __forceinline__ void pv_reads(VFrag& f, int vb) {
  using att::tr_read; using att::v_rd_off;
  f.l0 = tr_read<v_rd_off(D0, 0, 0)>(vb); f.h0 = tr_read<v_rd_off(D0, 0, 1)>(vb); f.l1 = tr_read<v_rd_off(D0, 1, 0)>(vb); f.h1 = tr_read<v_rd_off(D0, 1, 1)>(vb);
  f.l2 = tr_read<v_rd_off(D0, 2, 0)>(vb); f.h2 = tr_read<v_rd_off(D0, 2, 1)>(vb); f.l3 = tr_read<v_rd_off(D0, 3, 0)>(vb); f.h3 = tr_read<v_rd_off(D0, 3, 1)>(vb);
}
__device__ __forceinline__ void pv_mma(f32x16& od, const VFrag& f, bf16x8 pa0, bf16x8 pa1, bf16x8 pa2, bf16x8 pa3) {
#define PK(L, H) (bf16x8){L[0], L[1], L[2], L[3], H[0], H[1], H[2], H[3]}
  od = __builtin_amdgcn_mfma_f32_32x32x16_bf16(pa0, PK(f.l0, f.h0), od, 0, 0, 0);
  od = __builtin_amdgcn_mfma_f32_32x32x16_bf16(pa1, PK(f.l1, f.h1), od, 0, 0, 0);
  od = __builtin_amdgcn_mfma_f32_32x32x16_bf16(pa2, PK(f.l2, f.h2), od, 0, 0, 0);
  od = __builtin_amdgcn_mfma_f32_32x32x16_bf16(pa3, PK(f.l3, f.h3), od, 0, 0, 0);
#undef PK
}
__device__ __forceinline__ void pv_pipe(f32x16* o, int vb, bf16x8 pa0, bf16x8 pa1, bf16x8 pa2, bf16x8 pa3) {
  VFrag fa, fb;
  pv_reads<0>(fa, vb); pv_reads<1>(fb, vb);
  asm volatile("s_waitcnt lgkmcnt(8)" ::: "memory"); __builtin_amdgcn_sched_barrier(0); pv_mma(o[0], fa, pa0, pa1, pa2, pa3); __builtin_amdgcn_sched_barrier(0);
  pv_reads<2>(fa, vb);
  asm volatile("s_waitcnt lgkmcnt(8)" ::: "memory"); __builtin_amdgcn_sched_barrier(0); pv_mma(o[1], fb, pa0, pa1, pa2, pa3); __builtin_amdgcn_sched_barrier(0);
  pv_reads<3>(fb, vb);
  asm volatile("s_waitcnt lgkmcnt(8)" ::: "memory"); __builtin_amdgcn_sched_barrier(0); pv_mma(o[2], fa, pa0, pa1, pa2, pa3); __builtin_amdgcn_sched_barrier(0);
  asm volatile("s_waitcnt lgkmcnt(0)" ::: "memory"); __builtin_amdgcn_sched_barrier(0); pv_mma(o[3], fb, pa0, pa1, pa2, pa3);
}

template <int DQK, int ldq, int ldk, int ldkr, int ldv, int ldo>
__device__ __forceinline__ void attn_body2(const bf16_t* __restrict__ Qb, const bf16_t* __restrict__ Kh, const bf16_t* __restrict__ Kr, const bf16_t* __restrict__ Vh,
                                           unsigned char* __restrict__ Ob, int seq, LAS unsigned char* lds, int qt0, const float* __restrict__ rt, const float* __restrict__ qg, unsigned long long& pacc) {
  constexpr int ROWB = Cfg<DQK>::ROWB, SHM_K = Cfg<DQK>::SHM_K, SHM_V = Cfg<DQK>::SHM_V, NKI = SHM_K / 8192, NVI = SHM_V / 8192, NDMA = NKI + NVI, NQ = DQK / 16;
  constexpr bool X = DQK == 192;
  constexpr bool A2_REGSTAGE = X ? (A2_RS_MLA != 0) : (A2_RS_GQA != 0);
  constexpr int NSK = A2_REGSTAGE ? 3 : 4, NSV = A2_REGSTAGE ? 3 : (X ? 3 : 4);
  constexpr int NW_K = (NSK - 3) * NDMA, NW_V = (NSV - 3) * NDMA + NKI, NWAIT_M = NW_K < NW_V ? NW_K : NW_V, NWAIT_V = NWAIT_M + NDMA;
  static_assert(A2_REGSTAGE || (NSK >= 4 && NSV >= 3), "ring depths");
  static_assert(NSK == NSV || NSK == NSV + 1, "ring depths");
  constexpr int K_OFF = 0, V_OFF = NSK * SHM_K, WS_OFF = V_OFF + NSV * SHM_V;
  const int tid = opaque_v((int)threadIdx.x), wid = __builtin_amdgcn_readfirstlane(tid >> 6), lane = tid & 63, r32 = lane & 31, hi = lane >> 5, grp = wid >> 2;
  LAS float* ws = (LAS float*)(lds + WS_OFF) + wid * 64; LAS float* li_l = ws; LAS float* al_l = ws + 32;
  const char* srcK[NKI]; int stepK[NKI];
#pragma unroll
  for (int i = 0; i < NKI; ++i) { const int P = i * 8192 + wid * 1024 + lane * 16, row = P / ROWB, cbs = P - row * ROWB, cb = cbs ^ ((row & 7) << 4);
    if (X && cb >= 256) { srcK[i] = (const char*)Kr + (size_t)row * (ldkr * 2) + (cb - 256); stepK[i] = KVBLK * ldkr * 2; }
    else { srcK[i] = (const char*)Kh + (size_t)row * (ldk * 2) + cb; stepK[i] = KVBLK * ldk * 2; } }
  const char* srcV[NVI];
#pragma unroll
  for (int i = 0; i < NVI; ++i) { const int P = i * 8192 + wid * 1024 + lane * 16, sub = P >> 9, kkh = sub >> 2, cblk = sub & 3, win = P & 511, kkl = win >> 6, cl = (win & 63) >> 1;
    const int kk = kkh * 8 + kkl, k = (kk & ~0xC) | ((kk & 4) << 1) | ((kk & 8) >> 1), c = cblk * 32 + cl;
    srcV[i] = (const char*)Vh + (size_t)k * (ldv * 2) + c * 2; }
#if A2_BUF
  unsigned long long b0_ = (unsigned long long)(size_t)Kh; { const unsigned long long v_ = (unsigned long long)(size_t)Vh, r_ = X ? (unsigned long long)(size_t)Kr : b0_; b0_ = b0_ < v_ ? b0_ : v_; b0_ = b0_ < r_ ? b0_ : r_; }
  const unsigned b0lo = __builtin_amdgcn_readfirstlane((unsigned)b0_), b0hi = __builtin_amdgcn_readfirstlane((unsigned)(b0_ >> 32));
  const char* B0 = (const char*)(size_t)(((unsigned long long)b0hi << 32) | b0lo);
  const __amdgpu_buffer_rsrc_t rsrc = __builtin_amdgcn_make_buffer_rsrc((void*)B0, 0, -1, 0x00020000);
  unsigned offK[NKI], offV[NVI];
#pragma unroll
  for (int i = 0; i < NKI; ++i) offK[i] = (unsigned)(srcK[i] - B0);
#pragma unroll
  for (int i = 0; i < NVI; ++i) offV[i] = (unsigned)(srcV[i] - B0);
#define A2_ISSUE_K(t, st) do { _Pragma("unroll") for (int _i = 0; _i < NKI; ++_i) \
    __builtin_amdgcn_raw_ptr_buffer_load_lds(rsrc, (LAS void*)(lds + K_OFF + (st) * SHM_K + _i * 8192 + wid * 1024), 16, (int)(offK[_i] + __umul24((unsigned)(t), (unsigned)stepK[_i])), 0, 0, 0); } while (0)
#define A2_ISSUE_V(t, st) do { _Pragma("unroll") for (int _i = 0; _i < NVI; ++_i) \
    __builtin_amdgcn_raw_ptr_buffer_load_lds(rsrc, (LAS void*)(lds + V_OFF + (st) * SHM_V + _i * 8192 + wid * 1024), 16, (int)offV[_i], (int)((t) * (KVBLK * ldv * 2)), 0, 0); } while (0)
#else
#define A2_ISSUE_K(t, st) do { _Pragma("unroll") for (int _i = 0; _i < NKI; ++_i) \
    __builtin_amdgcn_global_load_lds((const unsigned*)(srcK[_i] + (size_t)(t) * stepK[_i]), (LAS unsigned*)(lds + K_OFF + (st) * SHM_K + _i * 8192 + wid * 1024), 16, 0, 0); } while (0)
#define A2_ISSUE_V(t, st) do { _Pragma("unroll") for (int _i = 0; _i < NVI; ++_i) \
    __builtin_amdgcn_global_load_lds((const unsigned*)(srcV[_i] + (size_t)(t) * (KVBLK * ldv * 2)), (LAS unsigned*)(lds + V_OFF + (st) * SHM_V + _i * 8192 + wid * 1024), 16, 0, 0); } while (0)
#endif
  u32x4 rgK[NKI], rgV[NVI];
#define A2_LOAD_K(t) do { _Pragma("unroll") for (int _i = 0; _i < NKI; ++_i) rgK[_i] = *(const u32x4*)(srcK[_i] + (size_t)(t) * stepK[_i]); } while (0)
#define A2_LOAD_V(t) do { _Pragma("unroll") for (int _i = 0; _i < NVI; ++_i) rgV[_i] = *(const u32x4*)(srcV[_i] + (size_t)(t) * (KVBLK * ldv * 2)); } while (0)
#define A2_WRITE_K(st) do { _Pragma("unroll") for (int _i = 0; _i < NKI; ++_i) *(LAS u32x4*)(lds + K_OFF + (st) * SHM_K + _i * 8192 + wid * 1024 + lane * 16) = rgK[_i]; } while (0)
#define A2_WRITE_V(st) do { _Pragma("unroll") for (int _i = 0; _i < NVI; ++_i) *(LAS u32x4*)(lds + V_OFF + (st) * SHM_V + _i * 8192 + wid * 1024 + lane * 16) = rgV[_i]; } while (0)
  const int NT = seq / KVBLK; A2_TDECL
  asm volatile("s_waitcnt vmcnt(0) lgkmcnt(0)" ::: "memory"); A2_BAR();
  if constexpr (A2_REGSTAGE) {
    A2_LOAD_K(0); A2_LOAD_V(0); A2_WRITE_K(0); A2_WRITE_V(0);
    A2_LOAD_K(NT > 1 ? 1 : 0); A2_WRITE_K(1);
    A2_LOAD_K(NT > 2 ? 2 : NT - 1); A2_LOAD_V(NT > 1 ? 1 : 0);
  } else {
#pragma unroll
  for (int t = 0; t < NSV - 2; ++t) A2_ISSUE_V(t < NT ? t : NT - 1, t);
#pragma unroll
  for (int t = 0; t < NSK - 1; ++t) A2_ISSUE_K(t < NT ? t : NT - 1, t);
  }
  float m_reg = -1e30f, l_reg = 0; f32x16 o[4] = {}; bf16x8 qr[NQ];
  const bf16_t* Qw = Qb + (long)(wid * QBLK + r32) * ldq + hi * 8;
#pragma unroll
  for (int d0 = 0; d0 < NQ; ++d0) qr[d0] = *reinterpret_cast<const bf16x8*>(Qw + d0 * 16);
  if constexpr (!X) {
    float ss = 0.f;
#pragma unroll
    for (int d0 = 0; d0 < 8; ++d0) { const u32x4 w = *reinterpret_cast<const u32x4*>(&qr[d0]);
#pragma unroll
      for (int q = 0; q < 4; ++q) { const float x0 = __uint_as_float(w[q] << 16), x1 = __uint_as_float(w[q] & 0xffff0000u); ss += x0 * x0 + x1 * x1; } }
    ss += __shfl_xor(ss, 32);
    const float rstd = 1.0f / sqrtf(ss * (1.0f / 128.0f) + 1e-6f);
    const int t = qt0 >= 0 ? qt0 + wid * QBLK + r32 : 0;
#pragma unroll
    for (int d0 = 0; d0 < 8; ++d0) { u32x4 w = *reinterpret_cast<const u32x4*>(&qr[d0]);
      const f32x4 g0 = *reinterpret_cast<const f32x4*>(qg + d0 * 16 + hi * 8), g1 = *reinterpret_cast<const f32x4*>(qg + d0 * 16 + hi * 8 + 4);
      const int pos = d0 < 4 ? (t >> 6) : (t & 63), ti = pos * 32 + (d0 & 3) * 8 + hi * 4; const f32x4 cs = *reinterpret_cast<const f32x4*>(rt + ti), sn = *reinterpret_cast<const f32x4*>(rt + 2048 + ti);
      const float gg[8] = {g0[0], g0[1], g0[2], g0[3], g1[0], g1[1], g1[2], g1[3]};
#pragma unroll
      for (int q = 0; q < 4; ++q) { const float x0 = __uint_as_float(w[q] << 16) * rstd * gg[2 * q], x1 = __uint_as_float(w[q] & 0xffff0000u) * rstd * gg[2 * q + 1]; w[q] = cvtpk(x0 * cs[q] - x1 * sn[q], x0 * sn[q] + x1 * cs[q]); }
      qr[d0] = *reinterpret_cast<const bf16x8*>(&w); }
  } else {
    { const int t = qt0 >= 0 ? qt0 + wid * QBLK + r32 : 0;
#pragma unroll
      for (int d0 = 8; d0 < 12; ++d0) { u32x4 w = *reinterpret_cast<const u32x4*>(&qr[d0]);
        const int j0 = (d0 - 8) * 8 + hi * 4, pos = d0 < 10 ? (t >> 6) : (t & 63), ti = pos * 16 + (j0 & 15);
        const f32x4 cs = *reinterpret_cast<const f32x4*>(rt + ti), sn = *reinterpret_cast<const f32x4*>(rt + 1024 + ti);
#pragma unroll
        for (int q = 0; q < 4; ++q) { const float x0 = __uint_as_float(w[q] << 16), x1 = __uint_as_float(w[q] & 0xffff0000u); w[q] = cvtpk(x0 * cs[q] - x1 * sn[q], x0 * sn[q] + x1 * cs[q]); }
        qr[d0] = *reinterpret_cast<const bf16x8*>(&w); } }
  }
  asm volatile("s_waitcnt vmcnt(0) lgkmcnt(0)" ::: "memory"); A2_BAR();
  if (grp == 1) A2_BAR();
  const int vb0 = (int)(unsigned)(size_t)(lds + V_OFF) + v_rd_base(lane);
  f32x16 s0, s1; bf16x8 pa0, pa1, pa2, pa3; float alpha;
  int kst = 0, kis = NSK - 1, vst = NSV - 1, vis = NSV - 2;
#pragma unroll 1
  for (int i = 0; i < NT; ++i) {
    A2_T(0);
    __builtin_amdgcn_s_setprio(1);
    qk_tile<DQK>(s0, s1, (const LASc*)(lds + K_OFF + kst * SHM_K), qr, r32, hi);
    A2_TQ();
    if (i > 0) pv_pipe(o, vb0 + vst * SHM_V, pa0, pa1, pa2, pa3);
    __builtin_amdgcn_s_setprio(0);
    A2_T(1);
    if constexpr (!A2_REGSTAGE) asm volatile("s_waitcnt vmcnt(%0)" :: "n"(NWAIT_M) : "memory");
    A2_BAR();
    A2_T(2);
    const int tv_ = i + NSV - 2 < NT ? i + NSV - 2 : NT - 1, tk_ = i + NSK - 1 < NT ? i + NSK - 1 : NT - 1;
    softmax_tile<DQK>(s0, s1, m_reg, l_reg, alpha, pa0, pa1, pa2, pa3, [&](const int k) {
      if constexpr (!A2_REGSTAGE && A2_SPREAD) {
        __builtin_amdgcn_sched_barrier(0);
        if (k < NVI) __builtin_amdgcn_global_load_lds((const unsigned*)(srcV[k] + (size_t)tv_ * (KVBLK * ldv * 2)), (LAS unsigned*)(lds + V_OFF + vis * SHM_V + k * 8192 + wid * 1024), 16, 0, 0);
        else if (k - NVI < NKI) __builtin_amdgcn_global_load_lds((const unsigned*)(srcK[k - NVI] + (size_t)tk_ * stepK[k - NVI]), (LAS unsigned*)(lds + K_OFF + kis * SHM_K + (k - NVI) * 8192 + wid * 1024), 16, 0, 0);
        __builtin_amdgcn_sched_barrier(0);
      } });
    A2_TX(7);
    if (__any(alpha < 1.f)) { if (hi == 0) al_l[r32] = alpha; asm volatile("s_waitcnt lgkmcnt(0)" ::: "memory");
#pragma unroll
      for (int d = 0; d < 4; ++d)
#pragma unroll
        for (int r = 0; r < 16; ++r) o[d][r] *= al_l[crow(r, hi)]; }
    __builtin_amdgcn_sched_barrier(0);
    A2_TX(8);
    if constexpr (A2_REGSTAGE) {
      A2_WRITE_V(vis); A2_WRITE_K(kis);
      __builtin_amdgcn_sched_barrier(0);
      { const int tv = i + 2 < NT ? i + 2 : NT - 1, tk = i + 3 < NT ? i + 3 : NT - 1; A2_LOAD_V(tv); A2_LOAD_K(tk); }
      A2_T3();
      asm volatile("s_waitcnt lgkmcnt(0)" ::: "memory"); A2_BAR();
    } else {
    if constexpr (!A2_SPREAD) { A2_ISSUE_V(tv_, vis); A2_ISSUE_K(tk_, kis); }
    A2_T3();
    asm volatile("s_waitcnt vmcnt(%0)" :: "n"(NWAIT_V) : "memory"); A2_BAR();
    }
    A2_T(4);
    kst = kst == NSK - 1 ? 0 : kst + 1; kis = kis == NSK - 1 ? 0 : kis + 1; vst = vst == NSV - 1 ? 0 : vst + 1; vis = vis == NSV - 1 ? 0 : vis + 1;
  }
  if (grp == 0) A2_BAR();
  pv_pipe(o, vb0 + vst * SHM_V, pa0, pa1, pa2, pa3);
  if (hi == 0) li_l[r32] = l_reg; asm volatile("s_waitcnt lgkmcnt(0)" ::: "memory");
  float rli[16];
#pragma unroll
  for (int r = 0; r < 16; ++r) rli[r] = __builtin_amdgcn_rcpf(li_l[crow(r, hi)]);
  unsigned char* Ow = Ob + (long)(wid * QBLK) * ldo;
#pragma unroll
  for (int r = 0; r < 16; ++r) { const int orow = crow(r, hi);
#pragma unroll
    for (int d0 = 0; d0 < 4; ++d0) { const float ov = __builtin_fminf(__builtin_fmaxf(o[d0][r] * rli[r] * AO_SCALE, -448.f), 448.f); Ow[(long)orow * ldo + d0 * 32 + r32] = (unsigned char)(__builtin_amdgcn_cvt_pk_fp8_f32(ov, 0.f, 0, false) & 0xff); } }
#undef A2_ISSUE_K
#undef A2_ISSUE_V
#undef A2_LOAD_K
#undef A2_LOAD_V
#undef A2_WRITE_K
#undef A2_WRITE_V
}
#undef KSWZ2
#undef A2_BAR
}
#ifndef TOPK_DYN
#define TOPK_DYN 0
#endif
struct Frame {
    LAS unsigned char* lds;
    int tid, lane, wave, vcu, G, gw, ngw;
    float* out;
    unsigned char* ws;
};
enum { I_X = 0, I_C, I_CTX, I_CCTX, I_ADAW, I_ADAB, I_LMG, I_LMB, I_LFG, I_LFB, I_RW, I_WG, I_WU, I_WDN, I_GQKV, I_GQG, I_GKG, I_GWO, I_MDQ, I_MQG, I_MUQ, I_MDKV, I_MKVG, I_MUKV, I_MWO };

__device__ __forceinline__ u32x2 pack4(const f32x4 v) { u32x2 w; w.x = cvt_pk_bf16(v[0], v[1]); w.y = cvt_pk_bf16(v[2], v[3]); return w; }
__device__ __forceinline__ f32x4 unpack4(const u32x2 w) { return (f32x4){__uint_as_float(w.x << 16), __uint_as_float(w.x & 0xffff0000u), __uint_as_float(w.y << 16), __uint_as_float(w.y & 0xffff0000u)}; }
__device__ __forceinline__ float silu_f(float x) { return x / (1.0f + __expf(-x)); }

__device__ __forceinline__ void transpose_item(const float* W, int N, const float* g, bf16_t* dst, int ldd, int row_off, int il, LAS float* scr, int item, int lane) {
    const int nblk = N / 32, kb = item / nblk, nb = item % nblk, k0 = 64 * kb, n0 = 32 * nb;
#pragma unroll 8
    for (int i = 0; i < 32; ++i) { const int kk = 2 * i + (lane >> 5); float v = __builtin_nontemporal_load(&W[(size_t)(k0 + kk) * N + n0 + (lane & 31)]); if (g) v *= g[k0 + kk]; scr[kk * 33 + (lane & 31)] = v; }
    LDS_WAIT(); asm volatile("" ::: "memory");
    const int c = lane & 7;
#pragma unroll
    for (int j = 0; j < 4; ++j) { const int n = (lane >> 3) + 8 * j; const LAS float* s = scr + (8 * c) * 33 + n;
        u32x4 o; o.x = cvt_pk_bf16(s[0 * 33], s[1 * 33]); o.y = cvt_pk_bf16(s[2 * 33], s[3 * 33]); o.z = cvt_pk_bf16(s[4 * 33], s[5 * 33]); o.w = cvt_pk_bf16(s[6 * 33], s[7 * 33]);
        const int nn = n0 + n, dr = row_off + (il ? ((nn >> 7) << 8) + (nn & 127) : nn);
        *(u32x4*)(dst + (size_t)dr * ldd + k0 + 8 * c) = o; }
    LDS_WAIT(); asm volatile("" ::: "memory");
}

__device__ __forceinline__ void transpose_item_fp8(const float* W, int N, float scale, unsigned char* dst, int ldd, int row_off, int il, LAS float* scr, int item, int lane, const float* g = nullptr) {
    const int nblk = N / 32, kb = item / nblk, nb = item % nblk, k0 = 64 * kb, n0 = 32 * nb;
    { f32x4 wv[8];
#pragma unroll
      for (int i = 0; i < 8; ++i) wv[i] = __builtin_nontemporal_load((const f32x4*)&W[(size_t)(k0 + 8 * i + (lane >> 3)) * N + n0 + 4 * (lane & 7)]);
#pragma unroll
      for (int i = 0; i < 8; ++i) { const int kk = 8 * i + (lane >> 3); float sc = scale; if (g) sc *= g[k0 + kk]; LAS float* d = scr + kk * 33 + 4 * (lane & 7);
        d[0] = wv[i][0] * sc; d[1] = wv[i][1] * sc; d[2] = wv[i][2] * sc; d[3] = wv[i][3] * sc; } }
    LDS_WAIT(); asm volatile("" ::: "memory");
    const int n = lane >> 1, kh = (lane & 1) * 32; const LAS float* s = scr + kh * 33 + n;
    u32x4 o0, o1;
#pragma unroll
    for (int q = 0; q < 4; ++q) { o0[q] = cvt4_fp8(s[(4 * q + 0) * 33], s[(4 * q + 1) * 33], s[(4 * q + 2) * 33], s[(4 * q + 3) * 33]); o1[q] = cvt4_fp8(s[(16 + 4 * q + 0) * 33], s[(16 + 4 * q + 1) * 33], s[(16 + 4 * q + 2) * 33], s[(16 + 4 * q + 3) * 33]); }
    const int nn = n0 + n, dr = row_off + (il ? ((nn >> 7) << 8) + (nn & 127) : nn);
    u32x4* dp = (u32x4*)(dst + (size_t)dr * ldd + k0 + kh); dp[0] = o0; dp[1] = o1;
    LDS_WAIT(); asm volatile("" ::: "memory");
}

__device__ __forceinline__ void phase_p0a(Frame& F) {
    LAS float* scr = (LAS float*)(F.lds + F.wave * 9216);
    constexpr int I_QKV = 16 * 48, I_WO = 16 * 32, I_DQ = 16 * 24, I_DKV = 16 * 10, I_UQ = 12 * 48, I_UKV = 4 * 64;
    constexpr int PERJ = I_QKV + I_WO + I_DQ + I_DKV + I_UQ + I_UKV + I_WO;
    for (int it = F.gw; it < 2 * PERJ; it += F.ngw) {
        const int j = it / PERJ; int r = it - j * PERJ;
        if (r < I_QKV) { transpose_item_fp8(in_ptr(I_GQKV) + (size_t)j * 1024 * 1536, 1536, WP_SCALE, (unsigned char*)(F.ws + WS_WQKV) + (size_t)j * 1536 * 1024, 1024, 0, 0, scr, r, F.lane); continue; } r -= I_QKV;
        if (r < I_WO) { transpose_item_fp8(in_ptr(I_GWO) + (size_t)j * 1024 * 1024, 1024, WO_SCALE, (unsigned char*)(F.ws + WS_WOG) + (size_t)j * 1024 * 1024, 1024, 0, 0, scr, r, F.lane); continue; } r -= I_WO;
        if (r < I_DQ) { transpose_item_fp8(in_ptr(I_MDQ) + (size_t)j * 1024 * 768, 768, WP_SCALE, (unsigned char*)(F.ws + WS_WD) + (size_t)j * 1280 * 1024, 1024, 0, 0, scr, r, F.lane); continue; } r -= I_DQ;
        if (r < I_DKV) { transpose_item_fp8(in_ptr(I_MDKV) + (size_t)j * 1024 * 320, 320, WP_SCALE, (unsigned char*)(F.ws + WS_WD) + (size_t)j * 1280 * 1024, 1024, 768, 0, scr, r, F.lane); continue; } r -= I_DKV;
        if (r < I_UQ) { transpose_item_fp8(in_ptr(I_MUQ) + (size_t)j * 768 * 1536, 1536, WP_SCALE, (unsigned char*)(F.ws + WS_WUQ) + (size_t)j * 1536 * 768, 768, 0, 0, scr, r, F.lane, in_ptr(I_MQG) + j * 768); continue; } r -= I_UQ;
        if (r < I_UKV) { transpose_item(in_ptr(I_MUKV) + (size_t)j * 256 * 2048, 2048, in_ptr(I_MKVG) + j * 256, (bf16_t*)(F.ws + WS_WUKV) + (size_t)j * 2048 * 256, 256, 0, 0, scr, r, F.lane); continue; } r -= I_UKV;
        transpose_item_fp8(in_ptr(I_MWO) + (size_t)j * 1024 * 1024, 1024, WO_SCALE, (unsigned char*)(F.ws + WS_WOM) + (size_t)j * 1024 * 1024, 1024, 0, 0, scr, r, F.lane);
    }
    for (int i = blockIdx.x * NTHR + F.tid; i < 2 * 12288; i += F.G * NTHR) { const int j = i / 12288, q = i - j * 12288;
        *((u32x4*)((unsigned char*)(F.ws + WS_WD) + (size_t)j * 1280 * 1024 + (size_t)1088 * 1024) + q) = (u32x4){0u, 0u, 0u, 0u}; }
    { int* idn = (int*)(F.ws + WS_GVAL); for (int i = blockIdx.x * NTHR + F.tid; i < NSLOT; i += F.G * NTHR) idn[i] = i; }
    { float* rt = (float*)(F.ws + WS_ROPE); const int i = blockIdx.x * NTHR + F.tid;
        if (i < 2048) { const int pos = i >> 5, m = i & 31; const float fr = powf(10000.0f, -(float)(2 * m) / 64.0f), a = (float)pos * fr; rt[i] = cosf(a); rt[2048 + i] = sinf(a); }
        else if (i < 3072) { const int q = i - 2048, pos = q >> 4, m = q & 15; const float fr = powf(10000.0f, -(float)(2 * m) / 32.0f), a = (float)pos * fr; rt[4096 + q] = cosf(a); rt[5120 + q] = sinf(a); } }
    { float* modp = (float*)(F.ws + WS_R + R_MODP); LAS float* s = (LAS float*)(F.lds + F.wave * 9216);
        for (int it = F.gw; it < NL * 96 * MOD_KC; it += F.ngw) {
            const int kc = it % MOD_KC, cg = (it / MOD_KC) % 96, li = it / (MOD_KC * 96);
            for (int q = F.lane; q < 33 * 64; q += 64) { const int b = q >> 6, kk = q & 63; const float cv = b < 32 ? in_ptr(I_C)[b * D + kc * 64 + kk] : in_ptr(I_CCTX)[kc * 64 + kk]; s[kk * 36 + b] = silu_f(cv); }
            LDS_WAIT(); asm volatile("" ::: "memory");
            float acc[33];
#pragma unroll
            for (int b = 0; b < 33; ++b) acc[b] = 0.f;
            const float* wp = in_ptr(I_ADAW) + ((size_t)li * D + kc * 64) * MODSZ + cg * 64 + F.lane;
#pragma unroll 1
            for (int k8 = 0; k8 < 64; k8 += 16) { float wv[16];
#pragma unroll
                for (int q = 0; q < 16; ++q) wv[q] = __builtin_nontemporal_load(&wp[(size_t)(k8 + q) * MODSZ]);
#pragma unroll
                for (int q = 0; q < 16; ++q) { const int kk = k8 + q; const float w = wv[q];
#pragma unroll
                    for (int b4 = 0; b4 < 8; ++b4) { const f32x4 sv = *(const LAS f32x4*)(s + kk * 36 + b4 * 4); acc[b4 * 4 + 0] += sv[0] * w; acc[b4 * 4 + 1] += sv[1] * w; acc[b4 * 4 + 2] += sv[2] * w; acc[b4 * 4 + 3] += sv[3] * w; }
                    acc[32] += s[kk * 36 + 32] * w; } }
            float* op = modp + ((size_t)(kc * NL + li) * 33) * MODSZ + cg * 64 + F.lane;
#pragma unroll
            for (int b = 0; b < 33; ++b) op[(size_t)b * MODSZ] = acc[b];
            LDS_WAIT(); asm volatile("" ::: "memory");
        } }
}
__device__ __forceinline__ void phase_p0b(Frame& F) {
    const float* modp = (const float*)(F.ws + WS_R + R_MODP); float* mod = (float*)(F.ws + WS_MOD);
    for (int i = blockIdx.x * NTHR + F.tid; i < NL * 33 * MODSZ; i += F.G * NTHR) { const int n = i % MODSZ, li = i / (33 * MODSZ); float a = in_ptr(I_ADAB)[li * MODSZ + n];
#pragma unroll
        for (int kc = 0; kc < MOD_KC; ++kc) a += modp[(size_t)kc * NL * 33 * MODSZ + i];
        mod[i] = a; }
}
__device__ __forceinline__ const float* xrow_in(const float* xl, const float* xc, int b, int p) { return p < CTXL ? xc + ((size_t)b * CTXL + p) * D : xl + ((size_t)b * SEQ + (p - CTXL)) * D; }

__device__ __forceinline__ void phase_p0c(Frame& F) {
    const float* mod = (const float*)(F.ws + WS_MOD); unsigned char* H8 = (unsigned char*)(F.ws + WS_H);
    for (int r2 = F.gw * 2; r2 < T; r2 += F.ngw * 2) {
        f32x4 xa[2][4];
#pragma unroll
        for (int i = 0; i < 2; ++i) { const int r = r2 + i, b = r / TPS, p = r - b * TPS; const f32x4* xr = (const f32x4*)xrow_in(in_ptr(I_X), in_ptr(I_CTX), b, p) + F.lane;
#pragma unroll
            for (int j = 0; j < 4; ++j) xa[i][j] = __builtin_nontemporal_load(&xr[64 * j]); }
#pragma unroll
        for (int i = 0; i < 2; ++i) { const int r = r2 + i, b = r / TPS, p = r - b * TPS; const float* mv = mod + (size_t)(p < CTXL ? 32 : b) * MODSZ; unsigned* hr = (unsigned*)(H8 + (size_t)r * D) + F.lane;
#pragma unroll
            for (int j = 0; j < 4; ++j) { const f32x4 sh = *((const f32x4*)mv + F.lane + 64 * j), sc = *((const f32x4*)(mv + D) + F.lane + 64 * j); const f32x4 hv = xa[i][j] * (1.0f + sc) + sh; hr[64 * j] = cvt4_fp8(hv[0], hv[1], hv[2], hv[3]); } } }
}

__device__ __forceinline__ void phase_qknorm(Frame& F, int j, bf16_t* dry) {
    bf16_t* QKV = (bf16_t*)(F.ws + WS_R + R_QKV); const ptrdiff_t dofs = dry ? dry - QKV : 0; const float* rt = (const float*)(F.ws + WS_ROPE);
    const float* kg = in_ptr(I_GKG) + j * 128;
    const int l16 = F.lane & 15, hd = (F.lane >> 4) & 1, rsel = F.lane >> 5;
    const f32x4 gk0 = *(const f32x4*)(kg + l16 * 8), gk1 = *(const f32x4*)(kg + l16 * 8 + 4);
    for (int r2 = F.gw; r2 < T / 2; r2 += F.ngw) { const int r = 2 * r2 + rsel; const int b = r / TPS, p = r - b * TPS; const int t = p >= CTXL ? p - CTXL : 0, trow = t >> 6, tcol = t & 63;
        const int j0 = l16 * 4, pos = j0 < 32 ? trow : tcol, ti = pos * 32 + (j0 & 31);
        const f32x4 cs = *(const f32x4*)(rt + ti), sn = *(const f32x4*)(rt + 2048 + ti);
        u32x4* ptr = (u32x4*)(QKV + (size_t)r * 1536 + 1024 + hd * 128 + l16 * 8); const u32x4 w = *ptr;
        f32x4 a = {__uint_as_float(w.x << 16), __uint_as_float(w.x & 0xffff0000u), __uint_as_float(w.y << 16), __uint_as_float(w.y & 0xffff0000u)};
        f32x4 c = {__uint_as_float(w.z << 16), __uint_as_float(w.z & 0xffff0000u), __uint_as_float(w.w << 16), __uint_as_float(w.w & 0xffff0000u)};
        float ss = (a[0] * a[0] + a[1] * a[1]) + (a[2] * a[2] + a[3] * a[3]) + (c[0] * c[0] + c[1] * c[1]) + (c[2] * c[2] + c[3] * c[3]);
        ss += __shfl_xor(ss, 1); ss += __shfl_xor(ss, 2); ss += __shfl_xor(ss, 4); ss += __shfl_xor(ss, 8);
        const float rstd = 1.0f / sqrtf(ss * (1.0f / 128.0f) + LN_EPS);
        a = a * rstd * gk0; c = c * rstd * gk1;
        const f32x4 a2 = {a[0] * cs[0] - a[1] * sn[0], a[0] * sn[0] + a[1] * cs[0], a[2] * cs[1] - a[3] * sn[1], a[2] * sn[1] + a[3] * cs[1]};
        const f32x4 c2 = {c[0] * cs[2] - c[1] * sn[2], c[0] * sn[2] + c[1] * cs[2], c[2] * cs[3] - c[3] * sn[3], c[2] * sn[3] + c[3] * cs[3]};
        u32x4 o; o.x = cvt_pk_bf16(a2[0], a2[1]); o.y = cvt_pk_bf16(a2[2], a2[3]); o.z = cvt_pk_bf16(c2[0], c2[1]); o.w = cvt_pk_bf16(c2[2], c2[3]); *(u32x4*)((bf16_t*)ptr + dofs) = o; }
}
__device__ __forceinline__ void phase_mla_stats(Frame& F, bf16_t* dry) {
    bf16_t* CQ = (bf16_t*)(F.ws + WS_R + R_CQ); unsigned char* CQ8 = (unsigned char*)(F.ws + WS_CQ8); bf16_t* KR = (bf16_t*)(F.ws + WS_KR); const ptrdiff_t dofs = dry ? dry - CQ : 0; const float* rt = (const float*)(F.ws + WS_ROPE) + 4096;
    for (int r4 = F.gw * 4; r4 < T; r4 += F.ngw * 4) {
        u32x4 w0a[4], w1a[4], wka[4];
#pragma unroll
        for (int i = 0; i < 4; ++i) { const bf16_t* row = CQ + (size_t)(r4 + i) * 1280; w0a[i] = *(const u32x4*)(row + F.lane * 8); w1a[i] = *(const u32x4*)(row + 512 + F.lane * 8); wka[i] = *(const u32x4*)(row + 1024 + (F.lane & 7) * 8); }
#pragma unroll
        for (int i = 0; i < 4; ++i) { const int r = r4 + i; const int b = r / TPS, p = r - b * TPS; const int t = p >= CTXL ? p - CTXL : 0, trow = t >> 6, tcol = t & 63;
        bf16_t* row = CQ + (size_t)r * 1280; const u32x4 w0 = w0a[i], w1 = w1a[i];
        float s0 = 0.f, s1 = 0.f;
#pragma unroll
        for (int q = 0; q < 4; ++q) { const float a = __uint_as_float(w0[q] << 16), c = __uint_as_float(w0[q] & 0xffff0000u); s0 += a * a + c * c; const float a1 = __uint_as_float(w1[q] << 16), c1 = __uint_as_float(w1[q] & 0xffff0000u); s1 += a1 * a1 + c1 * c1; }
        const float sq = wave_sum(s0 + (F.lane < 32 ? s1 : 0.f)), skv = wave_sum(F.lane >= 32 ? s1 : 0.f);
        const float rq = 1.0f / sqrtf(sq * (1.0f / 768.0f) + LN_EPS), rkv = 1.0f / sqrtf(skv * (1.0f / 256.0f) + LN_EPS);
        { unsigned char* c8 = CQ8 + (size_t)r * 768; u32x2 q0; q0.x = cvt4_fp8(__uint_as_float(w0[0] << 16) * rq, __uint_as_float(w0[0] & 0xffff0000u) * rq, __uint_as_float(w0[1] << 16) * rq, __uint_as_float(w0[1] & 0xffff0000u) * rq);
          q0.y = cvt4_fp8(__uint_as_float(w0[2] << 16) * rq, __uint_as_float(w0[2] & 0xffff0000u) * rq, __uint_as_float(w0[3] << 16) * rq, __uint_as_float(w0[3] & 0xffff0000u) * rq); *(u32x2*)(c8 + F.lane * 8) = q0;
          if (F.lane < 32) { u32x2 q1; q1.x = cvt4_fp8(__uint_as_float(w1[0] << 16) * rq, __uint_as_float(w1[0] & 0xffff0000u) * rq, __uint_as_float(w1[1] << 16) * rq, __uint_as_float(w1[1] & 0xffff0000u) * rq);
            q1.y = cvt4_fp8(__uint_as_float(w1[2] << 16) * rq, __uint_as_float(w1[2] & 0xffff0000u) * rq, __uint_as_float(w1[3] << 16) * rq, __uint_as_float(w1[3] & 0xffff0000u) * rq); *(u32x2*)(c8 + 512 + F.lane * 8) = q1; }
          else { u32x4 o1;
#pragma unroll
            for (int q = 0; q < 4; ++q) o1[q] = cvt_pk_bf16(__uint_as_float(w1[q] << 16) * rkv, __uint_as_float(w1[q] & 0xffff0000u) * rkv);
            *(u32x4*)(row + dofs + 512 + F.lane * 8) = o1; } }
        if (F.lane < 8) { const u32x4 w = wka[i]; u32x4 o = w;
            { const int j0 = F.lane * 4, pos = j0 < 16 ? trow : tcol, ti = pos * 16 + (j0 & 15); const f32x4 cs = *(const f32x4*)(rt + ti), sn = *(const f32x4*)(rt + 1024 + ti);
#pragma unroll
                for (int q = 0; q < 4; ++q) { const float x0 = __uint_as_float(w[q] << 16), x1 = __uint_as_float(w[q] & 0xffff0000u); o[q] = cvt_pk_bf16(x0 * cs[q] - x1 * sn[q], x0 * sn[q] + x1 * cs[q]); } }
            *(u32x4*)(KR + (size_t)r * 64 + F.lane * 8) = o; } } }
}

__device__ __forceinline__ float lane_xor32_sum(float a) { auto rr = __builtin_amdgcn_permlane32_swap(__float_as_uint(a), __float_as_uint(a), false, false); return __uint_as_float(rr[0]) + __uint_as_float(rr[1]); }
__device__ __forceinline__ float lane_xor32_max(float a) { auto rr = __builtin_amdgcn_permlane32_swap(__float_as_uint(a), __float_as_uint(a), false, false); return fmaxf(__uint_as_float(rr[0]), __uint_as_float(rr[1])); }
__device__ __forceinline__ float lane_xor4(float v) {
    const int a = __builtin_amdgcn_update_dpp(0, __builtin_bit_cast(int, v), 0x114, 0xf, 0xA, false);
    return __builtin_bit_cast(float, __builtin_amdgcn_update_dpp(a, __builtin_bit_cast(int, v), 0x104, 0xf, 0x5, false));
}
__device__ __forceinline__ void ln1_reduce16(float (&acc)[16], int lane, float& lg_e) {
#pragma unroll
    for (int e = 0; e < 8; ++e) { auto rr = __builtin_amdgcn_permlane32_swap(__float_as_uint(acc[e]), __float_as_uint(acc[e + 8]), false, false); acc[e] = __uint_as_float(rr[0]) + __uint_as_float(rr[1]); }
#pragma unroll
    for (int e = 0; e < 4; ++e) { const bool up = (lane & 16) != 0; const float send = up ? acc[e] : acc[e + 4], keep = up ? acc[e + 4] : acc[e]; acc[e] = keep + lane_xor16(send); }
#pragma unroll
    for (int e = 0; e < 2; ++e) { const bool up = (lane & 8) != 0; const float send = up ? acc[e] : acc[e + 2], keep = up ? acc[e + 2] : acc[e]; acc[e] = keep + DPP_MOV(send, 0x128); }
    { const bool up = (lane & 2) != 0; const float send = up ? acc[0] : acc[1], keep = up ? acc[1] : acc[0]; acc[0] = keep + DPP_MOV(send, 0x4E); }
    float v = acc[0]; v += DPP_MOV(v, 0xB1); v += lane_xor4(v); lg_e = v;
}
__device__ __forceinline__ void phase_ln1(Frame& F, int li, const float* xin_l, const float* xin_c, const bf16_t* O, float* xdry, bool skipctx) {
    LAS float* Wt = (LAS float*)F.lds;
    { const float* rw = in_ptr(I_RW) + (size_t)li * D * NE; for (int i = F.tid; i < D * NE; i += NTHR) Wt[(i & 15) * D + (i >> 4)] = rw[i]; }
    __syncthreads();
    const float* mod = (const float*)(F.ws + WS_MOD) + (size_t)li * 33 * MODSZ; unsigned char* H8 = (unsigned char*)(F.ws + WS_H); float* AFF = (float*)(F.ws + WS_AFF); int* INV = (int*)(F.ws + WS_INV);
    f32x4 lg[4], lb[4], g1[4], sh2[4], sc2[4];
    { const float* pg = in_ptr(I_LMG) + li * D; const float* pb = in_ptr(I_LMB) + li * D;
#pragma unroll
      for (int j = 0; j < 4; ++j) { lg[j] = *((const f32x4*)pg + F.lane + 64 * j); lb[j] = *((const f32x4*)pb + F.lane + 64 * j); } }
#pragma unroll 1
    for (int rp_ = 0; rp_ < REP_LN1; ++rp_) { float* xd = rp_ + 1 < REP_LN1 ? xdry : nullptr; float* Xl = xd ? xd + (size_t)NB * CTXL * D : F.out; float* Xc = xd ? xd : (float*)(F.ws + WS_XC);
    for (int wv = F.gw; wv < 2048; wv += F.ngw) { const int b = wv >> 6, w = wv & 63;
#pragma unroll 1
        for (int seg = skipctx ? 1 : 0; seg < 2; ++seg) { const float* mv = mod + (size_t)(seg == 0 ? 32 : b) * MODSZ;
#pragma unroll
            for (int j = 0; j < 4; ++j) { g1[j] = *((const f32x4*)(mv + 2 * D) + F.lane + 64 * j); sh2[j] = *((const f32x4*)(mv + 3 * D) + F.lane + 64 * j); sc2[j] = *((const f32x4*)(mv + 4 * D) + F.lane + 64 * j); }
            const int np = seg == 0 ? 2 : 16, p0 = seg == 0 ? 4 * w : CTXL + 32 * w;
            const float* xin = seg == 0 ? xin_c + (size_t)b * CTXL * D : xin_l + ((size_t)b * SEQ - CTXL) * D;
            float* xout = seg == 0 ? Xc + (size_t)b * CTXL * D : Xl + ((size_t)b * SEQ - CTXL) * D;
            f32x4 nx[2][4]; u32x2 no[2][4];
#define LN1_FETCH(pp) do { _Pragma("unroll") for (int q = 0; q < 2; ++q) { const f32x4* xr = (const f32x4*)(xin + (size_t)((pp) + q) * D) + F.lane; const u32x2* orow = (const u32x2*)(O + ((size_t)b * TPS + (pp) + q) * D) + F.lane; \
                _Pragma("unroll") for (int j = 0; j < 4; ++j) { nx[q][j] = __builtin_nontemporal_load(&xr[64 * j]); no[q][j] = __builtin_nontemporal_load(&orow[64 * j]); } } } while (0)
            LN1_FETCH(p0);
#pragma unroll 1
            for (int k = 0; k < np; ++k) { const int pA = p0 + 2 * k; const size_t rA = (size_t)b * TPS + pA;
                f32x4 v[2][4]; float s[2] = {0.f, 0.f};
#pragma unroll
                for (int q = 0; q < 2; ++q)
#pragma unroll
                    for (int j = 0; j < 4; ++j) { v[q][j] = nx[q][j] * ALPHA + g1[j] * unpack4(no[q][j]); s[q] += (v[q][j][0] + v[q][j][1]) + (v[q][j][2] + v[q][j][3]); }
                __builtin_amdgcn_sched_barrier(0);
                if (k + 1 < np) LN1_FETCH(pA + 2);
                __builtin_amdgcn_sched_barrier(0);
                float s2[2] = {0.f, 0.f};
#pragma unroll
                for (int q = 0; q < 2; ++q) { const float mean = wave_sum(s[q]) * (1.0f / D);
#pragma unroll
                    for (int j = 0; j < 4; ++j) { v[q][j] = v[q][j] - mean; s2[q] += (v[q][j][0] * v[q][j][0] + v[q][j][1] * v[q][j][1]) + (v[q][j][2] * v[q][j][2] + v[q][j][3] * v[q][j][3]); } }
#pragma unroll
                for (int q = 0; q < 2; ++q) { const float rstd = 1.0f / sqrtf(wave_sum(s2[q]) * (1.0f / D) + LN_EPS);
                    f32x4* xw = (f32x4*)(xout + (size_t)(pA + q) * D) + F.lane; unsigned* hr = (unsigned*)(H8 + (rA + q) * D) + F.lane;
#pragma unroll
                    for (int j = 0; j < 4; ++j) { v[q][j] = v[q][j] * rstd * lg[j] + lb[j]; __builtin_nontemporal_store(v[q][j], &xw[64 * j]); v[q][j] = v[q][j] * (1.0f + sc2[j]) + sh2[j]; hr[64 * j] = cvt4_fp8(v[q][j][0], v[q][j][1], v[q][j][2], v[q][j][3]); } }
                f32x2 hp[4][4];
#pragma unroll
                for (int j = 0; j < 4; ++j)
#pragma unroll
                    for (int c = 0; c < 4; ++c) hp[j][c] = (f32x2){v[0][j][c], v[1][j][c]};
                __builtin_amdgcn_sched_barrier(0);
                float accA[16], accB[16];
#pragma unroll
                for (int e = 0; e < 16; ++e) { f32x2 a2 = {0.f, 0.f};
#pragma unroll
                    for (int j = 0; j < 4; ++j) { const f32x4 wq = *(const LAS f32x4*)(Wt + e * D + 4 * F.lane + 256 * j);
#pragma unroll
                        for (int c = 0; c < 4; ++c) a2 = __builtin_elementwise_fma(hp[j][c], (f32x2){wq[c], wq[c]}, a2); }
                    accA[e] = a2[0]; accB[e] = a2[1]; if (e & 1) __builtin_amdgcn_sched_barrier(0); }
                float lgA, lgB; ln1_reduce16(accA, F.lane, lgA); ln1_reduce16(accB, F.lane, lgB);
#pragma unroll
                for (int q = 0; q < 2; ++q) { const float lg_e = q ? lgB : lgA;
                    float mx = lg_e; mx = fmaxf(mx, DPP_MOV(mx, 0x4E)); mx = fmaxf(mx, DPP_MOV(mx, 0x128)); mx = fmaxf(mx, lane_xor16(mx)); mx = lane_xor32_max(mx);
                    const float ex = __expf(lg_e - mx); float se = ex; se += DPP_MOV(se, 0x4E); se += DPP_MOV(se, 0x128); se += lane_xor16(se); se = lane_xor32_sum(se);
                    const int eidx = ((F.lane >> 5) << 3) | (((F.lane >> 4) & 1) << 2) | (((F.lane >> 3) & 1) << 1) | ((F.lane >> 1) & 1);
                    if ((F.lane & 5) == 0) { AFF[(rA + q) * NE + eidx] = ex / se; INV[(rA + q) * NE + eidx] = -1; } }
            } } } }
}

__device__ __forceinline__ void topk_item(Frame& F, LAS unsigned* keys, LAS unsigned* hist, int e, int row0  , int n, int cap, int slot0) {
    const float* AFF = (const float*)(F.ws + WS_AFF); int* INV = (int*)(F.ws + WS_INV); int* STOK = (int*)(F.ws + WS_STOK);
    const int nk = n >> 6;
#pragma unroll 4
    for (int k = 0; k < nk; ++k) keys[F.lane + 64 * k] = __float_as_uint(AFF[(size_t)(row0 + F.lane + 64 * k) * NE + e]);
    LDS_WAIT(); asm volatile("" ::: "memory");
    unsigned prefix = 0u, mask = 0u; int krem = cap;
#pragma unroll 1
    for (int pass = 0; pass < 4; ++pass) { const int shift = 24 - 8 * pass;
        *(LAS u32x4*)(hist + 4 * F.lane) = (u32x4){0u, 0u, 0u, 0u};
        LDS_WAIT(); asm volatile("" ::: "memory");
#pragma unroll 4
        for (int k = 0; k < nk; ++k) { const unsigned key = keys[F.lane + 64 * k]; if ((key & mask) == prefix) __hip_atomic_fetch_add(hist + ((key >> shift) & 255u), 1u, __ATOMIC_RELAXED, __HIP_MEMORY_SCOPE_WORKGROUP); }
        LDS_WAIT(); asm volatile("" ::: "memory");
        const u32x4 c = *(const LAS u32x4*)(hist + 4 * F.lane);
        const int s = (int)(c[0] + c[1] + c[2] + c[3]);
        int suf = s;
#pragma unroll
        for (int o = 1; o < 64; o <<= 1) { const int t = __shfl_down(suf, o); if (F.lane + o < 64) suf += t; }
        int cum = suf - s;
        int fbin = -1, fk = 0;
#pragma unroll
        for (int q = 3; q >= 0; --q) { const int cq = (int)c[q]; if (fbin < 0 && cum < krem && cum + cq >= krem) { fbin = 4 * F.lane + q; fk = krem - cum; } cum += cq; }
        const unsigned long long bal = __ballot(fbin >= 0); const int src = bal ? __ffsll((long long)bal) - 1 : 0;
        const int bin = __shfl(fbin, src), nkk = __shfl(fk, src);
        prefix |= (unsigned)bin << shift; mask |= 0xffu << shift; krem = nkk;
        asm volatile("" ::: "memory");
    }
    int nsel = 0, neq = 0;
    const unsigned long long lt = (1ull << F.lane) - 1ull;
#pragma unroll 2
    for (int k = 0; k < nk; ++k) { const unsigned key = keys[F.lane + 64 * k]; const bool gt = key > prefix, eq = key == prefix;
        const unsigned long long be = __ballot(eq); const int eqb = neq + __popcll(be & lt); const bool sel = gt || (eq && eqb < krem);
        const unsigned long long bs = __ballot(sel); const int pos = nsel + __popcll(bs & lt);
        if (sel && pos < cap) { const int row = row0 + F.lane + 64 * k, slot = slot0 + pos; STOK[slot] = row; INV[(size_t)row * NE + e] = slot; }
        nsel += __popcll(bs); neq += __popcll(be); }
    LDS_WAIT(); asm volatile("" ::: "memory");
}
__device__ __forceinline__ void phase_topk_conv(Frame& F, int li, bool skipctx) {
    LAS unsigned* hist = (LAS unsigned*)(F.lds + 8 * 9216 + F.wave * 1024);
#if TOPK_DYN
    LAS unsigned* ctr = (LAS unsigned*)(F.lds + MISC_OFF + 64);
    if (F.tid == 0) *ctr = 0u;
    __syncthreads();
#endif
    if (F.wave < 4) for (int it = F.vcu * 4 + F.wave; it < (skipctx ? 512 : 1024); it += F.G * 4) { const int set = it >> 9, b = (it >> 4) & 31, e = it & 15; LAS unsigned* keys = (LAS unsigned*)(F.lds + F.wave * 9216);
        if (set == 0) topk_item(F, keys, hist, e, b * TPS + CTXL, SEQ, CAPL, (b * NE + e) * CAPL);
        else topk_item(F, keys, hist, e, b * TPS, CTXL, CAPC, NSLOT_L + (e * 4 + (b >> 3)) * 256 + (b & 7) * CAPC); }
    LAS float* scr = (LAS float*)(F.lds + F.wave * 9216);
#if TOPK_DYN
    for (;;) { unsigned k_ = 0; if (F.lane == 0) k_ = __hip_atomic_fetch_add(ctr, 1u, __ATOMIC_RELAXED, __HIP_MEMORY_SCOPE_WORKGROUP); k_ = __builtin_amdgcn_readfirstlane(k_);
        const int it = F.vcu * NWAVES + (int)(k_ & 7u) + (int)(k_ >> 3) * F.ngw; if (it >= 3 * NE * 512) break;
#else
    for (int it = F.gw; it < 3 * NE * 512; it += F.ngw) {
#endif
        const int which = it / (NE * 512), rem = it - which * (NE * 512), e = rem >> 9, item = rem & 511;
        const size_t eoff = ((size_t)li * NE + e) * D * FF;
        if (which == 0) transpose_item_fp8(in_ptr(I_WG) + eoff, FF, WGU_SCALE, (unsigned char*)(F.ws + WS_WGU) + (size_t)e * 2048 * D, D, 0, 1, scr, item, F.lane);
        else if (which == 1) transpose_item_fp8(in_ptr(I_WU) + eoff, FF, WGU_SCALE, (unsigned char*)(F.ws + WS_WGU) + (size_t)e * 2048 * D, D, 128, 1, scr, item, F.lane);
        else transpose_item_fp8(in_ptr(I_WDN) + eoff, D, WDN_SCALE, (unsigned char*)(F.ws + WS_WDN) + (size_t)e * D * FF, FF, 0, 0, scr, item, F.lane); }
}
__device__ __forceinline__ void phase_gather(Frame& F) {
    const bf16_t* H = (const bf16_t*)(F.ws + WS_H); bf16_t* XS = (bf16_t*)(F.ws + WS_R + R_XS); const int* STOK = (const int*)(F.ws + WS_STOK);
    for (int s0 = F.gw * 4; s0 < NSLOT; s0 += F.ngw * 4) { u32x4 v[4][2];
#pragma unroll
        for (int q = 0; q < 4; ++q) { int row = STOK[s0 + q]; row = row < 0 ? 0 : (row >= T ? T - 1 : row); const u32x4* src = (const u32x4*)(H + (size_t)row * D) + F.lane; v[q][0] = src[0]; v[q][1] = src[64]; }
#pragma unroll
        for (int q = 0; q < 4; ++q) { u32x4* dst = (u32x4*)(XS + (size_t)(s0 + q) * D) + F.lane; dst[0] = v[q][0]; dst[64] = v[q][1]; } }
}
__device__ __forceinline__ void phase_ln2(Frame& F, int li, float* xdry, bool skipctx) {
    const float* mod = (const float*)(F.ws + WS_MOD) + (size_t)li * 33 * MODSZ; const float* modn = mod + (size_t)33 * MODSZ; const bool has_next = li + 1 < NL;
    unsigned char* H8 = (unsigned char*)(F.ws + WS_H); const int* INV = (const int*)(F.ws + WS_INV); const float* AFF = (const float*)(F.ws + WS_AFF); const bf16_t* Y = (const bf16_t*)(F.ws + WS_R + R_XS);
    float* Xl = F.out; float* Xc = (float*)(F.ws + WS_XC); float* Xdl = xdry ? xdry + (size_t)NB * CTXL * D : Xl; float* Xdc = xdry ? xdry : Xc;
    f32x4 lg[4], lb[4], g2[4];
    { const float* pg = in_ptr(I_LFG) + li * D; const float* pb = in_ptr(I_LFB) + li * D;
#pragma unroll
      for (int j = 0; j < 4; ++j) { lg[j] = *((const f32x4*)pg + F.lane + 64 * j); lb[j] = *((const f32x4*)pb + F.lane + 64 * j); } }
    for (int wv = F.gw; wv < 2048; wv += F.ngw) { const int b = wv >> 6, w = wv & 63;
#pragma unroll 1
        for (int seg = skipctx ? 1 : 0; seg < 2; ++seg) { const float* mv = mod + (size_t)(seg == 0 ? 32 : b) * MODSZ; const float* mn = modn + (size_t)(seg == 0 ? 32 : b) * MODSZ;
#pragma unroll
            for (int j = 0; j < 4; ++j) g2[j] = *((const f32x4*)(mv + 5 * D) + F.lane + 64 * j);
            const int np = seg == 0 ? 2 : 16, p0 = seg == 0 ? 4 * w : CTXL + 32 * w;
            float* xio = seg == 0 ? Xc + (size_t)b * CTXL * D : Xl + ((size_t)b * SEQ - CTXL) * D;
            float* xo2 = seg == 0 ? Xdc + (size_t)b * CTXL * D : Xdl + ((size_t)b * SEQ - CTXL) * D;
            int ninv[2]; float naff[2];
#pragma unroll
            for (int q = 0; q < 2; ++q) { ninv[q] = INV[((size_t)b * TPS + p0 + q) * NE + (F.lane & 15)]; naff[q] = AFF[((size_t)b * TPS + p0 + q) * NE + (F.lane & 15)]; }
#pragma unroll 1
            for (int k = 0; k < np; ++k) { const int pA = p0 + 2 * k; const size_t rA = (size_t)b * TPS + pA;
                int myinv[2]; float myaff[2]; f32x4 xv[2][4], f[2][4];
#pragma unroll
                for (int q = 0; q < 2; ++q) { myinv[q] = ninv[q]; myaff[q] = naff[q]; const size_t rn = k + 1 < np ? rA + 2 + q : rA + q; ninv[q] = INV[rn * NE + (F.lane & 15)]; naff[q] = AFF[rn * NE + (F.lane & 15)]; const f32x4* xr = (const f32x4*)(xio + (size_t)(pA + q) * D) + F.lane;
#pragma unroll
                    for (int j = 0; j < 4; ++j) { xv[q][j] = __builtin_nontemporal_load(&xr[64 * j]); f[q][j] = (f32x4){0.f, 0.f, 0.f, 0.f}; } }
                unsigned msk[2];
#pragma unroll
                for (int q = 0; q < 2; ++q) msk[q] = (unsigned)__ballot(F.lane < 16 && myinv[q] >= 0);
                while (msk[0] | msk[1]) {
                    int sl[2][2]; float gt[2][2];
#pragma unroll
                    for (int q = 0; q < 2; ++q)
#pragma unroll
                        for (int i = 0; i < 2; ++i) { const bool has = msk[q] != 0u; const int e = has ? __builtin_ctz(msk[q]) : 0; msk[q] &= msk[q] - 1u;
                            const int s_ = __builtin_amdgcn_readlane(myinv[q], e); const float g_ = __uint_as_float(__builtin_amdgcn_readlane(__float_as_uint(myaff[q]), e));
                            sl[q][i] = has ? s_ : 0; gt[q][i] = has ? g_ : 0.f; }
                    u32x2 yv[2][2][4];
#pragma unroll
                    for (int q = 0; q < 2; ++q)
#pragma unroll
                        for (int i = 0; i < 2; ++i) { const u32x2* yr = (const u32x2*)(Y + (size_t)sl[q][i] * D) + F.lane;
#pragma unroll
                            for (int j = 0; j < 4; ++j) yv[q][i][j] = __builtin_nontemporal_load(&yr[64 * j]); }
#pragma unroll
                    for (int q = 0; q < 2; ++q)
#pragma unroll
                        for (int i = 0; i < 2; ++i)
#pragma unroll
                            for (int j = 0; j < 4; ++j) f[q][j] += unpack4(yv[q][i][j]) * gt[q][i];
                }
                f32x4 v[2][4]; float s[2] = {0.f, 0.f}, s2[2] = {0.f, 0.f};
#pragma unroll
                for (int q = 0; q < 2; ++q)
#pragma unroll
                    for (int j = 0; j < 4; ++j) { v[q][j] = xv[q][j] * ALPHA + g2[j] * f[q][j]; s[q] += (v[q][j][0] + v[q][j][1]) + (v[q][j][2] + v[q][j][3]); }
#pragma unroll
                for (int q = 0; q < 2; ++q) { const float mean = wave_sum(s[q]) * (1.0f / D);
#pragma unroll
                    for (int j = 0; j < 4; ++j) { v[q][j] = v[q][j] - mean; s2[q] += (v[q][j][0] * v[q][j][0] + v[q][j][1] * v[q][j][1]) + (v[q][j][2] * v[q][j][2] + v[q][j][3] * v[q][j][3]); } }
#pragma unroll
                for (int q = 0; q < 2; ++q) { const float rstd = 1.0f / sqrtf(wave_sum(s2[q]) * (1.0f / D) + LN_EPS);
                    f32x4* xw = (f32x4*)(xo2 + (size_t)(pA + q) * D) + F.lane; unsigned* hr = (unsigned*)(H8 + (rA + q) * D) + F.lane;
#pragma unroll
                    for (int j = 0; j < 4; ++j) { v[q][j] = v[q][j] * rstd * lg[j] + lb[j]; __builtin_nontemporal_store(v[q][j], &xw[64 * j]); if (has_next) { const f32x4 sh1 = *((const f32x4*)mn + F.lane + 64 * j), sc1 = *((const f32x4*)(mn + D) + F.lane + 64 * j); const f32x4 hv = v[q][j] * (1.0f + sc1) + sh1; hr[64 * j] = cvt4_fp8(hv[0], hv[1], hv[2], hv[3]); } } }
            } } }
}
#ifndef ATT_V2
#define ATT_V2 0
#endif
template <int DQK, int SD>
__device__ __forceinline__ void phase_attn(Frame& F, int jg, bool skipctx, unsigned long long& pacc) {
    char* lds = (char*)F.lds;
    for (int u = F.vcu; u < (skipctx ? 2048 : 2048 + 256); u += F.G) {
        int b, h, prow, seq;
        if (u < 2048) { b = u >> 6; h = (u >> 3) & 7; prow = CTXL + (u & 7) * 256; seq = TPS; } else { const int q = u - 2048; b = q >> 3; h = q & 7; prow = 0; seq = CTXL; }
        const size_t row0 = (size_t)b * TPS;
        if constexpr (DQK == 128) {
            const bf16_t* QKV = (const bf16_t*)(F.ws + WS_R + R_QKV); unsigned char* AO = (unsigned char*)(F.ws + WS_R + R_AOG);
            const bf16_t* K = QKV + row0 * 1536 + 1024 + (h >> 2) * 128;
#if ATT_V2
            att2::attn_body2<128, 1536, 1536, 64, 1536, D>(QKV + (row0 + prow) * 1536 + h * 128, K, nullptr, K + 256, AO + (row0 + prow) * D + h * 128, seq, F.lds, prow - CTXL, (const float*)(F.ws + WS_ROPE), in_ptr(I_GQG) + jg * 128, pacc);
#else
            att::attn_body<128, SD, 1536, 1536, 64, 1536, D>(QKV + (row0 + prow) * 1536 + h * 128, K, nullptr, K + 256, AO + (row0 + prow) * D + h * 128, seq, lds, prow - CTXL, (const float*)(F.ws + WS_ROPE), in_ptr(I_GQG) + jg * 128);
#endif
        } else {
            const bf16_t* Q = (const bf16_t*)(F.ws + WS_R + R_Q); const bf16_t* KV = (const bf16_t*)(F.ws + WS_R + R_KV); const bf16_t* KR = (const bf16_t*)(F.ws + WS_KR); unsigned char* AO = (unsigned char*)(F.ws + WS_R + R_AOM);
            const bf16_t* K = KV + row0 * 2048 + h * 256;
#if ATT_V2
            att2::attn_body2<192, 1536, 2048, 64, 2048, D>(Q + (row0 + prow) * 1536 + h * 192, K, KR + row0 * 64, K + 128, AO + (row0 + prow) * D + h * 128, seq, F.lds, prow - CTXL, (const float*)(F.ws + WS_ROPE) + 4096, nullptr, pacc);
#else
            att::attn_body<192, SD, 1536, 2048, 64, 2048, D>(Q + (row0 + prow) * 1536 + h * 192, K, KR + row0 * 64, K + 128, AO + (row0 + prow) * D + h * 128, seq, lds, prow - CTXL, (const float*)(F.ws + WS_ROPE) + 4096, nullptr);
#endif
        }
        __syncthreads();
    }
}

#ifndef REP_DENSE
#define REP_DENSE 1
#endif
#ifndef REP_MOE
#define REP_MOE 1
#endif
#ifndef REP_ATTN
#define REP_ATTN 1
#endif
#ifndef REP_THIN
#define REP_THIN 1
#endif
#ifndef REP_LN1
#define REP_LN1 1
#endif
#ifndef REP_LN2
#define REP_LN2 1
#endif
#ifndef REP_QK
#define REP_QK 1
#endif
#ifndef REP_BAR
#define REP_BAR 1
#endif
#ifndef REP_ATTN_M
#define REP_ATTN_M REP_ATTN
#endif
#ifndef REP_ATTN_G
#define REP_ATTN_G REP_ATTN
#endif
#ifndef EN_ALL
#define EN_ALL 1
#endif
#ifndef EN_ATTN_MLA
#define EN_ATTN_MLA 1
#endif
#ifndef EN_ATTN_GQA
#define EN_ATTN_GQA 1
#endif
#ifndef ATT_SD_GQA
#define ATT_SD_GQA 1
#endif
#ifndef EN_UQ
#define EN_UQ 1
#endif
#ifndef EN_UKV
#define EN_UKV 1
#endif
#ifndef EN_P0A
#define EN_P0A EN_ALL
#endif
#ifndef EN_P0B
#define EN_P0B EN_ALL
#endif
#ifndef EN_P0C
#define EN_P0C EN_ALL
#endif
#ifndef EN_PROJ
#define EN_PROJ EN_ALL
#endif
#ifndef EN_THIN1
#define EN_THIN1 EN_ALL
#endif
#ifndef EN_UQKV
#define EN_UQKV EN_ALL
#endif
#ifndef EN_ATTN
#define EN_ATTN EN_ALL
#endif
#ifndef EN_OPROJ
#define EN_OPROJ EN_ALL
#endif
#ifndef EN_LN1
#define EN_LN1 EN_ALL
#endif
#ifndef EN_TOPK
#define EN_TOPK EN_ALL
#endif
#ifndef EN_GATHER
#define EN_GATHER 0
#endif
#ifndef EN_GU
#define EN_GU EN_ALL
#endif
#ifndef EN_DN
#define EN_DN EN_ALL
#endif
#ifndef EN_LN2
#define EN_LN2 EN_ALL
#endif
constexpr int NPH = 3 + NL * 11;
struct Args { const float* in[25]; float* out; unsigned char* ws; int ph_lo, ph_hi; };
__global__ void __launch_bounds__(NTHR, 2) mk_fwd(Args args) {
    extern __shared__ __attribute__((aligned(16))) unsigned char lds_raw[];
    Frame F;
    F.lds = (LAS unsigned char*)lds_raw;
    F.tid = threadIdx.x; F.lane = F.tid & 63; F.wave = __builtin_amdgcn_readfirstlane(F.tid >> 6);
    F.G = gridDim.x; { const int bx = blockIdx.x; F.vcu = (F.G % 8 == 0) ? (bx % 8) * (F.G / 8) + bx / 8 : bx; }
    F.gw = F.vcu * NWAVES + F.wave; F.ngw = F.G * NWAVES;
    F.out = args.out; F.ws = args.ws;
    volatile LAS unsigned* MISC = (volatile LAS unsigned*)(F.lds + MISC_OFF);
    if (F.tid < 4) MISC[F.tid] = 0u;
    __syncthreads();
    const int lo = args.ph_lo, hi = args.ph_hi;
    XcdBarrier bar; bar.bar = (unsigned*)(F.ws + WS_CTL) + CW_BAR; bar.x = 0; bar.st = MISC;
    if (hi - lo > 1) bar = xcd_barrier_post((unsigned*)(F.ws + WS_CTL) + CW_BAR, MISC);
#define IN(k) (lo <= (k) && (k) < hi)
#ifdef PROBE_SEL
#ifndef PROBE_WG
#define PROBE_WG 0
#endif
    unsigned long long pr_acc = 0ull, pr_t0 = 0ull; const bool pr_on = (int)blockIdx.x == PROBE_WG && F.wave == 0;
#define PSTART(g) do { if ((g) == PROBE_SEL && pr_on) pr_t0 = __builtin_amdgcn_s_memrealtime(); } while (0)
#define PEND(g) do { if ((g) == PROBE_SEL && pr_on) pr_acc += __builtin_amdgcn_s_memrealtime() - pr_t0; } while (0)
#else
#define PSTART(g) do { } while (0)
#define PEND(g) do { } while (0)
#endif
#define SEAM(k) do { if ((k) + 1 < hi) { PSTART(11); for (int rb_ = 0; rb_ < REP_BAR; ++rb_) xcd_barrier(bar); PEND(11); } } while (0)
#define SEAMG(k, g) do { if ((k) + 1 < hi) { PSTART(11); PSTART(20 + (g)); for (int rb_ = 0; rb_ < REP_BAR; ++rb_) xcd_barrier(bar); PEND(11); PEND(20 + (g)); } } while (0)
#define PB() do { F.lane = opaque_v(F.lane); F.tid = opaque_v(F.tid); F.gw = opaque_s(F.gw); F.wave = opaque_s(F.wave); F.vcu = opaque_s(F.vcu); } while (0)

#if EN_P0A
    if (IN(0)) { PB(); PSTART(0); _Pragma("unroll 1") for (int rep_ = 0; rep_ < REP_THIN; ++rep_) { phase_p0a(F); __syncthreads(); } PEND(0); SEAMG(0, 0); }
#endif
#if EN_P0B
    if (IN(1)) { PB(); PSTART(0); _Pragma("unroll 1") for (int rep_ = 0; rep_ < REP_THIN; ++rep_) { phase_p0b(F); __syncthreads(); } PEND(0); SEAMG(1, 0); }
#endif
#if EN_P0C
    if (IN(2)) { PB(); PSTART(0); _Pragma("unroll 1") for (int rep_ = 0; rep_ < REP_THIN; ++rep_) { phase_p0c(F); __syncthreads(); } PEND(0); SEAMG(2, 0); }
#endif

#pragma unroll 1
    for (int li = 0; li < NL; ++li) {
        const int pb = 3 + li * 11, j = li >> 1; const bool mla = (li & 1) != 0, lastl = li == NL - 1;
#if EN_PROJ
        if (IN(pb + 0)) { PB(); PSTART(1);
            const int N = mla ? 1280 : 1536;
            pg8::Gemm g{(const bf16_t*)(F.ws + WS_H), (const bf16_t*)(mla ? F.ws + WS_WD + (size_t)j * 1280 * 1024 : F.ws + WS_WQKV + (size_t)j * 1536 * 1024), D / 2, D / 2, D / 2, 0x7a7a7a7a  , (const int*)(F.ws + WS_GVAL)  };
            pg8::StaticOrder S; S.init(T, N, F.G, (int)blockIdx.x); S.rep = REP_DENSE;
            pg8::EpiStore E{(bf16_t*)(F.ws + WS_R), N, 0xffff};
            pg8::gemm_phase<pg8::EpiStore, pg8::StaticOrder, false, true, true>(F.lds, g, S, E, nullptr);
            PEND(1); SEAMG(pb + 0, 1);
        }
#endif
#if EN_THIN1
        if (IN(pb + 1)) { PB(); PSTART(2); _Pragma("unroll 1") for (int rp_ = 0; rp_ < REP_QK; ++rp_) { bf16_t* dry_ = rp_ + 1 < REP_QK ? (bf16_t*)(F.ws + WS_R + 396 * MiB) : nullptr; if (mla) phase_mla_stats(F, dry_); else phase_qknorm(F, j, dry_); __syncthreads(); } PEND(2); SEAMG(pb + 1, 2); }
#endif
#if EN_UQKV
        if (mla && IN(pb + 2)) { PB(); PSTART(3);
#if EN_UQ
            { pg8::Gemm g{(const bf16_t*)(F.ws + WS_CQ8), (const bf16_t*)(F.ws + WS_WUQ + (size_t)j * 1536 * 768), 384, 384, 384, 0x7a7a7a7a  , (const int*)(F.ws + WS_GVAL)  };
              pg8::StaticOrder S; S.init(lastl ? NB * SEQ : T, 1536, F.G, (int)blockIdx.x); S.rep = REP_DENSE; S.skipctx = lastl;
              pg8::EpiStore E{(bf16_t*)(F.ws + WS_R + R_Q), 1536, 0xffff};
              pg8::gemm_phase<pg8::EpiStore, pg8::StaticOrder, false, true, true>(F.lds, g, S, E, nullptr); }
#endif
#if EN_UKV
            { pg8::Gemm g{(const bf16_t*)(F.ws + WS_R + R_CQ) + 768, (const bf16_t*)(F.ws + WS_WUKV) + (size_t)j * 2048 * 256, 1280, 256, 256, 0};
              pg8::StaticOrder S; S.init(T, 2048, F.G, (int)blockIdx.x); S.rep = REP_DENSE;
              pg8::EpiStore E{(bf16_t*)(F.ws + WS_R + R_KV), 2048, 0xffff};
              pg8::gemm_phase<pg8::EpiStore, pg8::StaticOrder>(F.lds, g, S, E, nullptr); }
#endif
            PEND(3); SEAMG(pb + 2, 3);
        }
#endif
#if EN_ATTN
        if (IN(pb + 3)) { PB(); PSTART(4); unsigned long long pa_ = 0ull;
#if EN_ATTN_MLA
            _Pragma("unroll 1") for (int rep_ = 0; rep_ < REP_ATTN_M; ++rep_) { if (mla) phase_attn<192, ATT_SD_MLA>(F, j, lastl, pa_); __syncthreads(); }
#endif
#if EN_ATTN_GQA
            _Pragma("unroll 1") for (int rep_ = 0; rep_ < REP_ATTN_G; ++rep_) { if (!mla) phase_attn<128, ATT_SD_GQA>(F, j, lastl, pa_); __syncthreads(); }
#endif
#if defined(PROBE_SEL) && PROBE_SEL >= 50 && PROBE_SEL <= 59
            if (pr_on) pr_acc += pa_;
#endif
            PEND(4); SEAMG(pb + 3, 4); }
#endif
#if EN_OPROJ
        if (IN(pb + 4)) { PB(); PSTART(5);
            pg8::Gemm g{(const bf16_t*)(F.ws + WS_R + (mla ? R_AOM : R_AOG)), (const bf16_t*)(F.ws + (mla ? WS_WOM : WS_WOG) + (size_t)j * 1024 * 1024), D / 2, D / 2, D / 2, 0x75757575  , (const int*)(F.ws + WS_GVAL)  };
            pg8::StaticOrder S; S.init(lastl ? NB * SEQ : T, D, F.G, (int)blockIdx.x); S.rep = REP_DENSE; S.skipctx = lastl;
            pg8::EpiStore E{(bf16_t*)(F.ws + WS_R + (mla ? R_OM : R_OG)), D, 0xffff};
            pg8::gemm_phase<pg8::EpiStore, pg8::StaticOrder, false, true, true>(F.lds, g, S, E, nullptr);
            PEND(5); SEAMG(pb + 4, 5);
        }
#endif
#if EN_LN1
        if (IN(pb + 5)) { PB(); PSTART(6); phase_ln1(F, li, li == 0 ? in_ptr(I_X) : F.out, li == 0 ? in_ptr(I_CTX) : (const float*)(F.ws + WS_XC), (const bf16_t*)(F.ws + WS_R + (mla ? R_OM : R_OG)), (float*)(F.ws + WS_R + 396 * MiB), lastl); PEND(6); SEAMG(pb + 5, 6); }
#endif
#if EN_TOPK
        if (IN(pb + 6)) { PB(); PSTART(7); _Pragma("unroll 1") for (int rep_ = 0; rep_ < REP_THIN; ++rep_) { phase_topk_conv(F, li, lastl); __syncthreads(); } PEND(7); SEAMG(pb + 6, 7); }
#endif
#if EN_GATHER
        if (IN(pb + 7)) { PB(); PSTART(12); _Pragma("unroll 1") for (int rep_ = 0; rep_ < REP_THIN; ++rep_) { phase_gather(F); __syncthreads(); } PEND(12); SEAMG(pb + 7, 12); }
#endif
#if EN_GU
        if (IN(pb + 8)) { PB(); PSTART(8);
            pg8::Gemm g{(const bf16_t*)(F.ws + WS_H), (const bf16_t*)(F.ws + WS_WGU), D / 2, D / 2, D / 2, 0x7a7a7a7a  , (const int*)(F.ws + WS_STOK)};
            pg8::MoeOrder S; S.init(8, F.G, (int)blockIdx.x); S.rep = REP_MOE; if (lastl) S.nunits = 512 * 8;
            pg8::EpiSwiGlu E{(unsigned char*)(F.ws + WS_R + R_ACT)};
#if defined(PROBE_SEL) && (PROBE_SEL == 40 || PROBE_SEL == 41)
            { unsigned long long qk_ = 0, qe_ = 0; pg8::gemm_phase_x<pg8::EpiSwiGlu, pg8::MoeOrder, false, true, true, true>(F.lds, g, S, E, nullptr, qk_, qe_); if (pr_on) pr_acc += (PROBE_SEL == 40 ? qk_ : qe_); }
#else
            pg8::gemm_phase<pg8::EpiSwiGlu, pg8::MoeOrder, false, true, true>(F.lds, g, S, E, nullptr);
#endif
            PEND(8); SEAMG(pb + 8, 8);
        }
#endif
#if EN_DN
        if (IN(pb + 9)) { PB(); PSTART(9);
            pg8::Gemm g{(const bf16_t*)(F.ws + WS_R + R_ACT), (const bf16_t*)(F.ws + WS_WDN), FF / 2, FF / 2, FF / 2, 0x79797979  , (const int*)(F.ws + WS_GVAL)  };
            pg8::MoeOrder S; S.init(4, F.G, (int)blockIdx.x); S.rep = REP_MOE; if (lastl) S.nunits = 512 * 4;
            pg8::EpiStore E{(bf16_t*)(F.ws + WS_R + R_XS), D, 3};
#if defined(PROBE_SEL) && (PROBE_SEL == 42 || PROBE_SEL == 43)
            { unsigned long long qk_ = 0, qe_ = 0; pg8::gemm_phase_x<pg8::EpiStore, pg8::MoeOrder, false, true, true, true>(F.lds, g, S, E, nullptr, qk_, qe_); if (pr_on) pr_acc += (PROBE_SEL == 42 ? qk_ : qe_); }
#else
            pg8::gemm_phase<pg8::EpiStore, pg8::MoeOrder, false, true, true>(F.lds, g, S, E, nullptr);
#endif
            PEND(9); SEAMG(pb + 9, 9);
        }
#endif
#if EN_LN2
        if (IN(pb + 10)) { PB(); PSTART(10); _Pragma("unroll 1") for (int rp_ = 0; rp_ < REP_LN2; ++rp_) { phase_ln2(F, li, rp_ + 1 < REP_LN2 ? (float*)(F.ws + WS_R + 288 * MiB) : nullptr, lastl); __syncthreads(); } PEND(10); SEAMG(pb + 10, 10); }
#endif
    }
#ifdef PROBE_SEL
    if (pr_on) { const unsigned long long tgt = __builtin_amdgcn_s_memrealtime() + pr_acc; while (__builtin_amdgcn_s_memrealtime() < tgt) __builtin_amdgcn_s_sleep(64); }
#endif
#undef IN
#undef SEAM
}

extern "C" void kernel_launch(void* const* d_in, const int* in_sizes, int n_in, void* d_out, int out_size, void* d_ws, size_t ws_size, hipStream_t stream) {
    static int grid = 0;
    if (grid == 0) {
        if (n_in != 25 || out_size != NB * SEQ * D || ws_size < WS_END) { fprintf(stderr, "kernel_launch: shape/workspace mismatch (n_in %d out %d ws %zu need %zu); nothing launched\n", n_in, out_size, ws_size, (size_t)WS_END); grid = -1; return; }
        int dev = 0, cus = 0, per_cu = 0;
        if (hipGetDevice(&dev) != hipSuccess || hipDeviceGetAttribute(&cus, hipDeviceAttributeMultiprocessorCount, dev) != hipSuccess) { grid = -1; return; }
        if (hipFuncSetAttribute((const void*)mk_fwd, hipFuncAttributeMaxDynamicSharedMemorySize, LDS_BYTES) != hipSuccess) { fprintf(stderr, "kernel_launch: hipFuncSetAttribute failed\n"); grid = -1; return; }
        if (hipOccupancyMaxActiveBlocksPerMultiprocessor(&per_cu, (const void*)mk_fwd, NTHR, LDS_BYTES) != hipSuccess || per_cu < 1) { fprintf(stderr, "kernel_launch: occupancy query says %d\n", per_cu); (void)hipGetLastError(); grid = -1; return; }
        grid = cus < 256 ? cus : 256;
    }
    if (grid < 0) return;
    (void)hipMemsetAsync((char*)d_ws + WS_CTL, 0, CTL_ZERO_BYTES, stream);
    Args a{};
    for (int i = 0; i < 25; ++i) a.in[i] = (const float*)d_in[i];
    a.out = (float*)d_out; a.ws = (unsigned char*)d_ws;
#if MK_ONE_LAUNCH
    a.ph_lo = 0; a.ph_hi = NPH;
    hipLaunchKernelGGL(mk_fwd, dim3(grid), dim3(NTHR), LDS_BYTES, stream, a);
#else
    for (int p = 0; p < NPH; ++p) {
        if (p >= 3 && ((p - 3) % 11) == 2 && (((p - 3) / 11) & 1) == 0) continue;
        a.ph_lo = p; a.ph_hi = p + 1;
        hipLaunchKernelGGL(mk_fwd, dim3(grid), dim3(NTHR), LDS_BYTES, stream, a);
    }
#endif
    const hipError_t le = hipPeekAtLastError();
    if (le != hipSuccess) fprintf(stderr, "kernel_launch: launch failed: %s\n", hipGetErrorName(le));
}
```

```cpp
#define MK_ONE_LAUNCH 1
#define ATT_V2 1
#include <hip/hip_runtime.h>
#include <cstdio>
#include <cstdint>

#define LAS __attribute__((address_space(3)))
#define GAS __attribute__((address_space(1)))
typedef unsigned short bf16_t;
typedef short bf16x8 __attribute__((ext_vector_type(8)));
typedef short s16x4 __attribute__((ext_vector_type(4)));
typedef float f32x2 __attribute__((ext_vector_type(2)));
typedef float f32x4 __attribute__((ext_vector_type(4)));
typedef float f32x16 __attribute__((ext_vector_type(16)));
typedef unsigned u32x2 __attribute__((ext_vector_type(2)));
typedef unsigned u32x4 __attribute__((ext_vector_type(4)));

#ifndef REP_LN1
#define REP_LN1 1
#endif
#ifndef MK_ONE_LAUNCH
#define MK_ONE_LAUNCH 1
#endif

constexpr int D = 1024, NB = 32, SEQ = 2048, CTXL = 256, TPS = SEQ + CTXL  , T = NB * TPS  , NL = 4;
constexpr int NE = 16, FF = 1024, CAPL = 256, CAPC = 32;
constexpr int NSLOT_L = NB * NE * CAPL  , NSLOT = NSLOT_L + NB * NE * CAPC  , NPANEL = NSLOT / 256  ;
constexpr float ALPHA = 1.6817928305074292f, LN_EPS = 1e-6f;
constexpr int NWAVES = 8, NTHR = 512;
constexpr int MODSZ = 6 * D;
constexpr int MOD_KC = 16;

constexpr size_t MiB = 1u << 20;
constexpr size_t WS_CTL = 0, CTL_ZERO_BYTES = 64 * 1024;
constexpr size_t WS_MOD = 1 * MiB;
constexpr size_t WS_ROPE = 5 * MiB;
constexpr size_t WS_WQKV = 6 * MiB;
constexpr size_t WS_WOG = 12 * MiB;
constexpr size_t WS_WD = 16 * MiB;
constexpr size_t WS_WUQ = 21 * MiB;
constexpr size_t WS_WUKV = 26 * MiB;
constexpr size_t WS_WOM = 28 * MiB;
constexpr size_t WS_WGU = 32 * MiB;
constexpr size_t WS_WDN = 96 * MiB;
constexpr size_t WS_XC = 128 * MiB;
constexpr size_t WS_H = 160 * MiB;
constexpr size_t WS_CQ8 = WS_H + 72 * MiB;
constexpr size_t WS_AFF = 304 * MiB;
constexpr size_t WS_INV = 309 * MiB;
constexpr size_t WS_GVAL = 314 * MiB;
constexpr size_t WS_STOK = 315 * MiB;
constexpr size_t WS_RS = 316 * MiB;
constexpr size_t WS_KR = 317 * MiB;
constexpr size_t WS_R = 326 * MiB;
constexpr size_t R_QKV = 0, R_AOG = 216 * MiB, R_OG = 0;
constexpr size_t R_CQ = 0, R_Q = 180 * MiB, R_KV = 396 * MiB, R_AOM = 0, R_OM = 180 * MiB;
constexpr size_t R_O2 = 432 * MiB;
constexpr size_t R_XS = 0, R_ACT = 288 * MiB;
constexpr size_t R_MODP = 0;
constexpr size_t WS_END = WS_R + 684 * MiB;
static_assert((size_t)T * 2048 * 2 == 288 * MiB && (size_t)NSLOT * 1024 * 2 == 288 * MiB && (size_t)T * 1536 * 2 == 216 * MiB && (size_t)T * 1280 * 2 == 180 * MiB, "sizes");
constexpr int CW_BAR = 4096;

constexpr int RING_BYTES = 131072;
constexpr int LDS_BYTES = 163840;
constexpr int MISC_OFF = LDS_BYTES - 256;

__device__ __forceinline__ float bf2f(unsigned b) { return __uint_as_float(b << 16); }
__device__ __forceinline__ unsigned cvt_pk_bf16(float lo, float hi) { unsigned r; asm volatile("v_cvt_pk_bf16_f32 %0, %1, %2" : "=v"(r) : "v"(lo), "v"(hi)); return r; }
#define DPP_MOV(v, ctrl) __builtin_bit_cast(float, __builtin_amdgcn_update_dpp(0, __builtin_bit_cast(int, (float)(v)), (ctrl), 0xf, 0xf, true))
__device__ __forceinline__ float lane_xor16(float v) { return __builtin_bit_cast(float, __builtin_amdgcn_ds_swizzle(__builtin_bit_cast(int, v), 0x401F)); }
__device__ __forceinline__ float wave_sum(float v) {
    v += DPP_MOV(v, 0xB1);
    v += DPP_MOV(v, 0x4E);
    v += DPP_MOV(v, 0x141);
    v += DPP_MOV(v, 0x140);
    v += lane_xor16(v);
    { auto rr = __builtin_amdgcn_permlane32_swap(__float_as_uint(v), __float_as_uint(v), false, false); v = __uint_as_float(rr[0]) + __uint_as_float(rr[1]); }
    return v;
}
#define LDS_WAIT() asm volatile("s_waitcnt lgkmcnt(0)" ::: "memory")
#define VM_WAIT() asm volatile("s_waitcnt vmcnt(0)" ::: "memory")
__device__ __forceinline__ int opaque_v(int x) { asm volatile("" : "+v"(x)); return x; }
__device__ __forceinline__ int opaque_s(int x) { asm volatile("" : "+s"(x)); return x; }
__device__ __forceinline__ const float* in_ptr(int i) {
    const __attribute__((address_space(4))) char* kp = (const __attribute__((address_space(4))) char*)__builtin_amdgcn_kernarg_segment_ptr();
    const int off = opaque_s(i * 8);
    return *(const float* const __attribute__((address_space(4)))*)(kp + off);
}
__device__ __forceinline__ unsigned cvt4_fp8(float a, float b, float c, float d) {
    a = __builtin_fminf(__builtin_fmaxf(a, -448.f), 448.f); b = __builtin_fminf(__builtin_fmaxf(b, -448.f), 448.f); c = __builtin_fminf(__builtin_fmaxf(c, -448.f), 448.f); d = __builtin_fminf(__builtin_fmaxf(d, -448.f), 448.f);
    int w = 0; w = __builtin_amdgcn_cvt_pk_fp8_f32(a, b, w, false); w = __builtin_amdgcn_cvt_pk_fp8_f32(c, d, w, true); return (unsigned)w;
}
constexpr float WGU_SCALE = 32.f, WDN_SCALE = 64.f, WP_SCALE = 32.f, WO_SCALE = 64.f, AO_SCALE = 16.f;
#ifndef ATT_SD_MLA
#define ATT_SD_MLA 1
#endif
#define XB_TMO      128
#define XB_XCNT(j)  (256  + 64 * (j))
#define XB_XSUB(j)  (1280 + 64 * (j))
#define XB_XGEN(j)  (2304 + 64 * (j))
#define XB_TOP      3328
#define XB_TOPGEN   3392
#define XCD_BAR_WORDS 3456
#define XB_SPIN_CAP (1u << 18)

__device__ __forceinline__ unsigned xb_ld(unsigned* p)              { return __hip_atomic_load(p, __ATOMIC_RELAXED, __HIP_MEMORY_SCOPE_AGENT); }
__device__ __forceinline__ unsigned xb_add(unsigned* p, unsigned v) { return __hip_atomic_fetch_add(p, v, __ATOMIC_RELAXED, __HIP_MEMORY_SCOPE_AGENT); }
__device__ __forceinline__ unsigned xb_xcc_id() { return (unsigned)__builtin_amdgcn_s_getreg((3 << 11) | 20) & 0xFu; }
#define XB_SPIN(cond, bar) do { unsigned _sp = 0; while (cond) { __builtin_amdgcn_s_sleep(1); \
    if ((++_sp & 255u) == 0u) { if (xb_ld(&(bar)[XB_TMO])) break; if (_sp > XB_SPIN_CAP) { atomicAdd(&(bar)[XB_TMO], 1u); break; } } } } while (0)

struct XcdBarrier {
    unsigned* bar; unsigned x;
    volatile LAS unsigned* st;
};

__device__ __forceinline__ XcdBarrier xcd_barrier_post(unsigned* bar, volatile LAS unsigned* st) {
    XcdBarrier b; b.bar = bar; b.x = xb_xcc_id(); b.st = st;
    if (threadIdx.x == 0) (void)xb_add(&bar[XB_XCNT(b.x)], 1u);
    return b;
}
__device__ __forceinline__ void xcd_barrier_complete(unsigned* bar, unsigned x, unsigned& nloc, unsigned& nx) {
    const unsigned G = gridDim.x * gridDim.y * gridDim.z;
    unsigned sum, cnt, mine, sp = 0u;
    for (;;) {
        sum = 0u; cnt = 0u; mine = 0u;
#pragma unroll
        for (unsigned j = 0; j < 16; ++j) { const unsigned c = xb_ld(&bar[XB_XCNT(j)]); sum += c; cnt += (c > 0u) ? 1u : 0u; mine = (j == x) ? c : mine; }
        if (sum == G) break;
        __builtin_amdgcn_s_sleep(1);
        if ((++sp & 255u) == 0u) { if (xb_ld(&bar[XB_TMO])) break; if (sp > XB_SPIN_CAP) { atomicAdd(&bar[XB_TMO], 1u); break; } }
    }
    nloc = mine > 0u ? mine : 1u; nx = cnt > 0u ? cnt : 1u;
}

__device__ __forceinline__ void xcd_barrier(const XcdBarrier& b) {
    asm volatile("s_waitcnt vmcnt(0)" ::: "memory");
    __syncthreads();
    if (threadIdx.x == 0) {
        unsigned* bar = b.bar;
        __builtin_amdgcn_s_waitcnt(0);
        unsigned nloc = b.st[0], nx = b.st[1];
        if (nloc == 0u) { xcd_barrier_complete(bar, b.x, nloc, nx); b.st[0] = nloc; b.st[1] = nx; }
        const unsigned old = xb_add(&bar[XB_XSUB(b.x)], 1u);
        const unsigned gen = old / nloc;
        if (old + 1u == (gen + 1u) * nloc) {
            __builtin_amdgcn_fence(__ATOMIC_RELEASE, "agent");
            asm volatile("s_waitcnt vmcnt(0)" ::: "memory");
            const unsigned og = xb_add(&bar[XB_TOP], 1u);
            const unsigned tg = og / nx;
            if (og + 1u == (tg + 1u) * nx) xb_add(&bar[XB_TOPGEN], 1u);
            else XB_SPIN(xb_ld(&bar[XB_TOPGEN]) == tg, bar);
            __builtin_amdgcn_fence(__ATOMIC_ACQUIRE, "agent");
            xb_add(&bar[XB_XGEN(b.x)], 1u);
            asm volatile("s_waitcnt vmcnt(0)" ::: "memory");
        } else {
            XB_SPIN(xb_ld(&bar[XB_XGEN(b.x)]) == gen, bar);
            __builtin_amdgcn_fence(__ATOMIC_ACQUIRE, "agent");
            asm volatile("s_waitcnt vmcnt(0)" ::: "memory");
        }
    }
    __syncthreads();
}

namespace pg8 {
#define PG8_LAS __attribute__((address_space(3)))
constexpr int BM = 256, BK = 64, HALF = 128, HTB = HALF * BK * 2  , STAGE_BYTES = 8 * HTB, NXCD = 8, WGM = 8;

__host__ __device__ __forceinline__ int lds_byte(int r, int c) { const int st = (r >> 4) * 2 + (c >> 5), rr = r & 15, cc = c & 31, ob = rr * 64 + cc * 2; return st * 1024 + (ob ^ (((ob >> 9) & 1) << 5)); }
__host__ __device__ __forceinline__ void stage_rc(int b, int& R, int& C) { const int st = b / 1024, sb = b % 1024, swz = sb ^ (((sb >> 9) & 1) << 5); R = (st >> 1) * 16 + swz / 64; C = (st & 1) * 32 + (swz % 64) / 2; }
__host__ __device__ __forceinline__ int perm32(int rho) { const int n = rho >> 4, i = rho & 15; return 8 * (i >> 2) + 4 * n + (i & 3); }

struct Unit { int pm, pn; };
struct Gemm { const bf16_t* A; const bf16_t* Bt; int lda, ldb, K; int pad; const int* ridx = nullptr; };

struct StaticOrder {
    int nM, nN, nwg, G, c, rep; bool skipctx;
    __host__ __device__ void init(int M, int N, int G_, int c_) { nM = M / BM; nN = N / BM; nwg = nM * nN; G = G_; c = c_; rep = 1; skipctx = false; }
    __host__ __device__ bool next(int i, Unit& u) const {
        const long L = (long)(i / rep) * G + c; if (L >= nwg) return false;
        int wgid = (int)L; { const int q = nwg / NXCD, r = nwg % NXCD, xcd = wgid % NXCD, off = wgid / NXCD; wgid = (xcd < r ? xcd * (q + 1) : r * (q + 1) + (xcd - r) * q) + off; }
        const int nig = WGM * nN, gid = wgid / nig, fm = gid * WGM, gsz = (nM - fm) < WGM ? (nM - fm) : WGM;
        u.pm = fm + ((wgid % nig) % gsz); u.pn = (wgid % nig) / gsz; if (skipctx) u.pm = (u.pm >> 3) * 9 + 1 + (u.pm & 7); return true;
    }
    __device__ __forceinline__ void a_ready(const Unit&) const {}
    __device__ __forceinline__ void done(const Unit&) const {}
};
typedef int pg8_v8i __attribute__((ext_vector_type(8)));
#ifdef PROBE_CLK
#define PG8_PROBE_NOW() (__builtin_amdgcn_s_memtime() / 20ull)
#else
#define PG8_PROBE_NOW() __builtin_amdgcn_s_memrealtime()
#endif
#ifndef PG8_DMAMMA
#define PG8_DMAMMA 0
#endif
#ifndef PG8_BUF
#define PG8_BUF 0
#endif
__device__ __forceinline__ __amdgpu_buffer_rsrc_t pg8_rsrc(const void* p) {
    const unsigned long long v = (unsigned long long)(size_t)p; const unsigned lo = __builtin_amdgcn_readfirstlane((unsigned)v), hi = __builtin_amdgcn_readfirstlane((unsigned)(v >> 32));
    return __builtin_amdgcn_make_buffer_rsrc((void*)(size_t)(((unsigned long long)hi << 32) | lo), 0, -1, 0x00020000);
}
template <class Epi, class Sched, bool STAMP, bool GATHER, bool FP8, bool PRB>
__device__ __forceinline__ void gemm_phase_x(PG8_LAS unsigned char* lds, const Gemm g, const Sched& S, const Epi& E, unsigned long long* stamps, unsigned long long& pk, unsigned long long& pe);
template <class Epi, class Sched, bool STAMP = false, bool GATHER = false, bool FP8 = false>
__device__ __forceinline__ void gemm_phase(PG8_LAS unsigned char* lds, const Gemm g, const Sched& S, const Epi& E, unsigned long long* stamps) { unsigned long long a_ = 0, b_ = 0; gemm_phase_x<Epi, Sched, STAMP, GATHER, FP8, false>(lds, g, S, E, stamps, a_, b_); }
template <class Epi, class Sched, bool STAMP, bool GATHER, bool FP8, bool PRB>
__device__ __forceinline__ void gemm_phase_x(PG8_LAS unsigned char* lds, const Gemm g, const Sched& S, const Epi& E, unsigned long long* stamps, unsigned long long& pk, unsigned long long& pe) {
    unsigned long long pt_ = 0;
    const int tid = opaque_v((int)threadIdx.x), wid = __builtin_amdgcn_readfirstlane(tid >> 6), lane = tid & 63, wr = wid >> 2, wc = wid & 3, fr = lane & 15, fq = lane >> 4;
    const int K = g.K, nt = K / BK;
    const int wscale = g.pad;
    int ts_lo = 0, ts_hi = 0, nts = 0; const unsigned long long rt_entry = STAMP ? (unsigned long long)wall_clock64() : 0ull;
#define PG8_STAMP() do { if (STAMP && wid == 0 && nts < 64) { const unsigned long long _c = (unsigned long long)clock64(); \
        ts_lo = (lane == nts) ? (int)(unsigned)_c : ts_lo; ts_hi = (lane == nts) ? (int)(unsigned)(_c >> 32) : ts_hi; ++nts; } } while (0)
    PG8_STAMP();
    unsigned voffA[2], voffB[2];
#pragma unroll
    for (int i = 0; i < 2; ++i) { int R, C; stage_rc(tid * 16 + i * 8192, R, C); const int Rb = Epi::PERM ? ((R & ~31) + perm32(R & 31)) : R;
        voffA[i] = GATHER ? (unsigned)C * 2u : (unsigned)(R * g.lda + C) * 2u; voffB[i] = (unsigned)(Rb * g.ldb + C) * 2u; }
    unsigned vs[2][2];
#define PG8_LDRAW(pm_) do { if (wid < 4) __builtin_amdgcn_global_load_lds((const unsigned*)(g.ridx + ((pm_) * BM + wid * 64 + lane)), (PG8_LAS unsigned*)(lds + STAGE_BYTES + wid * 256), 4, 0, 0); } while (0)
#define PG8_CONV(vo) do { _Pragma("unroll") for (int _h = 0; _h < 2; ++_h) _Pragma("unroll") for (int _i = 0; _i < 2; ++_i) { int _R, _C; stage_rc(tid * 16 + _i * 8192, _R, _C); \
        int _v = *(const PG8_LAS int*)(lds + STAGE_BYTES + (_h * HALF + _R) * 4); _v = _v < 0 ? 0 : _v; (vo)[_h][_i] = (unsigned)_v * (unsigned)(g.lda * 2) + voffA[_i]; } } while (0)
    const size_t kstep = (size_t)(BK * 2);
    const size_t hstepA = (size_t)HALF * g.lda * 2, hstepB = (size_t)HALF * g.ldb * 2;
    const size_t tstepA = GATHER ? 0 : 2 * hstepA, tstepB = 2 * hstepB;
    const unsigned ldsw = (unsigned)wid * 1024u;
    const int aoff = lds_byte(wr * 64 + fr, fq * 8), boff = lds_byte(wc * 32 + fr, fq * 8);
#define PG8_SA(b, h) (((b) * 2 + (h)) * HTB)
#define PG8_SB(b, h) ((4 + (b) * 2 + (h)) * HTB)
#if PG8_BUF
    const __amdgpu_buffer_rsrc_t rsA = pg8_rsrc(g.A), rsB = pg8_rsrc(g.Bt);
#define PG8_STAGE_R(rs, base0, bufoff, gbase, voff) do { const int _so = __builtin_amdgcn_readfirstlane((int)(unsigned)((const char*)(gbase) - (const char*)(base0))); _Pragma("unroll") for (int _i = 0; _i < 2; ++_i) \
        __builtin_amdgcn_raw_ptr_buffer_load_lds(rs, (PG8_LAS void*)(lds + (bufoff) + ldsw + _i * 8192), 16, (int)(voff)[_i], _so, 0, 0); } while (0)
#define PG8_STAGE(bufoff, gbase, voff) PG8_STAGE_R(rsB, g.Bt, bufoff, gbase, voff)
#define PG8_STAGEA(bufoff, base, half, vsel) do { if constexpr (GATHER) PG8_STAGE_R(rsA, g.A, bufoff, base, vsel[half]); else PG8_STAGE_R(rsA, g.A, bufoff, (base) + (half) * hstepA, voffA); } while (0)
#else
#define PG8_STAGE(bufoff, gbase, voff) do { _Pragma("unroll") for (int _i = 0; _i < 2; ++_i) \
        __builtin_amdgcn_global_load_lds((const unsigned*)((const char*)(gbase) + (voff)[_i]), (PG8_LAS unsigned*)(lds + (bufoff) + ldsw + _i * 8192), 16, 0, 0); } while (0)
#define PG8_STAGEA(bufoff, base, half, vsel) do { if constexpr (GATHER) PG8_STAGE(bufoff, base, vsel[half]); else PG8_STAGE(bufoff, (base) + (half) * hstepA, voffA); } while (0)
#endif
#define PG8_LDA(dst, b, h) do { if constexpr (FP8) { _Pragma("unroll") for (int m = 0; m < 4; ++m) { const u32x4 lo_ = *(const PG8_LAS u32x4*)(lds + PG8_SA(b, h) + aoff + m * 2048), hi_ = *(const PG8_LAS u32x4*)(lds + PG8_SA(b, h) + aoff + m * 2048 + 1024); \
        dst##8[m] = __builtin_bit_cast(pg8_v8i, __builtin_shufflevector(lo_, hi_, 0, 1, 2, 3, 4, 5, 6, 7)); } } \
    else { _Pragma("unroll") for (int m = 0; m < 4; ++m) _Pragma("unroll") for (int k = 0; k < 2; ++k) dst[m][k] = *(const PG8_LAS bf16x8*)(lds + PG8_SA(b, h) + aoff + m * 2048 + k * 1024); } } while (0)
#define PG8_LDB(dst, b, h) do { if constexpr (FP8) { _Pragma("unroll") for (int n = 0; n < 2; ++n) { const u32x4 lo_ = *(const PG8_LAS u32x4*)(lds + PG8_SB(b, h) + boff + n * 2048), hi_ = *(const PG8_LAS u32x4*)(lds + PG8_SB(b, h) + boff + n * 2048 + 1024); \
        dst##8[n] = __builtin_bit_cast(pg8_v8i, __builtin_shufflevector(lo_, hi_, 0, 1, 2, 3, 4, 5, 6, 7)); } } \
    else { _Pragma("unroll") for (int n = 0; n < 2; ++n) _Pragma("unroll") for (int k = 0; k < 2; ++k) dst[n][k] = *(const PG8_LAS bf16x8*)(lds + PG8_SB(b, h) + boff + n * 2048 + k * 1024); } } while (0)
#define PG8_MMA(ai, bj, At, Bt) do { __builtin_amdgcn_s_setprio(1); _Pragma("unroll") for (int m = 0; m < 4; ++m) _Pragma("unroll") for (int n = 0; n < 2; ++n) _Pragma("unroll") for (int k = 0; k < 2; ++k) \
        acc[ai][bj][m][n] = __builtin_amdgcn_mfma_f32_16x16x32_bf16(Bt[n][k], At[m][k], acc[ai][bj][m][n], 0, 0, 0); __builtin_amdgcn_s_setprio(0); } while (0)
#define PG8_MMA8(ai, bj, At, Bt) do { __builtin_amdgcn_s_setprio(1); _Pragma("unroll") for (int m = 0; m < 4; ++m) _Pragma("unroll") for (int n = 0; n < 2; ++n) \
        acc[ai][bj][m][n] = __builtin_amdgcn_mfma_scale_f32_16x16x128_f8f6f4(Bt##8[n], At##8[m], acc[ai][bj][m][n], 0, 0, 0, wscale, 0, 0x7f7f7f7f); \
        __builtin_amdgcn_s_setprio(0); } while (0)
#define PG8_MMX(ai, bj, At, Bt) do { if constexpr (FP8) PG8_MMA8(ai, bj, At, Bt); else PG8_MMA(ai, bj, At, Bt); } while (0)
#define PG8_PIECE(bufoff, gbase, voff, i) __builtin_amdgcn_global_load_lds((const unsigned*)((const char*)(gbase) + (voff)[i]), (PG8_LAS unsigned*)(lds + (bufoff) + ldsw + (i) * 8192), 16, 0, 0)
#define PG8_PIECEB(bufoff, gbase, i) PG8_PIECE(bufoff, gbase, voffB, i)
#define PG8_PIECEA(bufoff, base, half, i) do { if constexpr (GATHER) PG8_PIECE(bufoff, base, vs[half], i); else PG8_PIECE(bufoff, (base) + (half) * hstepA, voffA, i); } while (0)
#define PG8_MF8(ai, bj, At, Bt, m, n) acc[ai][bj][m][n] = __builtin_amdgcn_mfma_scale_f32_16x16x128_f8f6f4(Bt##8[n], At##8[m], acc[ai][bj][m][n], 0, 0, 0, wscale, 0, 0x7f7f7f7f)
#define PG8_MF16(ai, bj, At, Bt, m, n) do { acc[ai][bj][m][n] = __builtin_amdgcn_mfma_f32_16x16x32_bf16(Bt[n][0], At[m][0], acc[ai][bj][m][n], 0, 0, 0); acc[ai][bj][m][n] = __builtin_amdgcn_mfma_f32_16x16x32_bf16(Bt[n][1], At[m][1], acc[ai][bj][m][n], 0, 0, 0); } while (0)
#define PG8_MF(ai, bj, At, Bt, m, n) do { if constexpr (FP8) PG8_MF8(ai, bj, At, Bt, m, n); else PG8_MF16(ai, bj, At, Bt, m, n); } while (0)
#define PG8_MMXS(ai, bj, At, Bt, S0, S1) do { __builtin_amdgcn_s_setprio(1); PG8_MF(ai, bj, At, Bt, 0, 0); PG8_MF(ai, bj, At, Bt, 0, 1); PG8_SCHED; S0; PG8_SCHED; \
        PG8_MF(ai, bj, At, Bt, 1, 0); PG8_MF(ai, bj, At, Bt, 1, 1); PG8_MF(ai, bj, At, Bt, 2, 0); PG8_SCHED; S1; PG8_SCHED; PG8_MF(ai, bj, At, Bt, 2, 1); PG8_MF(ai, bj, At, Bt, 3, 0); PG8_MF(ai, bj, At, Bt, 3, 1); \
        __builtin_amdgcn_s_setprio(0); } while (0)
#define PG8_WAIT_V(n) asm volatile("s_waitcnt vmcnt(" #n ")" ::: "memory")
#define PG8_WAIT_L(n) asm volatile("s_waitcnt lgkmcnt(" #n ")" ::: "memory")
#define PG8_BAR __builtin_amdgcn_s_barrier()
#define PG8_SCHED __builtin_amdgcn_sched_barrier(0)
    Unit cur, nxt; int ui = 0;
    if (!S.next(0, cur)) return;
    f32x4 acc[2][2][4][2];
#pragma unroll
    for (int a = 0; a < 2; ++a)
#pragma unroll
        for (int b = 0; b < 2; ++b)
#pragma unroll
            for (int m = 0; m < 4; ++m)
#pragma unroll
                for (int n = 0; n < 2; ++n) acc[a][b][m][n] = (f32x4){0.f, 0.f, 0.f, 0.f};
    bf16x8 At[4][2], B0[2][2], B1[2][2]; pg8_v8i At8[4], B08[2], B18[2];
    const char* cA = (const char*)g.A + (size_t)cur.pm * tstepA; const char* cB = (const char*)g.Bt + (size_t)cur.pn * tstepB;
    S.a_ready(cur);
    if constexpr (GATHER) { PG8_LDRAW(cur.pm); asm volatile("s_waitcnt vmcnt(0)" ::: "memory"); __builtin_amdgcn_s_barrier(); asm volatile("" ::: "memory"); PG8_CONV(vs); asm volatile("s_waitcnt lgkmcnt(0)" ::: "memory"); __builtin_amdgcn_s_barrier(); }
    PG8_STAGE(PG8_SB(0, 0), cB, voffB); PG8_STAGEA(PG8_SA(0, 0), cA, 0, vs); PG8_STAGE(PG8_SB(0, 1), cB + hstepB, voffB); PG8_STAGEA(PG8_SA(0, 1), cA, 1, vs);
    if (wr == 1) PG8_BAR;
    PG8_WAIT_V(4); PG8_BAR;
    PG8_STAGE(PG8_SB(1, 0), cB + kstep, voffB); PG8_STAGEA(PG8_SA(1, 0), cA + kstep, 0, vs); PG8_STAGE(PG8_SB(1, 1), cB + hstepB + kstep, voffB);
    PG8_WAIT_V(6); PG8_BAR;
    PG8_STAMP();
    for (;;) {
        if constexpr (PRB) { if (wid == 0) pt_ = PG8_PROBE_NOW(); }
        const bool has_next = S.next(ui + 1, nxt);
        if constexpr (GATHER) { if (has_next) PG8_LDRAW(nxt.pm); }
        const char* nA = has_next ? (const char*)g.A + (size_t)nxt.pm * tstepA : cA; const char* nB = has_next ? (const char*)g.Bt + (size_t)nxt.pn * tstepB : cB;
#pragma unroll 1
        for (int t = 0; t < nt; t += 2) {
            const bool last = (t == nt - 2);
            const char* a1 = cA + (size_t)(t + 1) * kstep;
            const char* a2 = last ? nA : cA + (size_t)(t + 2) * kstep; const char* b2 = last ? nB : cB + (size_t)(t + 2) * kstep;
            const char* a3 = a2 + kstep; const char* b3 = b2 + kstep;
            if (last && has_next) S.a_ready(nxt);
#if PG8_DMAMMA
            PG8_LDB(B0, 0, 0); PG8_SCHED; PG8_LDA(At, 0, 0);
            PG8_WAIT_L(8); PG8_BAR; PG8_WAIT_L(0); PG8_MMXS(0, 0, At, B0, PG8_PIECEA(PG8_SA(1, 1), a1, 1, 0), PG8_PIECEA(PG8_SA(1, 1), a1, 1, 1)); PG8_BAR; PG8_SCHED;
            PG8_LDB(B1, 0, 1);
            if constexpr (GATHER) { if (last && has_next) { PG8_CONV(vs); asm volatile("" : "+v"(vs[0][0]), "+v"(vs[0][1]), "+v"(vs[1][0]), "+v"(vs[1][1])); } }
            PG8_BAR; PG8_WAIT_L(0); PG8_MMXS(0, 1, At, B1, PG8_PIECEB(PG8_SB(0, 0), b2, 0), PG8_PIECEB(PG8_SB(0, 0), b2, 1)); PG8_BAR;
            PG8_LDA(At, 0, 1);
            PG8_BAR; PG8_WAIT_L(0); PG8_MMXS(1, 0, At, B0, PG8_PIECEA(PG8_SA(0, 0), a2, 0, 0), PG8_PIECEA(PG8_SA(0, 0), a2, 0, 1)); PG8_BAR; PG8_SCHED;
            PG8_WAIT_V(4); PG8_BAR; PG8_MMXS(1, 1, At, B1, PG8_PIECEB(PG8_SB(0, 1), b2 + hstepB, 0), PG8_PIECEB(PG8_SB(0, 1), b2 + hstepB, 1)); PG8_BAR;
            PG8_LDB(B0, 1, 0); PG8_SCHED; PG8_LDA(At, 1, 0);
            PG8_WAIT_L(8); PG8_BAR; PG8_WAIT_L(0); PG8_MMXS(0, 0, At, B0, PG8_PIECEA(PG8_SA(0, 1), a2, 1, 0), PG8_PIECEA(PG8_SA(0, 1), a2, 1, 1)); PG8_BAR; PG8_SCHED;
            PG8_LDB(B1, 1, 1);
            PG8_BAR; PG8_WAIT_L(0); PG8_MMXS(0, 1, At, B1, PG8_PIECEB(PG8_SB(1, 0), b3, 0), PG8_PIECEB(PG8_SB(1, 0), b3, 1)); PG8_BAR;
            PG8_LDA(At, 1, 1);
            PG8_BAR; PG8_WAIT_L(0); PG8_MMXS(1, 0, At, B0, PG8_PIECEA(PG8_SA(1, 0), a3, 0, 0), PG8_PIECEA(PG8_SA(1, 0), a3, 0, 1)); PG8_BAR; PG8_SCHED;
            PG8_WAIT_V(4); PG8_BAR; PG8_MMXS(1, 1, At, B1, PG8_PIECEB(PG8_SB(1, 1), b3 + hstepB, 0), PG8_PIECEB(PG8_SB(1, 1), b3 + hstepB, 1)); PG8_BAR;
#else
            PG8_LDB(B0, 0, 0); PG8_SCHED; PG8_LDA(At, 0, 0); PG8_STAGEA(PG8_SA(1, 1), a1, 1, vs);
            if constexpr (GATHER) { if (last && has_next) { PG8_CONV(vs); asm volatile("" : "+v"(vs[0][0]), "+v"(vs[0][1]), "+v"(vs[1][0]), "+v"(vs[1][1])); } }
            PG8_WAIT_L(8); PG8_BAR; PG8_WAIT_L(0); PG8_MMX(0, 0, At, B0); PG8_BAR; PG8_SCHED;
            PG8_LDB(B1, 0, 1); PG8_STAGE(PG8_SB(0, 0), b2, voffB);
            PG8_BAR; PG8_WAIT_L(0); PG8_MMX(0, 1, At, B1); PG8_BAR;
            PG8_LDA(At, 0, 1); PG8_STAGEA(PG8_SA(0, 0), a2, 0, vs);
            PG8_BAR; PG8_WAIT_L(0); PG8_MMX(1, 0, At, B0); PG8_BAR; PG8_SCHED;
            PG8_STAGE(PG8_SB(0, 1), b2 + hstepB, voffB);
            PG8_WAIT_V(6); PG8_BAR; PG8_MMX(1, 1, At, B1); PG8_BAR;
            PG8_LDB(B0, 1, 0); PG8_SCHED; PG8_LDA(At, 1, 0); PG8_STAGEA(PG8_SA(0, 1), a2, 1, vs);
            PG8_WAIT_L(8); PG8_BAR; PG8_WAIT_L(0); PG8_MMX(0, 0, At, B0); PG8_BAR; PG8_SCHED;
            PG8_LDB(B1, 1, 1); PG8_STAGE(PG8_SB(1, 0), b3, voffB);
            PG8_BAR; PG8_WAIT_L(0); PG8_MMX(0, 1, At, B1); PG8_BAR;
            PG8_LDA(At, 1, 1); PG8_STAGEA(PG8_SA(1, 0), a3, 0, vs);
            PG8_BAR; PG8_WAIT_L(0); PG8_MMX(1, 0, At, B0); PG8_BAR; PG8_SCHED;
            PG8_STAGE(PG8_SB(1, 1), b3 + hstepB, voffB);
            PG8_WAIT_V(6); PG8_BAR; PG8_MMX(1, 1, At, B1); PG8_BAR;
#endif
        }
        PG8_STAMP();
        if constexpr (PRB) { if (wid == 0) { const unsigned long long n_ = PG8_PROBE_NOW(); pk += n_ - pt_; pt_ = n_; } }
        if constexpr (!Epi::AFTER_DRAIN) { E(acc, cur, wr, wc, fr, fq); S.done(cur); }
        if constexpr (PRB) { if (wid == 0) { const unsigned long long n_ = PG8_PROBE_NOW(); pe += n_ - pt_; } }
        PG8_STAMP();
        if (!has_next) break;
#pragma unroll
        for (int a = 0; a < 2; ++a)
#pragma unroll
            for (int b = 0; b < 2; ++b)
#pragma unroll
                for (int m = 0; m < 4; ++m)
#pragma unroll
                    for (int n = 0; n < 2; ++n) acc[a][b][m][n] = (f32x4){0.f, 0.f, 0.f, 0.f};
        cur = nxt; cA = nA; cB = nB; ++ui;
    }
    PG8_WAIT_V(0);
    if (wr == 0) PG8_BAR;
    PG8_BAR;
    if constexpr (Epi::AFTER_DRAIN) { E.fused(acc, cur, wr, wc, fr, fq, lds, wid, lane); S.done(cur); }
    PG8_STAMP();
    if (STAMP && wid == 0) { stamps[lane] = lane < nts ? (((unsigned long long)(unsigned)ts_hi << 32) | (unsigned)ts_lo) : 0ull;
        if (lane == 62) stamps[62] = rt_entry; if (lane == 63) stamps[63] = (unsigned long long)wall_clock64(); }
#undef PG8_STAMP
#undef PG8_SA
#undef PG8_SB
#undef PG8_STAGE
#undef PG8_STAGEA
#undef PG8_LDRAW
#undef PG8_CONV
#undef PG8_LDA
#undef PG8_LDB
#undef PG8_MMA
#undef PG8_MMA8
#undef PG8_MMX
#undef PG8_WAIT_V
#undef PG8_WAIT_L
#undef PG8_BAR
#undef PG8_SCHED
}
}
namespace pg8 {
struct MoeOrder {
    int NT, G, c, nunits, rep;
    __device__ void init(int NT_, int G_, int c_) { NT = NT_; G = G_; c = c_; nunits = NPANEL * NT_; rep = 1; }
    __device__ bool next(int i, Unit& u) const {
        const long L0 = (long)(i / rep) * G + c; if (L0 >= nunits) return false;
        int pr, pnl;
        if (G == 256) { const int x = c & 7, jj = c >> 3, PX = 32 / NT; pr = (i / rep) * (256 / NT) + x * PX + jj / NT; pnl = jj % NT; }
        else { pr = (int)L0 / NT; pnl = (int)L0 % NT; }
        int pm, e;
        if (pr < 512) { e = pr >> 5; pm = (pr & 31) * 16 + e; } else { pm = pr; e = (pr - 512) >> 2; }
        u.pm = pm; u.pn = e * NT + pnl; return true;
    }
    __device__ __forceinline__ void a_ready(const Unit&) const {}
    __device__ __forceinline__ void done(const Unit&) const {}
};

__device__ __forceinline__ u32x4 pack8(const f32x4 a, const f32x4 b) { u32x4 w; w.x = cvt_pk_bf16(a[0], a[1]); w.y = cvt_pk_bf16(a[2], a[3]); w.z = cvt_pk_bf16(b[0], b[1]); w.w = cvt_pk_bf16(b[2], b[3]); return w; }

struct EpiStore {
    static constexpr bool PERM = true, AFTER_DRAIN = false;
    bf16_t* O; int ldc; int pnmask;
    __device__ __forceinline__ void operator()(const f32x4 (&acc)[2][2][4][2], const Unit& u, int wr, int wc, int fr, int fq) const {
        const int row0 = u.pm * BM + wr * 64 + fr, col0 = (u.pn & pnmask) * BM + wc * 32 + 8 * fq;
#pragma unroll
        for (int ai = 0; ai < 2; ++ai)
#pragma unroll
            for (int m = 0; m < 4; ++m) { const int row = row0 + ai * HALF + m * 16; bf16_t* rowp = O + (size_t)row * ldc + col0;
#pragma unroll
                for (int bj = 0; bj < 2; ++bj) *(u32x4*)(rowp + bj * HALF) = pack8(acc[ai][bj][m][0], acc[ai][bj][m][1]);
                __builtin_amdgcn_sched_barrier(0); }
    }
};
struct EpiUq {
    static constexpr bool PERM = true, AFTER_DRAIN = false;
    bf16_t* O; const float* rcos; const float* rsin;
    __device__ __forceinline__ void operator()(const f32x4 (&acc)[2][2][4][2], const Unit& u, int wr, int wc, int fr, int fq) const {
        const int row0 = u.pm * BM + wr * 64 + fr, col0 = u.pn * BM + wc * 32 + 8 * fq;
        const int bsmp = u.pm / 9, ptile = u.pm - bsmp * 9; const bool latent = ptile != 0;
        int j0[2]; bool inr[2];
#pragma unroll
        for (int bj = 0; bj < 2; ++bj) { const int c = col0 + bj * HALF, hd = c / 192, off = c - hd * 192; inr[bj] = latent && off >= 128; j0[bj] = (off - 128) >> 1; }
#pragma unroll
        for (int ai = 0; ai < 2; ++ai)
#pragma unroll
            for (int m = 0; m < 4; ++m) { const int row = row0 + ai * HALF + m * 16; bf16_t* rowp = O + (size_t)row * 1536 + col0;
                const int t = row - bsmp * TPS - CTXL, trow = (t >> 6) & 31, tcol = t & 63;
#pragma unroll
                for (int bj = 0; bj < 2; ++bj) { f32x4 a = acc[ai][bj][m][0], b = acc[ai][bj][m][1];
                    if (inr[bj]) { const int pos = j0[bj] < 16 ? trow : tcol, ti = pos * 16 + (j0[bj] & 15);
                        const f32x4 cs = *(const f32x4*)(rcos + ti), sn = *(const f32x4*)(rsin + ti);
                        const f32x4 a2 = {a[0] * cs[0] - a[1] * sn[0], a[0] * sn[0] + a[1] * cs[0], a[2] * cs[1] - a[3] * sn[1], a[2] * sn[1] + a[3] * cs[1]};
                        const f32x4 b2 = {b[0] * cs[2] - b[1] * sn[2], b[0] * sn[2] + b[1] * cs[2], b[2] * cs[3] - b[3] * sn[3], b[2] * sn[3] + b[3] * cs[3]};
                        a = a2; b = b2; }
                    *(u32x4*)(rowp + bj * HALF) = pack8(a, b); } }
    }
};
struct EpiSwiGlu {
    static constexpr bool PERM = true, AFTER_DRAIN = false;
    unsigned char* O;
    __device__ __forceinline__ void operator()(const f32x4 (&acc)[2][2][4][2], const Unit& u, int wr, int wc, int fr, int fq) const {
        const int row0 = u.pm * BM + wr * 64 + fr, col0 = (u.pn & 7) * HALF + wc * 32 + 8 * fq;
#pragma unroll
        for (int ai = 0; ai < 2; ++ai)
#pragma unroll
            for (int m = 0; m < 4; ++m) { unsigned char* rowp = O + (size_t)(row0 + ai * HALF + m * 16) * FF + col0; f32x4 r[2];
#pragma unroll
                for (int n = 0; n < 2; ++n) { const f32x4 g = acc[ai][0][m][n], up = acc[ai][1][m][n];
#pragma unroll
                    for (int j = 0; j < 4; ++j) r[n][j] = g[j] * __builtin_amdgcn_rcpf(1.0f + __builtin_amdgcn_exp2f(-1.4426950408889634f * g[j])) * up[j]; }
                u32x2 w; w.x = cvt4_fp8(r[0][0], r[0][1], r[0][2], r[0][3]); w.y = cvt4_fp8(r[1][0], r[1][1], r[1][2], r[1][3]);
                *(u32x2*)rowp = w; __builtin_amdgcn_sched_barrier(0); }
    }
};
struct EpiDown {
    static constexpr bool PERM = true, AFTER_DRAIN = false;
    bf16_t* O; const float* gv;
    __device__ __forceinline__ void operator()(const f32x4 (&acc)[2][2][4][2], const Unit& u, int wr, int wc, int fr, int fq) const {
        const int row0 = u.pm * BM + wr * 64 + fr, col0 = (u.pn & 3) * BM + wc * 32 + 8 * fq;
#pragma unroll
        for (int ai = 0; ai < 2; ++ai)
#pragma unroll
            for (int m = 0; m < 4; ++m) { const int row = row0 + ai * HALF + m * 16; const float s = gv[row]; bf16_t* rowp = O + (size_t)row * D + col0;
#pragma unroll
                for (int bj = 0; bj < 2; ++bj) *(u32x4*)(rowp + bj * HALF) = pack8(acc[ai][bj][m][0] * s, acc[ai][bj][m][1] * s); }
    }
};
}
namespace att {
constexpr int NW = 8, QBLK = 32, KVBLK = 64, DV = 128;
constexpr float THR = 8.f;
#ifndef ATT_QKPIPE_GQA
#define ATT_QKPIPE_GQA 0
#endif
#ifndef ATT_QKPIPE_MLA
#define ATT_QKPIPE_MLA 0
#endif
#ifndef MLA_QREG
#define MLA_QREG 4
#endif
#define SBAR() __builtin_amdgcn_sched_barrier(0)
__device__ __forceinline__ int crow(int r, int hi) { return (r & 3) + 8 * (r >> 2) + 4 * hi; }
__device__ __forceinline__ unsigned cvtpk(float lo, float hi) { unsigned r; asm volatile("v_cvt_pk_bf16_f32 %0, %1, %2" : "=v"(r) : "v"(lo), "v"(hi)); return r; }

template <int DQK> struct Cfg {
    static constexpr float SCALE = DQK == 128 ? 0.088388347648318440f : 0.072168783648703220f;
    static constexpr float C = SCALE * 1.4426950408889634f;
    static constexpr int ROWB = DQK * 2;
    static constexpr int SHM_K = KVBLK * DQK * 2, SHM_V = KVBLK * DV * 2;
    static constexpr int QREG = DQK == 128 ? 8 : MLA_QREG;
    static constexpr int SHM_ATTN = 2 * SHM_V + 2 * SHM_K + NW * 64 * 4 + NW * (DQK / 16 - QREG) * 1024;
};
#define KSWZ(row, colB) ((row) * ROWB + ((colB) ^ ((((colB) < 256) ? ((row) & 15) : ((row) & 7)) << 4)))

template <int DQK>
__device__ __forceinline__ void partialSM(f32x16& p0, f32x16& p1, float& m_reg, float& mn, float& alpha) {
  constexpr float C = Cfg<DQK>::C, SCALE = Cfg<DQK>::SCALE;
  float pmax = p0[0];
#pragma unroll
  for (int r = 1; r < 16; ++r) pmax = fmaxf(pmax, p0[r]);
#pragma unroll
  for (int r = 0; r < 16; ++r) pmax = fmaxf(pmax, p1[r]);
  { auto rr = __builtin_amdgcn_permlane32_swap(__float_as_uint(pmax), __float_as_uint(pmax), false, false);
    pmax = fmaxf(__uint_as_float(rr[0]), __uint_as_float(rr[1])); }
  if (__builtin_expect(__all(pmax - m_reg <= THR / SCALE), 1)) { mn = m_reg; alpha = 1.f; }
  else { mn = fmaxf(m_reg, pmax); alpha = __builtin_amdgcn_exp2f((m_reg - mn) * C); m_reg = mn; }
  float mnC = -mn * C;
#pragma unroll
  for (int r = 0; r < 16; ++r) p0[r] = fmaf(p0[r], C, mnC);
#pragma unroll
  for (int r = 0; r < 16; ++r) p1[r] = fmaf(p1[r], C, mnC);
#pragma unroll
  for (int r = 0; r < 16; ++r) p0[r] = __builtin_amdgcn_exp2f(p0[r]);
}
__device__ __forceinline__ void finishSM(f32x16& p0, f32x16& p1, float alpha, float& l_reg, bf16x8& pa0, bf16x8& pa1, bf16x8& pa2, bf16x8& pa3) {
#pragma unroll
  for (int r = 0; r < 16; ++r) p1[r] = __builtin_amdgcn_exp2f(p1[r]);
  float ps = 0;
#pragma unroll
  for (int r = 0; r < 16; ++r) ps += p0[r];
#pragma unroll
  for (int r = 0; r < 16; ++r) ps += p1[r];
  { auto rr = __builtin_amdgcn_permlane32_swap(__float_as_uint(ps), __float_as_uint(ps), false, false);
    ps = __uint_as_float(rr[0]) + __uint_as_float(rr[1]); }
  l_reg = l_reg * alpha + ps;
#define PK4(P, BASE, OUT) do { unsigned a0 = cvtpk(P[BASE + 0], P[BASE + 1]), a1 = cvtpk(P[BASE + 2], P[BASE + 3]);   \
    unsigned b0 = cvtpk(P[BASE + 4], P[BASE + 5]), b1 = cvtpk(P[BASE + 6], P[BASE + 7]);                              \
    auto r0 = __builtin_amdgcn_permlane32_swap(a0, b0, false, false); auto r1 = __builtin_amdgcn_permlane32_swap(a1, b1, false, false); \
    u32x4 w = {r0[0], r1[0], r0[1], r1[1]}; OUT = *reinterpret_cast<bf16x8*>(&w); } while (0)
  PK4(p0, 0, pa0); PK4(p0, 8, pa1); PK4(p1, 0, pa2); PK4(p1, 8, pa3);
#undef PK4
}
template <int DQK, int QREG>
__device__ __forceinline__ void qkt_plain(f32x16& p0, f32x16& p1, const char* Ks, const bf16x8* qr, const char* qx, int r32, int hi) {
  constexpr int ROWB = Cfg<DQK>::ROWB;
  p0 = f32x16{}; p1 = f32x16{};
#pragma unroll
  for (int d0 = 0; d0 < DQK / 16; ++d0) { int cb = (d0 * 16 + hi * 8) * 2;
    bf16x8 b0 = *reinterpret_cast<const bf16x8*>(Ks + KSWZ(r32, cb));
    bf16x8 b1 = *reinterpret_cast<const bf16x8*>(Ks + KSWZ(32 + r32, cb));
    bf16x8 q; if (d0 < QREG) q = qr[d0]; else q = *reinterpret_cast<const bf16x8*>(qx + (d0 - QREG) * 1024);
    p0 = __builtin_amdgcn_mfma_f32_32x32x16_bf16(b0, q, p0, 0, 0, 0);
    p1 = __builtin_amdgcn_mfma_f32_32x32x16_bf16(b1, q, p1, 0, 0, 0); }
}
template <int DQK, int QREG, int D0>
__device__ __forceinline__ void qk_issue(bf16x8 (&kl)[3], bf16x8 (&kh)[3], bf16x8 (&qf)[3], int kb, int s4, int s3, int hi16, int qxa) {
  constexpr int ROWB = Cfg<DQK>::ROWB;
  const int ad = kb + ((D0 * 32 + hi16) ^ (D0 < 8 ? s4 : s3));
  asm volatile("ds_read_b128 %0, %1" : "=v"(kl[D0 % 3]) : "v"(ad) : "memory");
  asm volatile("ds_read_b128 %0, %1 offset:%2" : "=v"(kh[D0 % 3]) : "v"(ad), "n"(32 * ROWB) : "memory");
  if constexpr (D0 >= QREG) asm volatile("ds_read_b128 %0, %1 offset:%2" : "=v"(qf[D0 % 3]) : "v"(qxa), "n"((D0 - QREG) * 1024) : "memory");
}
template <int DQK, int QREG, int D0>
__device__ __forceinline__ void qk_steps(f32x16& p0, f32x16& p1, bf16x8 (&kl)[3], bf16x8 (&kh)[3], bf16x8 (&qf)[3], const bf16x8* qr, int kb, int s4, int s3, int hi16, int qxa) {
  constexpr int ND = DQK / 16;
  if constexpr (D0 < ND) {
    constexpr int R1 = D0 + 1 < ND ? 2 + (D0 + 1 >= QREG ? 1 : 0) : 0, R2 = D0 + 2 < ND ? 2 + (D0 + 2 >= QREG ? 1 : 0) : 0;
    if constexpr (D0 >= QREG) asm volatile("s_waitcnt lgkmcnt(%3)" : "+v"(kl[D0 % 3]), "+v"(kh[D0 % 3]), "+v"(qf[D0 % 3]) : "n"(R1 + R2));
    else asm volatile("s_waitcnt lgkmcnt(%2)" : "+v"(kl[D0 % 3]), "+v"(kh[D0 % 3]) : "n"(R1 + R2));
    bf16x8 q; if constexpr (D0 < QREG) q = qr[D0]; else q = qf[D0 % 3];
    if constexpr (D0 == 0) { p0 = __builtin_amdgcn_mfma_f32_32x32x16_bf16(kl[0], q, f32x16{}, 0, 0, 0); p1 = __builtin_amdgcn_mfma_f32_32x32x16_bf16(kh[0], q, f32x16{}, 0, 0, 0); }
    else { p0 = __builtin_amdgcn_mfma_f32_32x32x16_bf16(kl[D0 % 3], q, p0, 0, 0, 0); p1 = __builtin_amdgcn_mfma_f32_32x32x16_bf16(kh[D0 % 3], q, p1, 0, 0, 0); }
    if constexpr (D0 + 3 < ND) qk_issue<DQK, QREG, D0 + 3>(kl, kh, qf, kb, s4, s3, hi16, qxa);
    qk_steps<DQK, QREG, D0 + 1>(p0, p1, kl, kh, qf, qr, kb, s4, s3, hi16, qxa);
  }
}
template <int DQK, int QREG>
__device__ __forceinline__ void qkt(f32x16& p0, f32x16& p1, const char* Ks, const bf16x8* qr, const char* qx, int r32, int hi) {
  constexpr int ROWB = Cfg<DQK>::ROWB;
  if constexpr ((DQK == 128 && !ATT_QKPIPE_GQA) || (DQK == 192 && !ATT_QKPIPE_MLA)) { qkt_plain<DQK, QREG>(p0, p1, Ks, qr, qx, r32, hi); return; }
  const int kb = (int)(unsigned)(uintptr_t)Ks + r32 * ROWB, s4 = (r32 & 15) << 4, s3 = (r32 & 7) << 4, hi16 = hi * 16, qxa = (int)(unsigned)(uintptr_t)qx;
  bf16x8 kl[3], kh[3], qf[3];
  qk_issue<DQK, QREG, 0>(kl, kh, qf, kb, s4, s3, hi16, qxa); qk_issue<DQK, QREG, 1>(kl, kh, qf, kb, s4, s3, hi16, qxa); qk_issue<DQK, QREG, 2>(kl, kh, qf, kb, s4, s3, hi16, qxa);
  qk_steps<DQK, QREG, 0>(p0, p1, kl, kh, qf, qr, kb, s4, s3, hi16, qxa);
}
__device__ __forceinline__ int v_st(int k, int c) { const int kk = (k & ~0xC) | ((k & 4) << 1) | ((k & 8) >> 1); return ((kk >> 3) * 4 + (c >> 5)) * 512 + ((kk & 7) * 32 + (c & 31)) * 2; }
__device__ __forceinline__ int v_rd_base(int lane) { return ((lane & 3) << 3) | (((lane >> 2) & 3) << 6) | (((lane >> 4) & 1) << 5) | (((lane >> 5) & 1) << 8); }
constexpr int v_rd_off(int d0, int ks, int half) { return d0 * 512 + ks * 4096 + half * 2048; }
template <int OFF> __device__ __forceinline__ s16x4 tr_read(int vb) {
  s16x4 r; asm volatile("ds_read_b64_tr_b16 %0, %1 offset:%2" : "=&v"(r) : "v"(vb), "i"(OFF) : "memory"); return r;
}
template <int D0> __device__ __forceinline__ void pv_one(f32x16& od, int vb, bf16x8 pa0, bf16x8 pa1, bf16x8 pa2, bf16x8 pa3) {
  const s16x4 l0 = tr_read<v_rd_off(D0, 0, 0)>(vb), h0 = tr_read<v_rd_off(D0, 0, 1)>(vb), l1 = tr_read<v_rd_off(D0, 1, 0)>(vb), h1 = tr_read<v_rd_off(D0, 1, 1)>(vb);
  const s16x4 l2 = tr_read<v_rd_off(D0, 2, 0)>(vb), h2 = tr_read<v_rd_off(D0, 2, 1)>(vb), l3 = tr_read<v_rd_off(D0, 3, 0)>(vb), h3 = tr_read<v_rd_off(D0, 3, 1)>(vb);
  asm volatile("s_waitcnt lgkmcnt(0)" ::: "memory"); SBAR();
#define PK(L, H) (bf16x8){L[0], L[1], L[2], L[3], H[0], H[1], H[2], H[3]}
  od = __builtin_amdgcn_mfma_f32_32x32x16_bf16(pa0, PK(l0, h0), od, 0, 0, 0);
  od = __builtin_amdgcn_mfma_f32_32x32x16_bf16(pa1, PK(l1, h1), od, 0, 0, 0);
  od = __builtin_amdgcn_mfma_f32_32x32x16_bf16(pa2, PK(l2, h2), od, 0, 0, 0);
  od = __builtin_amdgcn_mfma_f32_32x32x16_bf16(pa3, PK(l3, h3), od, 0, 0, 0);
#undef PK
}
__device__ __forceinline__ void pv_d0(f32x16* o, int vb, bf16x8 pa0, bf16x8 pa1, bf16x8 pa2, bf16x8 pa3) {
  pv_one<0>(o[0], vb, pa0, pa1, pa2, pa3); pv_one<1>(o[1], vb, pa0, pa1, pa2, pa3); pv_one<2>(o[2], vb, pa0, pa1, pa2, pa3); pv_one<3>(o[3], vb, pa0, pa1, pa2, pa3);
}

template <int DQK, int SDEPTH, int ldq, int ldk, int ldkr, int ldv, int ldo>
__device__ __forceinline__ void attn_body(const bf16_t* __restrict__ Qb, const bf16_t* __restrict__ Kh, const bf16_t* __restrict__ Kr,
                                          const bf16_t* __restrict__ Vh, unsigned char* __restrict__ Ob, int seq, char* lds, int qt0, const float* __restrict__ rt, const float* __restrict__ qg) {
  constexpr int ROWB = Cfg<DQK>::ROWB, SHM_K = Cfg<DQK>::SHM_K, SHM_V = Cfg<DQK>::SHM_V;
  constexpr bool X = DQK == 192; constexpr int QREG = Cfg<DQK>::QREG, QLDS = DQK / 16 - QREG;
  const int tid = opaque_v((int)threadIdx.x), wid = tid >> 6, lane = tid & 63, r32 = lane & 31, hi = lane >> 5;
  char* V_lds = lds; char* K_lds = lds + 2 * SHM_V;
  float* ws = (float*)(lds + 2 * SHM_V + 2 * SHM_K) + wid * 64; float* li_l = ws; float* al_l = ws + 32;
  float m_reg = -1e30f, l_reg = 0; f32x16 o[4] = {}; bf16x8 qr[QREG];
  const bf16_t* Qw = Qb + (long)(wid * QBLK + r32) * ldq + hi * 8;
  char* qx = lds + 2 * SHM_V + 2 * SHM_K + NW * 64 * 4 + wid * (QLDS * 1024) + lane * 16;
#pragma unroll
  for (int d0 = 0; d0 < QREG; ++d0) qr[d0] = *reinterpret_cast<const bf16x8*>(Qw + d0 * 16);
  if constexpr (X) {
#pragma unroll
    for (int d0 = QREG; d0 < 8; ++d0) *reinterpret_cast<bf16x8*>(qx + (d0 - QREG) * 1024) = *reinterpret_cast<const bf16x8*>(Qw + d0 * 16);
  }
  if constexpr (!X) {
    float ss = 0.f;
#pragma unroll
    for (int d0 = 0; d0 < 8; ++d0) { const u32x4 w = *reinterpret_cast<const u32x4*>(&qr[d0]);
#pragma unroll
      for (int q = 0; q < 4; ++q) { const float x0 = __uint_as_float(w[q] << 16), x1 = __uint_as_float(w[q] & 0xffff0000u); ss += x0 * x0 + x1 * x1; } }
    ss += __shfl_xor(ss, 32);
    const float rstd = 1.0f / sqrtf(ss * (1.0f / 128.0f) + 1e-6f);
    const int t = qt0 >= 0 ? qt0 + wid * QBLK + r32 : 0;
#pragma unroll
    for (int d0 = 0; d0 < 8; ++d0) { u32x4 w = *reinterpret_cast<const u32x4*>(&qr[d0]);
      const f32x4 g0 = *reinterpret_cast<const f32x4*>(qg + d0 * 16 + hi * 8), g1 = *reinterpret_cast<const f32x4*>(qg + d0 * 16 + hi * 8 + 4);
      const int pos = d0 < 4 ? (t >> 6) : (t & 63), ti = pos * 32 + (d0 & 3) * 8 + hi * 4; const f32x4 cs = *reinterpret_cast<const f32x4*>(rt + ti), sn = *reinterpret_cast<const f32x4*>(rt + 2048 + ti);
      const float gg[8] = {g0[0], g0[1], g0[2], g0[3], g1[0], g1[1], g1[2], g1[3]};
#pragma unroll
      for (int q = 0; q < 4; ++q) { const float x0 = __uint_as_float(w[q] << 16) * rstd * gg[2 * q], x1 = __uint_as_float(w[q] & 0xffff0000u) * rstd * gg[2 * q + 1]; w[q] = cvtpk(x0 * cs[q] - x1 * sn[q], x0 * sn[q] + x1 * cs[q]); }
      qr[d0] = *reinterpret_cast<const bf16x8*>(&w); }
  }
  if constexpr (X) {
#pragma unroll
    for (int d0 = 8; d0 < 12; ++d0) {
      u32x4 w = *reinterpret_cast<const u32x4*>(Qw + d0 * 16);
      { const int t = qt0 >= 0 ? qt0 + wid * QBLK + r32 : 0, j0 = (d0 - 8) * 8 + hi * 4, pos = d0 < 10 ? (t >> 6) : (t & 63), ti = pos * 16 + (j0 & 15);
        const f32x4 cs = *reinterpret_cast<const f32x4*>(rt + ti), sn = *reinterpret_cast<const f32x4*>(rt + 1024 + ti);
#pragma unroll
        for (int q = 0; q < 4; ++q) { const float x0 = __uint_as_float(w[q] << 16), x1 = __uint_as_float(w[q] & 0xffff0000u); w[q] = cvtpk(x0 * cs[q] - x1 * sn[q], x0 * sn[q] + x1 * cs[q]); } }
      *reinterpret_cast<u32x4*>(qx + (d0 - QREG) * 1024) = w; }
  }
  const int sr = tid >> 4, sc = (tid & 15) * 8, vst0 = v_st(sr, sc), vst1 = v_st(32 + sr, sc);
  const int xr = tid >> 3, xc = (tid & 7) * 8;
  const int vb0 = (int)(uintptr_t)V_lds + v_rd_base(lane);
  struct { bf16x8 vs0, vs1, ks0, ks1, kx; } sr_[SDEPTH];
#define LD8(p) (*reinterpret_cast<const bf16x8*>(p))
#define SLOAD(i, k0) do { sr_[i].vs0 = LD8(&Vh[(long)((k0) + sr) * ldv + sc]); sr_[i].vs1 = LD8(&Vh[(long)((k0) + 32 + sr) * ldv + sc]); \
    sr_[i].ks0 = LD8(&Kh[(long)((k0) + sr) * ldk + sc]); sr_[i].ks1 = LD8(&Kh[(long)((k0) + 32 + sr) * ldk + sc]); \
    if constexpr (X) sr_[i].kx = LD8(&Kr[(long)((k0) + xr) * ldkr + xc]); } while (0)
#define SWRITE(b, i) do { *(bf16x8*)(V_lds + (b) * SHM_V + vst0) = sr_[i].vs0;          \
    *(bf16x8*)(V_lds + (b) * SHM_V + vst1) = sr_[i].vs1; int kc = sc * 2;               \
    *(bf16x8*)(K_lds + (b) * SHM_K + KSWZ(sr, kc)) = sr_[i].ks0;                       \
    *(bf16x8*)(K_lds + (b) * SHM_K + KSWZ(32 + sr, kc)) = sr_[i].ks1;                  \
    if constexpr (X) { int kx_ = 256 + xc * 2; *(bf16x8*)(K_lds + (b) * SHM_K + KSWZ(xr, kx_)) = sr_[i].kx; } } while (0)
#define SWAIT() do { if constexpr (SDEPTH == 2) { if constexpr (X) asm volatile("s_waitcnt vmcnt(5)" ::: "memory"); else asm volatile("s_waitcnt vmcnt(4)" ::: "memory"); } else asm volatile("s_waitcnt vmcnt(0)" ::: "memory"); } while (0)
#define RESC(a) do { if (__any((a) < 1.f)) { if (hi == 0) al_l[r32] = (a); asm volatile("s_waitcnt lgkmcnt(0)" ::: "memory"); \
    _Pragma("unroll") for (int d = 0; d < 4; ++d) _Pragma("unroll") for (int r = 0; r < 16; ++r) o[d][r] *= al_l[crow(r, hi)]; } } while (0)
  f32x16 pA0, pA1, pB0, pB1; float mnA, mnB, alA, alB; bf16x8 pa0, pa1, pa2, pa3; const int NT = seq / KVBLK;
  constexpr int SE = 0, SO = SDEPTH - 1;
  SLOAD(SE, 0); asm volatile("s_waitcnt vmcnt(0)" ::: "memory"); SWRITE(0, SE); __syncthreads();
  qkt<DQK, QREG>(pA0, pA1, K_lds, qr, qx, r32, hi); partialSM<DQK>(pA0, pA1, m_reg, mnA, alA);
  SLOAD(SO, KVBLK); if constexpr (SDEPTH == 2) { if (2 < NT) SLOAD(SE, 2 * KVBLK); }
  SWAIT(); SWRITE(1, SO); __syncthreads();
  for (int j = 1; j + 1 < NT; j += 2) {
    SBAR(); qkt<DQK, QREG>(pB0, pB1, K_lds + SHM_K, qr, qx, r32, hi);
    finishSM(pA0, pA1, alA, l_reg, pa0, pa1, pa2, pa3); SBAR();
    SLOAD(SO, (j + SDEPTH) * KVBLK); SBAR();
    pv_d0(o, vb0, pa0, pa1, pa2, pa3); partialSM<DQK>(pB0, pB1, m_reg, mnB, alB);
    __syncthreads(); SWAIT(); SWRITE(0, SE);
    RESC(alB); __syncthreads();
    SBAR(); qkt<DQK, QREG>(pA0, pA1, K_lds, qr, qx, r32, hi);
    finishSM(pB0, pB1, alB, l_reg, pa0, pa1, pa2, pa3); SBAR();
    if (SDEPTH == 1 || j + 3 < NT) SLOAD(SE, (j + 1 + SDEPTH) * KVBLK); SBAR();
    pv_d0(o, vb0 + (int)SHM_V, pa0, pa1, pa2, pa3); partialSM<DQK>(pA0, pA1, m_reg, mnA, alA);
    __syncthreads(); SWAIT(); SWRITE(1, SO);
    RESC(alA); __syncthreads();
  }
  SBAR(); qkt<DQK, QREG>(pB0, pB1, K_lds + SHM_K, qr, qx, r32, hi);
  finishSM(pA0, pA1, alA, l_reg, pa0, pa1, pa2, pa3); SBAR();
  pv_d0(o, vb0, pa0, pa1, pa2, pa3); partialSM<DQK>(pB0, pB1, m_reg, mnB, alB);
  __syncthreads(); RESC(alB);
  finishSM(pB0, pB1, alB, l_reg, pa0, pa1, pa2, pa3); SBAR();
  pv_d0(o, vb0 + (int)SHM_V, pa0, pa1, pa2, pa3);
  if (hi == 0) li_l[r32] = l_reg; asm volatile("s_waitcnt lgkmcnt(0)" ::: "memory");
  float rli[16];
#pragma unroll
  for (int r = 0; r < 16; ++r) rli[r] = __builtin_amdgcn_rcpf(li_l[crow(r, hi)]);
  unsigned char* Ow = Ob + (long)(wid * QBLK) * ldo;
#pragma unroll
  for (int r = 0; r < 16; ++r) { int orow = crow(r, hi);
#pragma unroll
    for (int d0 = 0; d0 < 4; ++d0) { const float ov = __builtin_fminf(__builtin_fmaxf(o[d0][r] * rli[r] * AO_SCALE, -448.f), 448.f); Ow[(long)orow * ldo + d0 * 32 + r32] = (unsigned char)(__builtin_amdgcn_cvt_pk_fp8_f32(ov, 0.f, 0, false) & 0xff); } }
#undef LD8
#undef SLOAD
#undef SWRITE
#undef SWAIT
#undef RESC
}
#undef KSWZ
}
#ifndef A2_RS_GQA
#define A2_RS_GQA 0
#endif
#ifndef A2_SPREAD
#define A2_SPREAD 0
#endif
#ifndef A2_SHADOW_GQA
#define A2_SHADOW_GQA 0
#endif
#ifndef A2_SHADOW_MLA
#define A2_SHADOW_MLA 0
#endif
#ifndef A2_PKSM
#define A2_PKSM 0
#endif
#ifndef A2_BUF
#define A2_BUF 1
#endif
#ifndef A2_RS_MLA
#define A2_RS_MLA 0
#endif
namespace att2 {
#if defined(PROBE_SEL) && PROBE_SEL >= 50 && PROBE_SEL <= 59
#define A2_T(n) do { if (wid == 0) { const unsigned long long t_ = __builtin_amdgcn_s_memrealtime(); if ((n) == PROBE_SEL - 49) pacc += t_ - a2_t; a2_t = t_; } } while (0)
#define A2_TDECL unsigned long long a2_t = 0ull;
#if PROBE_SEL == 54
#define A2_TQ() do { __builtin_amdgcn_sched_barrier(0); if (wid == 0) { pacc += __builtin_amdgcn_s_memrealtime() - a2_t; } } while (0)
#else
#define A2_TQ() do { } while (0)
#endif
#if PROBE_SEL >= 56
#define A2_TX(n) A2_T(n)
#define A2_T3() A2_T(9)
#else
#define A2_TX(n) do { } while (0)
#define A2_T3() A2_T(3)
#endif
#else
#define A2_TX(n) do { } while (0)
#define A2_T3() do { } while (0)
#define A2_TQ() do { } while (0)
#define A2_T(n) do { } while (0)
#define A2_TDECL
#endif
using att::Cfg; using att::crow; using att::cvtpk; using att::v_rd_base; using att::pv_d0;
typedef LAS char LASc; typedef LAS bf16x8 LASv;
constexpr int NW = 8, QBLK = 32, KVBLK = 64;
constexpr float THR = 8.f;
#define KSWZ2(row, colB) ((row) * ROWB + ((colB) ^ (((row) & 7) << 4)))
#define A2_BAR() do { asm volatile("" ::: "memory"); __builtin_amdgcn_sched_barrier(0); __builtin_amdgcn_s_barrier(); __builtin_amdgcn_sched_barrier(0); asm volatile("" ::: "memory"); } while (0)

template <int DQK>
__device__ __forceinline__ void qk_tile(f32x16& p0, f32x16& p1, const LASc* Ks, const bf16x8* qr, int r32, int hi) {
  constexpr int ROWB = Cfg<DQK>::ROWB;
  const int kb = (int)(unsigned)(size_t)Ks + r32 * ROWB, s3 = (r32 & 7) << 4, hi16 = hi * 16;
  bf16x8 kl[3], kh[3], qf[3];
  att::qk_issue<DQK, DQK / 16, 0>(kl, kh, qf, kb, s3, s3, hi16, 0); att::qk_issue<DQK, DQK / 16, 1>(kl, kh, qf, kb, s3, s3, hi16, 0); att::qk_issue<DQK, DQK / 16, 2>(kl, kh, qf, kb, s3, s3, hi16, 0);
  att::qk_steps<DQK, DQK / 16, 0>(p0, p1, kl, kh, qf, qr, kb, s3, s3, hi16, 0);
}
template <int DQK, class HOOK>
__device__ __forceinline__ void softmax_tile(f32x16& p0, f32x16& p1, float& m_reg, float& l_reg, float& alpha, bf16x8& pa0, bf16x8& pa1, bf16x8& pa2, bf16x8& pa3, HOOK&& hook) {
  constexpr float C = Cfg<DQK>::C, SCALE = Cfg<DQK>::SCALE;
  float pmax = p0[0];
#pragma unroll
  for (int r = 1; r < 16; ++r) pmax = fmaxf(pmax, p0[r]);
#pragma unroll
  for (int r = 0; r < 16; ++r) pmax = fmaxf(pmax, p1[r]);
  { auto rr = __builtin_amdgcn_permlane32_swap(__float_as_uint(pmax), __float_as_uint(pmax), false, false);
    pmax = fmaxf(__uint_as_float(rr[0]), __uint_as_float(rr[1])); }
  float mn;
  if (__builtin_expect(__all(pmax - m_reg <= THR / SCALE), 1)) { mn = m_reg; alpha = 1.f; }
  else { mn = fmaxf(m_reg, pmax); alpha = __builtin_amdgcn_exp2f((m_reg - mn) * C); m_reg = mn; }
  const float mnC = -mn * C;
#if A2_PKSM
  const f32x2 Cv = {C, C}, Mv = {mnC, mnC}; f32x2 ps2 = {0.f, 0.f};
#pragma unroll
  for (int r = 0; r < 16; r += 2) { f32x2 t = {p0[r], p0[r + 1]}; t = __builtin_elementwise_fma(t, Cv, Mv); p0[r] = __builtin_amdgcn_exp2f(t[0]); p0[r + 1] = __builtin_amdgcn_exp2f(t[1]); }
#pragma unroll
  for (int r = 0; r < 16; r += 2) { f32x2 t = {p1[r], p1[r + 1]}; t = __builtin_elementwise_fma(t, Cv, Mv); p1[r] = __builtin_amdgcn_exp2f(t[0]); p1[r + 1] = __builtin_amdgcn_exp2f(t[1]); }
#pragma unroll
  for (int r = 0; r < 16; r += 2) { const f32x2 t = {p0[r], p0[r + 1]}; ps2 += t; }
#pragma unroll
  for (int r = 0; r < 16; r += 2) { const f32x2 t = {p1[r], p1[r + 1]}; ps2 += t; }
  float ps = ps2[0] + ps2[1];
#else
  hook(0);
#pragma unroll
  for (int r = 0; r < 8; ++r) p0[r] = __builtin_amdgcn_exp2f(fmaf(p0[r], C, mnC));
  hook(1);
#pragma unroll
  for (int r = 8; r < 16; ++r) p0[r] = __builtin_amdgcn_exp2f(fmaf(p0[r], C, mnC));
  hook(2);
#pragma unroll
  for (int r = 0; r < 8; ++r) p1[r] = __builtin_amdgcn_exp2f(fmaf(p1[r], C, mnC));
  hook(3);
#pragma unroll
  for (int r = 8; r < 16; ++r) p1[r] = __builtin_amdgcn_exp2f(fmaf(p1[r], C, mnC));
  hook(4);
  float ps = 0;
#pragma unroll
  for (int r = 0; r < 16; ++r) ps += p0[r];
#pragma unroll
  for (int r = 0; r < 16; ++r) ps += p1[r];
#endif
  { auto rr = __builtin_amdgcn_permlane32_swap(__float_as_uint(ps), __float_as_uint(ps), false, false);
    ps = __uint_as_float(rr[0]) + __uint_as_float(rr[1]); }
  l_reg = l_reg * alpha + ps;
#define PK4(P, BASE, OUT) do { unsigned a0 = cvtpk(P[BASE + 0], P[BASE + 1]), a1 = cvtpk(P[BASE + 2], P[BASE + 3]);   \
    unsigned b0 = cvtpk(P[BASE + 4], P[BASE + 5]), b1 = cvtpk(P[BASE + 6], P[BASE + 7]);                              \
    auto r0 = __builtin_amdgcn_permlane32_swap(a0, b0, false, false); auto r1 = __builtin_amdgcn_permlane32_swap(a1, b1, false, false); \
    u32x4 w = {r0[0], r1[0], r0[1], r1[1]}; OUT = *reinterpret_cast<bf16x8*>(&w); } while (0)
  PK4(p0, 0, pa0); PK4(p0, 8, pa1); PK4(p1, 0, pa2); PK4(p1, 8, pa3);
#undef PK4
}

struct VFrag { s16x4 l0, h0, l1, h1, l2, h2, l3, h3; };
template <int D0> __device__ __forceinline__ void pv_reads(VFrag& f, int vb) {
  using att::tr_read; using att::v_rd_off;
  f.l0 = tr_read<v_rd_off(D0, 0, 0)>(vb); f.h0 = tr_read<v_rd_off(D0, 0, 1)>(vb); f.l1 = tr_read<v_rd_off(D0, 1, 0)>(vb); f.h1 = tr_read<v_rd_off(D0, 1, 1)>(vb);
  f.l2 = tr_read<v_rd_off(D0, 2, 0)>(vb); f.h2 = tr_read<v_rd_off(D0, 2, 1)>(vb); f.l3 = tr_read<v_rd_off(D0, 3, 0)>(vb); f.h3 = tr_read<v_rd_off(D0, 3, 1)>(vb);
}
__device__ __forceinline__ void pv_mma(f32x16& od, const VFrag& f, bf16x8 pa0, bf16x8 pa1, bf16x8 pa2, bf16x8 pa3) {
#define PK(L, H) (bf16x8){L[0], L[1], L[2], L[3], H[0], H[1], H[2], H[3]}
  od = __builtin_amdgcn_mfma_f32_32x32x16_bf16(pa0, PK(f.l0, f.h0), od, 0, 0, 0);
  od = __builtin_amdgcn_mfma_f32_32x32x16_bf16(pa1, PK(f.l1, f.h1), od, 0, 0, 0);
  od = __builtin_amdgcn_mfma_f32_32x32x16_bf16(pa2, PK(f.l2, f.h2), od, 0, 0, 0);
  od = __builtin_amdgcn_mfma_f32_32x32x16_bf16(pa3, PK(f.l3, f.h3), od, 0, 0, 0);
#undef PK
}
__device__ __forceinline__ void pv_pipe(f32x16* o, int vb, bf16x8 pa0, bf16x8 pa1, bf16x8 pa2, bf16x8 pa3) {
  VFrag fa, fb;
  pv_reads<0>(fa, vb); pv_reads<1>(fb, vb);
  asm volatile("s_waitcnt lgkmcnt(8)" ::: "memory"); __builtin_amdgcn_sched_barrier(0); pv_mma(o[0], fa, pa0, pa1, pa2, pa3); __builtin_amdgcn_sched_barrier(0);
  pv_reads<2>(fa, vb);
  asm volatile("s_waitcnt lgkmcnt(8)" ::: "memory"); __builtin_amdgcn_sched_barrier(0); pv_mma(o[1], fb, pa0, pa1, pa2, pa3); __builtin_amdgcn_sched_barrier(0);
  pv_reads<3>(fb, vb);
  asm volatile("s_waitcnt lgkmcnt(8)" ::: "memory"); __builtin_amdgcn_sched_barrier(0); pv_mma(o[2], fa, pa0, pa1, pa2, pa3); __builtin_amdgcn_sched_barrier(0);
  asm volatile("s_waitcnt lgkmcnt(0)" ::: "memory"); __builtin_amdgcn_sched_barrier(0); pv_mma(o[3], fb, pa0, pa1, pa2, pa3);
}

#if A2_NOSGB
#define A2_SGB4(nv) do { } while (0)
#else
#define A2_SGB4(nv) do { _Pragma("unroll") for (int g_ = 0; g_ < 4; ++g_) { __builtin_amdgcn_sched_group_barrier(0x008, 1, 0); __builtin_amdgcn_sched_group_barrier(0x002, (nv), 0); } } while (0)
#endif
#define A2_SGB4X() do { _Pragma("unroll") for (int g_ = 0; g_ < 4; ++g_) { __builtin_amdgcn_sched_group_barrier(0x008, 1, 0); __builtin_amdgcn_sched_group_barrier(0x002, 2, 0); __builtin_amdgcn_sched_group_barrier(0x400, 2, 0); } } while (0)
template <int DQK, bool PV>
__device__ __forceinline__ void pv_pipe_s1(f32x16* o, int vb, bf16x8 pa0, bf16x8 pa1, bf16x8 pa2, bf16x8 pa3, f32x16& p0, f32x16& p1, float& m_reg, float& alpha, float& mnC) {
  constexpr float C = Cfg<DQK>::C, SCALE = Cfg<DQK>::SCALE;
  VFrag fa, fb;
  if constexpr (PV) { pv_reads<0>(fa, vb); pv_reads<1>(fb, vb); asm volatile("s_waitcnt lgkmcnt(8)" ::: "memory"); }
  __builtin_amdgcn_sched_barrier(0);
  if constexpr (PV) pv_mma(o[0], fa, pa0, pa1, pa2, pa3);
  float ma = fmaxf(p0[0], p0[1]), mb = fmaxf(p1[0], p1[1]);
#pragma unroll
  for (int r = 2; r < 16; r += 2) { ma = fmaxf(fmaxf(ma, p0[r]), p0[r + 1]); mb = fmaxf(fmaxf(mb, p1[r]), p1[r + 1]); }
  if constexpr (PV) A2_SGB4(4);
  __builtin_amdgcn_sched_barrier(0);
  if constexpr (PV) { pv_reads<2>(fa, vb); asm volatile("s_waitcnt lgkmcnt(8)" ::: "memory"); }
  __builtin_amdgcn_sched_barrier(0);
  if constexpr (PV) pv_mma(o[1], fb, pa0, pa1, pa2, pa3);
  { float pmax = fmaxf(ma, mb);
    auto rr = __builtin_amdgcn_permlane32_swap(__float_as_uint(pmax), __float_as_uint(pmax), false, false);
    pmax = fmaxf(__uint_as_float(rr[0]), __uint_as_float(rr[1]));
    const bool keep = __all(pmax - m_reg <= THR / SCALE);
    const float mn = keep ? m_reg : fmaxf(m_reg, pmax);
    alpha = __builtin_amdgcn_exp2f((m_reg - mn) * C); m_reg = mn; mnC = -mn * C; }
  if constexpr (PV) A2_SGB4(3);
  __builtin_amdgcn_sched_barrier(0);
  if constexpr (PV) { pv_reads<3>(fb, vb); asm volatile("s_waitcnt lgkmcnt(8)" ::: "memory"); }
  __builtin_amdgcn_sched_barrier(0);
  if constexpr (PV) pv_mma(o[2], fa, pa0, pa1, pa2, pa3);
#pragma unroll
  for (int r = 0; r < 8; ++r) p0[r] = __builtin_amdgcn_exp2f(fmaf(p0[r], C, mnC));
  if constexpr (PV) A2_SGB4X();
  __builtin_amdgcn_sched_barrier(0);
  if constexpr (PV) asm volatile("s_waitcnt lgkmcnt(0)" ::: "memory");
  __builtin_amdgcn_sched_barrier(0);
  if constexpr (PV) pv_mma(o[3], fb, pa0, pa1, pa2, pa3);
#pragma unroll
  for (int r = 8; r < 16; ++r) p0[r] = __builtin_amdgcn_exp2f(fmaf(p0[r], C, mnC));
  if constexpr (PV) A2_SGB4X();
  __builtin_amdgcn_sched_barrier(0);
}
template <int DQK>
__device__ __forceinline__ void softmax_p2(f32x16& p0, f32x16& p1, float mnC, float alpha, float& l_reg, bf16x8& pa0, bf16x8& pa1, bf16x8& pa2, bf16x8& pa3) {
  constexpr float C = Cfg<DQK>::C;
#pragma unroll
  for (int r = 0; r < 16; ++r) p1[r] = __builtin_amdgcn_exp2f(fmaf(p1[r], C, mnC));
  float ps = 0;
#pragma unroll
  for (int r = 0; r < 16; ++r) ps += p0[r];
#pragma unroll
  for (int r = 0; r < 16; ++r) ps += p1[r];
  { auto rr = __builtin_amdgcn_permlane32_swap(__float_as_uint(ps), __float_as_uint(ps), false, false);
    ps = __uint_as_float(rr[0]) + __uint_as_float(rr[1]); }
  l_reg = l_reg * alpha + ps;
#define PK4(P, BASE, OUT) do { unsigned a0 = cvtpk(P[BASE + 0], P[BASE + 1]), a1 = cvtpk(P[BASE + 2], P[BASE + 3]);   \
    unsigned b0 = cvtpk(P[BASE + 4], P[BASE + 5]), b1 = cvtpk(P[BASE + 6], P[BASE + 7]);                              \
    auto r0 = __builtin_amdgcn_permlane32_swap(a0, b0, false, false); auto r1 = __builtin_amdgcn_permlane32_swap(a1, b1, false, false); \
    u32x4 w = {r0[0], r1[0], r0[1], r1[1]}; OUT = *reinterpret_cast<bf16x8*>(&w); } while (0)
  PK4(p0, 0, pa0); PK4(p0, 8, pa1); PK4(p1, 0, pa2); PK4(p1, 8, pa3);
#undef PK4
}

template <int DQK, int ldq, int ldk, int ldkr, int ldv, int ldo>
__device__ __forceinline__ void attn_body2(const bf16_t* __restrict__ Qb, const bf16_t* __restrict__ Kh, const bf16_t* __restrict__ Kr, const bf16_t* __restrict__ Vh,
                                           unsigned char* __restrict__ Ob, int seq, LAS unsigned char* lds, int qt0, const float* __restrict__ rt, const float* __restrict__ qg, unsigned long long& pacc) {
  constexpr int ROWB = Cfg<DQK>::ROWB, SHM_K = Cfg<DQK>::SHM_K, SHM_V = Cfg<DQK>::SHM_V, NKI = SHM_K / 8192, NVI = SHM_V / 8192, NDMA = NKI + NVI, NQ = DQK / 16;
  constexpr bool X = DQK == 192;
  constexpr bool A2_SHADOW_ = X ? (A2_SHADOW_MLA != 0) : (A2_SHADOW_GQA != 0);
  constexpr bool A2_REGSTAGE = X ? (A2_RS_MLA != 0) : (A2_RS_GQA != 0);
  constexpr int NSK = A2_REGSTAGE ? 3 : 4, NSV = A2_REGSTAGE ? 3 : (X ? 3 : 4);
  constexpr int NW_K = (NSK - 3) * NDMA, NW_V = (NSV - 3) * NDMA + NKI, NWAIT_M = NW_K < NW_V ? NW_K : NW_V, NWAIT_V = NWAIT_M + NDMA;
  static_assert(A2_REGSTAGE || (NSK >= 4 && NSV >= 3), "ring depths");
  static_assert(NSK == NSV || NSK == NSV + 1, "ring depths");
  constexpr int K_OFF = 0, V_OFF = NSK * SHM_K, WS_OFF = V_OFF + NSV * SHM_V;
  const int tid = opaque_v((int)threadIdx.x), wid = __builtin_amdgcn_readfirstlane(tid >> 6), lane = tid & 63, r32 = lane & 31, hi = lane >> 5, grp = wid >> 2;
  LAS float* ws = (LAS float*)(lds + WS_OFF) + wid * 64; LAS float* li_l = ws; LAS float* al_l = ws + 32;
  const char* srcK[NKI]; int stepK[NKI];
#pragma unroll
  for (int i = 0; i < NKI; ++i) { const int P = i * 8192 + wid * 1024 + lane * 16, row = P / ROWB, cbs = P - row * ROWB, cb = cbs ^ ((row & 7) << 4);
    if (X && cb >= 256) { srcK[i] = (const char*)Kr + (size_t)row * (ldkr * 2) + (cb - 256); stepK[i] = KVBLK * ldkr * 2; }
    else { srcK[i] = (const char*)Kh + (size_t)row * (ldk * 2) + cb; stepK[i] = KVBLK * ldk * 2; } }
  const char* srcV[NVI];
#pragma unroll
  for (int i = 0; i < NVI; ++i) { const int P = i * 8192 + wid * 1024 + lane * 16, sub = P >> 9, kkh = sub >> 2, cblk = sub & 3, win = P & 511, kkl = win >> 6, cl = (win & 63) >> 1;
    const int kk = kkh * 8 + kkl, k = (kk & ~0xC) | ((kk & 4) << 1) | ((kk & 8) >> 1), c = cblk * 32 + cl;
    srcV[i] = (const char*)Vh + (size_t)k * (ldv * 2) + c * 2; }
#if A2_BUF
  unsigned long long b0_ = (unsigned long long)(size_t)Kh; { const unsigned long long v_ = (unsigned long long)(size_t)Vh, r_ = X ? (unsigned long long)(size_t)Kr : b0_; b0_ = b0_ < v_ ? b0_ : v_; b0_ = b0_ < r_ ? b0_ : r_; }
  const unsigned b0lo = __builtin_amdgcn_readfirstlane((unsigned)b0_), b0hi = __builtin_amdgcn_readfirstlane((unsigned)(b0_ >> 32));
  const char* B0 = (const char*)(size_t)(((unsigned long long)b0hi << 32) | b0lo);
  const __amdgpu_buffer_rsrc_t rsrc = __builtin_amdgcn_make_buffer_rsrc((void*)B0, 0, -1, 0x00020000);
  unsigned offK[NKI], offV[NVI];
#pragma unroll
  for (int i = 0; i < NKI; ++i) offK[i] = (unsigned)(srcK[i] - B0);
#pragma unroll
  for (int i = 0; i < NVI; ++i) offV[i] = (unsigned)(srcV[i] - B0);
#define A2_ISSUE_K(t, st) do { _Pragma("unroll") for (int _i = 0; _i < NKI; ++_i) \
    __builtin_amdgcn_raw_ptr_buffer_load_lds(rsrc, (LAS void*)(lds + K_OFF + (st) * SHM_K + _i * 8192 + wid * 1024), 16, (int)(offK[_i] + __umul24((unsigned)(t), (unsigned)stepK[_i])), 0, 0, 0); } while (0)
#define A2_ISSUE_V(t, st) do { _Pragma("unroll") for (int _i = 0; _i < NVI; ++_i) \
    __builtin_amdgcn_raw_ptr_buffer_load_lds(rsrc, (LAS void*)(lds + V_OFF + (st) * SHM_V + _i * 8192 + wid * 1024), 16, (int)offV[_i], (int)((t) * (KVBLK * ldv * 2)), 0, 0); } while (0)
#else
#define A2_ISSUE_K(t, st) do { _Pragma("unroll") for (int _i = 0; _i < NKI; ++_i) \
    __builtin_amdgcn_global_load_lds((const unsigned*)(srcK[_i] + (size_t)(t) * stepK[_i]), (LAS unsigned*)(lds + K_OFF + (st) * SHM_K + _i * 8192 + wid * 1024), 16, 0, 0); } while (0)
#define A2_ISSUE_V(t, st) do { _Pragma("unroll") for (int _i = 0; _i < NVI; ++_i) \
    __builtin_amdgcn_global_load_lds((const unsigned*)(srcV[_i] + (size_t)(t) * (KVBLK * ldv * 2)), (LAS unsigned*)(lds + V_OFF + (st) * SHM_V + _i * 8192 + wid * 1024), 16, 0, 0); } while (0)
#endif
  u32x4 rgK[NKI], rgV[NVI];
#define A2_LOAD_K(t) do { _Pragma("unroll") for (int _i = 0; _i < NKI; ++_i) rgK[_i] = *(const u32x4*)(srcK[_i] + (size_t)(t) * stepK[_i]); } while (0)
#define A2_LOAD_V(t) do { _Pragma("unroll") for (int _i = 0; _i < NVI; ++_i) rgV[_i] = *(const u32x4*)(srcV[_i] + (size_t)(t) * (KVBLK * ldv * 2)); } while (0)
#define A2_WRITE_K(st) do { _Pragma("unroll") for (int _i = 0; _i < NKI; ++_i) *(LAS u32x4*)(lds + K_OFF + (st) * SHM_K + _i * 8192 + wid * 1024 + lane * 16) = rgK[_i]; } while (0)
#define A2_WRITE_V(st) do { _Pragma("unroll") for (int _i = 0; _i < NVI; ++_i) *(LAS u32x4*)(lds + V_OFF + (st) * SHM_V + _i * 8192 + wid * 1024 + lane * 16) = rgV[_i]; } while (0)
  const int NT = seq / KVBLK; A2_TDECL
  asm volatile("s_waitcnt vmcnt(0) lgkmcnt(0)" ::: "memory"); A2_BAR();
  if constexpr (A2_REGSTAGE) {
    A2_LOAD_K(0); A2_LOAD_V(0); A2_WRITE_K(0); A2_WRITE_V(0);
    A2_LOAD_K(NT > 1 ? 1 : 0); A2_WRITE_K(1);
    A2_LOAD_K(NT > 2 ? 2 : NT - 1); A2_LOAD_V(NT > 1 ? 1 : 0);
  } else {
#pragma unroll
  for (int t = 0; t < NSV - 2; ++t) A2_ISSUE_V(t < NT ? t : NT - 1, t);
#pragma unroll
  for (int t = 0; t < NSK - 1; ++t) A2_ISSUE_K(t < NT ? t : NT - 1, t);
  }
  float m_reg = -1e30f, l_reg = 0; f32x16 o[4] = {}; bf16x8 qr[NQ];
  const bf16_t* Qw = Qb + (long)(wid * QBLK + r32) * ldq + hi * 8;
#pragma unroll
  for (int d0 = 0; d0 < NQ; ++d0) qr[d0] = *reinterpret_cast<const bf16x8*>(Qw + d0 * 16);
  if constexpr (!X) {
    float ss = 0.f;
#pragma unroll
    for (int d0 = 0; d0 < 8; ++d0) { const u32x4 w = *reinterpret_cast<const u32x4*>(&qr[d0]);
#pragma unroll
      for (int q = 0; q < 4; ++q) { const float x0 = __uint_as_float(w[q] << 16), x1 = __uint_as_float(w[q] & 0xffff0000u); ss += x0 * x0 + x1 * x1; } }
    ss += __shfl_xor(ss, 32);
    const float rstd = 1.0f / sqrtf(ss * (1.0f / 128.0f) + 1e-6f);
    const int t = qt0 >= 0 ? qt0 + wid * QBLK + r32 : 0;
#pragma unroll
    for (int d0 = 0; d0 < 8; ++d0) { u32x4 w = *reinterpret_cast<const u32x4*>(&qr[d0]);
      const f32x4 g0 = *reinterpret_cast<const f32x4*>(qg + d0 * 16 + hi * 8), g1 = *reinterpret_cast<const f32x4*>(qg + d0 * 16 + hi * 8 + 4);
      const int pos = d0 < 4 ? (t >> 6) : (t & 63), ti = pos * 32 + (d0 & 3) * 8 + hi * 4; const f32x4 cs = *reinterpret_cast<const f32x4*>(rt + ti), sn = *reinterpret_cast<const f32x4*>(rt + 2048 + ti);
      const float gg[8] = {g0[0], g0[1], g0[2], g0[3], g1[0], g1[1], g1[2], g1[3]};
#pragma unroll
      for (int q = 0; q < 4; ++q) { const float x0 = __uint_as_float(w[q] << 16) * rstd * gg[2 * q], x1 = __uint_as_float(w[q] & 0xffff0000u) * rstd * gg[2 * q + 1]; w[q] = cvtpk(x0 * cs[q] - x1 * sn[q], x0 * sn[q] + x1 * cs[q]); }
      qr[d0] = *reinterpret_cast<const bf16x8*>(&w); }
  } else {
    { const int t = qt0 >= 0 ? qt0 + wid * QBLK + r32 : 0;
#pragma unroll
      for (int d0 = 8; d0 < 12; ++d0) { u32x4 w = *reinterpret_cast<const u32x4*>(&qr[d0]);
        const int j0 = (d0 - 8) * 8 + hi * 4, pos = d0 < 10 ? (t >> 6) : (t & 63), ti = pos * 16 + (j0 & 15);
        const f32x4 cs = *reinterpret_cast<const f32x4*>(rt + ti), sn = *reinterpret_cast<const f32x4*>(rt + 1024 + ti);
#pragma unroll
        for (int q = 0; q < 4; ++q) { const float x0 = __uint_as_float(w[q] << 16), x1 = __uint_as_float(w[q] & 0xffff0000u); w[q] = cvtpk(x0 * cs[q] - x1 * sn[q], x0 * sn[q] + x1 * cs[q]); }
        qr[d0] = *reinterpret_cast<const bf16x8*>(&w); } }
  }
  asm volatile("s_waitcnt vmcnt(0) lgkmcnt(0)" ::: "memory"); A2_BAR();
  if (grp == 1) A2_BAR();
  const int vb0 = (int)(unsigned)(size_t)(lds + V_OFF) + v_rd_base(lane);
  f32x16 s0, s1; bf16x8 pa0, pa1, pa2, pa3; float alpha, mnC_ = 0.f;
  if constexpr (A2_SHADOW_) { pa0 = (bf16x8){}; pa1 = pa0; pa2 = pa0; pa3 = pa0; }
  int kst = 0, kis = NSK - 1, vst = NSV - 1, vis = NSV - 2;
#pragma unroll 1
  for (int i = 0; i < NT; ++i) {
    A2_T(0);
    __builtin_amdgcn_s_setprio(1);
    qk_tile<DQK>(s0, s1, (const LASc*)(lds + K_OFF + kst * SHM_K), qr, r32, hi);
    A2_TQ();
    if constexpr (A2_SHADOW_) { pv_pipe_s1<DQK, true>(o, vb0 + (i > 0 ? vst : 0) * SHM_V, pa0, pa1, pa2, pa3, s0, s1, m_reg, alpha, mnC_); }
    else { if (i > 0) pv_pipe(o, vb0 + vst * SHM_V, pa0, pa1, pa2, pa3); }
    __builtin_amdgcn_s_setprio(0);
    A2_T(1);
    if constexpr (!A2_REGSTAGE) asm volatile("s_waitcnt vmcnt(%0)" :: "n"(NWAIT_M) : "memory");
    A2_BAR();
    A2_T(2);
    const int tv_ = i + NSV - 2 < NT ? i + NSV - 2 : NT - 1, tk_ = i + NSK - 1 < NT ? i + NSK - 1 : NT - 1;
    if constexpr (A2_SHADOW_) softmax_p2<DQK>(s0, s1, mnC_, alpha, l_reg, pa0, pa1, pa2, pa3);
    else
    softmax_tile<DQK>(s0, s1, m_reg, l_reg, alpha, pa0, pa1, pa2, pa3, [&](const int k) {
      if constexpr (!A2_REGSTAGE && A2_SPREAD) {
        __builtin_amdgcn_sched_barrier(0);
        if (k < NVI) __builtin_amdgcn_global_load_lds((const unsigned*)(srcV[k] + (size_t)tv_ * (KVBLK * ldv * 2)), (LAS unsigned*)(lds + V_OFF + vis * SHM_V + k * 8192 + wid * 1024), 16, 0, 0);
        else if (k - NVI < NKI) __builtin_amdgcn_global_load_lds((const unsigned*)(srcK[k - NVI] + (size_t)tk_ * stepK[k - NVI]), (LAS unsigned*)(lds + K_OFF + kis * SHM_K + (k - NVI) * 8192 + wid * 1024), 16, 0, 0);
        __builtin_amdgcn_sched_barrier(0);
      } });
    A2_TX(7);
    if (__any(alpha < 1.f)) { if (hi == 0) al_l[r32] = alpha; asm volatile("s_waitcnt lgkmcnt(0)" ::: "memory");
#pragma unroll
      for (int d = 0; d < 4; ++d)
#pragma unroll
        for (int r = 0; r < 16; ++r) o[d][r] *= al_l[crow(r, hi)]; }
    __builtin_amdgcn_sched_barrier(0);
    A2_TX(8);
    if constexpr (A2_REGSTAGE) {
      A2_WRITE_V(vis); A2_WRITE_K(kis);
      __builtin_amdgcn_sched_barrier(0);
      { const int tv = i + 2 < NT ? i + 2 : NT - 1, tk = i + 3 < NT ? i + 3 : NT - 1; A2_LOAD_V(tv); A2_LOAD_K(tk); }
      A2_T3();
      asm volatile("s_waitcnt lgkmcnt(0)" ::: "memory"); A2_BAR();
    } else {
    if constexpr (!A2_SPREAD) { A2_ISSUE_V(tv_, vis); A2_ISSUE_K(tk_, kis); }
    A2_T3();
    asm volatile("s_waitcnt vmcnt(%0)" :: "n"(NWAIT_V) : "memory"); A2_BAR();
    }
    A2_T(4);
    kst = kst == NSK - 1 ? 0 : kst + 1; kis = kis == NSK - 1 ? 0 : kis + 1; vst = vst == NSV - 1 ? 0 : vst + 1; vis = vis == NSV - 1 ? 0 : vis + 1;
  }
  if (grp == 0) A2_BAR();
  pv_pipe(o, vb0 + vst * SHM_V, pa0, pa1, pa2, pa3);
  if (hi == 0) li_l[r32] = l_reg; asm volatile("s_waitcnt lgkmcnt(0)" ::: "memory");
  float rli[16];
#pragma unroll
  for (int r = 0; r < 16; ++r) rli[r] = __builtin_amdgcn_rcpf(li_l[crow(r, hi)]);
  unsigned char* Ow = Ob + (long)(wid * QBLK) * ldo;
#pragma unroll
  for (int r = 0; r < 16; ++r) { const int orow = crow(r, hi);
#pragma unroll
    for (int d0 = 0; d0 < 4; ++d0) { const float ov = __builtin_fminf(__builtin_fmaxf(o[d0][r] * rli[r] * AO_SCALE, -448.f), 448.f); Ow[(long)orow * ldo + d0 * 32 + r32] = (unsigned char)(__builtin_amdgcn_cvt_pk_fp8_f32(ov, 0.f, 0, false) & 0xff); } }
#undef A2_ISSUE_K
#undef A2_ISSUE_V
#undef A2_LOAD_K
#undef A2_LOAD_V
#undef A2_WRITE_K
#undef A2_WRITE_V
}
#undef KSWZ2
#undef A2_BAR
}
#ifndef TOPK_DYN
#define TOPK_DYN 0
#endif
#ifndef LN_RECOMP
#define LN_RECOMP 1
#endif
struct Frame {
    LAS unsigned char* lds;
    int tid, lane, wave, vcu, G, gw, ngw;
    float* out;
    unsigned char* ws;
};
enum { I_X = 0, I_C, I_CTX, I_CCTX, I_ADAW, I_ADAB, I_LMG, I_LMB, I_LFG, I_LFB, I_RW, I_WG, I_WU, I_WDN, I_GQKV, I_GQG, I_GKG, I_GWO, I_MDQ, I_MQG, I_MUQ, I_MDKV, I_MKVG, I_MUKV, I_MWO };

__device__ __forceinline__ u32x2 pack4(const f32x4 v) { u32x2 w; w.x = cvt_pk_bf16(v[0], v[1]); w.y = cvt_pk_bf16(v[2], v[3]); return w; }
__device__ __forceinline__ f32x4 unpack4(const u32x2 w) { return (f32x4){__uint_as_float(w.x << 16), __uint_as_float(w.x & 0xffff0000u), __uint_as_float(w.y << 16), __uint_as_float(w.y & 0xffff0000u)}; }
__device__ __forceinline__ float silu_f(float x) { return x / (1.0f + __expf(-x)); }

__device__ __forceinline__ void transpose_item(const float* W, int N, const float* g, bf16_t* dst, int ldd, int row_off, int il, LAS float* scr, int item, int lane) {
    const int nblk = N / 32, kb = item / nblk, nb = item % nblk, k0 = 64 * kb, n0 = 32 * nb;
#pragma unroll 8
    for (int i = 0; i < 32; ++i) { const int kk = 2 * i + (lane >> 5); float v = __builtin_nontemporal_load(&W[(size_t)(k0 + kk) * N + n0 + (lane & 31)]); if (g) v *= g[k0 + kk]; scr[kk * 33 + (lane & 31)] = v; }
    LDS_WAIT(); asm volatile("" ::: "memory");
    const int c = lane & 7;
#pragma unroll
    for (int j = 0; j < 4; ++j) { const int n = (lane >> 3) + 8 * j; const LAS float* s = scr + (8 * c) * 33 + n;
        u32x4 o; o.x = cvt_pk_bf16(s[0 * 33], s[1 * 33]); o.y = cvt_pk_bf16(s[2 * 33], s[3 * 33]); o.z = cvt_pk_bf16(s[4 * 33], s[5 * 33]); o.w = cvt_pk_bf16(s[6 * 33], s[7 * 33]);
        const int nn = n0 + n, dr = row_off + (il ? ((nn >> 7) << 8) + (nn & 127) : nn);
        *(u32x4*)(dst + (size_t)dr * ldd + k0 + 8 * c) = o; }
    LDS_WAIT(); asm volatile("" ::: "memory");
}

__device__ __forceinline__ void transpose_item_fp8(const float* W, int N, float scale, unsigned char* dst, int ldd, int row_off, int il, LAS float* scr, int item, int lane, const float* g = nullptr) {
    const int nblk = N / 32, kb = item / nblk, nb = item % nblk, k0 = 64 * kb, n0 = 32 * nb;
    { f32x4 wv[8];
#pragma unroll
      for (int i = 0; i < 8; ++i) wv[i] = __builtin_nontemporal_load((const f32x4*)&W[(size_t)(k0 + 8 * i + (lane >> 3)) * N + n0 + 4 * (lane & 7)]);
#pragma unroll
      for (int i = 0; i < 8; ++i) { const int kk = 8 * i + (lane >> 3); float sc = scale; if (g) sc *= g[k0 + kk]; LAS float* d = scr + kk * 33 + 4 * (lane & 7);
        d[0] = wv[i][0] * sc; d[1] = wv[i][1] * sc; d[2] = wv[i][2] * sc; d[3] = wv[i][3] * sc; } }
    LDS_WAIT(); asm volatile("" ::: "memory");
    const int n = lane >> 1, kh = (lane & 1) * 32; const LAS float* s = scr + kh * 33 + n;
    u32x4 o0, o1;
#pragma unroll
    for (int q = 0; q < 4; ++q) { o0[q] = cvt4_fp8(s[(4 * q + 0) * 33], s[(4 * q + 1) * 33], s[(4 * q + 2) * 33], s[(4 * q + 3) * 33]); o1[q] = cvt4_fp8(s[(16 + 4 * q + 0) * 33], s[(16 + 4 * q + 1) * 33], s[(16 + 4 * q + 2) * 33], s[(16 + 4 * q + 3) * 33]); }
    const int nn = n0 + n, dr = row_off + (il ? ((nn >> 7) << 8) + (nn & 127) : nn);
    u32x4* dp = (u32x4*)(dst + (size_t)dr * ldd + k0 + kh); dp[0] = o0; dp[1] = o1;
    LDS_WAIT(); asm volatile("" ::: "memory");
}

__device__ __forceinline__ void phase_p0a(Frame& F) {
    LAS float* scr = (LAS float*)(F.lds + F.wave * 9216);
    constexpr int I_QKV = 16 * 48, I_WO = 16 * 32, I_DQ = 16 * 24, I_DKV = 16 * 10, I_UQ = 12 * 48, I_UKV = 4 * 64;
    constexpr int PERJ = I_QKV + I_WO + I_DQ + I_DKV + I_UQ + I_UKV + I_WO;
    for (int it = F.gw; it < 2 * PERJ; it += F.ngw) {
        const int j = it / PERJ; int r = it - j * PERJ;
        if (r < I_QKV) { transpose_item_fp8(in_ptr(I_GQKV) + (size_t)j * 1024 * 1536, 1536, WP_SCALE, (unsigned char*)(F.ws + WS_WQKV) + (size_t)j * 1536 * 1024, 1024, 0, 0, scr, r, F.lane); continue; } r -= I_QKV;
        if (r < I_WO) { transpose_item_fp8(in_ptr(I_GWO) + (size_t)j * 1024 * 1024, 1024, WO_SCALE, (unsigned char*)(F.ws + WS_WOG) + (size_t)j * 1024 * 1024, 1024, 0, 0, scr, r, F.lane); continue; } r -= I_WO;
        if (r < I_DQ) { transpose_item_fp8(in_ptr(I_MDQ) + (size_t)j * 1024 * 768, 768, WP_SCALE, (unsigned char*)(F.ws + WS_WD) + (size_t)j * 1280 * 1024, 1024, 0, 0, scr, r, F.lane); continue; } r -= I_DQ;
        if (r < I_DKV) { transpose_item_fp8(in_ptr(I_MDKV) + (size_t)j * 1024 * 320, 320, WP_SCALE, (unsigned char*)(F.ws + WS_WD) + (size_t)j * 1280 * 1024, 1024, 768, 0, scr, r, F.lane); continue; } r -= I_DKV;
        if (r < I_UQ) { transpose_item_fp8(in_ptr(I_MUQ) + (size_t)j * 768 * 1536, 1536, WP_SCALE, (unsigned char*)(F.ws + WS_WUQ) + (size_t)j * 1536 * 768, 768, 0, 0, scr, r, F.lane, in_ptr(I_MQG) + j * 768); continue; } r -= I_UQ;
        if (r < I_UKV) { transpose_item(in_ptr(I_MUKV) + (size_t)j * 256 * 2048, 2048, in_ptr(I_MKVG) + j * 256, (bf16_t*)(F.ws + WS_WUKV) + (size_t)j * 2048 * 256, 256, 0, 0, scr, r, F.lane); continue; } r -= I_UKV;
        transpose_item_fp8(in_ptr(I_MWO) + (size_t)j * 1024 * 1024, 1024, WO_SCALE, (unsigned char*)(F.ws + WS_WOM) + (size_t)j * 1024 * 1024, 1024, 0, 0, scr, r, F.lane);
    }
    for (int i = blockIdx.x * NTHR + F.tid; i < 2 * 12288; i += F.G * NTHR) { const int j = i / 12288, q = i - j * 12288;
        *((u32x4*)((unsigned char*)(F.ws + WS_WD) + (size_t)j * 1280 * 1024 + (size_t)1088 * 1024) + q) = (u32x4){0u, 0u, 0u, 0u}; }
    { int* idn = (int*)(F.ws + WS_GVAL); for (int i = blockIdx.x * NTHR + F.tid; i < NSLOT; i += F.G * NTHR) idn[i] = i; }
    { float* rt = (float*)(F.ws + WS_ROPE); const int i = blockIdx.x * NTHR + F.tid;
        if (i < 2048) { const int pos = i >> 5, m = i & 31; const float fr = powf(10000.0f, -(float)(2 * m) / 64.0f), a = (float)pos * fr; rt[i] = cosf(a); rt[2048 + i] = sinf(a); }
        else if (i < 3072) { const int q = i - 2048, pos = q >> 4, m = q & 15; const float fr = powf(10000.0f, -(float)(2 * m) / 32.0f), a = (float)pos * fr; rt[4096 + q] = cosf(a); rt[5120 + q] = sinf(a); } }
    { float* modp = (float*)(F.ws + WS_R + R_MODP); LAS float* s = (LAS float*)(F.lds + F.wave * 9216);
        for (int it = F.gw; it < NL * 96 * MOD_KC; it += F.ngw) {
            const int kc = it % MOD_KC, cg = (it / MOD_KC) % 96, li = it / (MOD_KC * 96);
            for (int q = F.lane; q < 33 * 64; q += 64) { const int b = q >> 6, kk = q & 63; const float cv = b < 32 ? in_ptr(I_C)[b * D + kc * 64 + kk] : in_ptr(I_CCTX)[kc * 64 + kk]; s[kk * 36 + b] = silu_f(cv); }
            LDS_WAIT(); asm volatile("" ::: "memory");
            float acc[33];
#pragma unroll
            for (int b = 0; b < 33; ++b) acc[b] = 0.f;
            const float* wp = in_ptr(I_ADAW) + ((size_t)li * D + kc * 64) * MODSZ + cg * 64 + F.lane;
#pragma unroll 1
            for (int k8 = 0; k8 < 64; k8 += 16) { float wv[16];
#pragma unroll
                for (int q = 0; q < 16; ++q) wv[q] = __builtin_nontemporal_load(&wp[(size_t)(k8 + q) * MODSZ]);
#pragma unroll
                for (int q = 0; q < 16; ++q) { const int kk = k8 + q; const float w = wv[q];
#pragma unroll
                    for (int b4 = 0; b4 < 8; ++b4) { const f32x4 sv = *(const LAS f32x4*)(s + kk * 36 + b4 * 4); acc[b4 * 4 + 0] += sv[0] * w; acc[b4 * 4 + 1] += sv[1] * w; acc[b4 * 4 + 2] += sv[2] * w; acc[b4 * 4 + 3] += sv[3] * w; }
                    acc[32] += s[kk * 36 + 32] * w; } }
            float* op = modp + ((size_t)(kc * NL + li) * 33) * MODSZ + cg * 64 + F.lane;
#pragma unroll
            for (int b = 0; b < 33; ++b) op[(size_t)b * MODSZ] = acc[b];
            LDS_WAIT(); asm volatile("" ::: "memory");
        } }
}
__device__ __forceinline__ void phase_p0b(Frame& F) {
    const float* modp = (const float*)(F.ws + WS_R + R_MODP); float* mod = (float*)(F.ws + WS_MOD);
    for (int i = blockIdx.x * NTHR + F.tid; i < NL * 33 * MODSZ; i += F.G * NTHR) { const int n = i % MODSZ, li = i / (33 * MODSZ); float a = in_ptr(I_ADAB)[li * MODSZ + n];
#pragma unroll
        for (int kc = 0; kc < MOD_KC; ++kc) a += modp[(size_t)kc * NL * 33 * MODSZ + i];
        mod[i] = a; }
}
__device__ __forceinline__ const float* xrow_in(const float* xl, const float* xc, int b, int p) { return p < CTXL ? xc + ((size_t)b * CTXL + p) * D : xl + ((size_t)b * SEQ + (p - CTXL)) * D; }

__device__ __forceinline__ void phase_p0c(Frame& F) {
    const float* mod = (const float*)(F.ws + WS_MOD); unsigned char* H8 = (unsigned char*)(F.ws + WS_H);
    for (int r2 = F.gw * 2; r2 < T; r2 += F.ngw * 2) {
        f32x4 xa[2][4];
#pragma unroll
        for (int i = 0; i < 2; ++i) { const int r = r2 + i, b = r / TPS, p = r - b * TPS; const f32x4* xr = (const f32x4*)xrow_in(in_ptr(I_X), in_ptr(I_CTX), b, p) + F.lane;
#pragma unroll
            for (int j = 0; j < 4; ++j) xa[i][j] = __builtin_nontemporal_load(&xr[64 * j]); }
#pragma unroll
        for (int i = 0; i < 2; ++i) { const int r = r2 + i, b = r / TPS, p = r - b * TPS; const float* mv = mod + (size_t)(p < CTXL ? 32 : b) * MODSZ; unsigned* hr = (unsigned*)(H8 + (size_t)r * D) + F.lane;
#pragma unroll
            for (int j = 0; j < 4; ++j) { const f32x4 sh = *((const f32x4*)mv + F.lane + 64 * j), sc = *((const f32x4*)(mv + D) + F.lane + 64 * j); const f32x4 hv = xa[i][j] * (1.0f + sc) + sh; hr[64 * j] = cvt4_fp8(hv[0], hv[1], hv[2], hv[3]); } } }
}

__device__ __forceinline__ void phase_qknorm(Frame& F, int j, bf16_t* dry) {
    bf16_t* QKV = (bf16_t*)(F.ws + WS_R + R_QKV); const ptrdiff_t dofs = dry ? dry - QKV : 0; const float* rt = (const float*)(F.ws + WS_ROPE);
    const float* kg = in_ptr(I_GKG) + j * 128;
    const int l16 = F.lane & 15, hd = (F.lane >> 4) & 1, rsel = F.lane >> 5;
    const f32x4 gk0 = *(const f32x4*)(kg + l16 * 8), gk1 = *(const f32x4*)(kg + l16 * 8 + 4);
    for (int r2 = F.gw; r2 < T / 2; r2 += F.ngw) { const int r = 2 * r2 + rsel; const int b = r / TPS, p = r - b * TPS; const int t = p >= CTXL ? p - CTXL : 0, trow = t >> 6, tcol = t & 63;
        const int j0 = l16 * 4, pos = j0 < 32 ? trow : tcol, ti = pos * 32 + (j0 & 31);
        const f32x4 cs = *(const f32x4*)(rt + ti), sn = *(const f32x4*)(rt + 2048 + ti);
        u32x4* ptr = (u32x4*)(QKV + (size_t)r * 1536 + 1024 + hd * 128 + l16 * 8); const u32x4 w = *ptr;
        f32x4 a = {__uint_as_float(w.x << 16), __uint_as_float(w.x & 0xffff0000u), __uint_as_float(w.y << 16), __uint_as_float(w.y & 0xffff0000u)};
        f32x4 c = {__uint_as_float(w.z << 16), __uint_as_float(w.z & 0xffff0000u), __uint_as_float(w.w << 16), __uint_as_float(w.w & 0xffff0000u)};
        float ss = (a[0] * a[0] + a[1] * a[1]) + (a[2] * a[2] + a[3] * a[3]) + (c[0] * c[0] + c[1] * c[1]) + (c[2] * c[2] + c[3] * c[3]);
        ss += __shfl_xor(ss, 1); ss += __shfl_xor(ss, 2); ss += __shfl_xor(ss, 4); ss += __shfl_xor(ss, 8);
        const float rstd = 1.0f / sqrtf(ss * (1.0f / 128.0f) + LN_EPS);
        a = a * rstd * gk0; c = c * rstd * gk1;
        const f32x4 a2 = {a[0] * cs[0] - a[1] * sn[0], a[0] * sn[0] + a[1] * cs[0], a[2] * cs[1] - a[3] * sn[1], a[2] * sn[1] + a[3] * cs[1]};
        const f32x4 c2 = {c[0] * cs[2] - c[1] * sn[2], c[0] * sn[2] + c[1] * cs[2], c[2] * cs[3] - c[3] * sn[3], c[2] * sn[3] + c[3] * cs[3]};
        u32x4 o; o.x = cvt_pk_bf16(a2[0], a2[1]); o.y = cvt_pk_bf16(a2[2], a2[3]); o.z = cvt_pk_bf16(c2[0], c2[1]); o.w = cvt_pk_bf16(c2[2], c2[3]); *(u32x4*)((bf16_t*)ptr + dofs) = o; }
}
__device__ __forceinline__ void phase_mla_stats(Frame& F, bf16_t* dry) {
    bf16_t* CQ = (bf16_t*)(F.ws + WS_R + R_CQ); unsigned char* CQ8 = (unsigned char*)(F.ws + WS_CQ8); bf16_t* KR = (bf16_t*)(F.ws + WS_KR); const ptrdiff_t dofs = dry ? dry - CQ : 0; const float* rt = (const float*)(F.ws + WS_ROPE) + 4096;
    for (int r4 = F.gw * 4; r4 < T; r4 += F.ngw * 4) {
        u32x4 w0a[4], w1a[4], wka[4];
#pragma unroll
        for (int i = 0; i < 4; ++i) { const bf16_t* row = CQ + (size_t)(r4 + i) * 1280; w0a[i] = *(const u32x4*)(row + F.lane * 8); w1a[i] = *(const u32x4*)(row + 512 + F.lane * 8); wka[i] = *(const u32x4*)(row + 1024 + (F.lane & 7) * 8); }
#pragma unroll
        for (int i = 0; i < 4; ++i) { const int r = r4 + i; const int b = r / TPS, p = r - b * TPS; const int t = p >= CTXL ? p - CTXL : 0, trow = t >> 6, tcol = t & 63;
        bf16_t* row = CQ + (size_t)r * 1280; const u32x4 w0 = w0a[i], w1 = w1a[i];
        float s0 = 0.f, s1 = 0.f;
#pragma unroll
        for (int q = 0; q < 4; ++q) { const float a = __uint_as_float(w0[q] << 16), c = __uint_as_float(w0[q] & 0xffff0000u); s0 += a * a + c * c; const float a1 = __uint_as_float(w1[q] << 16), c1 = __uint_as_float(w1[q] & 0xffff0000u); s1 += a1 * a1 + c1 * c1; }
        const float sq = wave_sum(s0 + (F.lane < 32 ? s1 : 0.f)), skv = wave_sum(F.lane >= 32 ? s1 : 0.f);
        const float rq = 1.0f / sqrtf(sq * (1.0f / 768.0f) + LN_EPS), rkv = 1.0f / sqrtf(skv * (1.0f / 256.0f) + LN_EPS);
        { unsigned char* c8 = CQ8 + (size_t)r * 768; u32x2 q0; q0.x = cvt4_fp8(__uint_as_float(w0[0] << 16) * rq, __uint_as_float(w0[0] & 0xffff0000u) * rq, __uint_as_float(w0[1] << 16) * rq, __uint_as_float(w0[1] & 0xffff0000u) * rq);
          q0.y = cvt4_fp8(__uint_as_float(w0[2] << 16) * rq, __uint_as_float(w0[2] & 0xffff0000u) * rq, __uint_as_float(w0[3] << 16) * rq, __uint_as_float(w0[3] & 0xffff0000u) * rq); *(u32x2*)(c8 + F.lane * 8) = q0;
          if (F.lane < 32) { u32x2 q1; q1.x = cvt4_fp8(__uint_as_float(w1[0] << 16) * rq, __uint_as_float(w1[0] & 0xffff0000u) * rq, __uint_as_float(w1[1] << 16) * rq, __uint_as_float(w1[1] & 0xffff0000u) * rq);
            q1.y = cvt4_fp8(__uint_as_float(w1[2] << 16) * rq, __uint_as_float(w1[2] & 0xffff0000u) * rq, __uint_as_float(w1[3] << 16) * rq, __uint_as_float(w1[3] & 0xffff0000u) * rq); *(u32x2*)(c8 + 512 + F.lane * 8) = q1; }
          else { u32x4 o1;
#pragma unroll
            for (int q = 0; q < 4; ++q) o1[q] = cvt_pk_bf16(__uint_as_float(w1[q] << 16) * rkv, __uint_as_float(w1[q] & 0xffff0000u) * rkv);
            *(u32x4*)(row + dofs + 512 + F.lane * 8) = o1; } }
        if (F.lane < 8) { const u32x4 w = wka[i]; u32x4 o = w;
            { const int j0 = F.lane * 4, pos = j0 < 16 ? trow : tcol, ti = pos * 16 + (j0 & 15); const f32x4 cs = *(const f32x4*)(rt + ti), sn = *(const f32x4*)(rt + 1024 + ti);
#pragma unroll
                for (int q = 0; q < 4; ++q) { const float x0 = __uint_as_float(w[q] << 16), x1 = __uint_as_float(w[q] & 0xffff0000u); o[q] = cvt_pk_bf16(x0 * cs[q] - x1 * sn[q], x0 * sn[q] + x1 * cs[q]); } }
            *(u32x4*)(KR + (size_t)r * 64 + F.lane * 8) = o; } } }
}

__device__ __forceinline__ float lane_xor32_sum(float a) { auto rr = __builtin_amdgcn_permlane32_swap(__float_as_uint(a), __float_as_uint(a), false, false); return __uint_as_float(rr[0]) + __uint_as_float(rr[1]); }
__device__ __forceinline__ float lane_xor32_max(float a) { auto rr = __builtin_amdgcn_permlane32_swap(__float_as_uint(a), __float_as_uint(a), false, false); return fmaxf(__uint_as_float(rr[0]), __uint_as_float(rr[1])); }
__device__ __forceinline__ float lane_xor4(float v) {
    const int a = __builtin_amdgcn_update_dpp(0, __builtin_bit_cast(int, v), 0x114, 0xf, 0xA, false);
    return __builtin_bit_cast(float, __builtin_amdgcn_update_dpp(a, __builtin_bit_cast(int, v), 0x104, 0xf, 0x5, false));
}
__device__ __forceinline__ void ln1_reduce16(float (&acc)[16], int lane, float& lg_e) {
#pragma unroll
    for (int e = 0; e < 8; ++e) { auto rr = __builtin_amdgcn_permlane32_swap(__float_as_uint(acc[e]), __float_as_uint(acc[e + 8]), false, false); acc[e] = __uint_as_float(rr[0]) + __uint_as_float(rr[1]); }
#pragma unroll
    for (int e = 0; e < 4; ++e) { const bool up = (lane & 16) != 0; const float send = up ? acc[e] : acc[e + 4], keep = up ? acc[e + 4] : acc[e]; acc[e] = keep + lane_xor16(send); }
#pragma unroll
    for (int e = 0; e < 2; ++e) { const bool up = (lane & 8) != 0; const float send = up ? acc[e] : acc[e + 2], keep = up ? acc[e + 2] : acc[e]; acc[e] = keep + DPP_MOV(send, 0x128); }
    { const bool up = (lane & 2) != 0; const float send = up ? acc[0] : acc[1], keep = up ? acc[1] : acc[0]; acc[0] = keep + DPP_MOV(send, 0x4E); }
    float v = acc[0]; v += DPP_MOV(v, 0xB1); v += lane_xor4(v); lg_e = v;
}
__device__ __forceinline__ void phase_ln1(Frame& F, int li, const float* xin_l, const float* xin_c, const bf16_t* O, float* xdry, bool skipctx) {
    LAS float* Wt = (LAS float*)F.lds;
    { const float* rw = in_ptr(I_RW) + (size_t)li * D * NE; for (int i = F.tid; i < D * NE; i += NTHR) Wt[(i & 15) * D + (i >> 4)] = rw[i]; }
    __syncthreads();
    const float* mod = (const float*)(F.ws + WS_MOD) + (size_t)li * 33 * MODSZ; unsigned char* H8 = (unsigned char*)(F.ws + WS_H); float* AFF = (float*)(F.ws + WS_AFF); int* INV = (int*)(F.ws + WS_INV);
    f32x4 lg[4], lb[4], g1[4], sh2[4], sc2[4];
    { const float* pg = in_ptr(I_LMG) + li * D; const float* pb = in_ptr(I_LMB) + li * D;
#pragma unroll
      for (int j = 0; j < 4; ++j) { lg[j] = *((const f32x4*)pg + F.lane + 64 * j); lb[j] = *((const f32x4*)pb + F.lane + 64 * j); } }
#pragma unroll 1
    for (int rp_ = 0; rp_ < REP_LN1; ++rp_) { float* xd = rp_ + 1 < REP_LN1 ? xdry : nullptr; float* Xl = xd ? xd + (size_t)NB * CTXL * D : F.out; float* Xc = xd ? xd : (float*)(F.ws + WS_XC);
    for (int wv = F.gw; wv < 2048; wv += F.ngw) { const int b = wv >> 6, w = wv & 63;
#pragma unroll 1
        for (int seg = skipctx ? 1 : 0; seg < 2; ++seg) { const float* mv = mod + (size_t)(seg == 0 ? 32 : b) * MODSZ;
#pragma unroll
            for (int j = 0; j < 4; ++j) { g1[j] = *((const f32x4*)(mv + 2 * D) + F.lane + 64 * j); sh2[j] = *((const f32x4*)(mv + 3 * D) + F.lane + 64 * j); sc2[j] = *((const f32x4*)(mv + 4 * D) + F.lane + 64 * j); }
            const int np = seg == 0 ? 2 : 16, p0 = seg == 0 ? 4 * w : CTXL + 32 * w;
            const float* xin = seg == 0 ? xin_c + (size_t)b * CTXL * D : xin_l + ((size_t)b * SEQ - CTXL) * D;
            float* xout = seg == 0 ? Xc + (size_t)b * CTXL * D : Xl + ((size_t)b * SEQ - CTXL) * D;
            f32x4 nx[2][4]; u32x2 no[2][4];
#define LN1_FETCH(pp) do { _Pragma("unroll") for (int q = 0; q < 2; ++q) { const f32x4* xr = (const f32x4*)(xin + (size_t)((pp) + q) * D) + F.lane; const u32x2* orow = (const u32x2*)(O + ((size_t)b * TPS + (pp) + q) * D) + F.lane; \
                _Pragma("unroll") for (int j = 0; j < 4; ++j) { nx[q][j] = __builtin_nontemporal_load(&xr[64 * j]); no[q][j] = __builtin_nontemporal_load(&orow[64 * j]); } } } while (0)
            LN1_FETCH(p0);
#pragma unroll 1
            for (int k = 0; k < np; ++k) { const int pA = p0 + 2 * k; const size_t rA = (size_t)b * TPS + pA;
                f32x4 v[2][4]; float s[2] = {0.f, 0.f};
#pragma unroll
                for (int q = 0; q < 2; ++q)
#pragma unroll
                    for (int j = 0; j < 4; ++j) { v[q][j] = nx[q][j] * ALPHA + g1[j] * unpack4(no[q][j]); s[q] += (v[q][j][0] + v[q][j][1]) + (v[q][j][2] + v[q][j][3]); }
                __builtin_amdgcn_sched_barrier(0);
                if (k + 1 < np) LN1_FETCH(pA + 2);
                __builtin_amdgcn_sched_barrier(0);
                float s2[2] = {0.f, 0.f};
#pragma unroll
                for (int q = 0; q < 2; ++q) { const float mean = wave_sum(s[q]) * (1.0f / D);
#pragma unroll
                    for (int j = 0; j < 4; ++j) { v[q][j] = v[q][j] - mean; s2[q] += (v[q][j][0] * v[q][j][0] + v[q][j][1] * v[q][j][1]) + (v[q][j][2] * v[q][j][2] + v[q][j][3] * v[q][j][3]); } }
#pragma unroll
                for (int q = 0; q < 2; ++q) { const float rstd = 1.0f / sqrtf(wave_sum(s2[q]) * (1.0f / D) + LN_EPS);
                    f32x4* xw = (f32x4*)(xout + (size_t)(pA + q) * D) + F.lane; unsigned* hr = (unsigned*)(H8 + (rA + q) * D) + F.lane;
#pragma unroll
                    for (int j = 0; j < 4; ++j) { v[q][j] = v[q][j] * rstd * lg[j] + lb[j]; if (!LN_RECOMP) __builtin_nontemporal_store(v[q][j], &xw[64 * j]); v[q][j] = v[q][j] * (1.0f + sc2[j]) + sh2[j]; hr[64 * j] = cvt4_fp8(v[q][j][0], v[q][j][1], v[q][j][2], v[q][j][3]); } }
                f32x2 hp[4][4];
#pragma unroll
                for (int j = 0; j < 4; ++j)
#pragma unroll
                    for (int c = 0; c < 4; ++c) hp[j][c] = (f32x2){v[0][j][c], v[1][j][c]};
                __builtin_amdgcn_sched_barrier(0);
                float accA[16], accB[16];
#pragma unroll
                for (int e = 0; e < 16; ++e) { f32x2 a2 = {0.f, 0.f};
#pragma unroll
                    for (int j = 0; j < 4; ++j) { const f32x4 wq = *(const LAS f32x4*)(Wt + e * D + 4 * F.lane + 256 * j);
#pragma unroll
                        for (int c = 0; c < 4; ++c) a2 = __builtin_elementwise_fma(hp[j][c], (f32x2){wq[c], wq[c]}, a2); }
                    accA[e] = a2[0]; accB[e] = a2[1]; if (e & 1) __builtin_amdgcn_sched_barrier(0); }
                float lgA, lgB; ln1_reduce16(accA, F.lane, lgA); ln1_reduce16(accB, F.lane, lgB);
#pragma unroll
                for (int q = 0; q < 2; ++q) { const float lg_e = q ? lgB : lgA;
                    float mx = lg_e; mx = fmaxf(mx, DPP_MOV(mx, 0x4E)); mx = fmaxf(mx, DPP_MOV(mx, 0x128)); mx = fmaxf(mx, lane_xor16(mx)); mx = lane_xor32_max(mx);
                    const float ex = __expf(lg_e - mx); float se = ex; se += DPP_MOV(se, 0x4E); se += DPP_MOV(se, 0x128); se += lane_xor16(se); se = lane_xor32_sum(se);
                    const int eidx = ((F.lane >> 5) << 3) | (((F.lane >> 4) & 1) << 2) | (((F.lane >> 3) & 1) << 1) | ((F.lane >> 1) & 1);
                    if ((F.lane & 5) == 0) { AFF[(rA + q) * NE + eidx] = ex / se; INV[(rA + q) * NE + eidx] = -1; } }
            } } } }
}

__device__ __forceinline__ void topk_item(Frame& F, LAS unsigned* keys, LAS unsigned* hist, int e, int row0  , int n, int cap, int slot0) {
    const float* AFF = (const float*)(F.ws + WS_AFF); int* INV = (int*)(F.ws + WS_INV); int* STOK = (int*)(F.ws + WS_STOK);
    const int nk = n >> 6;
#pragma unroll 4
    for (int k = 0; k < nk; ++k) keys[F.lane + 64 * k] = __float_as_uint(AFF[(size_t)(row0 + F.lane + 64 * k) * NE + e]);
    LDS_WAIT(); asm volatile("" ::: "memory");
    unsigned prefix = 0u, mask = 0u; int krem = cap;
#pragma unroll 1
    for (int pass = 0; pass < 4; ++pass) { const int shift = 24 - 8 * pass;
        *(LAS u32x4*)(hist + 4 * F.lane) = (u32x4){0u, 0u, 0u, 0u};
        LDS_WAIT(); asm volatile("" ::: "memory");
#pragma unroll 4
        for (int k = 0; k < nk; ++k) { const unsigned key = keys[F.lane + 64 * k]; if ((key & mask) == prefix) __hip_atomic_fetch_add(hist + ((key >> shift) & 255u), 1u, __ATOMIC_RELAXED, __HIP_MEMORY_SCOPE_WORKGROUP); }
        LDS_WAIT(); asm volatile("" ::: "memory");
        const u32x4 c = *(const LAS u32x4*)(hist + 4 * F.lane);
        const int s = (int)(c[0] + c[1] + c[2] + c[3]);
        int suf = s;
#pragma unroll
        for (int o = 1; o < 64; o <<= 1) { const int t = __shfl_down(suf, o); if (F.lane + o < 64) suf += t; }
        int cum = suf - s;
        int fbin = -1, fk = 0;
#pragma unroll
        for (int q = 3; q >= 0; --q) { const int cq = (int)c[q]; if (fbin < 0 && cum < krem && cum + cq >= krem) { fbin = 4 * F.lane + q; fk = krem - cum; } cum += cq; }
        const unsigned long long bal = __ballot(fbin >= 0); const int src = bal ? __ffsll((long long)bal) - 1 : 0;
        const int bin = __shfl(fbin, src), nkk = __shfl(fk, src);
        prefix |= (unsigned)bin << shift; mask |= 0xffu << shift; krem = nkk;
        asm volatile("" ::: "memory");
    }
    int nsel = 0, neq = 0;
    const unsigned long long lt = (1ull << F.lane) - 1ull;
#pragma unroll 2
    for (int k = 0; k < nk; ++k) { const unsigned key = keys[F.lane + 64 * k]; const bool gt = key > prefix, eq = key == prefix;
        const unsigned long long be = __ballot(eq); const int eqb = neq + __popcll(be & lt); const bool sel = gt || (eq && eqb < krem);
        const unsigned long long bs = __ballot(sel); const int pos = nsel + __popcll(bs & lt);
        if (sel && pos < cap) { const int row = row0 + F.lane + 64 * k, slot = slot0 + pos; STOK[slot] = row; INV[(size_t)row * NE + e] = slot; }
        nsel += __popcll(bs); neq += __popcll(be); }
    LDS_WAIT(); asm volatile("" ::: "memory");
}
__device__ __forceinline__ void phase_topk_conv(Frame& F, int li, bool skipctx) {
    LAS unsigned* hist = (LAS unsigned*)(F.lds + 8 * 9216 + F.wave * 1024);
#if TOPK_DYN
    LAS unsigned* ctr = (LAS unsigned*)(F.lds + MISC_OFF + 64);
    if (F.tid == 0) *ctr = 0u;
    __syncthreads();
#endif
    if (F.wave < 4) for (int it = F.vcu * 4 + F.wave; it < (skipctx ? 512 : 1024); it += F.G * 4) { const int set = it >> 9, b = (it >> 4) & 31, e = it & 15; LAS unsigned* keys = (LAS unsigned*)(F.lds + F.wave * 9216);
        if (set == 0) topk_item(F, keys, hist, e, b * TPS + CTXL, SEQ, CAPL, (b * NE + e) * CAPL);
        else topk_item(F, keys, hist, e, b * TPS, CTXL, CAPC, NSLOT_L + (e * 4 + (b >> 3)) * 256 + (b & 7) * CAPC); }
    LAS float* scr = (LAS float*)(F.lds + F.wave * 9216);
#if TOPK_DYN
    for (;;) { unsigned k_ = 0; if (F.lane == 0) k_ = __hip_atomic_fetch_add(ctr, 1u, __ATOMIC_RELAXED, __HIP_MEMORY_SCOPE_WORKGROUP); k_ = __builtin_amdgcn_readfirstlane(k_);
        const int it = F.vcu * NWAVES + (int)(k_ & 7u) + (int)(k_ >> 3) * F.ngw; if (it >= 3 * NE * 512) break;
#else
    for (int it = F.gw; it < 3 * NE * 512; it += F.ngw) {
#endif
        const int which = it / (NE * 512), rem = it - which * (NE * 512), e = rem >> 9, item = rem & 511;
        const size_t eoff = ((size_t)li * NE + e) * D * FF;
        if (which == 0) transpose_item_fp8(in_ptr(I_WG) + eoff, FF, WGU_SCALE, (unsigned char*)(F.ws + WS_WGU) + (size_t)e * 2048 * D, D, 0, 1, scr, item, F.lane);
        else if (which == 1) transpose_item_fp8(in_ptr(I_WU) + eoff, FF, WGU_SCALE, (unsigned char*)(F.ws + WS_WGU) + (size_t)e * 2048 * D, D, 128, 1, scr, item, F.lane);
        else transpose_item_fp8(in_ptr(I_WDN) + eoff, D, WDN_SCALE, (unsigned char*)(F.ws + WS_WDN) + (size_t)e * D * FF, FF, 0, 0, scr, item, F.lane); }
}
__device__ __forceinline__ void phase_gather(Frame& F) {
    const bf16_t* H = (const bf16_t*)(F.ws + WS_H); bf16_t* XS = (bf16_t*)(F.ws + WS_R + R_XS); const int* STOK = (const int*)(F.ws + WS_STOK);
    for (int s0 = F.gw * 4; s0 < NSLOT; s0 += F.ngw * 4) { u32x4 v[4][2];
#pragma unroll
        for (int q = 0; q < 4; ++q) { int row = STOK[s0 + q]; row = row < 0 ? 0 : (row >= T ? T - 1 : row); const u32x4* src = (const u32x4*)(H + (size_t)row * D) + F.lane; v[q][0] = src[0]; v[q][1] = src[64]; }
#pragma unroll
        for (int q = 0; q < 4; ++q) { u32x4* dst = (u32x4*)(XS + (size_t)(s0 + q) * D) + F.lane; dst[0] = v[q][0]; dst[64] = v[q][1]; } }
}
__device__ __forceinline__ void phase_ln2(Frame& F, int li, float* xdry, bool skipctx, const float* xin_l, const float* xin_c, const bf16_t* O) {
    const float* mod = (const float*)(F.ws + WS_MOD) + (size_t)li * 33 * MODSZ; const float* modn = mod + (size_t)33 * MODSZ; const bool has_next = li + 1 < NL;
    unsigned char* H8 = (unsigned char*)(F.ws + WS_H); const int* INV = (const int*)(F.ws + WS_INV); const float* AFF = (const float*)(F.ws + WS_AFF); const bf16_t* Y = (const bf16_t*)(F.ws + WS_R + R_XS);
    float* Xl = F.out; float* Xc = (float*)(F.ws + WS_XC); float* Xdl = xdry ? xdry + (size_t)NB * CTXL * D : Xl; float* Xdc = xdry ? xdry : Xc;
    f32x4 lg[4], lb[4], g2[4];
    { const float* pg = in_ptr(I_LFG) + li * D; const float* pb = in_ptr(I_LFB) + li * D;
#pragma unroll
      for (int j = 0; j < 4; ++j) { lg[j] = *((const f32x4*)pg + F.lane + 64 * j); lb[j] = *((const f32x4*)pb + F.lane + 64 * j); } }
    for (int wv = F.gw; wv < 2048; wv += F.ngw) { const int b = wv >> 6, w = wv & 63;
#pragma unroll 1
        for (int seg = skipctx ? 1 : 0; seg < 2; ++seg) { const float* mv = mod + (size_t)(seg == 0 ? 32 : b) * MODSZ; const float* mn = modn + (size_t)(seg == 0 ? 32 : b) * MODSZ;
#pragma unroll
            for (int j = 0; j < 4; ++j) g2[j] = *((const f32x4*)(mv + 5 * D) + F.lane + 64 * j);
            const int np = seg == 0 ? 2 : 16, p0 = seg == 0 ? 4 * w : CTXL + 32 * w;
            const float* xio = LN_RECOMP ? (seg == 0 ? xin_c + (size_t)b * CTXL * D : xin_l + ((size_t)b * SEQ - CTXL) * D) : (seg == 0 ? Xc + (size_t)b * CTXL * D : Xl + ((size_t)b * SEQ - CTXL) * D);
            float* xo2 = seg == 0 ? Xdc + (size_t)b * CTXL * D : Xdl + ((size_t)b * SEQ - CTXL) * D;
            int ninv[2]; float naff[2];
#pragma unroll
            for (int q = 0; q < 2; ++q) { ninv[q] = INV[((size_t)b * TPS + p0 + q) * NE + (F.lane & 15)]; naff[q] = AFF[((size_t)b * TPS + p0 + q) * NE + (F.lane & 15)]; }
#pragma unroll 1
            for (int k = 0; k < np; ++k) { const int pA = p0 + 2 * k; const size_t rA = (size_t)b * TPS + pA;
                int myinv[2]; float myaff[2]; f32x4 xv[2][4], f[2][4];
#pragma unroll
                for (int q = 0; q < 2; ++q) { myinv[q] = ninv[q]; myaff[q] = naff[q]; const size_t rn = k + 1 < np ? rA + 2 + q : rA + q; ninv[q] = INV[rn * NE + (F.lane & 15)]; naff[q] = AFF[rn * NE + (F.lane & 15)]; const f32x4* xr = (const f32x4*)(xio + (size_t)(pA + q) * D) + F.lane;
#pragma unroll
                    for (int j = 0; j < 4; ++j) { xv[q][j] = __builtin_nontemporal_load(&xr[64 * j]); f[q][j] = (f32x4){0.f, 0.f, 0.f, 0.f}; } }
                if constexpr (LN_RECOMP != 0) {
                    u32x2 ov[2][4]; float s1[2] = {0.f, 0.f}, s1b[2] = {0.f, 0.f};
#pragma unroll
                    for (int q = 0; q < 2; ++q) { const u32x2* orow = (const u32x2*)(O + (rA + q) * D) + F.lane;
#pragma unroll
                        for (int j = 0; j < 4; ++j) ov[q][j] = __builtin_nontemporal_load(&orow[64 * j]); }
#pragma unroll
                    for (int j = 0; j < 4; ++j) { const f32x4 g1j = *((const f32x4*)(mv + 2 * D) + F.lane + 64 * j);
#pragma unroll
                        for (int q = 0; q < 2; ++q) { xv[q][j] = xv[q][j] * ALPHA + g1j * unpack4(ov[q][j]); s1[q] += (xv[q][j][0] + xv[q][j][1]) + (xv[q][j][2] + xv[q][j][3]); } }
#pragma unroll
                    for (int q = 0; q < 2; ++q) { const float mean = wave_sum(s1[q]) * (1.0f / D);
#pragma unroll
                        for (int j = 0; j < 4; ++j) { xv[q][j] = xv[q][j] - mean; s1b[q] += (xv[q][j][0] * xv[q][j][0] + xv[q][j][1] * xv[q][j][1]) + (xv[q][j][2] * xv[q][j][2] + xv[q][j][3] * xv[q][j][3]); } }
                    float rs1[2];
#pragma unroll
                    for (int q = 0; q < 2; ++q) rs1[q] = 1.0f / sqrtf(wave_sum(s1b[q]) * (1.0f / D) + LN_EPS);
#pragma unroll
                    for (int j = 0; j < 4; ++j) { const f32x4 mg = *((const f32x4*)(in_ptr(I_LMG) + li * D) + F.lane + 64 * j), mb = *((const f32x4*)(in_ptr(I_LMB) + li * D) + F.lane + 64 * j);
#pragma unroll
                        for (int q = 0; q < 2; ++q) xv[q][j] = xv[q][j] * rs1[q] * mg + mb; }
                }
                unsigned msk[2];
#pragma unroll
                for (int q = 0; q < 2; ++q) msk[q] = (unsigned)__ballot(F.lane < 16 && myinv[q] >= 0);
                while (msk[0] | msk[1]) {
                    int sl[2][2]; float gt[2][2];
#pragma unroll
                    for (int q = 0; q < 2; ++q)
#pragma unroll
                        for (int i = 0; i < 2; ++i) { const bool has = msk[q] != 0u; const int e = has ? __builtin_ctz(msk[q]) : 0; msk[q] &= msk[q] - 1u;
                            const int s_ = __builtin_amdgcn_readlane(myinv[q], e); const float g_ = __uint_as_float(__builtin_amdgcn_readlane(__float_as_uint(myaff[q]), e));
                            sl[q][i] = has ? s_ : 0; gt[q][i] = has ? g_ : 0.f; }
                    u32x2 yv[2][2][4];
#pragma unroll
                    for (int q = 0; q < 2; ++q)
#pragma unroll
                        for (int i = 0; i < 2; ++i) { const u32x2* yr = (const u32x2*)(Y + (size_t)sl[q][i] * D) + F.lane;
#pragma unroll
                            for (int j = 0; j < 4; ++j) yv[q][i][j] = __builtin_nontemporal_load(&yr[64 * j]); }
#pragma unroll
                    for (int q = 0; q < 2; ++q)
#pragma unroll
                        for (int i = 0; i < 2; ++i)
#pragma unroll
                            for (int j = 0; j < 4; ++j) f[q][j] += unpack4(yv[q][i][j]) * gt[q][i];
                }
                f32x4 v[2][4]; float s[2] = {0.f, 0.f}, s2[2] = {0.f, 0.f};
#pragma unroll
                for (int q = 0; q < 2; ++q)
#pragma unroll
                    for (int j = 0; j < 4; ++j) { v[q][j] = xv[q][j] * ALPHA + g2[j] * f[q][j]; s[q] += (v[q][j][0] + v[q][j][1]) + (v[q][j][2] + v[q][j][3]); }
#pragma unroll
                for (int q = 0; q < 2; ++q) { const float mean = wave_sum(s[q]) * (1.0f / D);
#pragma unroll
                    for (int j = 0; j < 4; ++j) { v[q][j] = v[q][j] - mean; s2[q] += (v[q][j][0] * v[q][j][0] + v[q][j][1] * v[q][j][1]) + (v[q][j][2] * v[q][j][2] + v[q][j][3] * v[q][j][3]); } }
#pragma unroll
                for (int q = 0; q < 2; ++q) { const float rstd = 1.0f / sqrtf(wave_sum(s2[q]) * (1.0f / D) + LN_EPS);
                    f32x4* xw = (f32x4*)(xo2 + (size_t)(pA + q) * D) + F.lane; unsigned* hr = (unsigned*)(H8 + (rA + q) * D) + F.lane;
#pragma unroll
                    for (int j = 0; j < 4; ++j) { v[q][j] = v[q][j] * rstd * lg[j] + lb[j]; __builtin_nontemporal_store(v[q][j], &xw[64 * j]); if (has_next) { const f32x4 sh1 = *((const f32x4*)mn + F.lane + 64 * j), sc1 = *((const f32x4*)(mn + D) + F.lane + 64 * j); const f32x4 hv = v[q][j] * (1.0f + sc1) + sh1; hr[64 * j] = cvt4_fp8(hv[0], hv[1], hv[2], hv[3]); } } }
            } } }
}
#ifndef ATT_V2
#define ATT_V2 0
#endif
template <int DQK, int SD>
__device__ __forceinline__ void phase_attn(Frame& F, int jg, bool skipctx, unsigned long long& pacc) {
    char* lds = (char*)F.lds;
    for (int u = F.vcu; u < (skipctx ? 2048 : 2048 + 256); u += F.G) {
        int b, h, prow, seq;
        if (u < 2048) { b = u >> 6; h = (u >> 3) & 7; prow = CTXL + (u & 7) * 256; seq = TPS; } else { const int q = u - 2048; b = q >> 3; h = q & 7; prow = 0; seq = CTXL; }
        const size_t row0 = (size_t)b * TPS;
        if constexpr (DQK == 128) {
            const bf16_t* QKV = (const bf16_t*)(F.ws + WS_R + R_QKV); unsigned char* AO = (unsigned char*)(F.ws + WS_R + R_AOG);
            const bf16_t* K = QKV + row0 * 1536 + 1024 + (h >> 2) * 128;
#if ATT_V2
            att2::attn_body2<128, 1536, 1536, 64, 1536, D>(QKV + (row0 + prow) * 1536 + h * 128, K, nullptr, K + 256, AO + (row0 + prow) * D + h * 128, seq, F.lds, prow - CTXL, (const float*)(F.ws + WS_ROPE), in_ptr(I_GQG) + jg * 128, pacc);
#else
            att::attn_body<128, SD, 1536, 1536, 64, 1536, D>(QKV + (row0 + prow) * 1536 + h * 128, K, nullptr, K + 256, AO + (row0 + prow) * D + h * 128, seq, lds, prow - CTXL, (const float*)(F.ws + WS_ROPE), in_ptr(I_GQG) + jg * 128);
#endif
        } else {
            const bf16_t* Q = (const bf16_t*)(F.ws + WS_R + R_Q); const bf16_t* KV = (const bf16_t*)(F.ws + WS_R + R_KV); const bf16_t* KR = (const bf16_t*)(F.ws + WS_KR); unsigned char* AO = (unsigned char*)(F.ws + WS_R + R_AOM);
            const bf16_t* K = KV + row0 * 2048 + h * 256;
#if ATT_V2
            att2::attn_body2<192, 1536, 2048, 64, 2048, D>(Q + (row0 + prow) * 1536 + h * 192, K, KR + row0 * 64, K + 128, AO + (row0 + prow) * D + h * 128, seq, F.lds, prow - CTXL, (const float*)(F.ws + WS_ROPE) + 4096, nullptr, pacc);
#else
            att::attn_body<192, SD, 1536, 2048, 64, 2048, D>(Q + (row0 + prow) * 1536 + h * 192, K, KR + row0 * 64, K + 128, AO + (row0 + prow) * D + h * 128, seq, lds, prow - CTXL, (const float*)(F.ws + WS_ROPE) + 4096, nullptr);
#endif
        }
        __syncthreads();
    }
}

#ifndef REP_DENSE
#define REP_DENSE 1
#endif
#ifndef REP_MOE
#define REP_MOE 1
#endif
#ifndef REP_ATTN
#define REP_ATTN 1
#endif
#ifndef REP_THIN
#define REP_THIN 1
#endif
#ifndef REP_LN1
#define REP_LN1 1
#endif
#ifndef REP_LN2
#define REP_LN2 1
#endif
#ifndef REP_QK
#define REP_QK 1
#endif
#ifndef REP_BAR
#define REP_BAR 1
#endif
#ifndef REP_ATTN_M
#define REP_ATTN_M REP_ATTN
#endif
#ifndef REP_ATTN_G
#define REP_ATTN_G REP_ATTN
#endif
#ifndef EN_ALL
#define EN_ALL 1
#endif
#ifndef EN_ATTN_MLA
#define EN_ATTN_MLA 1
#endif
#ifndef EN_ATTN_GQA
#define EN_ATTN_GQA 1
#endif
#ifndef ATT_SD_GQA
#define ATT_SD_GQA 1
#endif
#ifndef EN_UQ
#define EN_UQ 1
#endif
#ifndef EN_UKV
#define EN_UKV 1
#endif
#ifndef EN_P0A
#define EN_P0A EN_ALL
#endif
#ifndef EN_P0B
#define EN_P0B EN_ALL
#endif
#ifndef EN_P0C
#define EN_P0C EN_ALL
#endif
#ifndef EN_PROJ
#define EN_PROJ EN_ALL
#endif
#ifndef EN_THIN1
#define EN_THIN1 EN_ALL
#endif
#ifndef EN_UQKV
#define EN_UQKV EN_ALL
#endif
#ifndef EN_ATTN
#define EN_ATTN EN_ALL
#endif
#ifndef EN_OPROJ
#define EN_OPROJ EN_ALL
#endif
#ifndef EN_LN1
#define EN_LN1 EN_ALL
#endif
#ifndef EN_TOPK
#define EN_TOPK EN_ALL
#endif
#ifndef EN_GATHER
#define EN_GATHER 0
#endif
#ifndef EN_GU
#define EN_GU EN_ALL
#endif
#ifndef EN_DN
#define EN_DN EN_ALL
#endif
#ifndef EN_LN2
#define EN_LN2 EN_ALL
#endif
constexpr int NPH = 3 + NL * 11;
struct Args { const float* in[25]; float* out; unsigned char* ws; int ph_lo, ph_hi; };
__global__ void __launch_bounds__(NTHR, 2) mk_fwd(Args args) {
    extern __shared__ __attribute__((aligned(16))) unsigned char lds_raw[];
    Frame F;
    F.lds = (LAS unsigned char*)lds_raw;
    F.tid = threadIdx.x; F.lane = F.tid & 63; F.wave = __builtin_amdgcn_readfirstlane(F.tid >> 6);
    F.G = gridDim.x; { const int bx = blockIdx.x; F.vcu = (F.G % 8 == 0) ? (bx % 8) * (F.G / 8) + bx / 8 : bx; }
    F.gw = F.vcu * NWAVES + F.wave; F.ngw = F.G * NWAVES;
    F.out = args.out; F.ws = args.ws;
    volatile LAS unsigned* MISC = (volatile LAS unsigned*)(F.lds + MISC_OFF);
    if (F.tid < 4) MISC[F.tid] = 0u;
    __syncthreads();
    const int lo = args.ph_lo, hi = args.ph_hi;
    XcdBarrier bar; bar.bar = (unsigned*)(F.ws + WS_CTL) + CW_BAR; bar.x = 0; bar.st = MISC;
    if (hi - lo > 1) bar = xcd_barrier_post((unsigned*)(F.ws + WS_CTL) + CW_BAR, MISC);
#define IN(k) (lo <= (k) && (k) < hi)
#ifdef PROBE_SEL
#ifndef PROBE_WG
#define PROBE_WG 0
#endif
    unsigned long long pr_acc = 0ull, pr_t0 = 0ull; const bool pr_on = (int)blockIdx.x == PROBE_WG && F.wave == 0;
#define PSTART(g) do { if ((g) == PROBE_SEL && pr_on) pr_t0 = __builtin_amdgcn_s_memrealtime(); } while (0)
#define PEND(g) do { if ((g) == PROBE_SEL && pr_on) pr_acc += __builtin_amdgcn_s_memrealtime() - pr_t0; } while (0)
#else
#define PSTART(g) do { } while (0)
#define PEND(g) do { } while (0)
#endif
#define SEAM(k) do { if ((k) + 1 < hi) { PSTART(11); for (int rb_ = 0; rb_ < REP_BAR; ++rb_) xcd_barrier(bar); PEND(11); } } while (0)
#define SEAMG(k, g) do { if ((k) + 1 < hi) { PSTART(11); PSTART(20 + (g)); for (int rb_ = 0; rb_ < REP_BAR; ++rb_) xcd_barrier(bar); PEND(11); PEND(20 + (g)); } } while (0)
#define PB() do { F.lane = opaque_v(F.lane); F.tid = opaque_v(F.tid); F.gw = opaque_s(F.gw); F.wave = opaque_s(F.wave); F.vcu = opaque_s(F.vcu); } while (0)

#if EN_P0A
    if (IN(0)) { PB(); PSTART(0); _Pragma("unroll 1") for (int rep_ = 0; rep_ < REP_THIN; ++rep_) { phase_p0a(F); __syncthreads(); } PEND(0); SEAMG(0, 0); }
#endif
#if EN_P0B
    if (IN(1)) { PB(); PSTART(0); _Pragma("unroll 1") for (int rep_ = 0; rep_ < REP_THIN; ++rep_) { phase_p0b(F); __syncthreads(); } PEND(0); SEAMG(1, 0); }
#endif
#if EN_P0C
    if (IN(2)) { PB(); PSTART(0); _Pragma("unroll 1") for (int rep_ = 0; rep_ < REP_THIN; ++rep_) { phase_p0c(F); __syncthreads(); } PEND(0); SEAMG(2, 0); }
#endif

#pragma unroll 1
    for (int li = 0; li < NL; ++li) {
        const int pb = 3 + li * 11, j = li >> 1; const bool mla = (li & 1) != 0, lastl = li == NL - 1;
#if EN_PROJ
        if (IN(pb + 0)) { PB(); PSTART(1);
            const int N = mla ? 1280 : 1536;
            pg8::Gemm g{(const bf16_t*)(F.ws + WS_H), (const bf16_t*)(mla ? F.ws + WS_WD + (size_t)j * 1280 * 1024 : F.ws + WS_WQKV + (size_t)j * 1536 * 1024), D / 2, D / 2, D / 2, 0x7a7a7a7a  , (const int*)(F.ws + WS_GVAL)  };
            pg8::StaticOrder S; S.init(T, N, F.G, (int)blockIdx.x); S.rep = REP_DENSE;
            pg8::EpiStore E{(bf16_t*)(F.ws + WS_R), N, 0xffff};
            pg8::gemm_phase<pg8::EpiStore, pg8::StaticOrder, false, true, true>(F.lds, g, S, E, nullptr);
            PEND(1); SEAMG(pb + 0, 1);
        }
#endif
#if EN_THIN1
        if (IN(pb + 1)) { PB(); PSTART(2); _Pragma("unroll 1") for (int rp_ = 0; rp_ < REP_QK; ++rp_) { bf16_t* dry_ = rp_ + 1 < REP_QK ? (bf16_t*)(F.ws + WS_R + 396 * MiB) : nullptr; if (mla) phase_mla_stats(F, dry_); else phase_qknorm(F, j, dry_); __syncthreads(); } PEND(2); SEAMG(pb + 1, 2); }
#endif
#if EN_UQKV
        if (mla && IN(pb + 2)) { PB(); PSTART(3);
#if EN_UQ
            { pg8::Gemm g{(const bf16_t*)(F.ws + WS_CQ8), (const bf16_t*)(F.ws + WS_WUQ + (size_t)j * 1536 * 768), 384, 384, 384, 0x7a7a7a7a  , (const int*)(F.ws + WS_GVAL)  };
              pg8::StaticOrder S; S.init(lastl ? NB * SEQ : T, 1536, F.G, (int)blockIdx.x); S.rep = REP_DENSE; S.skipctx = lastl;
              pg8::EpiStore E{(bf16_t*)(F.ws + WS_R + R_Q), 1536, 0xffff};
              pg8::gemm_phase<pg8::EpiStore, pg8::StaticOrder, false, true, true>(F.lds, g, S, E, nullptr); }
#endif
#if EN_UKV
            { pg8::Gemm g{(const bf16_t*)(F.ws + WS_R + R_CQ) + 768, (const bf16_t*)(F.ws + WS_WUKV) + (size_t)j * 2048 * 256, 1280, 256, 256, 0};
              pg8::StaticOrder S; S.init(T, 2048, F.G, (int)blockIdx.x); S.rep = REP_DENSE;
              pg8::EpiStore E{(bf16_t*)(F.ws + WS_R + R_KV), 2048, 0xffff};
              pg8::gemm_phase<pg8::EpiStore, pg8::StaticOrder>(F.lds, g, S, E, nullptr); }
#endif
            PEND(3); SEAMG(pb + 2, 3);
        }
#endif
#if EN_ATTN
        if (IN(pb + 3)) { PB(); PSTART(4); unsigned long long pa_ = 0ull;
#if EN_ATTN_MLA
            _Pragma("unroll 1") for (int rep_ = 0; rep_ < REP_ATTN_M; ++rep_) { if (mla) phase_attn<192, ATT_SD_MLA>(F, j, lastl, pa_); __syncthreads(); }
#endif
#if EN_ATTN_GQA
            _Pragma("unroll 1") for (int rep_ = 0; rep_ < REP_ATTN_G; ++rep_) { if (!mla) phase_attn<128, ATT_SD_GQA>(F, j, lastl, pa_); __syncthreads(); }
#endif
#if defined(PROBE_SEL) && PROBE_SEL >= 50 && PROBE_SEL <= 59
            if (pr_on) pr_acc += pa_;
#endif
            PEND(4); SEAMG(pb + 3, 4); }
#endif
#if EN_OPROJ
        if (IN(pb + 4)) { PB(); PSTART(5);
            pg8::Gemm g{(const bf16_t*)(F.ws + WS_R + (mla ? R_AOM : R_AOG)), (const bf16_t*)(F.ws + (mla ? WS_WOM : WS_WOG) + (size_t)j * 1024 * 1024), D / 2, D / 2, D / 2, 0x75757575  , (const int*)(F.ws + WS_GVAL)  };
            pg8::StaticOrder S; S.init(lastl ? NB * SEQ : T, D, F.G, (int)blockIdx.x); S.rep = REP_DENSE; S.skipctx = lastl;
            pg8::EpiStore E{(bf16_t*)(F.ws + WS_R + (LN_RECOMP ? R_O2 : (mla ? R_OM : R_OG))), D, 0xffff};
            pg8::gemm_phase<pg8::EpiStore, pg8::StaticOrder, false, true, true>(F.lds, g, S, E, nullptr);
            PEND(5); SEAMG(pb + 4, 5);
        }
#endif
#if EN_LN1
        if (IN(pb + 5)) { PB(); PSTART(6); phase_ln1(F, li, li == 0 ? in_ptr(I_X) : F.out, li == 0 ? in_ptr(I_CTX) : (const float*)(F.ws + WS_XC), (const bf16_t*)(F.ws + WS_R + (LN_RECOMP ? R_O2 : (mla ? R_OM : R_OG))), (float*)(F.ws + WS_R + 396 * MiB), lastl); PEND(6); SEAMG(pb + 5, 6); }
#endif
#if EN_TOPK
        if (IN(pb + 6)) { PB(); PSTART(7); _Pragma("unroll 1") for (int rep_ = 0; rep_ < REP_THIN; ++rep_) { phase_topk_conv(F, li, lastl); __syncthreads(); } PEND(7); SEAMG(pb + 6, 7); }
#endif
#if EN_GATHER
        if (IN(pb + 7)) { PB(); PSTART(12); _Pragma("unroll 1") for (int rep_ = 0; rep_ < REP_THIN; ++rep_) { phase_gather(F); __syncthreads(); } PEND(12); SEAMG(pb + 7, 12); }
#endif
#if EN_GU
        if (IN(pb + 8)) { PB(); PSTART(8);
            pg8::Gemm g{(const bf16_t*)(F.ws + WS_H), (const bf16_t*)(F.ws + WS_WGU), D / 2, D / 2, D / 2, 0x7a7a7a7a  , (const int*)(F.ws + WS_STOK)};
            pg8::MoeOrder S; S.init(8, F.G, (int)blockIdx.x); S.rep = REP_MOE; if (lastl) S.nunits = 512 * 8;
            pg8::EpiSwiGlu E{(unsigned char*)(F.ws + WS_R + R_ACT)};
#if defined(PROBE_SEL) && (PROBE_SEL == 40 || PROBE_SEL == 41)
            { unsigned long long qk_ = 0, qe_ = 0; pg8::gemm_phase_x<pg8::EpiSwiGlu, pg8::MoeOrder, false, true, true, true>(F.lds, g, S, E, nullptr, qk_, qe_); if (pr_on) pr_acc += (PROBE_SEL == 40 ? qk_ : qe_); }
#else
            pg8::gemm_phase<pg8::EpiSwiGlu, pg8::MoeOrder, false, true, true>(F.lds, g, S, E, nullptr);
#endif
            PEND(8); SEAMG(pb + 8, 8);
        }
#endif
#if EN_DN
        if (IN(pb + 9)) { PB(); PSTART(9);
            pg8::Gemm g{(const bf16_t*)(F.ws + WS_R + R_ACT), (const bf16_t*)(F.ws + WS_WDN), FF / 2, FF / 2, FF / 2, 0x79797979  , (const int*)(F.ws + WS_GVAL)  };
            pg8::MoeOrder S; S.init(4, F.G, (int)blockIdx.x); S.rep = REP_MOE; if (lastl) S.nunits = 512 * 4;
            pg8::EpiStore E{(bf16_t*)(F.ws + WS_R + R_XS), D, 3};
#if defined(PROBE_SEL) && (PROBE_SEL == 42 || PROBE_SEL == 43)
            { unsigned long long qk_ = 0, qe_ = 0; pg8::gemm_phase_x<pg8::EpiStore, pg8::MoeOrder, false, true, true, true>(F.lds, g, S, E, nullptr, qk_, qe_); if (pr_on) pr_acc += (PROBE_SEL == 42 ? qk_ : qe_); }
#else
            pg8::gemm_phase<pg8::EpiStore, pg8::MoeOrder, false, true, true>(F.lds, g, S, E, nullptr);
#endif
            PEND(9); SEAMG(pb + 9, 9);
        }
#endif
#if EN_LN2
        if (IN(pb + 10)) { PB(); PSTART(10); _Pragma("unroll 1") for (int rp_ = 0; rp_ < REP_LN2; ++rp_) { phase_ln2(F, li, rp_ + 1 < REP_LN2 ? (float*)(F.ws + WS_R + 288 * MiB) : nullptr, lastl, li == 0 ? in_ptr(I_X) : F.out, li == 0 ? in_ptr(I_CTX) : (const float*)(F.ws + WS_XC), (const bf16_t*)(F.ws + WS_R + R_O2)); __syncthreads(); } PEND(10); SEAMG(pb + 10, 10); }
#endif
    }
#ifdef PROBE_SEL
    if (pr_on) { const unsigned long long tgt = __builtin_amdgcn_s_memrealtime() + pr_acc; while (__builtin_amdgcn_s_memrealtime() < tgt) __builtin_amdgcn_s_sleep(64); }
#endif
#undef IN
#undef SEAM
}

extern "C" void kernel_launch(void* const* d_in, const int* in_sizes, int n_in, void* d_out, int out_size, void* d_ws, size_t ws_size, hipStream_t stream) {
    static int grid = 0;
    if (grid == 0) {
        if (n_in != 25 || out_size != NB * SEQ * D || ws_size < WS_END) { fprintf(stderr, "kernel_launch: shape/workspace mismatch (n_in %d out %d ws %zu need %zu); nothing launched\n", n_in, out_size, ws_size, (size_t)WS_END); grid = -1; return; }
        int dev = 0, cus = 0, per_cu = 0;
        if (hipGetDevice(&dev) != hipSuccess || hipDeviceGetAttribute(&cus, hipDeviceAttributeMultiprocessorCount, dev) != hipSuccess) { grid = -1; return; }
        if (hipFuncSetAttribute((const void*)mk_fwd, hipFuncAttributeMaxDynamicSharedMemorySize, LDS_BYTES) != hipSuccess) { fprintf(stderr, "kernel_launch: hipFuncSetAttribute failed\n"); grid = -1; return; }
        if (hipOccupancyMaxActiveBlocksPerMultiprocessor(&per_cu, (const void*)mk_fwd, NTHR, LDS_BYTES) != hipSuccess || per_cu < 1) { fprintf(stderr, "kernel_launch: occupancy query says %d\n", per_cu); (void)hipGetLastError(); grid = -1; return; }
        grid = cus < 256 ? cus : 256;
    }
    if (grid < 0) return;
    (void)hipMemsetAsync((char*)d_ws + WS_CTL, 0, CTL_ZERO_BYTES, stream);
    Args a{};
    for (int i = 0; i < 25; ++i) a.in[i] = (const float*)d_in[i];
    a.out = (float*)d_out; a.ws = (unsigned char*)d_ws;
#if MK_ONE_LAUNCH
    a.ph_lo = 0; a.ph_hi = NPH;
    hipLaunchKernelGGL(mk_fwd, dim3(grid), dim3(NTHR), LDS_BYTES, stream, a);
#else
    for (int p = 0; p < NPH; ++p) {
        if (p >= 3 && ((p - 3) % 11) == 2 && (((p - 3) / 11) & 1) == 0) continue;
        a.ph_lo = p; a.ph_hi = p + 1;
        hipLaunchKernelGGL(mk_fwd, dim3(grid), dim3(NTHR), LDS_BYTES, stream, a);
    }
#endif
    const hipError_t le = hipPeekAtLastError();
    if (le != hipSuccess) fprintf(stderr, "kernel_launch: launch failed: %s\n", hipGetErrorName(le));
}
```

```cpp
#define MK_ONE_LAUNCH 1
#define ATT_V2 1
#include <hip/hip_runtime.h>
#include <cstdio>
#include <cstdint>

#define LAS __attribute__((address_space(3)))
#define GAS __attribute__((address_space(1)))
typedef unsigned short bf16_t;
typedef short bf16x8 __attribute__((ext_vector_type(8)));
typedef short s16x4 __attribute__((ext_vector_type(4)));
typedef float f32x2 __attribute__((ext_vector_type(2)));
typedef float f32x4 __attribute__((ext_vector_type(4)));
typedef float f32x16 __attribute__((ext_vector_type(16)));
typedef unsigned u32x2 __attribute__((ext_vector_type(2)));
typedef unsigned u32x4 __attribute__((ext_vector_type(4)));

#ifndef REP_LN1
#define REP_LN1 1
#endif
#ifndef MK_ONE_LAUNCH
#define MK_ONE_LAUNCH 1
#endif

constexpr int D = 1024, NB = 32, SEQ = 2048, CTXL = 256, TPS = SEQ + CTXL  , T = NB * TPS  , NL = 4;
constexpr int NE = 16, FF = 1024, CAPL = 256, CAPC = 32;
constexpr int NSLOT_L = NB * NE * CAPL  , NSLOT = NSLOT_L + NB * NE * CAPC  , NPANEL = NSLOT / 256  ;
constexpr float ALPHA = 1.6817928305074292f, LN_EPS = 1e-6f;
constexpr int NWAVES = 8, NTHR = 512;
constexpr int MODSZ = 6 * D;
constexpr int MOD_KC = 16;

constexpr size_t MiB = 1u << 20;
constexpr size_t WS_CTL = 0, CTL_ZERO_BYTES = 64 * 1024;
constexpr size_t WS_MOD = 1 * MiB;
constexpr size_t WS_ROPE = 5 * MiB;
constexpr size_t WS_WQKV = 6 * MiB;
constexpr size_t WS_WOG = 12 * MiB;
constexpr size_t WS_WD = 16 * MiB;
constexpr size_t WS_WUQ = 21 * MiB;
constexpr size_t WS_WUKV = 26 * MiB;
constexpr size_t WS_WOM = 28 * MiB;
constexpr size_t WS_WGU = 32 * MiB;
constexpr size_t WS_WDN = 96 * MiB;
constexpr size_t WS_XC = 128 * MiB;
constexpr size_t WS_H = 160 * MiB;
constexpr size_t WS_CQ8 = WS_H + 72 * MiB;
constexpr size_t WS_AFF = 304 * MiB;
constexpr size_t WS_INV = 309 * MiB;
constexpr size_t WS_GVAL = 314 * MiB;
constexpr size_t WS_STOK = 315 * MiB;
constexpr size_t WS_RS = 316 * MiB;
constexpr size_t WS_KR = 317 * MiB;
constexpr size_t WS_R = 326 * MiB;
constexpr size_t R_QKV = 0, R_AOG = 216 * MiB, R_OG = 0;
constexpr size_t R_CQ = 0, R_Q = 180 * MiB, R_KV = 396 * MiB, R_AOM = 0, R_OM = 180 * MiB;
constexpr size_t R_O2 = 432 * MiB;
constexpr size_t R_XS = 0, R_ACT = 288 * MiB;
constexpr size_t R_MODP = 0;
constexpr size_t WS_END = WS_R + 684 * MiB;
static_assert((size_t)T * 2048 * 2 == 288 * MiB && (size_t)NSLOT * 1024 * 2 == 288 * MiB && (size_t)T * 1536 * 2 == 216 * MiB && (size_t)T * 1280 * 2 == 180 * MiB, "sizes");
constexpr int CW_BAR = 4096;

constexpr int RING_BYTES = 131072;
constexpr int LDS_BYTES = 163840;
constexpr int MISC_OFF = LDS_BYTES - 256;

__device__ __forceinline__ float bf2f(unsigned b) { return __uint_as_float(b << 16); }
__device__ __forceinline__ unsigned cvt_pk_bf16(float lo, float hi) { unsigned r; asm volatile("v_cvt_pk_bf16_f32 %0, %1, %2" : "=v"(r) : "v"(lo), "v"(hi)); return r; }
#define DPP_MOV(v, ctrl) __builtin_bit_cast(float, __builtin_amdgcn_update_dpp(0, __builtin_bit_cast(int, (float)(v)), (ctrl), 0xf, 0xf, true))
__device__ __forceinline__ float lane_xor16(float v) { return __builtin_bit_cast(float, __builtin_amdgcn_ds_swizzle(__builtin_bit_cast(int, v), 0x401F)); }
__device__ __forceinline__ float wave_sum(float v) {
    v += DPP_MOV(v, 0xB1);
    v += DPP_MOV(v, 0x4E);
    v += DPP_MOV(v, 0x141);
    v += DPP_MOV(v, 0x140);
    v += lane_xor16(v);
    { auto rr = __builtin_amdgcn_permlane32_swap(__float_as_uint(v), __float_as_uint(v), false, false); v = __uint_as_float(rr[0]) + __uint_as_float(rr[1]); }
    return v;
}
#define LDS_WAIT() asm volatile("s_waitcnt lgkmcnt(0)" ::: "memory")
#define VM_WAIT() asm volatile("s_waitcnt vmcnt(0)" ::: "memory")
__device__ __forceinline__ int opaque_v(int x) { asm volatile("" : "+v"(x)); return x; }
__device__ __forceinline__ int opaque_s(int x) { asm volatile("" : "+s"(x)); return x; }
__device__ __forceinline__ const float* in_ptr(int i) {
    const __attribute__((address_space(4))) char* kp = (const __attribute__((address_space(4))) char*)__builtin_amdgcn_kernarg_segment_ptr();
    const int off = opaque_s(i * 8);
    return *(const float* const __attribute__((address_space(4)))*)(kp + off);
}
__device__ __forceinline__ unsigned cvt4_fp8(float a, float b, float c, float d) {
    a = __builtin_fminf(__builtin_fmaxf(a, -448.f), 448.f); b = __builtin_fminf(__builtin_fmaxf(b, -448.f), 448.f); c = __builtin_fminf(__builtin_fmaxf(c, -448.f), 448.f); d = __builtin_fminf(__builtin_fmaxf(d, -448.f), 448.f);
    int w = 0; w = __builtin_amdgcn_cvt_pk_fp8_f32(a, b, w, false); w = __builtin_amdgcn_cvt_pk_fp8_f32(c, d, w, true); return (unsigned)w;
}
constexpr float WGU_SCALE = 32.f, WDN_SCALE = 64.f, WP_SCALE = 32.f, WO_SCALE = 64.f, AO_SCALE = 16.f;
#ifndef ATT_SD_MLA
#define ATT_SD_MLA 1
#endif
#define XB_TMO      128
#define XB_XCNT(j)  (256  + 64 * (j))
#define XB_XSUB(j)  (1280 + 64 * (j))
#define XB_XGEN(j)  (2304 + 64 * (j))
#define XB_TOP      3328
#define XB_TOPGEN   3392
#define XCD_BAR_WORDS 3456
#define XB_SPIN_CAP (1u << 18)

__device__ __forceinline__ unsigned xb_ld(unsigned* p)              { return __hip_atomic_load(p, __ATOMIC_RELAXED, __HIP_MEMORY_SCOPE_AGENT); }
__device__ __forceinline__ unsigned xb_add(unsigned* p, unsigned v) { return __hip_atomic_fetch_add(p, v, __ATOMIC_RELAXED, __HIP_MEMORY_SCOPE_AGENT); }
__device__ __forceinline__ unsigned xb_xcc_id() { return (unsigned)__builtin_amdgcn_s_getreg((3 << 11) | 20) & 0xFu; }
#define XB_SPIN(cond, bar) do { unsigned _sp = 0; while (cond) { __builtin_amdgcn_s_sleep(1); \
    if ((++_sp & 255u) == 0u) { if (xb_ld(&(bar)[XB_TMO])) break; if (_sp > XB_SPIN_CAP) { atomicAdd(&(bar)[XB_TMO], 1u); break; } } } } while (0)

struct XcdBarrier {
    unsigned* bar; unsigned x;
    volatile LAS unsigned* st;
};

__device__ __forceinline__ XcdBarrier xcd_barrier_post(unsigned* bar, volatile LAS unsigned* st) {
    XcdBarrier b; b.bar = bar; b.x = xb_xcc_id(); b.st = st;
    if (threadIdx.x == 0) (void)xb_add(&bar[XB_XCNT(b.x)], 1u);
    return b;
}
__device__ __forceinline__ void xcd_barrier_complete(unsigned* bar, unsigned x, unsigned& nloc, unsigned& nx) {
    const unsigned G = gridDim.x * gridDim.y * gridDim.z;
    unsigned sum, cnt, mine, sp = 0u;
    for (;;) {
        sum = 0u; cnt = 0u; mine = 0u;
#pragma unroll
        for (unsigned j = 0; j < 16; ++j) { const unsigned c = xb_ld(&bar[XB_XCNT(j)]); sum += c; cnt += (c > 0u) ? 1u : 0u; mine = (j == x) ? c : mine; }
        if (sum == G) break;
        __builtin_amdgcn_s_sleep(1);
        if ((++sp & 255u) == 0u) { if (xb_ld(&bar[XB_TMO])) break; if (sp > XB_SPIN_CAP) { atomicAdd(&bar[XB_TMO], 1u); break; } }
    }
    nloc = mine > 0u ? mine : 1u; nx = cnt > 0u ? cnt : 1u;
}

__device__ __forceinline__ void xcd_barrier(const XcdBarrier& b) {
    asm volatile("s_waitcnt vmcnt(0)" ::: "memory");
    __syncthreads();
    if (threadIdx.x == 0) {
        unsigned* bar = b.bar;
        __builtin_amdgcn_s_waitcnt(0);
        unsigned nloc = b.st[0], nx = b.st[1];
        if (nloc == 0u) { xcd_barrier_complete(bar, b.x, nloc, nx); b.st[0] = nloc; b.st[1] = nx; }
        const unsigned old = xb_add(&bar[XB_XSUB(b.x)], 1u);
        const unsigned gen = old / nloc;
        if (old + 1u == (gen + 1u) * nloc) {
            __builtin_amdgcn_fence(__ATOMIC_RELEASE, "agent");
            asm volatile("s_waitcnt vmcnt(0)" ::: "memory");
            const unsigned og = xb_add(&bar[XB_TOP], 1u);
            const unsigned tg = og / nx;
            if (og + 1u == (tg + 1u) * nx) xb_add(&bar[XB_TOPGEN], 1u);
            else XB_SPIN(xb_ld(&bar[XB_TOPGEN]) == tg, bar);
            __builtin_amdgcn_fence(__ATOMIC_ACQUIRE, "agent");
            xb_add(&bar[XB_XGEN(b.x)], 1u);
            asm volatile("s_waitcnt vmcnt(0)" ::: "memory");
        } else {
            XB_SPIN(xb_ld(&bar[XB_XGEN(b.x)]) == gen, bar);
            __builtin_amdgcn_fence(__ATOMIC_ACQUIRE, "agent");
            asm volatile("s_waitcnt vmcnt(0)" ::: "memory");
        }
    }
    __syncthreads();
}

namespace pg8 {
#define PG8_LAS __attribute__((address_space(3)))
constexpr int BM = 256, BK = 64, HALF = 128, HTB = HALF * BK * 2  , STAGE_BYTES = 8 * HTB, NXCD = 8, WGM = 8;

__host__ __device__ __forceinline__ int lds_byte(int r, int c) { const int st = (r >> 4) * 2 + (c >> 5), rr = r & 15, cc = c & 31, ob = rr * 64 + cc * 2; return st * 1024 + (ob ^ (((ob >> 9) & 1) << 5)); }
__host__ __device__ __forceinline__ void stage_rc(int b, int& R, int& C) { const int st = b / 1024, sb = b % 1024, swz = sb ^ (((sb >> 9) & 1) << 5); R = (st >> 1) * 16 + swz / 64; C = (st & 1) * 32 + (swz % 64) / 2; }
__host__ __device__ __forceinline__ int perm32(int rho) { const int n = rho >> 4, i = rho & 15; return 8 * (i >> 2) + 4 * n + (i & 3); }

struct Unit { int pm, pn; };
struct Gemm { const bf16_t* A; const bf16_t* Bt; int lda, ldb, K; int pad; const int* ridx = nullptr; };

struct StaticOrder {
    int nM, nN, nwg, G, c, rep; bool skipctx;
    __host__ __device__ void init(int M, int N, int G_, int c_) { nM = M / BM; nN = N / BM; nwg = nM * nN; G = G_; c = c_; rep = 1; skipctx = false; }
    __host__ __device__ bool next(int i, Unit& u) const {
        const long L = (long)(i / rep) * G + c; if (L >= nwg) return false;
        int wgid = (int)L; { const int q = nwg / NXCD, r = nwg % NXCD, xcd = wgid % NXCD, off = wgid / NXCD; wgid = (xcd < r ? xcd * (q + 1) : r * (q + 1) + (xcd - r) * q) + off; }
        const int nig = WGM * nN, gid = wgid / nig, fm = gid * WGM, gsz = (nM - fm) < WGM ? (nM - fm) : WGM;
        u.pm = fm + ((wgid % nig) % gsz); u.pn = (wgid % nig) / gsz; if (skipctx) u.pm = (u.pm >> 3) * 9 + 1 + (u.pm & 7); return true;
    }
    __device__ __forceinline__ void a_ready(const Unit&) const {}
    __device__ __forceinline__ void done(const Unit&) const {}
};
typedef int pg8_v8i __attribute__((ext_vector_type(8)));
#ifdef PROBE_CLK
#define PG8_PROBE_NOW() (__builtin_amdgcn_s_memtime() / 20ull)
#else
#define PG8_PROBE_NOW() __builtin_amdgcn_s_memrealtime()
#endif
#ifndef PG8_DMAMMA
#define PG8_DMAMMA 0
#endif
#ifndef PG8_BUF
#define PG8_BUF 0
#endif
__device__ __forceinline__ __amdgpu_buffer_rsrc_t pg8_rsrc(const void* p) {
    const unsigned long long v = (unsigned long long)(size_t)p; const unsigned lo = __builtin_amdgcn_readfirstlane((unsigned)v), hi = __builtin_amdgcn_readfirstlane((unsigned)(v >> 32));
    return __builtin_amdgcn_make_buffer_rsrc((void*)(size_t)(((unsigned long long)hi << 32) | lo), 0, -1, 0x00020000);
}
template <class Epi, class Sched, bool STAMP, bool GATHER, bool FP8, bool PRB>
__device__ __forceinline__ void gemm_phase_x(PG8_LAS unsigned char* lds, const Gemm g, const Sched& S, const Epi& E, unsigned long long* stamps, unsigned long long& pk, unsigned long long& pe);
template <class Epi, class Sched, bool STAMP = false, bool GATHER = false, bool FP8 = false>
__device__ __forceinline__ void gemm_phase(PG8_LAS unsigned char* lds, const Gemm g, const Sched& S, const Epi& E, unsigned long long* stamps) { unsigned long long a_ = 0, b_ = 0; gemm_phase_x<Epi, Sched, STAMP, GATHER, FP8, false>(lds, g, S, E, stamps, a_, b_); }
template <class Epi, class Sched, bool STAMP, bool GATHER, bool FP8, bool PRB>
__device__ __forceinline__ void gemm_phase_x(PG8_LAS unsigned char* lds, const Gemm g, const Sched& S, const Epi& E, unsigned long long* stamps, unsigned long long& pk, unsigned long long& pe) {
    unsigned long long pt_ = 0;
    const int tid = opaque_v((int)threadIdx.x), wid = __builtin_amdgcn_readfirstlane(tid >> 6), lane = tid & 63, wr = wid >> 2, wc = wid & 3, fr = lane & 15, fq = lane >> 4;
    const int K = g.K, nt = K / BK;
    const int wscale = g.pad;
    int ts_lo = 0, ts_hi = 0, nts = 0; const unsigned long long rt_entry = STAMP ? (unsigned long long)wall_clock64() : 0ull;
#define PG8_STAMP() do { if (STAMP && wid == 0 && nts < 64) { const unsigned long long _c = (unsigned long long)clock64(); \
        ts_lo = (lane == nts) ? (int)(unsigned)_c : ts_lo; ts_hi = (lane == nts) ? (int)(unsigned)(_c >> 32) : ts_hi; ++nts; } } while (0)
    PG8_STAMP();
    unsigned voffA[2], voffB[2];
#pragma unroll
    for (int i = 0; i < 2; ++i) { int R, C; stage_rc(tid * 16 + i * 8192, R, C); const int Rb = Epi::PERM ? ((R & ~31) + perm32(R & 31)) : R;
        voffA[i] = GATHER ? (unsigned)C * 2u : (unsigned)(R * g.lda + C) * 2u; voffB[i] = (unsigned)(Rb * g.ldb + C) * 2u; }
    unsigned vs[2][2];
#define PG8_LDRAW(pm_) do { if (wid < 4) __builtin_amdgcn_global_load_lds((const unsigned*)(g.ridx + ((pm_) * BM + wid * 64 + lane)), (PG8_LAS unsigned*)(lds + STAGE_BYTES + wid * 256), 4, 0, 0); } while (0)
#define PG8_CONV(vo) do { _Pragma("unroll") for (int _h = 0; _h < 2; ++_h) _Pragma("unroll") for (int _i = 0; _i < 2; ++_i) { int _R, _C; stage_rc(tid * 16 + _i * 8192, _R, _C); \
        int _v = *(const PG8_LAS int*)(lds + STAGE_BYTES + (_h * HALF + _R) * 4); _v = _v < 0 ? 0 : _v; (vo)[_h][_i] = (unsigned)_v * (unsigned)(g.lda * 2) + voffA[_i]; } } while (0)
    const size_t kstep = (size_t)(BK * 2);
    const size_t hstepA = (size_t)HALF * g.lda * 2, hstepB = (size_t)HALF * g.ldb * 2;
    const size_t tstepA = GATHER ? 0 : 2 * hstepA, tstepB = 2 * hstepB;
    const unsigned ldsw = (unsigned)wid * 1024u;
    const int aoff = lds_byte(wr * 64 + fr, fq * 8), boff = lds_byte(wc * 32 + fr, fq * 8);
#define PG8_SA(b, h) (((b) * 2 + (h)) * HTB)
#define PG8_SB(b, h) ((4 + (b) * 2 + (h)) * HTB)
#if PG8_BUF
    const __amdgpu_buffer_rsrc_t rsA = pg8_rsrc(g.A), rsB = pg8_rsrc(g.Bt);
#define PG8_STAGE_R(rs, base0, bufoff, gbase, voff) do { const int _so = __builtin_amdgcn_readfirstlane((int)(unsigned)((const char*)(gbase) - (const char*)(base0))); _Pragma("unroll") for (int _i = 0; _i < 2; ++_i) \
        __builtin_amdgcn_raw_ptr_buffer_load_lds(rs, (PG8_LAS void*)(lds + (bufoff) + ldsw + _i * 8192), 16, (int)(voff)[_i], _so, 0, 0); } while (0)
#define PG8_STAGE(bufoff, gbase, voff) PG8_STAGE_R(rsB, g.Bt, bufoff, gbase, voff)
#define PG8_STAGEA(bufoff, base, half, vsel) do { if constexpr (GATHER) PG8_STAGE_R(rsA, g.A, bufoff, base, vsel[half]); else PG8_STAGE_R(rsA, g.A, bufoff, (base) + (half) * hstepA, voffA); } while (0)
#else
#define PG8_STAGE(bufoff, gbase, voff) do { _Pragma("unroll") for (int _i = 0; _i < 2; ++_i) \
        __builtin_amdgcn_global_load_lds((const unsigned*)((const char*)(gbase) + (voff)[_i]), (PG8_LAS unsigned*)(lds + (bufoff) + ldsw + _i * 8192), 16, 0, 0); } while (0)
#define PG8_STAGEA(bufoff, base, half, vsel) do { if constexpr (GATHER) PG8_STAGE(bufoff, base, vsel[half]); else PG8_STAGE(bufoff, (base) + (half) * hstepA, voffA); } while (0)
#endif
#define PG8_LDA(dst, b, h) do { if constexpr (FP8) { _Pragma("unroll") for (int m = 0; m < 4; ++m) { const u32x4 lo_ = *(const PG8_LAS u32x4*)(lds + PG8_SA(b, h) + aoff + m * 2048), hi_ = *(const PG8_LAS u32x4*)(lds + PG8_SA(b, h) + aoff + m * 2048 + 1024); \
        dst##8[m] = __builtin_bit_cast(pg8_v8i, __builtin_shufflevector(lo_, hi_, 0, 1, 2, 3, 4, 5, 6, 7)); } } \
    else { _Pragma("unroll") for (int m = 0; m < 4; ++m) _Pragma("unroll") for (int k = 0; k < 2; ++k) dst[m][k] = *(const PG8_LAS bf16x8*)(lds + PG8_SA(b, h) + aoff + m * 2048 + k * 1024); } } while (0)
#define PG8_LDB(dst, b, h) do { if constexpr (FP8) { _Pragma("unroll") for (int n = 0; n < 2; ++n) { const u32x4 lo_ = *(const PG8_LAS u32x4*)(lds + PG8_SB(b, h) + boff + n * 2048), hi_ = *(const PG8_LAS u32x4*)(lds + PG8_SB(b, h) + boff + n * 2048 + 1024); \
        dst##8[n] = __builtin_bit_cast(pg8_v8i, __builtin_shufflevector(lo_, hi_, 0, 1, 2, 3, 4, 5, 6, 7)); } } \
    else { _Pragma("unroll") for (int n = 0; n < 2; ++n) _Pragma("unroll") for (int k = 0; k < 2; ++k) dst[n][k] = *(const PG8_LAS bf16x8*)(lds + PG8_SB(b, h) + boff + n * 2048 + k * 1024); } } while (0)
#define PG8_MMA(ai, bj, At, Bt) do { __builtin_amdgcn_s_setprio(1); _Pragma("unroll") for (int m = 0; m < 4; ++m) _Pragma("unroll") for (int n = 0; n < 2; ++n) _Pragma("unroll") for (int k = 0; k < 2; ++k) \
        acc[ai][bj][m][n] = __builtin_amdgcn_mfma_f32_16x16x32_bf16(Bt[n][k], At[m][k], acc[ai][bj][m][n], 0, 0, 0); __builtin_amdgcn_s_setprio(0); } while (0)
#define PG8_MMA8(ai, bj, At, Bt) do { __builtin_amdgcn_s_setprio(1); _Pragma("unroll") for (int m = 0; m < 4; ++m) _Pragma("unroll") for (int n = 0; n < 2; ++n) \
        acc[ai][bj][m][n] = __builtin_amdgcn_mfma_scale_f32_16x16x128_f8f6f4(Bt##8[n], At##8[m], acc[ai][bj][m][n], 0, 0, 0, wscale, 0, 0x7f7f7f7f); \
        __builtin_amdgcn_s_setprio(0); } while (0)
#define PG8_MMX(ai, bj, At, Bt) do { if constexpr (FP8) PG8_MMA8(ai, bj, At, Bt); else PG8_MMA(ai, bj, At, Bt); } while (0)
#define PG8_PIECE(bufoff, gbase, voff, i) __builtin_amdgcn_global_load_lds((const unsigned*)((const char*)(gbase) + (voff)[i]), (PG8_LAS unsigned*)(lds + (bufoff) + ldsw + (i) * 8192), 16, 0, 0)
#define PG8_PIECEB(bufoff, gbase, i) PG8_PIECE(bufoff, gbase, voffB, i)
#define PG8_PIECEA(bufoff, base, half, i) do { if constexpr (GATHER) PG8_PIECE(bufoff, base, vs[half], i); else PG8_PIECE(bufoff, (base) + (half) * hstepA, voffA, i); } while (0)
#define PG8_MF8(ai, bj, At, Bt, m, n) acc[ai][bj][m][n] = __builtin_amdgcn_mfma_scale_f32_16x16x128_f8f6f4(Bt##8[n], At##8[m], acc[ai][bj][m][n], 0, 0, 0, wscale, 0, 0x7f7f7f7f)
#define PG8_MF16(ai, bj, At, Bt, m, n) do { acc[ai][bj][m][n] = __builtin_amdgcn_mfma_f32_16x16x32_bf16(Bt[n][0], At[m][0], acc[ai][bj][m][n], 0, 0, 0); acc[ai][bj][m][n] = __builtin_amdgcn_mfma_f32_16x16x32_bf16(Bt[n][1], At[m][1], acc[ai][bj][m][n], 0, 0, 0); } while (0)
#define PG8_MF(ai, bj, At, Bt, m, n) do { if constexpr (FP8) PG8_MF8(ai, bj, At, Bt, m, n); else PG8_MF16(ai, bj, At, Bt, m, n); } while (0)
#define PG8_MMXS(ai, bj, At, Bt, S0, S1) do { __builtin_amdgcn_s_setprio(1); PG8_MF(ai, bj, At, Bt, 0, 0); PG8_MF(ai, bj, At, Bt, 0, 1); PG8_SCHED; S0; PG8_SCHED; \
        PG8_MF(ai, bj, At, Bt, 1, 0); PG8_MF(ai, bj, At, Bt, 1, 1); PG8_MF(ai, bj, At, Bt, 2, 0); PG8_SCHED; S1; PG8_SCHED; PG8_MF(ai, bj, At, Bt, 2, 1); PG8_MF(ai, bj, At, Bt, 3, 0); PG8_MF(ai, bj, At, Bt, 3, 1); \
        __builtin_amdgcn_s_setprio(0); } while (0)
#define PG8_WAIT_V(n) asm volatile("s_waitcnt vmcnt(" #n ")" ::: "memory")
#define PG8_WAIT_L(n) asm volatile("s_waitcnt lgkmcnt(" #n ")" ::: "memory")
#define PG8_BAR __builtin_amdgcn_s_barrier()
#define PG8_SCHED __builtin_amdgcn_sched_barrier(0)
    Unit cur, nxt; int ui = 0;
    if (!S.next(0, cur)) return;
    f32x4 acc[2][2][4][2];
#pragma unroll
    for (int a = 0; a < 2; ++a)
#pragma unroll
        for (int b = 0; b < 2; ++b)
#pragma unroll
            for (int m = 0; m < 4; ++m)
#pragma unroll
                for (int n = 0; n < 2; ++n) acc[a][b][m][n] = (f32x4){0.f, 0.f, 0.f, 0.f};
    bf16x8 At[4][2], B0[2][2], B1[2][2]; pg8_v8i At8[4], B08[2], B18[2];
    const char* cA = (const char*)g.A + (size_t)cur.pm * tstepA; const char* cB = (const char*)g.Bt + (size_t)cur.pn * tstepB;
    S.a_ready(cur);
    if constexpr (GATHER) { PG8_LDRAW(cur.pm); asm volatile("s_waitcnt vmcnt(0)" ::: "memory"); __builtin_amdgcn_s_barrier(); asm volatile("" ::: "memory"); PG8_CONV(vs); asm volatile("s_waitcnt lgkmcnt(0)" ::: "memory"); __builtin_amdgcn_s_barrier(); }
    PG8_STAGE(PG8_SB(0, 0), cB, voffB); PG8_STAGEA(PG8_SA(0, 0), cA, 0, vs); PG8_STAGE(PG8_SB(0, 1), cB + hstepB, voffB); PG8_STAGEA(PG8_SA(0, 1), cA, 1, vs);
    if (wr == 1) PG8_BAR;
    PG8_WAIT_V(4); PG8_BAR;
    PG8_STAGE(PG8_SB(1, 0), cB + kstep, voffB); PG8_STAGEA(PG8_SA(1, 0), cA + kstep, 0, vs); PG8_STAGE(PG8_SB(1, 1), cB + hstepB + kstep, voffB);
    PG8_WAIT_V(6); PG8_BAR;
    PG8_STAMP();
    for (;;) {
        if constexpr (PRB) { if (wid == 0) pt_ = PG8_PROBE_NOW(); }
        const bool has_next = S.next(ui + 1, nxt);
        if constexpr (GATHER) { if (has_next) PG8_LDRAW(nxt.pm); }
        const char* nA = has_next ? (const char*)g.A + (size_t)nxt.pm * tstepA : cA; const char* nB = has_next ? (const char*)g.Bt + (size_t)nxt.pn * tstepB : cB;
#pragma unroll 1
        for (int t = 0; t < nt; t += 2) {
            const bool last = (t == nt - 2);
            const char* a1 = cA + (size_t)(t + 1) * kstep;
            const char* a2 = last ? nA : cA + (size_t)(t + 2) * kstep; const char* b2 = last ? nB : cB + (size_t)(t + 2) * kstep;
            const char* a3 = a2 + kstep; const char* b3 = b2 + kstep;
            if (last && has_next) S.a_ready(nxt);
#if PG8_DMAMMA
            PG8_LDB(B0, 0, 0); PG8_SCHED; PG8_LDA(At, 0, 0);
            PG8_WAIT_L(8); PG8_BAR; PG8_WAIT_L(0); PG8_MMXS(0, 0, At, B0, PG8_PIECEA(PG8_SA(1, 1), a1, 1, 0), PG8_PIECEA(PG8_SA(1, 1), a1, 1, 1)); PG8_BAR; PG8_SCHED;
            PG8_LDB(B1, 0, 1);
            if constexpr (GATHER) { if (last && has_next) { PG8_CONV(vs); asm volatile("" : "+v"(vs[0][0]), "+v"(vs[0][1]), "+v"(vs[1][0]), "+v"(vs[1][1])); } }
            PG8_BAR; PG8_WAIT_L(0); PG8_MMXS(0, 1, At, B1, PG8_PIECEB(PG8_SB(0, 0), b2, 0), PG8_PIECEB(PG8_SB(0, 0), b2, 1)); PG8_BAR;
            PG8_LDA(At, 0, 1);
            PG8_BAR; PG8_WAIT_L(0); PG8_MMXS(1, 0, At, B0, PG8_PIECEA(PG8_SA(0, 0), a2, 0, 0), PG8_PIECEA(PG8_SA(0, 0), a2, 0, 1)); PG8_BAR; PG8_SCHED;
            PG8_WAIT_V(4); PG8_BAR; PG8_MMXS(1, 1, At, B1, PG8_PIECEB(PG8_SB(0, 1), b2 + hstepB, 0), PG8_PIECEB(PG8_SB(0, 1), b2 + hstepB, 1)); PG8_BAR;
            PG8_LDB(B0, 1, 0); PG8_SCHED; PG8_LDA(At, 1, 0);
            PG8_WAIT_L(8); PG8_BAR; PG8_WAIT_L(0); PG8_MMXS(0, 0, At, B0, PG8_PIECEA(PG8_SA(0, 1), a2, 1, 0), PG8_PIECEA(PG8_SA(0, 1), a2, 1, 1)); PG8_BAR; PG8_SCHED;
            PG8_LDB(B1, 1, 1);
            PG8_BAR; PG8_WAIT_L(0); PG8_MMXS(0, 1, At, B1, PG8_PIECEB(PG8_SB(1, 0), b3, 0), PG8_PIECEB(PG8_SB(1, 0), b3, 1)); PG8_BAR;
            PG8_LDA(At, 1, 1);
            PG8_BAR; PG8_WAIT_L(0); PG8_MMXS(1, 0, At, B0, PG8_PIECEA(PG8_SA(1, 0), a3, 0, 0), PG8_PIECEA(PG8_SA(1, 0), a3, 0, 1)); PG8_BAR; PG8_SCHED;
            PG8_WAIT_V(4); PG8_BAR; PG8_MMXS(1, 1, At, B1, PG8_PIECEB(PG8_SB(1, 1), b3 + hstepB, 0), PG8_PIECEB(PG8_SB(1, 1), b3 + hstepB, 1)); PG8_BAR;
#else
            PG8_LDB(B0, 0, 0); PG8_SCHED; PG8_LDA(At, 0, 0); PG8_STAGEA(PG8_SA(1, 1), a1, 1, vs);
            if constexpr (GATHER) { if (last && has_next) { PG8_CONV(vs); asm volatile("" : "+v"(vs[0][0]), "+v"(vs[0][1]), "+v"(vs[1][0]), "+v"(vs[1][1])); } }
            PG8_WAIT_L(8); PG8_BAR; PG8_WAIT_L(0); PG8_MMX(0, 0, At, B0); PG8_BAR; PG8_SCHED;
            PG8_LDB(B1, 0, 1); PG8_STAGE(PG8_SB(0, 0), b2, voffB);
            PG8_BAR; PG8_WAIT_L(0); PG8_MMX(0, 1, At, B1); PG8_BAR;
            PG8_LDA(At, 0, 1); PG8_STAGEA(PG8_SA(0, 0), a2, 0, vs);
            PG8_BAR; PG8_WAIT_L(0); PG8_MMX(1, 0, At, B0); PG8_BAR; PG8_SCHED;
            PG8_STAGE(PG8_SB(0, 1), b2 + hstepB, voffB);
            PG8_WAIT_V(6); PG8_BAR; PG8_MMX(1, 1, At, B1); PG8_BAR;
            PG8_LDB(B0, 1, 0); PG8_SCHED; PG8_LDA(At, 1, 0); PG8_STAGEA(PG8_SA(0, 1), a2, 1, vs);
            PG8_WAIT_L(8); PG8_BAR; PG8_WAIT_L(0); PG8_MMX(0, 0, At, B0); PG8_BAR; PG8_SCHED;
            PG8_LDB(B1, 1, 1); PG8_STAGE(PG8_SB(1, 0), b3, voffB);
            PG8_BAR; PG8_WAIT_L(0); PG8_MMX(0, 1, At, B1); PG8_BAR;
            PG8_LDA(At, 1, 1); PG8_STAGEA(PG8_SA(1, 0), a3, 0, vs);
            PG8_BAR; PG8_WAIT_L(0); PG8_MMX(1, 0, At, B0); PG8_BAR; PG8_SCHED;
            PG8_STAGE(PG8_SB(1, 1), b3 + hstepB, voffB);
            PG8_WAIT_V(6); PG8_BAR; PG8_MMX(1, 1, At, B1); PG8_BAR;
#endif
        }
        PG8_STAMP();
        if constexpr (PRB) { if (wid == 0) { const unsigned long long n_ = PG8_PROBE_NOW(); pk += n_ - pt_; pt_ = n_; } }
        if constexpr (!Epi::AFTER_DRAIN) { E(acc, cur, wr, wc, fr, fq); S.done(cur); }
        if constexpr (PRB) { if (wid == 0) { const unsigned long long n_ = PG8_PROBE_NOW(); pe += n_ - pt_; } }
        PG8_STAMP();
        if (!has_next) break;
#pragma unroll
        for (int a = 0; a < 2; ++a)
#pragma unroll
            for (int b = 0; b < 2; ++b)
#pragma unroll
                for (int m = 0; m < 4; ++m)
#pragma unroll
                    for (int n = 0; n < 2; ++n) acc[a][b][m][n] = (f32x4){0.f, 0.f, 0.f, 0.f};
        cur = nxt; cA = nA; cB = nB; ++ui;
    }
    PG8_WAIT_V(0);
    if (wr == 0) PG8_BAR;
    PG8_BAR;
    if constexpr (Epi::AFTER_DRAIN) { E.fused(acc, cur, wr, wc, fr, fq, lds, wid, lane); S.done(cur); }
    PG8_STAMP();
    if (STAMP && wid == 0) { stamps[lane] = lane < nts ? (((unsigned long long)(unsigned)ts_hi << 32) | (unsigned)ts_lo) : 0ull;
        if (lane == 62) stamps[62] = rt_entry; if (lane == 63) stamps[63] = (unsigned long long)wall_clock64(); }
#undef PG8_STAMP
#undef PG8_SA
#undef PG8_SB
#undef PG8_STAGE
#undef PG8_STAGEA
#undef PG8_LDRAW
#undef PG8_CONV
#undef PG8_LDA
#undef PG8_LDB
#undef PG8_MMA
#undef PG8_MMA8
#undef PG8_MMX
#undef PG8_WAIT_V
#undef PG8_WAIT_L
#undef PG8_BAR
#undef PG8_SCHED
}
}
namespace pg8 {
struct MoeOrder {
    int NT, G, c, nunits, rep;
    __device__ void init(int NT_, int G_, int c_) { NT = NT_; G = G_; c = c_; nunits = NPANEL * NT_; rep = 1; }
    __device__ bool next(int i, Unit& u) const {
        const long L0 = (long)(i / rep) * G + c; if (L0 >= nunits) return false;
        int pr, pnl;
        if (G == 256) { const int x = c & 7, jj = c >> 3, PX = 32 / NT; pr = (i / rep) * (256 / NT) + x * PX + jj / NT; pnl = jj % NT; }
        else { pr = (int)L0 / NT; pnl = (int)L0 % NT; }
        int pm, e;
        if (pr < 512) { e = pr >> 5; pm = (pr & 31) * 16 + e; } else { pm = pr; e = (pr - 512) >> 2; }
        u.pm = pm; u.pn = e * NT + pnl; return true;
    }
    __device__ __forceinline__ void a_ready(const Unit&) const {}
    __device__ __forceinline__ void done(const Unit&) const {}
};

__device__ __forceinline__ u32x4 pack8(const f32x4 a, const f32x4 b) { u32x4 w; w.x = cvt_pk_bf16(a[0], a[1]); w.y = cvt_pk_bf16(a[2], a[3]); w.z = cvt_pk_bf16(b[0], b[1]); w.w = cvt_pk_bf16(b[2], b[3]); return w; }

struct EpiStore {
    static constexpr bool PERM = true, AFTER_DRAIN = false;
    bf16_t* O; int ldc; int pnmask;
    __device__ __forceinline__ void operator()(const f32x4 (&acc)[2][2][4][2], const Unit& u, int wr, int wc, int fr, int fq) const {
        const int row0 = u.pm * BM + wr * 64 + fr, col0 = (u.pn & pnmask) * BM + wc * 32 + 8 * fq;
#pragma unroll
        for (int ai = 0; ai < 2; ++ai)
#pragma unroll
            for (int m = 0; m < 4; ++m) { const int row = row0 + ai * HALF + m * 16; bf16_t* rowp = O + (size_t)row * ldc + col0;
#pragma unroll
                for (int bj = 0; bj < 2; ++bj) *(u32x4*)(rowp + bj * HALF) = pack8(acc[ai][bj][m][0], acc[ai][bj][m][1]);
                __builtin_amdgcn_sched_barrier(0); }
    }
};
struct EpiUq {
    static constexpr bool PERM = true, AFTER_DRAIN = false;
    bf16_t* O; const float* rcos; const float* rsin;
    __device__ __forceinline__ void operator()(const f32x4 (&acc)[2][2][4][2], const Unit& u, int wr, int wc, int fr, int fq) const {
        const int row0 = u.pm * BM + wr * 64 + fr, col0 = u.pn * BM + wc * 32 + 8 * fq;
        const int bsmp = u.pm / 9, ptile = u.pm - bsmp * 9; const bool latent = ptile != 0;
        int j0[2]; bool inr[2];
#pragma unroll
        for (int bj = 0; bj < 2; ++bj) { const int c = col0 + bj * HALF, hd = c / 192, off = c - hd * 192; inr[bj] = latent && off >= 128; j0[bj] = (off - 128) >> 1; }
#pragma unroll
        for (int ai = 0; ai < 2; ++ai)
#pragma unroll
            for (int m = 0; m < 4; ++m) { const int row = row0 + ai * HALF + m * 16; bf16_t* rowp = O + (size_t)row * 1536 + col0;
                const int t = row - bsmp * TPS - CTXL, trow = (t >> 6) & 31, tcol = t & 63;
#pragma unroll
                for (int bj = 0; bj < 2; ++bj) { f32x4 a = acc[ai][bj][m][0], b = acc[ai][bj][m][1];
                    if (inr[bj]) { const int pos = j0[bj] < 16 ? trow : tcol, ti = pos * 16 + (j0[bj] & 15);
                        const f32x4 cs = *(const f32x4*)(rcos + ti), sn = *(const f32x4*)(rsin + ti);
                        const f32x4 a2 = {a[0] * cs[0] - a[1] * sn[0], a[0] * sn[0] + a[1] * cs[0], a[2] * cs[1] - a[3] * sn[1], a[2] * sn[1] + a[3] * cs[1]};
                        const f32x4 b2 = {b[0] * cs[2] - b[1] * sn[2], b[0] * sn[2] + b[1] * cs[2], b[2] * cs[3] - b[3] * sn[3], b[2] * sn[3] + b[3] * cs[3]};
                        a = a2; b = b2; }
                    *(u32x4*)(rowp + bj * HALF) = pack8(a, b); } }
    }
};
struct EpiSwiGlu {
    static constexpr bool PERM = true, AFTER_DRAIN = false;
    unsigned char* O;
    __device__ __forceinline__ void operator()(const f32x4 (&acc)[2][2][4][2], const Unit& u, int wr, int wc, int fr, int fq) const {
        const int row0 = u.pm * BM + wr * 64 + fr, col0 = (u.pn & 7) * HALF + wc * 32 + 8 * fq;
#pragma unroll
        for (int ai = 0; ai < 2; ++ai)
#pragma unroll
            for (int m = 0; m < 4; ++m) { unsigned char* rowp = O + (size_t)(row0 + ai * HALF + m * 16) * FF + col0; f32x4 r[2];
#pragma unroll
                for (int n = 0; n < 2; ++n) { const f32x4 g = acc[ai][0][m][n], up = acc[ai][1][m][n];
#pragma unroll
                    for (int j = 0; j < 4; ++j) r[n][j] = g[j] * __builtin_amdgcn_rcpf(1.0f + __builtin_amdgcn_exp2f(-1.4426950408889634f * g[j])) * up[j]; }
                u32x2 w; w.x = cvt4_fp8(r[0][0], r[0][1], r[0][2], r[0][3]); w.y = cvt4_fp8(r[1][0], r[1][1], r[1][2], r[1][3]);
                *(u32x2*)rowp = w; __builtin_amdgcn_sched_barrier(0); }
    }
};
struct EpiDown {
    static constexpr bool PERM = true, AFTER_DRAIN = false;
    bf16_t* O; const float* gv;
    __device__ __forceinline__ void operator()(const f32x4 (&acc)[2][2][4][2], const Unit& u, int wr, int wc, int fr, int fq) const {
        const int row0 = u.pm * BM + wr * 64 + fr, col0 = (u.pn & 3) * BM + wc * 32 + 8 * fq;
#pragma unroll
        for (int ai = 0; ai < 2; ++ai)
#pragma unroll
            for (int m = 0; m < 4; ++m) { const int row = row0 + ai * HALF + m * 16; const float s = gv[row]; bf16_t* rowp = O + (size_t)row * D + col0;
#pragma unroll
                for (int bj = 0; bj < 2; ++bj) *(u32x4*)(rowp + bj * HALF) = pack8(acc[ai][bj][m][0] * s, acc[ai][bj][m][1] * s); }
    }
};
}
namespace att {
constexpr int NW = 8, QBLK = 32, KVBLK = 64, DV = 128;
constexpr float THR = 8.f;
#ifndef ATT_QKPIPE_GQA
#define ATT_QKPIPE_GQA 0
#endif
#ifndef ATT_QKPIPE_MLA
#define ATT_QKPIPE_MLA 0
#endif
#ifndef MLA_QREG
#define MLA_QREG 4
#endif
#define SBAR() __builtin_amdgcn_sched_barrier(0)
__device__ __forceinline__ int crow(int r, int hi) { return (r & 3) + 8 * (r >> 2) + 4 * hi; }
__device__ __forceinline__ unsigned cvtpk(float lo, float hi) { unsigned r; asm volatile("v_cvt_pk_bf16_f32 %0, %1, %2" : "=v"(r) : "v"(lo), "v"(hi)); return r; }

template <int DQK> struct Cfg {
    static constexpr float SCALE = DQK == 128 ? 0.088388347648318440f : 0.072168783648703220f;
    static constexpr float C = SCALE * 1.4426950408889634f;
    static constexpr int ROWB = DQK * 2;
    static constexpr int SHM_K = KVBLK * DQK * 2, SHM_V = KVBLK * DV * 2;
    static constexpr int QREG = DQK == 128 ? 8 : MLA_QREG;
    static constexpr int SHM_ATTN = 2 * SHM_V + 2 * SHM_K + NW * 64 * 4 + NW * (DQK / 16 - QREG) * 1024;
};
#define KSWZ(row, colB) ((row) * ROWB + ((colB) ^ ((((colB) < 256) ? ((row) & 15) : ((row) & 7)) << 4)))

template <int DQK>
__device__ __forceinline__ void partialSM(f32x16& p0, f32x16& p1, float& m_reg, float& mn, float& alpha) {
  constexpr float C = Cfg<DQK>::C, SCALE = Cfg<DQK>::SCALE;
  float pmax = p0[0];
#pragma unroll
  for (int r = 1; r < 16; ++r) pmax = fmaxf(pmax, p0[r]);
#pragma unroll
  for (int r = 0; r < 16; ++r) pmax = fmaxf(pmax, p1[r]);
  { auto rr = __builtin_amdgcn_permlane32_swap(__float_as_uint(pmax), __float_as_uint(pmax), false, false);
    pmax = fmaxf(__uint_as_float(rr[0]), __uint_as_float(rr[1])); }
  if (__builtin_expect(__all(pmax - m_reg <= THR / SCALE), 1)) { mn = m_reg; alpha = 1.f; }
  else { mn = fmaxf(m_reg, pmax); alpha = __builtin_amdgcn_exp2f((m_reg - mn) * C); m_reg = mn; }
  float mnC = -mn * C;
#pragma unroll
  for (int r = 0; r < 16; ++r) p0[r] = fmaf(p0[r], C, mnC);
#pragma unroll
  for (int r = 0; r < 16; ++r) p1[r] = fmaf(p1[r], C, mnC);
#pragma unroll
  for (int r = 0; r < 16; ++r) p0[r] = __builtin_amdgcn_exp2f(p0[r]);
}
__device__ __forceinline__ void finishSM(f32x16& p0, f32x16& p1, float alpha, float& l_reg, bf16x8& pa0, bf16x8& pa1, bf16x8& pa2, bf16x8& pa3) {
#pragma unroll
  for (int r = 0; r < 16; ++r) p1[r] = __builtin_amdgcn_exp2f(p1[r]);
  float ps = 0;
#pragma unroll
  for (int r = 0; r < 16; ++r) ps += p0[r];
#pragma unroll
  for (int r = 0; r < 16; ++r) ps += p1[r];
  { auto rr = __builtin_amdgcn_permlane32_swap(__float_as_uint(ps), __float_as_uint(ps), false, false);
    ps = __uint_as_float(rr[0]) + __uint_as_float(rr[1]); }
  l_reg = l_reg * alpha + ps;
#define PK4(P, BASE, OUT) do { unsigned a0 = cvtpk(P[BASE + 0], P[BASE + 1]), a1 = cvtpk(P[BASE + 2], P[BASE + 3]);   \
    unsigned b0 = cvtpk(P[BASE + 4], P[BASE + 5]), b1 = cvtpk(P[BASE + 6], P[BASE + 7]);                              \
    auto r0 = __builtin_amdgcn_permlane32_swap(a0, b0, false, false); auto r1 = __builtin_amdgcn_permlane32_swap(a1, b1, false, false); \
    u32x4 w = {r0[0], r1[0], r0[1], r1[1]}; OUT = *reinterpret_cast<bf16x8*>(&w); } while (0)
  PK4(p0, 0, pa0); PK4(p0, 8, pa1); PK4(p1, 0, pa2); PK4(p1, 8, pa3);
#undef PK4
}
template <int DQK, int QREG>
__device__ __forceinline__ void qkt_plain(f32x16& p0, f32x16& p1, const char* Ks, const bf16x8* qr, const char* qx, int r32, int hi) {
  constexpr int ROWB = Cfg<DQK>::ROWB;
  p0 = f32x16{}; p1 = f32x16{};
#pragma unroll
  for (int d0 = 0; d0 < DQK / 16; ++d0) { int cb = (d0 * 16 + hi * 8) * 2;
    bf16x8 b0 = *reinterpret_cast<const bf16x8*>(Ks + KSWZ(r32, cb));
    bf16x8 b1 = *reinterpret_cast<const bf16x8*>(Ks + KSWZ(32 + r32, cb));
    bf16x8 q; if (d0 < QREG) q = qr[d0]; else q = *reinterpret_cast<const bf16x8*>(qx + (d0 - QREG) * 1024);
    p0 = __builtin_amdgcn_mfma_f32_32x32x16_bf16(b0, q, p0, 0, 0, 0);
    p1 = __builtin_amdgcn_mfma_f32_32x32x16_bf16(b1, q, p1, 0, 0, 0); }
}
template <int DQK, int QREG, int D0>
__device__ __forceinline__ void qk_issue(bf16x8 (&kl)[3], bf16x8 (&kh)[3], bf16x8 (&qf)[3], int kb, int s4, int s3, int hi16, int qxa) {
  constexpr int ROWB = Cfg<DQK>::ROWB;
  const int ad = kb + ((D0 * 32 + hi16) ^ (D0 < 8 ? s4 : s3));
  asm volatile("ds_read_b128 %0, %1" : "=v"(kl[D0 % 3]) : "v"(ad) : "memory");
  asm volatile("ds_read_b128 %0, %1 offset:%2" : "=v"(kh[D0 % 3]) : "v"(ad), "n"(32 * ROWB) : "memory");
  if constexpr (D0 >= QREG) asm volatile("ds_read_b128 %0, %1 offset:%2" : "=v"(qf[D0 % 3]) : "v"(qxa), "n"((D0 - QREG) * 1024) : "memory");
}
template <int DQK, int QREG, int D0>
__device__ __forceinline__ void qk_steps(f32x16& p0, f32x16& p1, bf16x8 (&kl)[3], bf16x8 (&kh)[3], bf16x8 (&qf)[3], const bf16x8* qr, int kb, int s4, int s3, int hi16, int qxa) {
  constexpr int ND = DQK / 16;
  if constexpr (D0 < ND) {
    constexpr int R1 = D0 + 1 < ND ? 2 + (D0 + 1 >= QREG ? 1 : 0) : 0, R2 = D0 + 2 < ND ? 2 + (D0 + 2 >= QREG ? 1 : 0) : 0;
    if constexpr (D0 >= QREG) asm volatile("s_waitcnt lgkmcnt(%3)" : "+v"(kl[D0 % 3]), "+v"(kh[D0 % 3]), "+v"(qf[D0 % 3]) : "n"(R1 + R2));
    else asm volatile("s_waitcnt lgkmcnt(%2)" : "+v"(kl[D0 % 3]), "+v"(kh[D0 % 3]) : "n"(R1 + R2));
    bf16x8 q; if constexpr (D0 < QREG) q = qr[D0]; else q = qf[D0 % 3];
    if constexpr (D0 == 0) { p0 = __builtin_amdgcn_mfma_f32_32x32x16_bf16(kl[0], q, f32x16{}, 0, 0, 0); p1 = __builtin_amdgcn_mfma_f32_32x32x16_bf16(kh[0], q, f32x16{}, 0, 0, 0); }
    else { p0 = __builtin_amdgcn_mfma_f32_32x32x16_bf16(kl[D0 % 3], q, p0, 0, 0, 0); p1 = __builtin_amdgcn_mfma_f32_32x32x16_bf16(kh[D0 % 3], q, p1, 0, 0, 0); }
    if constexpr (D0 + 3 < ND) qk_issue<DQK, QREG, D0 + 3>(kl, kh, qf, kb, s4, s3, hi16, qxa);
    qk_steps<DQK, QREG, D0 + 1>(p0, p1, kl, kh, qf, qr, kb, s4, s3, hi16, qxa);
  }
}
template <int DQK, int QREG>
__device__ __forceinline__ void qkt(f32x16& p0, f32x16& p1, const char* Ks, const bf16x8* qr, const char* qx, int r32, int hi) {
  constexpr int ROWB = Cfg<DQK>::ROWB;
  if constexpr ((DQK == 128 && !ATT_QKPIPE_GQA) || (DQK == 192 && !ATT_QKPIPE_MLA)) { qkt_plain<DQK, QREG>(p0, p1, Ks, qr, qx, r32, hi); return; }
  const int kb = (int)(unsigned)(uintptr_t)Ks + r32 * ROWB, s4 = (r32 & 15) << 4, s3 = (r32 & 7) << 4, hi16 = hi * 16, qxa = (int)(unsigned)(uintptr_t)qx;
  bf16x8 kl[3], kh[3], qf[3];
  qk_issue<DQK, QREG, 0>(kl, kh, qf, kb, s4, s3, hi16, qxa); qk_issue<DQK, QREG, 1>(kl, kh, qf, kb, s4, s3, hi16, qxa); qk_issue<DQK, QREG, 2>(kl, kh, qf, kb, s4, s3, hi16, qxa);
  qk_steps<DQK, QREG, 0>(p0, p1, kl, kh, qf, qr, kb, s4, s3, hi16, qxa);
}
__device__ __forceinline__ int v_st(int k, int c) { const int kk = (k & ~0xC) | ((k & 4) << 1) | ((k & 8) >> 1); return ((kk >> 3) * 4 + (c >> 5)) * 512 + ((kk & 7) * 32 + (c & 31)) * 2; }
__device__ __forceinline__ int v_rd_base(int lane) { return ((lane & 3) << 3) | (((lane >> 2) & 3) << 6) | (((lane >> 4) & 1) << 5) | (((lane >> 5) & 1) << 8); }
constexpr int v_rd_off(int d0, int ks, int half) { return d0 * 512 + ks * 4096 + half * 2048; }
template <int OFF> __device__ __forceinline__ s16x4 tr_read(int vb) {
  s16x4 r; asm volatile("ds_read_b64_tr_b16 %0, %1 offset:%2" : "=&v"(r) : "v"(vb), "i"(OFF) : "memory"); return r;
}
template <int D0> __device__ __forceinline__ void pv_one(f32x16& od, int vb, bf16x8 pa0, bf16x8 pa1, bf16x8 pa2, bf16x8 pa3) {
  const s16x4 l0 = tr_read<v_rd_off(D0, 0, 0)>(vb), h0 = tr_read<v_rd_off(D0, 0, 1)>(vb), l1 = tr_read<v_rd_off(D0, 1, 0)>(vb), h1 = tr_read<v_rd_off(D0, 1, 1)>(vb);
  const s16x4 l2 = tr_read<v_rd_off(D0, 2, 0)>(vb), h2 = tr_read<v_rd_off(D0, 2, 1)>(vb), l3 = tr_read<v_rd_off(D0, 3, 0)>(vb), h3 = tr_read<v_rd_off(D0, 3, 1)>(vb);
  asm volatile("s_waitcnt lgkmcnt(0)" ::: "memory"); SBAR();
#define PK(L, H) (bf16x8){L[0], L[1], L[2], L[3], H[0], H[1], H[2], H[3]}
  od = __builtin_amdgcn_mfma_f32_32x32x16_bf16(pa0, PK(l0, h0), od, 0, 0, 0);
  od = __builtin_amdgcn_mfma_f32_32x32x16_bf16(pa1, PK(l1, h1), od, 0, 0, 0);
  od = __builtin_amdgcn_mfma_f32_32x32x16_bf16(pa2, PK(l2, h2), od, 0, 0, 0);
  od = __builtin_amdgcn_mfma_f32_32x32x16_bf16(pa3, PK(l3, h3), od, 0, 0, 0);
#undef PK
}
__device__ __forceinline__ void pv_d0(f32x16* o, int vb, bf16x8 pa0, bf16x8 pa1, bf16x8 pa2, bf16x8 pa3) {
  pv_one<0>(o[0], vb, pa0, pa1, pa2, pa3); pv_one<1>(o[1], vb, pa0, pa1, pa2, pa3); pv_one<2>(o[2], vb, pa0, pa1, pa2, pa3); pv_one<3>(o[3], vb, pa0, pa1, pa2, pa3);
}

template <int DQK, int SDEPTH, int ldq, int ldk, int ldkr, int ldv, int ldo>
__device__ __forceinline__ void attn_body(const bf16_t* __restrict__ Qb, const bf16_t* __restrict__ Kh, const bf16_t* __restrict__ Kr,
                                          const bf16_t* __restrict__ Vh, unsigned char* __restrict__ Ob, int seq, char* lds, int qt0, const float* __restrict__ rt, const float* __restrict__ qg) {
  constexpr int ROWB = Cfg<DQK>::ROWB, SHM_K = Cfg<DQK>::SHM_K, SHM_V = Cfg<DQK>::SHM_V;
  constexpr bool X = DQK == 192; constexpr int QREG = Cfg<DQK>::QREG, QLDS = DQK / 16 - QREG;
  const int tid = opaque_v((int)threadIdx.x), wid = tid >> 6, lane = tid & 63, r32 = lane & 31, hi = lane >> 5;
  char* V_lds = lds; char* K_lds = lds + 2 * SHM_V;
  float* ws = (float*)(lds + 2 * SHM_V + 2 * SHM_K) + wid * 64; float* li_l = ws; float* al_l = ws + 32;
  float m_reg = -1e30f, l_reg = 0; f32x16 o[4] = {}; bf16x8 qr[QREG];
  const bf16_t* Qw = Qb + (long)(wid * QBLK + r32) * ldq + hi * 8;
  char* qx = lds + 2 * SHM_V + 2 * SHM_K + NW * 64 * 4 + wid * (QLDS * 1024) + lane * 16;
#pragma unroll
  for (int d0 = 0; d0 < QREG; ++d0) qr[d0] = *reinterpret_cast<const bf16x8*>(Qw + d0 * 16);
  if constexpr (X) {
#pragma unroll
    for (int d0 = QREG; d0 < 8; ++d0) *reinterpret_cast<bf16x8*>(qx + (d0 - QREG) * 1024) = *reinterpret_cast<const bf16x8*>(Qw + d0 * 16);
  }
  if constexpr (!X) {
    float ss = 0.f;
#pragma unroll
    for (int d0 = 0; d0 < 8; ++d0) { const u32x4 w = *reinterpret_cast<const u32x4*>(&qr[d0]);
#pragma unroll
      for (int q = 0; q < 4; ++q) { const float x0 = __uint_as_float(w[q] << 16), x1 = __uint_as_float(w[q] & 0xffff0000u); ss += x0 * x0 + x1 * x1; } }
    ss += __shfl_xor(ss, 32);
    const float rstd = 1.0f / sqrtf(ss * (1.0f / 128.0f) + 1e-6f);
    const int t = qt0 >= 0 ? qt0 + wid * QBLK + r32 : 0;
#pragma unroll
    for (int d0 = 0; d0 < 8; ++d0) { u32x4 w = *reinterpret_cast<const u32x4*>(&qr[d0]);
      const f32x4 g0 = *reinterpret_cast<const f32x4*>(qg + d0 * 16 + hi * 8), g1 = *reinterpret_cast<const f32x4*>(qg + d0 * 16 + hi * 8 + 4);
      const int pos = d0 < 4 ? (t >> 6) : (t & 63), ti = pos * 32 + (d0 & 3) * 8 + hi * 4; const f32x4 cs = *reinterpret_cast<const f32x4*>(rt + ti), sn = *reinterpret_cast<const f32x4*>(rt + 2048 + ti);
      const float gg[8] = {g0[0], g0[1], g0[2], g0[3], g1[0], g1[1], g1[2], g1[3]};
#pragma unroll
      for (int q = 0; q < 4; ++q) { const float x0 = __uint_as_float(w[q] << 16) * rstd * gg[2 * q], x1 = __uint_as_float(w[q] & 0xffff0000u) * rstd * gg[2 * q + 1]; w[q] = cvtpk(x0 * cs[q] - x1 * sn[q], x0 * sn[q] + x1 * cs[q]); }
      qr[d0] = *reinterpret_cast<const bf16x8*>(&w); }
  }
  if constexpr (X) {
#pragma unroll
    for (int d0 = 8; d0 < 12; ++d0) {
      u32x4 w = *reinterpret_cast<const u32x4*>(Qw + d0 * 16);
      { const int t = qt0 >= 0 ? qt0 + wid * QBLK + r32 : 0, j0 = (d0 - 8) * 8 + hi * 4, pos = d0 < 10 ? (t >> 6) : (t & 63), ti = pos * 16 + (j0 & 15);
        const f32x4 cs = *reinterpret_cast<const f32x4*>(rt + ti), sn = *reinterpret_cast<const f32x4*>(rt + 1024 + ti);
#pragma unroll
        for (int q = 0; q < 4; ++q) { const float x0 = __uint_as_float(w[q] << 16), x1 = __uint_as_float(w[q] & 0xffff0000u); w[q] = cvtpk(x0 * cs[q] - x1 * sn[q], x0 * sn[q] + x1 * cs[q]); } }
      *reinterpret_cast<u32x4*>(qx + (d0 - QREG) * 1024) = w; }
  }
  const int sr = tid >> 4, sc = (tid & 15) * 8, vst0 = v_st(sr, sc), vst1 = v_st(32 + sr, sc);
  const int xr = tid >> 3, xc = (tid & 7) * 8;
  const int vb0 = (int)(uintptr_t)V_lds + v_rd_base(lane);
  struct { bf16x8 vs0, vs1, ks0, ks1, kx; } sr_[SDEPTH];
#define LD8(p) (*reinterpret_cast<const bf16x8*>(p))
#define SLOAD(i, k0) do { sr_[i].vs0 = LD8(&Vh[(long)((k0) + sr) * ldv + sc]); sr_[i].vs1 = LD8(&Vh[(long)((k0) + 32 + sr) * ldv + sc]); \
    sr_[i].ks0 = LD8(&Kh[(long)((k0) + sr) * ldk + sc]); sr_[i].ks1 = LD8(&Kh[(long)((k0) + 32 + sr) * ldk + sc]); \
    if constexpr (X) sr_[i].kx = LD8(&Kr[(long)((k0) + xr) * ldkr + xc]); } while (0)
#define SWRITE(b, i) do { *(bf16x8*)(V_lds + (b) * SHM_V + vst0) = sr_[i].vs0;          \
    *(bf16x8*)(V_lds + (b) * SHM_V + vst1) = sr_[i].vs1; int kc = sc * 2;               \
    *(bf16x8*)(K_lds + (b) * SHM_K + KSWZ(sr, kc)) = sr_[i].ks0;                       \
    *(bf16x8*)(K_lds + (b) * SHM_K + KSWZ(32 + sr, kc)) = sr_[i].ks1;                  \
    if constexpr (X) { int kx_ = 256 + xc * 2; *(bf16x8*)(K_lds + (b) * SHM_K + KSWZ(xr, kx_)) = sr_[i].kx; } } while (0)
#define SWAIT() do { if constexpr (SDEPTH == 2) { if constexpr (X) asm volatile("s_waitcnt vmcnt(5)" ::: "memory"); else asm volatile("s_waitcnt vmcnt(4)" ::: "memory"); } else asm volatile("s_waitcnt vmcnt(0)" ::: "memory"); } while (0)
#define RESC(a) do { if (__any((a) < 1.f)) { if (hi == 0) al_l[r32] = (a); asm volatile("s_waitcnt lgkmcnt(0)" ::: "memory"); \
    _Pragma("unroll") for (int d = 0; d < 4; ++d) _Pragma("unroll") for (int r = 0; r < 16; ++r) o[d][r] *= al_l[crow(r, hi)]; } } while (0)
  f32x16 pA0, pA1, pB0, pB1; float mnA, mnB, alA, alB; bf16x8 pa0, pa1, pa2, pa3; const int NT = seq / KVBLK;
  constexpr int SE = 0, SO = SDEPTH - 1;
  SLOAD(SE, 0); asm volatile("s_waitcnt vmcnt(0)" ::: "memory"); SWRITE(0, SE); __syncthreads();
  qkt<DQK, QREG>(pA0, pA1, K_lds, qr, qx, r32, hi); partialSM<DQK>(pA0, pA1, m_reg, mnA, alA);
  SLOAD(SO, KVBLK); if constexpr (SDEPTH == 2) { if (2 < NT) SLOAD(SE, 2 * KVBLK); }
  SWAIT(); SWRITE(1, SO); __syncthreads();
  for (int j = 1; j + 1 < NT; j += 2) {
    SBAR(); qkt<DQK, QREG>(pB0, pB1, K_lds + SHM_K, qr, qx, r32, hi);
    finishSM(pA0, pA1, alA, l_reg, pa0, pa1, pa2, pa3); SBAR();
    SLOAD(SO, (j + SDEPTH) * KVBLK); SBAR();
    pv_d0(o, vb0, pa0, pa1, pa2, pa3); partialSM<DQK>(pB0, pB1, m_reg, mnB, alB);
    __syncthreads(); SWAIT(); SWRITE(0, SE);
    RESC(alB); __syncthreads();
    SBAR(); qkt<DQK, QREG>(pA0, pA1, K_lds, qr, qx, r32, hi);
    finishSM(pB0, pB1, alB, l_reg, pa0, pa1, pa2, pa3); SBAR();
    if (SDEPTH == 1 || j + 3 < NT) SLOAD(SE, (j + 1 + SDEPTH) * KVBLK); SBAR();
    pv_d0(o, vb0 + (int)SHM_V, pa0, pa1, pa2, pa3); partialSM<DQK>(pA0, pA1, m_reg, mnA, alA);
    __syncthreads(); SWAIT(); SWRITE(1, SO);
    RESC(alA); __syncthreads();
  }
  SBAR(); qkt<DQK, QREG>(pB0, pB1, K_lds + SHM_K, qr, qx, r32, hi);
  finishSM(pA0, pA1, alA, l_reg, pa0, pa1, pa2, pa3); SBAR();
  pv_d0(o, vb0, pa0, pa1, pa2, pa3); partialSM<DQK>(pB0, pB1, m_reg, mnB, alB);
  __syncthreads(); RESC(alB);
  finishSM(pB0, pB1, alB, l_reg, pa0, pa1, pa2, pa3); SBAR();
  pv_d0(o, vb0 + (int)SHM_V, pa0, pa1, pa2, pa3);
  if (hi == 0) li_l[r32] = l_reg; asm volatile("s_waitcnt lgkmcnt(0)" ::: "memory");
  float rli[16];
#pragma unroll
  for (int r = 0; r < 16; ++r) rli[r] = __builtin_amdgcn_rcpf(li_l[crow(r, hi)]);
  unsigned char* Ow = Ob + (long)(wid * QBLK) * ldo;
#pragma unroll
  for (int r = 0; r < 16; ++r) { int orow = crow(r, hi);
#pragma unroll
    for (int d0 = 0; d0 < 4; ++d0) { const float ov = __builtin_fminf(__builtin_fmaxf(o[d0][r] * rli[r] * AO_SCALE, -448.f), 448.f); Ow[(long)orow * ldo + d0 * 32 + r32] = (unsigned char)(__builtin_amdgcn_cvt_pk_fp8_f32(ov, 0.f, 0, false) & 0xff); } }
#undef LD8
#undef SLOAD
#undef SWRITE
#undef SWAIT
#undef RESC
}
#undef KSWZ
}
#ifndef A2_RS_GQA
#define A2_RS_GQA 0
#endif
#ifndef A2_SPREAD
#define A2_SPREAD 0
#endif
#ifndef A2_SHADOW_GQA
#define A2_SHADOW_GQA 0
#endif
#ifndef A2_SHADOW_MLA
#define A2_SHADOW_MLA 0
#endif
#ifndef A2_PKSM
#define A2_PKSM 0
#endif
#ifndef A2_BUF
#define A2_BUF 1
#endif
#ifndef A2_RS_MLA
#define A2_RS_MLA 0
#endif
namespace att2 {
#if defined(PROBE_SEL) && PROBE_SEL >= 50 && PROBE_SEL <= 59
#define A2_T(n) do { if (wid == 0) { const unsigned long long t_ = __builtin_amdgcn_s_memrealtime(); if ((n) == PROBE_SEL - 49) pacc += t_ - a2_t; a2_t = t_; } } while (0)
#define A2_TDECL unsigned long long a2_t = 0ull;
#if PROBE_SEL == 54
#define A2_TQ() do { __builtin_amdgcn_sched_barrier(0); if (wid == 0) { pacc += __builtin_amdgcn_s_memrealtime() - a2_t; } } while (0)
#else
#define A2_TQ() do { } while (0)
#endif
#if PROBE_SEL >= 56
#define A2_TX(n) A2_T(n)
#define A2_T3() A2_T(9)
#else
#define A2_TX(n) do { } while (0)
#define A2_T3() A2_T(3)
#endif
#else
#define A2_TX(n) do { } while (0)
#define A2_T3() do { } while (0)
#define A2_TQ() do { } while (0)
#define A2_T(n) do { } while (0)
#define A2_TDECL
#endif
using att::Cfg; using att::crow; using att::cvtpk; using att::v_rd_base; using att::pv_d0;
typedef LAS char LASc; typedef LAS bf16x8 LASv;
constexpr int NW = 8, QBLK = 32, KVBLK = 64;
constexpr float THR = 8.f;
#define KSWZ2(row, colB) ((row) * ROWB + ((colB) ^ (((row) & 7) << 4)))
#define A2_BAR() do { asm volatile("" ::: "memory"); __builtin_amdgcn_sched_barrier(0); __builtin_amdgcn_s_barrier(); __builtin_amdgcn_sched_barrier(0); asm volatile("" ::: "memory"); } while (0)

template <int DQK>
__device__ __forceinline__ void qk_tile(f32x16& p0, f32x16& p1, const LASc* Ks, const bf16x8* qr, int r32, int hi) {
  constexpr int ROWB = Cfg<DQK>::ROWB;
  const int kb = (int)(unsigned)(size_t)Ks + r32 * ROWB, s3 = (r32 & 7) << 4, hi16 = hi * 16;
  bf16x8 kl[3], kh[3], qf[3];
  att::qk_issue<DQK, DQK / 16, 0>(kl, kh, qf, kb, s3, s3, hi16, 0); att::qk_issue<DQK, DQK / 16, 1>(kl, kh, qf, kb, s3, s3, hi16, 0); att::qk_issue<DQK, DQK / 16, 2>(kl, kh, qf, kb, s3, s3, hi16, 0);
  att::qk_steps<DQK, DQK / 16, 0>(p0, p1, kl, kh, qf, qr, kb, s3, s3, hi16, 0);
}
template <int DQK, class HOOK>
__device__ __forceinline__ void softmax_tile(f32x16& p0, f32x16& p1, float& m_reg, float& l_reg, float& alpha, bf16x8& pa0, bf16x8& pa1, bf16x8& pa2, bf16x8& pa3, HOOK&& hook) {
  constexpr float C = Cfg<DQK>::C, SCALE = Cfg<DQK>::SCALE;
  float pmax = p0[0];
#pragma unroll
  for (int r = 1; r < 16; ++r) pmax = fmaxf(pmax, p0[r]);
#pragma unroll
  for (int r = 0; r < 16; ++r) pmax = fmaxf(pmax, p1[r]);
  { auto rr = __builtin_amdgcn_permlane32_swap(__float_as_uint(pmax), __float_as_uint(pmax), false, false);
    pmax = fmaxf(__uint_as_float(rr[0]), __uint_as_float(rr[1])); }
  float mn;
  if (__builtin_expect(__all(pmax - m_reg <= THR / SCALE), 1)) { mn = m_reg; alpha = 1.f; }
  else { mn = fmaxf(m_reg, pmax); alpha = __builtin_amdgcn_exp2f((m_reg - mn) * C); m_reg = mn; }
  const float mnC = -mn * C;
#if A2_PKSM
  const f32x2 Cv = {C, C}, Mv = {mnC, mnC}; f32x2 ps2 = {0.f, 0.f};
#pragma unroll
  for (int r = 0; r < 16; r += 2) { f32x2 t = {p0[r], p0[r + 1]}; t = __builtin_elementwise_fma(t, Cv, Mv); p0[r] = __builtin_amdgcn_exp2f(t[0]); p0[r + 1] = __builtin_amdgcn_exp2f(t[1]); }
#pragma unroll
  for (int r = 0; r < 16; r += 2) { f32x2 t = {p1[r], p1[r + 1]}; t = __builtin_elementwise_fma(t, Cv, Mv); p1[r] = __builtin_amdgcn_exp2f(t[0]); p1[r + 1] = __builtin_amdgcn_exp2f(t[1]); }
#pragma unroll
  for (int r = 0; r < 16; r += 2) { const f32x2 t = {p0[r], p0[r + 1]}; ps2 += t; }
#pragma unroll
  for (int r = 0; r < 16; r += 2) { const f32x2 t = {p1[r], p1[r + 1]}; ps2 += t; }
  float ps = ps2[0] + ps2[1];
#else
  hook(0);
#pragma unroll
  for (int r = 0; r < 8; ++r) p0[r] = __builtin_amdgcn_exp2f(fmaf(p0[r], C, mnC));
  hook(1);
#pragma unroll
  for (int r = 8; r < 16; ++r) p0[r] = __builtin_amdgcn_exp2f(fmaf(p0[r], C, mnC));
  hook(2);
#pragma unroll
  for (int r = 0; r < 8; ++r) p1[r] = __builtin_amdgcn_exp2f(fmaf(p1[r], C, mnC));
  hook(3);
#pragma unroll
  for (int r = 8; r < 16; ++r) p1[r] = __builtin_amdgcn_exp2f(fmaf(p1[r], C, mnC));
  hook(4);
  float ps = 0;
#pragma unroll
  for (int r = 0; r < 16; ++r) ps += p0[r];
#pragma unroll
  for (int r = 0; r < 16; ++r) ps += p1[r];
#endif
  { auto rr = __builtin_amdgcn_permlane32_swap(__float_as_uint(ps), __float_as_uint(ps), false, false);
    ps = __uint_as_float(rr[0]) + __uint_as_float(rr[1]); }
  l_reg = l_reg * alpha + ps;
#define PK4(P, BASE, OUT) do { unsigned a0 = cvtpk(P[BASE + 0], P[BASE + 1]), a1 = cvtpk(P[BASE + 2], P[BASE + 3]);   \
    unsigned b0 = cvtpk(P[BASE + 4], P[BASE + 5]), b1 = cvtpk(P[BASE + 6], P[BASE + 7]);                              \
    auto r0 = __builtin_amdgcn_permlane32_swap(a0, b0, false, false); auto r1 = __builtin_amdgcn_permlane32_swap(a1, b1, false, false); \
    u32x4 w = {r0[0], r1[0], r0[1], r1[1]}; OUT = *reinterpret_cast<bf16x8*>(&w); } while (0)
  PK4(p0, 0, pa0); PK4(p0, 8, pa1); PK4(p1, 0, pa2); PK4(p1, 8, pa3);
#undef PK4
}

struct VFrag { s16x4 l0, h0, l1, h1, l2, h2, l3, h3; };
template <int D0> __device__ __forceinline__ void pv_reads(VFrag& f, int vb) {
  using att::tr_read; using att::v_rd_off;
  f.l0 = tr_read<v_rd_off(D0, 0, 0)>(vb); f.h0 = tr_read<v_rd_off(D0, 0, 1)>(vb); f.l1 = tr_read<v_rd_off(D0, 1, 0)>(vb); f.h1 = tr_read<v_rd_off(D0, 1, 1)>(vb);
  f.l2 = tr_read<v_rd_off(D0, 2, 0)>(vb); f.h2 = tr_read<v_rd_off(D0, 2, 1)>(vb); f.l3 = tr_read<v_rd_off(D0, 3, 0)>(vb); f.h3 = tr_read<v_rd_off(D0, 3, 1)>(vb);
}
__device__ __forceinline__ void pv_mma(f32x16& od, const VFrag& f, bf16x8 pa0, bf16x8 pa1, bf16x8 pa2, bf16x8 pa3) {
#define PK(L, H) (bf16x8){L[0], L[1], L[2], L[3], H[0], H[1], H[2], H[3]}
  od = __builtin_amdgcn_mfma_f32_32x32x16_bf16(pa0, PK(f.l0, f.h0), od, 0, 0, 0);
  od = __builtin_amdgcn_mfma_f32_32x32x16_bf16(pa1, PK(f.l1, f.h1), od, 0, 0, 0);
  od = __builtin_amdgcn_mfma_f32_32x32x16_bf16(pa2, PK(f.l2, f.h2), od, 0, 0, 0);
  od = __builtin_amdgcn_mfma_f32_32x32x16_bf16(pa3, PK(f.l3, f.h3), od, 0, 0, 0);
#undef PK
}
__device__ __forceinline__ void pv_pipe(f32x16* o, int vb, bf16x8 pa0, bf16x8 pa1, bf16x8 pa2, bf16x8 pa3) {
  VFrag fa, fb;
  pv_reads<0>(fa, vb); pv_reads<1>(fb, vb);
  asm volatile("s_waitcnt lgkmcnt(8)" ::: "memory"); __builtin_amdgcn_sched_barrier(0); pv_mma(o[0], fa, pa0, pa1, pa2, pa3); __builtin_amdgcn_sched_barrier(0);
  pv_reads<2>(fa, vb);
  asm volatile("s_waitcnt lgkmcnt(8)" ::: "memory"); __builtin_amdgcn_sched_barrier(0); pv_mma(o[1], fb, pa0, pa1, pa2, pa3); __builtin_amdgcn_sched_barrier(0);
  pv_reads<3>(fb, vb);
  asm volatile("s_waitcnt lgkmcnt(8)" ::: "memory"); __builtin_amdgcn_sched_barrier(0); pv_mma(o[2], fa, pa0, pa1, pa2, pa3); __builtin_amdgcn_sched_barrier(0);
  asm volatile("s_waitcnt lgkmcnt(0)" ::: "memory"); __builtin_amdgcn_sched_barrier(0); pv_mma(o[3], fb, pa0, pa1, pa2, pa3);
}

#if A2_NOSGB
#define A2_SGB4(nv) do { } while (0)
#else
#define A2_SGB4(nv) do { _Pragma("unroll") for (int g_ = 0; g_ < 4; ++g_) { __builtin_amdgcn_sched_group_barrier(0x008, 1, 0); __builtin_amdgcn_sched_group_barrier(0x002, (nv), 0); } } while (0)
#endif
#define A2_SGB4X() do { _Pragma("unroll") for (int g_ = 0; g_ < 4; ++g_) { __builtin_amdgcn_sched_group_barrier(0x008, 1, 0); __builtin_amdgcn_sched_group_barrier(0x002, 2, 0); __builtin_amdgcn_sched_group_barrier(0x400, 2, 0); } } while (0)
template <int DQK, bool PV>
__device__ __forceinline__ void pv_pipe_s1(f32x16* o, int vb, bf16x8 pa0, bf16x8 pa1, bf16x8 pa2, bf16x8 pa3, f32x16& p0, f32x16& p1, float& m_reg, float& alpha, float& mnC) {
  constexpr float C = Cfg<DQK>::C, SCALE = Cfg<DQK>::SCALE;
  VFrag fa, fb;
  if constexpr (PV) { pv_reads<0>(fa, vb); pv_reads<1>(fb, vb); asm volatile("s_waitcnt lgkmcnt(8)" ::: "memory"); }
  __builtin_amdgcn_sched_barrier(0);
  if constexpr (PV) pv_mma(o[0], fa, pa0, pa1, pa2, pa3);
  float ma = fmaxf(p0[0], p0[1]), mb = fmaxf(p1[0], p1[1]);
#pragma unroll
  for (int r = 2; r < 16; r += 2) { ma = fmaxf(fmaxf(ma, p0[r]), p0[r + 1]); mb = fmaxf(fmaxf(mb, p1[r]), p1[r + 1]); }
  if constexpr (PV) A2_SGB4(4);
  __builtin_amdgcn_sched_barrier(0);
  if constexpr (PV) { pv_reads<2>(fa, vb); asm volatile("s_waitcnt lgkmcnt(8)" ::: "memory"); }
  __builtin_amdgcn_sched_barrier(0);
  if constexpr (PV) pv_mma(o[1], fb, pa0, pa1, pa2, pa3);
  { float pmax = fmaxf(ma, mb);
    auto rr = __builtin_amdgcn_permlane32_swap(__float_as_uint(pmax), __float_as_uint(pmax), false, false);
    pmax = fmaxf(__uint_as_float(rr[0]), __uint_as_float(rr[1]));
    const bool keep = __all(pmax - m_reg <= THR / SCALE);
    const float mn = keep ? m_reg : fmaxf(m_reg, pmax);
    alpha = __builtin_amdgcn_exp2f((m_reg - mn) * C); m_reg = mn; mnC = -mn * C; }
  if constexpr (PV) A2_SGB4(3);
  __builtin_amdgcn_sched_barrier(0);
  if constexpr (PV) { pv_reads<3>(fb, vb); asm volatile("s_waitcnt lgkmcnt(8)" ::: "memory"); }
  __builtin_amdgcn_sched_barrier(0);
  if constexpr (PV) pv_mma(o[2], fa, pa0, pa1, pa2, pa3);
#pragma unroll
  for (int r = 0; r < 8; ++r) p0[r] = __builtin_amdgcn_exp2f(fmaf(p0[r], C, mnC));
  if constexpr (PV) A2_SGB4X();
  __builtin_amdgcn_sched_barrier(0);
  if constexpr (PV) asm volatile("s_waitcnt lgkmcnt(0)" ::: "memory");
  __builtin_amdgcn_sched_barrier(0);
  if constexpr (PV) pv_mma(o[3], fb, pa0, pa1, pa2, pa3);
#pragma unroll
  for (int r = 8; r < 16; ++r) p0[r] = __builtin_amdgcn_exp2f(fmaf(p0[r], C, mnC));
  if constexpr (PV) A2_SGB4X();
  __builtin_amdgcn_sched_barrier(0);
}
template <int DQK>
__device__ __forceinline__ void softmax_p2(f32x16& p0, f32x16& p1, float mnC, float alpha, float& l_reg, bf16x8& pa0, bf16x8& pa1, bf16x8& pa2, bf16x8& pa3) {
  constexpr float C = Cfg<DQK>::C;
#pragma unroll
  for (int r = 0; r < 16; ++r) p1[r] = __builtin_amdgcn_exp2f(fmaf(p1[r], C, mnC));
  float ps = 0;
#pragma unroll
  for (int r = 0; r < 16; ++r) ps += p0[r];
#pragma unroll
  for (int r = 0; r < 16; ++r) ps += p1[r];
  { auto rr = __builtin_amdgcn_permlane32_swap(__float_as_uint(ps), __float_as_uint(ps), false, false);
    ps = __uint_as_float(rr[0]) + __uint_as_float(rr[1]); }
  l_reg = l_reg * alpha + ps;
#define PK4(P, BASE, OUT) do { unsigned a0 = cvtpk(P[BASE + 0], P[BASE + 1]), a1 = cvtpk(P[BASE + 2], P[BASE + 3]);   \
    unsigned b0 = cvtpk(P[BASE + 4], P[BASE + 5]), b1 = cvtpk(P[BASE + 6], P[BASE + 7]);                              \
    auto r0 = __builtin_amdgcn_permlane32_swap(a0, b0, false, false); auto r1 = __builtin_amdgcn_permlane32_swap(a1, b1, false, false); \
    u32x4 w = {r0[0], r1[0], r0[1], r1[1]}; OUT = *reinterpret_cast<bf16x8*>(&w); } while (0)
  PK4(p0, 0, pa0); PK4(p0, 8, pa1); PK4(p1, 0, pa2); PK4(p1, 8, pa3);
#undef PK4
}

template <int DQK, int ldq, int ldk, int ldkr, int ldv, int ldo>
__device__ __forceinline__ void attn_body2(const bf16_t* __restrict__ Qb, const bf16_t* __restrict__ Kh, const bf16_t* __restrict__ Kr, const bf16_t* __restrict__ Vh,
                                           unsigned char* __restrict__ Ob, int seq, LAS unsigned char* lds, int qt0, const float* __restrict__ rt, const float* __restrict__ qg, unsigned long long& pacc) {
  constexpr int ROWB = Cfg<DQK>::ROWB, SHM_K = Cfg<DQK>::SHM_K, SHM_V = Cfg<DQK>::SHM_V, NKI = SHM_K / 8192, NVI = SHM_V / 8192, NDMA = NKI + NVI, NQ = DQK / 16;
  constexpr bool X = DQK == 192;
  constexpr bool A2_SHADOW_ = X ? (A2_SHADOW_MLA != 0) : (A2_SHADOW_GQA != 0);
  constexpr bool A2_REGSTAGE = X ? (A2_RS_MLA != 0) : (A2_RS_GQA != 0);
  constexpr int NSK = A2_REGSTAGE ? 3 : 4, NSV = A2_REGSTAGE ? 3 : (X ? 3 : 4);
  constexpr int NW_K = (NSK - 3) * NDMA, NW_V = (NSV - 3) * NDMA + NKI, NWAIT_M = NW_K < NW_V ? NW_K : NW_V, NWAIT_V = NWAIT_M + NDMA;
  static_assert(A2_REGSTAGE || (NSK >= 4 && NSV >= 3), "ring depths");
  static_assert(NSK == NSV || NSK == NSV + 1, "ring depths");
  constexpr int K_OFF = 0, V_OFF = NSK * SHM_K, WS_OFF = V_OFF + NSV * SHM_V;
  const int tid = opaque_v((int)threadIdx.x), wid = __builtin_amdgcn_readfirstlane(tid >> 6), lane = tid & 63, r32 = lane & 31, hi = lane >> 5, grp = wid >> 2;
  LAS float* ws = (LAS float*)(lds + WS_OFF) + wid * 64; LAS float* li_l = ws; LAS float* al_l = ws + 32;
  const char* srcK[NKI]; int stepK[NKI];
#pragma unroll
  for (int i = 0; i < NKI; ++i) { const int P = i * 8192 + wid * 1024 + lane * 16, row = P / ROWB, cbs = P - row * ROWB, cb = cbs ^ ((row & 7) << 4);
    if (X && cb >= 256) { srcK[i] = (const char*)Kr + (size_t)row * (ldkr * 2) + (cb - 256); stepK[i] = KVBLK * ldkr * 2; }
    else { srcK[i] = (const char*)Kh + (size_t)row * (ldk * 2) + cb; stepK[i] = KVBLK * ldk * 2; } }
  const char* srcV[NVI];
#pragma unroll
  for (int i = 0; i < NVI; ++i) { const int P = i * 8192 + wid * 1024 + lane * 16, sub = P >> 9, kkh = sub >> 2, cblk = sub & 3, win = P & 511, kkl = win >> 6, cl = (win & 63) >> 1;
    const int kk = kkh * 8 + kkl, k = (kk & ~0xC) | ((kk & 4) << 1) | ((kk & 8) >> 1), c = cblk * 32 + cl;
    srcV[i] = (const char*)Vh + (size_t)k * (ldv * 2) + c * 2; }
#if A2_BUF
  unsigned long long b0_ = (unsigned long long)(size_t)Kh; { const unsigned long long v_ = (unsigned long long)(size_t)Vh, r_ = X ? (unsigned long long)(size_t)Kr : b0_; b0_ = b0_ < v_ ? b0_ : v_; b0_ = b0_ < r_ ? b0_ : r_; }
  const unsigned b0lo = __builtin_amdgcn_readfirstlane((unsigned)b0_), b0hi = __builtin_amdgcn_readfirstlane((unsigned)(b0_ >> 32));
  const char* B0 = (const char*)(size_t)(((unsigned long long)b0hi << 32) | b0lo);
  const __amdgpu_buffer_rsrc_t rsrc = __builtin_amdgcn_make_buffer_rsrc((void*)B0, 0, -1, 0x00020000);
  unsigned offK[NKI], offV[NVI];
#pragma unroll
  for (int i = 0; i < NKI; ++i) offK[i] = (unsigned)(srcK[i] - B0);
#pragma unroll
  for (int i = 0; i < NVI; ++i) offV[i] = (unsigned)(srcV[i] - B0);
#define A2_ISSUE_K(t, st) do { _Pragma("unroll") for (int _i = 0; _i < NKI; ++_i) \
    __builtin_amdgcn_raw_ptr_buffer_load_lds(rsrc, (LAS void*)(lds + K_OFF + (st) * SHM_K + _i * 8192 + wid * 1024), 16, (int)(offK[_i] + __umul24((unsigned)(t), (unsigned)stepK[_i])), 0, 0, 0); } while (0)
#define A2_ISSUE_V(t, st) do { _Pragma("unroll") for (int _i = 0; _i < NVI; ++_i) \
    __builtin_amdgcn_raw_ptr_buffer_load_lds(rsrc, (LAS void*)(lds + V_OFF + (st) * SHM_V + _i * 8192 + wid * 1024), 16, (int)offV[_i], (int)((t) * (KVBLK * ldv * 2)), 0, 0); } while (0)
#else
#define A2_ISSUE_K(t, st) do { _Pragma("unroll") for (int _i = 0; _i < NKI; ++_i) \
    __builtin_amdgcn_global_load_lds((const unsigned*)(srcK[_i] + (size_t)(t) * stepK[_i]), (LAS unsigned*)(lds + K_OFF + (st) * SHM_K + _i * 8192 + wid * 1024), 16, 0, 0); } while (0)
#define A2_ISSUE_V(t, st) do { _Pragma("unroll") for (int _i = 0; _i < NVI; ++_i) \
    __builtin_amdgcn_global_load_lds((const unsigned*)(srcV[_i] + (size_t)(t) * (KVBLK * ldv * 2)), (LAS unsigned*)(lds + V_OFF + (st) * SHM_V + _i * 8192 + wid * 1024), 16, 0, 0); } while (0)
#endif
  u32x4 rgK[NKI], rgV[NVI];
#define A2_LOAD_K(t) do { _Pragma("unroll") for (int _i = 0; _i < NKI; ++_i) rgK[_i] = *(const u32x4*)(srcK[_i] + (size_t)(t) * stepK[_i]); } while (0)
#define A2_LOAD_V(t) do { _Pragma("unroll") for (int _i = 0; _i < NVI; ++_i) rgV[_i] = *(const u32x4*)(srcV[_i] + (size_t)(t) * (KVBLK * ldv * 2)); } while (0)
#define A2_WRITE_K(st) do { _Pragma("unroll") for (int _i = 0; _i < NKI; ++_i) *(LAS u32x4*)(lds + K_OFF + (st) * SHM_K + _i * 8192 + wid * 1024 + lane * 16) = rgK[_i]; } while (0)
#define A2_WRITE_V(st) do { _Pragma("unroll") for (int _i = 0; _i < NVI; ++_i) *(LAS u32x4*)(lds + V_OFF + (st) * SHM_V + _i * 8192 + wid * 1024 + lane * 16) = rgV[_i]; } while (0)
  const int NT = seq / KVBLK; A2_TDECL
  asm volatile("s_waitcnt vmcnt(0) lgkmcnt(0)" ::: "memory"); A2_BAR();
  if constexpr (A2_REGSTAGE) {
    A2_LOAD_K(0); A2_LOAD_V(0); A2_WRITE_K(0); A2_WRITE_V(0);
    A2_LOAD_K(NT > 1 ? 1 : 0); A2_WRITE_K(1);
    A2_LOAD_K(NT > 2 ? 2 : NT - 1); A2_LOAD_V(NT > 1 ? 1 : 0);
  } else {
#pragma unroll
  for (int t = 0; t < NSV - 2; ++t) A2_ISSUE_V(t < NT ? t : NT - 1, t);
#pragma unroll
  for (int t = 0; t < NSK - 1; ++t) A2_ISSUE_K(t < NT ? t : NT - 1, t);
  }
  float m_reg = -1e30f, l_reg = 0; f32x16 o[4] = {}; bf16x8 qr[NQ];
  const bf16_t* Qw = Qb + (long)(wid * QBLK + r32) * ldq + hi * 8;
#pragma unroll
  for (int d0 = 0; d0 < NQ; ++d0) qr[d0] = *reinterpret_cast<const bf16x8*>(Qw + d0 * 16);
  if constexpr (!X) {
    float ss = 0.f;
#pragma unroll
    for (int d0 = 0; d0 < 8; ++d0) { const u32x4 w = *reinterpret_cast<const u32x4*>(&qr[d0]);
#pragma unroll
      for (int q = 0; q < 4; ++q) { const float x0 = __uint_as_float(w[q] << 16), x1 = __uint_as_float(w[q] & 0xffff0000u); ss += x0 * x0 + x1 * x1; } }
    ss += __shfl_xor(ss, 32);
    const float rstd = 1.0f / sqrtf(ss * (1.0f / 128.0f) + 1e-6f);
    const int t = qt0 >= 0 ? qt0 + wid * QBLK + r32 : 0;
#pragma unroll
    for (int d0 = 0; d0 < 8; ++d0) { u32x4 w = *reinterpret_cast<const u32x4*>(&qr[d0]);
      const f32x4 g0 = *reinterpret_cast<const f32x4*>(qg + d0 * 16 + hi * 8), g1 = *reinterpret_cast<const f32x4*>(qg + d0 * 16 + hi * 8 + 4);
      const int pos = d0 < 4 ? (t >> 6) : (t & 63), ti = pos * 32 + (d0 & 3) * 8 + hi * 4; const f32x4 cs = *reinterpret_cast<const f32x4*>(rt + ti), sn = *reinterpret_cast<const f32x4*>(rt + 2048 + ti);
      const float gg[8] = {g0[0], g0[1], g0[2], g0[3], g1[0], g1[1], g1[2], g1[3]};
#pragma unroll
      for (int q = 0; q < 4; ++q) { const float x0 = __uint_as_float(w[q] << 16) * rstd * gg[2 * q], x1 = __uint_as_float(w[q] & 0xffff0000u) * rstd * gg[2 * q + 1]; w[q] = cvtpk(x0 * cs[q] - x1 * sn[q], x0 * sn[q] + x1 * cs[q]); }
      qr[d0] = *reinterpret_cast<const bf16x8*>(&w); }
  } else {
    { const int t = qt0 >= 0 ? qt0 + wid * QBLK + r32 : 0;
#pragma unroll
      for (int d0 = 8; d0 < 12; ++d0) { u32x4 w = *reinterpret_cast<const u32x4*>(&qr[d0]);
        const int j0 = (d0 - 8) * 8 + hi * 4, pos = d0 < 10 ? (t >> 6) : (t & 63), ti = pos * 16 + (j0 & 15);
        const f32x4 cs = *reinterpret_cast<const f32x4*>(rt + ti), sn = *reinterpret_cast<const f32x4*>(rt + 1024 + ti);
#pragma unroll
        for (int q = 0; q < 4; ++q) { const float x0 = __uint_as_float(w[q] << 16), x1 = __uint_as_float(w[q] & 0xffff0000u); w[q] = cvtpk(x0 * cs[q] - x1 * sn[q], x0 * sn[q] + x1 * cs[q]); }
        qr[d0] = *reinterpret_cast<const bf16x8*>(&w); } }
  }
  asm volatile("s_waitcnt vmcnt(0) lgkmcnt(0)" ::: "memory"); A2_BAR();
  if (grp == 1) A2_BAR();
  const int vb0 = (int)(unsigned)(size_t)(lds + V_OFF) + v_rd_base(lane);
  f32x16 s0, s1; bf16x8 pa0, pa1, pa2, pa3; float alpha, mnC_ = 0.f;
  if constexpr (A2_SHADOW_) { pa0 = (bf16x8){}; pa1 = pa0; pa2 = pa0; pa3 = pa0; }
  int kst = 0, kis = NSK - 1, vst = NSV - 1, vis = NSV - 2;
#pragma unroll 1
  for (int i = 0; i < NT; ++i) {
    A2_T(0);
    __builtin_amdgcn_s_setprio(1);
    qk_tile<DQK>(s0, s1, (const LASc*)(lds + K_OFF + kst * SHM_K), qr, r32, hi);
    A2_TQ();
    if constexpr (A2_SHADOW_) { pv_pipe_s1<DQK, true>(o, vb0 + (i > 0 ? vst : 0) * SHM_V, pa0, pa1, pa2, pa3, s0, s1, m_reg, alpha, mnC_); }
    else { if (i > 0) pv_pipe(o, vb0 + vst * SHM_V, pa0, pa1, pa2, pa3); }
    __builtin_amdgcn_s_setprio(0);
    A2_T(1);
    if constexpr (!A2_REGSTAGE) asm volatile("s_waitcnt vmcnt(%0)" :: "n"(NWAIT_M) : "memory");
    A2_BAR();
    A2_T(2);
    const int tv_ = i + NSV - 2 < NT ? i + NSV - 2 : NT - 1, tk_ = i + NSK - 1 < NT ? i + NSK - 1 : NT - 1;
    if constexpr (A2_SHADOW_) softmax_p2<DQK>(s0, s1, mnC_, alpha, l_reg, pa0, pa1, pa2, pa3);
    else
    softmax_tile<DQK>(s0, s1, m_reg, l_reg, alpha, pa0, pa1, pa2, pa3, [&](const int k) {
      if constexpr (!A2_REGSTAGE && A2_SPREAD) {
        __builtin_amdgcn_sched_barrier(0);
        if (k < NVI) __builtin_amdgcn_global_load_lds((const unsigned*)(srcV[k] + (size_t)tv_ * (KVBLK * ldv * 2)), (LAS unsigned*)(lds + V_OFF + vis * SHM_V + k * 8192 + wid * 1024), 16, 0, 0);
        else if (k - NVI < NKI) __builtin_amdgcn_global_load_lds((const unsigned*)(srcK[k - NVI] + (size_t)tk_ * stepK[k - NVI]), (LAS unsigned*)(lds + K_OFF + kis * SHM_K + (k - NVI) * 8192 + wid * 1024), 16, 0, 0);
        __builtin_amdgcn_sched_barrier(0);
      } });
    A2_TX(7);
    if (__any(alpha < 1.f)) { if (hi == 0) al_l[r32] = alpha; asm volatile("s_waitcnt lgkmcnt(0)" ::: "memory");
#pragma unroll
      for (int d = 0; d < 4; ++d)
#pragma unroll
        for (int r = 0; r < 16; ++r) o[d][r] *= al_l[crow(r, hi)]; }
    __builtin_amdgcn_sched_barrier(0);
    A2_TX(8);
    if constexpr (A2_REGSTAGE) {
      A2_WRITE_V(vis); A2_WRITE_K(kis);
      __builtin_amdgcn_sched_barrier(0);
      { const int tv = i + 2 < NT ? i + 2 : NT - 1, tk = i + 3 < NT ? i + 3 : NT - 1; A2_LOAD_V(tv); A2_LOAD_K(tk); }
      A2_T3();
      asm volatile("s_waitcnt lgkmcnt(0)" ::: "memory"); A2_BAR();
    } else {
    if constexpr (!A2_SPREAD) { A2_ISSUE_V(tv_, vis); A2_ISSUE_K(tk_, kis); }
    A2_T3();
    asm volatile("s_waitcnt vmcnt(%0)" :: "n"(NWAIT_V) : "memory"); A2_BAR();
    }
    A2_T(4);
    kst = kst == NSK - 1 ? 0 : kst + 1; kis = kis == NSK - 1 ? 0 : kis + 1; vst = vst == NSV - 1 ? 0 : vst + 1; vis = vis == NSV - 1 ? 0 : vis + 1;
  }
  if (grp == 0) A2_BAR();
  pv_pipe(o, vb0 + vst * SHM_V, pa0, pa1, pa2, pa3);
  if (hi == 0) li_l[r32] = l_reg; asm volatile("s_waitcnt lgkmcnt(0)" ::: "memory");
  float rli[16];
#pragma unroll
  for (int r = 0; r < 16; ++r) rli[r] = __builtin_amdgcn_rcpf(li_l[crow(r, hi)]);
  unsigned char* Ow = Ob + (long)(wid * QBLK) * ldo;
#pragma unroll
  for (int r = 0; r < 16; ++r) { const int orow = crow(r, hi);
#pragma unroll
    for (int d0 = 0; d0 < 4; ++d0) { const float ov = __builtin_fminf(__builtin_fmaxf(o[d0][r] * rli[r] * AO_SCALE, -448.f), 448.f); Ow[(long)orow * ldo + d0 * 32 + r32] = (unsigned char)(__builtin_amdgcn_cvt_pk_fp8_f32(ov, 0.f, 0, false) & 0xff); } }
#undef A2_ISSUE_K
#undef A2_ISSUE_V
#undef A2_LOAD_K
#undef A2_LOAD_V
#undef A2_WRITE_K
#undef A2_WRITE_V
}
#undef KSWZ2
#undef A2_BAR
}
#ifndef TOPK_DYN
#define TOPK_DYN 0
#endif
#ifndef LN2_LDSV
#define LN2_LDSV 1
#endif
#ifndef LN2_SKIP
#define LN2_SKIP 1
#endif
#ifndef LN2_NEB
#define LN2_NEB 2
#endif
#ifndef LN_RECOMP
#define LN_RECOMP 1
#endif
struct Frame {
    LAS unsigned char* lds;
    int tid, lane, wave, vcu, G, gw, ngw;
    float* out;
    unsigned char* ws;
};
enum { I_X = 0, I_C, I_CTX, I_CCTX, I_ADAW, I_ADAB, I_LMG, I_LMB, I_LFG, I_LFB, I_RW, I_WG, I_WU, I_WDN, I_GQKV, I_GQG, I_GKG, I_GWO, I_MDQ, I_MQG, I_MUQ, I_MDKV, I_MKVG, I_MUKV, I_MWO };

__device__ __forceinline__ u32x2 pack4(const f32x4 v) { u32x2 w; w.x = cvt_pk_bf16(v[0], v[1]); w.y = cvt_pk_bf16(v[2], v[3]); return w; }
__device__ __forceinline__ f32x4 unpack4(const u32x2 w) { return (f32x4){__uint_as_float(w.x << 16), __uint_as_float(w.x & 0xffff0000u), __uint_as_float(w.y << 16), __uint_as_float(w.y & 0xffff0000u)}; }
__device__ __forceinline__ float silu_f(float x) { return x / (1.0f + __expf(-x)); }

__device__ __forceinline__ void transpose_item(const float* W, int N, const float* g, bf16_t* dst, int ldd, int row_off, int il, LAS float* scr, int item, int lane) {
    const int nblk = N / 32, kb = item / nblk, nb = item % nblk, k0 = 64 * kb, n0 = 32 * nb;
#pragma unroll 8
    for (int i = 0; i < 32; ++i) { const int kk = 2 * i + (lane >> 5); float v = __builtin_nontemporal_load(&W[(size_t)(k0 + kk) * N + n0 + (lane & 31)]); if (g) v *= g[k0 + kk]; scr[kk * 33 + (lane & 31)] = v; }
    LDS_WAIT(); asm volatile("" ::: "memory");
    const int c = lane & 7;
#pragma unroll
    for (int j = 0; j < 4; ++j) { const int n = (lane >> 3) + 8 * j; const LAS float* s = scr + (8 * c) * 33 + n;
        u32x4 o; o.x = cvt_pk_bf16(s[0 * 33], s[1 * 33]); o.y = cvt_pk_bf16(s[2 * 33], s[3 * 33]); o.z = cvt_pk_bf16(s[4 * 33], s[5 * 33]); o.w = cvt_pk_bf16(s[6 * 33], s[7 * 33]);
        const int nn = n0 + n, dr = row_off + (il ? ((nn >> 7) << 8) + (nn & 127) : nn);
        *(u32x4*)(dst + (size_t)dr * ldd + k0 + 8 * c) = o; }
    LDS_WAIT(); asm volatile("" ::: "memory");
}

__device__ __forceinline__ void transpose_item_fp8(const float* W, int N, float scale, unsigned char* dst, int ldd, int row_off, int il, LAS float* scr, int item, int lane, const float* g = nullptr) {
    const int nblk = N / 32, kb = item / nblk, nb = item % nblk, k0 = 64 * kb, n0 = 32 * nb;
    { f32x4 wv[8];
#pragma unroll
      for (int i = 0; i < 8; ++i) wv[i] = __builtin_nontemporal_load((const f32x4*)&W[(size_t)(k0 + 8 * i + (lane >> 3)) * N + n0 + 4 * (lane & 7)]);
#pragma unroll
      for (int i = 0; i < 8; ++i) { const int kk = 8 * i + (lane >> 3); float sc = scale; if (g) sc *= g[k0 + kk]; LAS float* d = scr + kk * 33 + 4 * (lane & 7);
        d[0] = wv[i][0] * sc; d[1] = wv[i][1] * sc; d[2] = wv[i][2] * sc; d[3] = wv[i][3] * sc; } }
    LDS_WAIT(); asm volatile("" ::: "memory");
    const int n = lane >> 1, kh = (lane & 1) * 32; const LAS float* s = scr + kh * 33 + n;
    u32x4 o0, o1;
#pragma unroll
    for (int q = 0; q < 4; ++q) { o0[q] = cvt4_fp8(s[(4 * q + 0) * 33], s[(4 * q + 1) * 33], s[(4 * q + 2) * 33], s[(4 * q + 3) * 33]); o1[q] = cvt4_fp8(s[(16 + 4 * q + 0) * 33], s[(16 + 4 * q + 1) * 33], s[(16 + 4 * q + 2) * 33], s[(16 + 4 * q + 3) * 33]); }
    const int nn = n0 + n, dr = row_off + (il ? ((nn >> 7) << 8) + (nn & 127) : nn);
    u32x4* dp = (u32x4*)(dst + (size_t)dr * ldd + k0 + kh); dp[0] = o0; dp[1] = o1;
    LDS_WAIT(); asm volatile("" ::: "memory");
}

__device__ __forceinline__ void phase_p0a(Frame& F) {
    LAS float* scr = (LAS float*)(F.lds + F.wave * 9216);
    constexpr int I_QKV = 16 * 48, I_WO = 16 * 32, I_DQ = 16 * 24, I_DKV = 16 * 10, I_UQ = 12 * 48, I_UKV = 4 * 64;
    constexpr int PERJ = I_QKV + I_WO + I_DQ + I_DKV + I_UQ + I_UKV + I_WO;
    for (int it = F.gw; it < 2 * PERJ; it += F.ngw) {
        const int j = it / PERJ; int r = it - j * PERJ;
        if (r < I_QKV) { transpose_item_fp8(in_ptr(I_GQKV) + (size_t)j * 1024 * 1536, 1536, WP_SCALE, (unsigned char*)(F.ws + WS_WQKV) + (size_t)j * 1536 * 1024, 1024, 0, 0, scr, r, F.lane); continue; } r -= I_QKV;
        if (r < I_WO) { transpose_item_fp8(in_ptr(I_GWO) + (size_t)j * 1024 * 1024, 1024, WO_SCALE, (unsigned char*)(F.ws + WS_WOG) + (size_t)j * 1024 * 1024, 1024, 0, 0, scr, r, F.lane); continue; } r -= I_WO;
        if (r < I_DQ) { transpose_item_fp8(in_ptr(I_MDQ) + (size_t)j * 1024 * 768, 768, WP_SCALE, (unsigned char*)(F.ws + WS_WD) + (size_t)j * 1280 * 1024, 1024, 0, 0, scr, r, F.lane); continue; } r -= I_DQ;
        if (r < I_DKV) { transpose_item_fp8(in_ptr(I_MDKV) + (size_t)j * 1024 * 320, 320, WP_SCALE, (unsigned char*)(F.ws + WS_WD) + (size_t)j * 1280 * 1024, 1024, 768, 0, scr, r, F.lane); continue; } r -= I_DKV;
        if (r < I_UQ) { transpose_item_fp8(in_ptr(I_MUQ) + (size_t)j * 768 * 1536, 1536, WP_SCALE, (unsigned char*)(F.ws + WS_WUQ) + (size_t)j * 1536 * 768, 768, 0, 0, scr, r, F.lane, in_ptr(I_MQG) + j * 768); continue; } r -= I_UQ;
        if (r < I_UKV) { transpose_item(in_ptr(I_MUKV) + (size_t)j * 256 * 2048, 2048, in_ptr(I_MKVG) + j * 256, (bf16_t*)(F.ws + WS_WUKV) + (size_t)j * 2048 * 256, 256, 0, 0, scr, r, F.lane); continue; } r -= I_UKV;
        transpose_item_fp8(in_ptr(I_MWO) + (size_t)j * 1024 * 1024, 1024, WO_SCALE, (unsigned char*)(F.ws + WS_WOM) + (size_t)j * 1024 * 1024, 1024, 0, 0, scr, r, F.lane);
    }
    for (int i = blockIdx.x * NTHR + F.tid; i < 2 * 12288; i += F.G * NTHR) { const int j = i / 12288, q = i - j * 12288;
        *((u32x4*)((unsigned char*)(F.ws + WS_WD) + (size_t)j * 1280 * 1024 + (size_t)1088 * 1024) + q) = (u32x4){0u, 0u, 0u, 0u}; }
    { int* idn = (int*)(F.ws + WS_GVAL); for (int i = blockIdx.x * NTHR + F.tid; i < NSLOT; i += F.G * NTHR) idn[i] = i; }
    { float* rt = (float*)(F.ws + WS_ROPE); const int i = blockIdx.x * NTHR + F.tid;
        if (i < 2048) { const int pos = i >> 5, m = i & 31; const float fr = powf(10000.0f, -(float)(2 * m) / 64.0f), a = (float)pos * fr; rt[i] = cosf(a); rt[2048 + i] = sinf(a); }
        else if (i < 3072) { const int q = i - 2048, pos = q >> 4, m = q & 15; const float fr = powf(10000.0f, -(float)(2 * m) / 32.0f), a = (float)pos * fr; rt[4096 + q] = cosf(a); rt[5120 + q] = sinf(a); } }
    { float* modp = (float*)(F.ws + WS_R + R_MODP); LAS float* s = (LAS float*)(F.lds + F.wave * 9216);
        for (int it = F.gw; it < NL * 96 * MOD_KC; it += F.ngw) {
            const int kc = it % MOD_KC, cg = (it / MOD_KC) % 96, li = it / (MOD_KC * 96);
            for (int q = F.lane; q < 33 * 64; q += 64) { const int b = q >> 6, kk = q & 63; const float cv = b < 32 ? in_ptr(I_C)[b * D + kc * 64 + kk] : in_ptr(I_CCTX)[kc * 64 + kk]; s[kk * 36 + b] = silu_f(cv); }
            LDS_WAIT(); asm volatile("" ::: "memory");
            float acc[33];
#pragma unroll
            for (int b = 0; b < 33; ++b) acc[b] = 0.f;
            const float* wp = in_ptr(I_ADAW) + ((size_t)li * D + kc * 64) * MODSZ + cg * 64 + F.lane;
#pragma unroll 1
            for (int k8 = 0; k8 < 64; k8 += 16) { float wv[16];
#pragma unroll
                for (int q = 0; q < 16; ++q) wv[q] = __builtin_nontemporal_load(&wp[(size_t)(k8 + q) * MODSZ]);
#pragma unroll
                for (int q = 0; q < 16; ++q) { const int kk = k8 + q; const float w = wv[q];
#pragma unroll
                    for (int b4 = 0; b4 < 8; ++b4) { const f32x4 sv = *(const LAS f32x4*)(s + kk * 36 + b4 * 4); acc[b4 * 4 + 0] += sv[0] * w; acc[b4 * 4 + 1] += sv[1] * w; acc[b4 * 4 + 2] += sv[2] * w; acc[b4 * 4 + 3] += sv[3] * w; }
                    acc[32] += s[kk * 36 + 32] * w; } }
            float* op = modp + ((size_t)(kc * NL + li) * 33) * MODSZ + cg * 64 + F.lane;
#pragma unroll
            for (int b = 0; b < 33; ++b) op[(size_t)b * MODSZ] = acc[b];
            LDS_WAIT(); asm volatile("" ::: "memory");
        } }
}
__device__ __forceinline__ void phase_p0b(Frame& F) {
    const float* modp = (const float*)(F.ws + WS_R + R_MODP); float* mod = (float*)(F.ws + WS_MOD);
    for (int i = blockIdx.x * NTHR + F.tid; i < NL * 33 * MODSZ; i += F.G * NTHR) { const int n = i % MODSZ, li = i / (33 * MODSZ); float a = in_ptr(I_ADAB)[li * MODSZ + n];
#pragma unroll
        for (int kc = 0; kc < MOD_KC; ++kc) a += modp[(size_t)kc * NL * 33 * MODSZ + i];
        mod[i] = a; }
}
__device__ __forceinline__ const float* xrow_in(const float* xl, const float* xc, int b, int p) { return p < CTXL ? xc + ((size_t)b * CTXL + p) * D : xl + ((size_t)b * SEQ + (p - CTXL)) * D; }

__device__ __forceinline__ void phase_p0c(Frame& F) {
    const float* mod = (const float*)(F.ws + WS_MOD); unsigned char* H8 = (unsigned char*)(F.ws + WS_H);
    for (int r2 = F.gw * 2; r2 < T; r2 += F.ngw * 2) {
        f32x4 xa[2][4];
#pragma unroll
        for (int i = 0; i < 2; ++i) { const int r = r2 + i, b = r / TPS, p = r - b * TPS; const f32x4* xr = (const f32x4*)xrow_in(in_ptr(I_X), in_ptr(I_CTX), b, p) + F.lane;
#pragma unroll
            for (int j = 0; j < 4; ++j) xa[i][j] = __builtin_nontemporal_load(&xr[64 * j]); }
#pragma unroll
        for (int i = 0; i < 2; ++i) { const int r = r2 + i, b = r / TPS, p = r - b * TPS; const float* mv = mod + (size_t)(p < CTXL ? 32 : b) * MODSZ; unsigned* hr = (unsigned*)(H8 + (size_t)r * D) + F.lane;
#pragma unroll
            for (int j = 0; j < 4; ++j) { const f32x4 sh = *((const f32x4*)mv + F.lane + 64 * j), sc = *((const f32x4*)(mv + D) + F.lane + 64 * j); const f32x4 hv = xa[i][j] * (1.0f + sc) + sh; hr[64 * j] = cvt4_fp8(hv[0], hv[1], hv[2], hv[3]); } } }
}

__device__ __forceinline__ void phase_qknorm(Frame& F, int j, bf16_t* dry) {
    bf16_t* QKV = (bf16_t*)(F.ws + WS_R + R_QKV); const ptrdiff_t dofs = dry ? dry - QKV : 0; const float* rt = (const float*)(F.ws + WS_ROPE);
    const float* kg = in_ptr(I_GKG) + j * 128;
    const int l16 = F.lane & 15, hd = (F.lane >> 4) & 1, rsel = F.lane >> 5;
    const f32x4 gk0 = *(const f32x4*)(kg + l16 * 8), gk1 = *(const f32x4*)(kg + l16 * 8 + 4);
    for (int r2 = F.gw; r2 < T / 2; r2 += F.ngw) { const int r = 2 * r2 + rsel; const int b = r / TPS, p = r - b * TPS; const int t = p >= CTXL ? p - CTXL : 0, trow = t >> 6, tcol = t & 63;
        const int j0 = l16 * 4, pos = j0 < 32 ? trow : tcol, ti = pos * 32 + (j0 & 31);
        const f32x4 cs = *(const f32x4*)(rt + ti), sn = *(const f32x4*)(rt + 2048 + ti);
        u32x4* ptr = (u32x4*)(QKV + (size_t)r * 1536 + 1024 + hd * 128 + l16 * 8); const u32x4 w = *ptr;
        f32x4 a = {__uint_as_float(w.x << 16), __uint_as_float(w.x & 0xffff0000u), __uint_as_float(w.y << 16), __uint_as_float(w.y & 0xffff0000u)};
        f32x4 c = {__uint_as_float(w.z << 16), __uint_as_float(w.z & 0xffff0000u), __uint_as_float(w.w << 16), __uint_as_float(w.w & 0xffff0000u)};
        float ss = (a[0] * a[0] + a[1] * a[1]) + (a[2] * a[2] + a[3] * a[3]) + (c[0] * c[0] + c[1] * c[1]) + (c[2] * c[2] + c[3] * c[3]);
        ss += __shfl_xor(ss, 1); ss += __shfl_xor(ss, 2); ss += __shfl_xor(ss, 4); ss += __shfl_xor(ss, 8);
        const float rstd = 1.0f / sqrtf(ss * (1.0f / 128.0f) + LN_EPS);
        a = a * rstd * gk0; c = c * rstd * gk1;
        const f32x4 a2 = {a[0] * cs[0] - a[1] * sn[0], a[0] * sn[0] + a[1] * cs[0], a[2] * cs[1] - a[3] * sn[1], a[2] * sn[1] + a[3] * cs[1]};
        const f32x4 c2 = {c[0] * cs[2] - c[1] * sn[2], c[0] * sn[2] + c[1] * cs[2], c[2] * cs[3] - c[3] * sn[3], c[2] * sn[3] + c[3] * cs[3]};
        u32x4 o; o.x = cvt_pk_bf16(a2[0], a2[1]); o.y = cvt_pk_bf16(a2[2], a2[3]); o.z = cvt_pk_bf16(c2[0], c2[1]); o.w = cvt_pk_bf16(c2[2], c2[3]); *(u32x4*)((bf16_t*)ptr + dofs) = o; }
}
__device__ __forceinline__ void phase_mla_stats(Frame& F, bf16_t* dry) {
    bf16_t* CQ = (bf16_t*)(F.ws + WS_R + R_CQ); unsigned char* CQ8 = (unsigned char*)(F.ws + WS_CQ8); bf16_t* KR = (bf16_t*)(F.ws + WS_KR); const ptrdiff_t dofs = dry ? dry - CQ : 0; const float* rt = (const float*)(F.ws + WS_ROPE) + 4096;
    for (int r4 = F.gw * 4; r4 < T; r4 += F.ngw * 4) {
        u32x4 w0a[4], w1a[4], wka[4];
#pragma unroll
        for (int i = 0; i < 4; ++i) { const bf16_t* row = CQ + (size_t)(r4 + i) * 1280; w0a[i] = *(const u32x4*)(row + F.lane * 8); w1a[i] = *(const u32x4*)(row + 512 + F.lane * 8); wka[i] = *(const u32x4*)(row + 1024 + (F.lane & 7) * 8); }
#pragma unroll
        for (int i = 0; i < 4; ++i) { const int r = r4 + i; const int b = r / TPS, p = r - b * TPS; const int t = p >= CTXL ? p - CTXL : 0, trow = t >> 6, tcol = t & 63;
        bf16_t* row = CQ + (size_t)r * 1280; const u32x4 w0 = w0a[i], w1 = w1a[i];
        float s0 = 0.f, s1 = 0.f;
#pragma unroll
        for (int q = 0; q < 4; ++q) { const float a = __uint_as_float(w0[q] << 16), c = __uint_as_float(w0[q] & 0xffff0000u); s0 += a * a + c * c; const float a1 = __uint_as_float(w1[q] << 16), c1 = __uint_as_float(w1[q] & 0xffff0000u); s1 += a1 * a1 + c1 * c1; }
        const float sq = wave_sum(s0 + (F.lane < 32 ? s1 : 0.f)), skv = wave_sum(F.lane >= 32 ? s1 : 0.f);
        const float rq = 1.0f / sqrtf(sq * (1.0f / 768.0f) + LN_EPS), rkv = 1.0f / sqrtf(skv * (1.0f / 256.0f) + LN_EPS);
        { unsigned char* c8 = CQ8 + (size_t)r * 768; u32x2 q0; q0.x = cvt4_fp8(__uint_as_float(w0[0] << 16) * rq, __uint_as_float(w0[0] & 0xffff0000u) * rq, __uint_as_float(w0[1] << 16) * rq, __uint_as_float(w0[1] & 0xffff0000u) * rq);
          q0.y = cvt4_fp8(__uint_as_float(w0[2] << 16) * rq, __uint_as_float(w0[2] & 0xffff0000u) * rq, __uint_as_float(w0[3] << 16) * rq, __uint_as_float(w0[3] & 0xffff0000u) * rq); *(u32x2*)(c8 + F.lane * 8) = q0;
          if (F.lane < 32) { u32x2 q1; q1.x = cvt4_fp8(__uint_as_float(w1[0] << 16) * rq, __uint_as_float(w1[0] & 0xffff0000u) * rq, __uint_as_float(w1[1] << 16) * rq, __uint_as_float(w1[1] & 0xffff0000u) * rq);
            q1.y = cvt4_fp8(__uint_as_float(w1[2] << 16) * rq, __uint_as_float(w1[2] & 0xffff0000u) * rq, __uint_as_float(w1[3] << 16) * rq, __uint_as_float(w1[3] & 0xffff0000u) * rq); *(u32x2*)(c8 + 512 + F.lane * 8) = q1; }
          else { u32x4 o1;
#pragma unroll
            for (int q = 0; q < 4; ++q) o1[q] = cvt_pk_bf16(__uint_as_float(w1[q] << 16) * rkv, __uint_as_float(w1[q] & 0xffff0000u) * rkv);
            *(u32x4*)(row + dofs + 512 + F.lane * 8) = o1; } }
        if (F.lane < 8) { const u32x4 w = wka[i]; u32x4 o = w;
            { const int j0 = F.lane * 4, pos = j0 < 16 ? trow : tcol, ti = pos * 16 + (j0 & 15); const f32x4 cs = *(const f32x4*)(rt + ti), sn = *(const f32x4*)(rt + 1024 + ti);
#pragma unroll
                for (int q = 0; q < 4; ++q) { const float x0 = __uint_as_float(w[q] << 16), x1 = __uint_as_float(w[q] & 0xffff0000u); o[q] = cvt_pk_bf16(x0 * cs[q] - x1 * sn[q], x0 * sn[q] + x1 * cs[q]); } }
            *(u32x4*)(KR + (size_t)r * 64 + F.lane * 8) = o; } } }
}

__device__ __forceinline__ float lane_xor32_sum(float a) { auto rr = __builtin_amdgcn_permlane32_swap(__float_as_uint(a), __float_as_uint(a), false, false); return __uint_as_float(rr[0]) + __uint_as_float(rr[1]); }
__device__ __forceinline__ float lane_xor32_max(float a) { auto rr = __builtin_amdgcn_permlane32_swap(__float_as_uint(a), __float_as_uint(a), false, false); return fmaxf(__uint_as_float(rr[0]), __uint_as_float(rr[1])); }
__device__ __forceinline__ float lane_xor4(float v) {
    const int a = __builtin_amdgcn_update_dpp(0, __builtin_bit_cast(int, v), 0x114, 0xf, 0xA, false);
    return __builtin_bit_cast(float, __builtin_amdgcn_update_dpp(a, __builtin_bit_cast(int, v), 0x104, 0xf, 0x5, false));
}
__device__ __forceinline__ void ln1_reduce16(float (&acc)[16], int lane, float& lg_e) {
#pragma unroll
    for (int e = 0; e < 8; ++e) { auto rr = __builtin_amdgcn_permlane32_swap(__float_as_uint(acc[e]), __float_as_uint(acc[e + 8]), false, false); acc[e] = __uint_as_float(rr[0]) + __uint_as_float(rr[1]); }
#pragma unroll
    for (int e = 0; e < 4; ++e) { const bool up = (lane & 16) != 0; const float send = up ? acc[e] : acc[e + 4], keep = up ? acc[e + 4] : acc[e]; acc[e] = keep + lane_xor16(send); }
#pragma unroll
    for (int e = 0; e < 2; ++e) { const bool up = (lane & 8) != 0; const float send = up ? acc[e] : acc[e + 2], keep = up ? acc[e + 2] : acc[e]; acc[e] = keep + DPP_MOV(send, 0x128); }
    { const bool up = (lane & 2) != 0; const float send = up ? acc[0] : acc[1], keep = up ? acc[1] : acc[0]; acc[0] = keep + DPP_MOV(send, 0x4E); }
    float v = acc[0]; v += DPP_MOV(v, 0xB1); v += lane_xor4(v); lg_e = v;
}
__device__ __forceinline__ void phase_ln1(Frame& F, int li, const float* xin_l, const float* xin_c, const bf16_t* O, float* xdry, bool skipctx) {
    LAS float* Wt = (LAS float*)F.lds;
    { const float* rw = in_ptr(I_RW) + (size_t)li * D * NE; for (int i = F.tid; i < D * NE; i += NTHR) Wt[(i & 15) * D + (i >> 4)] = rw[i]; }
    __syncthreads();
    const float* mod = (const float*)(F.ws + WS_MOD) + (size_t)li * 33 * MODSZ; unsigned char* H8 = (unsigned char*)(F.ws + WS_H); float* AFF = (float*)(F.ws + WS_AFF); int* INV = (int*)(F.ws + WS_INV);
    f32x4 lg[4], lb[4], g1[4], sh2[4], sc2[4];
    { const float* pg = in_ptr(I_LMG) + li * D; const float* pb = in_ptr(I_LMB) + li * D;
#pragma unroll
      for (int j = 0; j < 4; ++j) { lg[j] = *((const f32x4*)pg + F.lane + 64 * j); lb[j] = *((const f32x4*)pb + F.lane + 64 * j); } }
#pragma unroll 1
    for (int rp_ = 0; rp_ < REP_LN1; ++rp_) { float* xd = rp_ + 1 < REP_LN1 ? xdry : nullptr; float* Xl = xd ? xd + (size_t)NB * CTXL * D : F.out; float* Xc = xd ? xd : (float*)(F.ws + WS_XC);
    for (int wv = F.gw; wv < 2048; wv += F.ngw) { const int b = wv >> 6, w = wv & 63;
#pragma unroll 1
        for (int seg = skipctx ? 1 : 0; seg < 2; ++seg) { const float* mv = mod + (size_t)(seg == 0 ? 32 : b) * MODSZ;
#pragma unroll
            for (int j = 0; j < 4; ++j) { g1[j] = *((const f32x4*)(mv + 2 * D) + F.lane + 64 * j); sh2[j] = *((const f32x4*)(mv + 3 * D) + F.lane + 64 * j); sc2[j] = *((const f32x4*)(mv + 4 * D) + F.lane + 64 * j); }
            const int np = seg == 0 ? 2 : 16, p0 = seg == 0 ? 4 * w : CTXL + 32 * w;
            const float* xin = seg == 0 ? xin_c + (size_t)b * CTXL * D : xin_l + ((size_t)b * SEQ - CTXL) * D;
            float* xout = seg == 0 ? Xc + (size_t)b * CTXL * D : Xl + ((size_t)b * SEQ - CTXL) * D;
            f32x4 nx[2][4]; u32x2 no[2][4];
#define LN1_FETCH(pp) do { _Pragma("unroll") for (int q = 0; q < 2; ++q) { const f32x4* xr = (const f32x4*)(xin + (size_t)((pp) + q) * D) + F.lane; const u32x2* orow = (const u32x2*)(O + ((size_t)b * TPS + (pp) + q) * D) + F.lane; \
                _Pragma("unroll") for (int j = 0; j < 4; ++j) { nx[q][j] = __builtin_nontemporal_load(&xr[64 * j]); no[q][j] = __builtin_nontemporal_load(&orow[64 * j]); } } } while (0)
            LN1_FETCH(p0);
#pragma unroll 1
            for (int k = 0; k < np; ++k) { const int pA = p0 + 2 * k; const size_t rA = (size_t)b * TPS + pA;
                f32x4 v[2][4]; float s[2] = {0.f, 0.f};
#pragma unroll
                for (int q = 0; q < 2; ++q)
#pragma unroll
                    for (int j = 0; j < 4; ++j) { v[q][j] = nx[q][j] * ALPHA + g1[j] * unpack4(no[q][j]); s[q] += (v[q][j][0] + v[q][j][1]) + (v[q][j][2] + v[q][j][3]); }
                __builtin_amdgcn_sched_barrier(0);
                if (k + 1 < np) LN1_FETCH(pA + 2);
                __builtin_amdgcn_sched_barrier(0);
                float s2[2] = {0.f, 0.f};
#pragma unroll
                for (int q = 0; q < 2; ++q) { const float mean = wave_sum(s[q]) * (1.0f / D);
#pragma unroll
                    for (int j = 0; j < 4; ++j) { v[q][j] = v[q][j] - mean; s2[q] += (v[q][j][0] * v[q][j][0] + v[q][j][1] * v[q][j][1]) + (v[q][j][2] * v[q][j][2] + v[q][j][3] * v[q][j][3]); } }
#pragma unroll
                for (int q = 0; q < 2; ++q) { const float rstd = 1.0f / sqrtf(wave_sum(s2[q]) * (1.0f / D) + LN_EPS);
                    f32x4* xw = (f32x4*)(xout + (size_t)(pA + q) * D) + F.lane; unsigned* hr = (unsigned*)(H8 + (rA + q) * D) + F.lane;
#pragma unroll
                    for (int j = 0; j < 4; ++j) { v[q][j] = v[q][j] * rstd * lg[j] + lb[j]; if (!LN_RECOMP) __builtin_nontemporal_store(v[q][j], &xw[64 * j]); v[q][j] = v[q][j] * (1.0f + sc2[j]) + sh2[j]; hr[64 * j] = cvt4_fp8(v[q][j][0], v[q][j][1], v[q][j][2], v[q][j][3]); } }
                f32x2 hp[4][4];
#pragma unroll
                for (int j = 0; j < 4; ++j)
#pragma unroll
                    for (int c = 0; c < 4; ++c) hp[j][c] = (f32x2){v[0][j][c], v[1][j][c]};
                __builtin_amdgcn_sched_barrier(0);
                float accA[16], accB[16];
#pragma unroll
                for (int e = 0; e < 16; ++e) { f32x2 a2 = {0.f, 0.f};
#pragma unroll
                    for (int j = 0; j < 4; ++j) { const f32x4 wq = *(const LAS f32x4*)(Wt + e * D + 4 * F.lane + 256 * j);
#pragma unroll
                        for (int c = 0; c < 4; ++c) a2 = __builtin_elementwise_fma(hp[j][c], (f32x2){wq[c], wq[c]}, a2); }
                    accA[e] = a2[0]; accB[e] = a2[1]; if (e & 1) __builtin_amdgcn_sched_barrier(0); }
                float lgA, lgB; ln1_reduce16(accA, F.lane, lgA); ln1_reduce16(accB, F.lane, lgB);
#pragma unroll
                for (int q = 0; q < 2; ++q) { const float lg_e = q ? lgB : lgA;
                    float mx = lg_e; mx = fmaxf(mx, DPP_MOV(mx, 0x4E)); mx = fmaxf(mx, DPP_MOV(mx, 0x128)); mx = fmaxf(mx, lane_xor16(mx)); mx = lane_xor32_max(mx);
                    const float ex = __expf(lg_e - mx); float se = ex; se += DPP_MOV(se, 0x4E); se += DPP_MOV(se, 0x128); se += lane_xor16(se); se = lane_xor32_sum(se);
                    const int eidx = ((F.lane >> 5) << 3) | (((F.lane >> 4) & 1) << 2) | (((F.lane >> 3) & 1) << 1) | ((F.lane >> 1) & 1);
                    if ((F.lane & 5) == 0) { AFF[(rA + q) * NE + eidx] = ex / se; INV[(rA + q) * NE + eidx] = -1; } }
            } } } }
}

__device__ __forceinline__ void topk_item(Frame& F, LAS unsigned* keys, LAS unsigned* hist, int e, int row0  , int n, int cap, int slot0) {
    const float* AFF = (const float*)(F.ws + WS_AFF); int* INV = (int*)(F.ws + WS_INV); int* STOK = (int*)(F.ws + WS_STOK);
    const int nk = n >> 6;
#pragma unroll 4
    for (int k = 0; k < nk; ++k) keys[F.lane + 64 * k] = __float_as_uint(AFF[(size_t)(row0 + F.lane + 64 * k) * NE + e]);
    LDS_WAIT(); asm volatile("" ::: "memory");
    unsigned prefix = 0u, mask = 0u; int krem = cap;
#pragma unroll 1
    for (int pass = 0; pass < 4; ++pass) { const int shift = 24 - 8 * pass;
        *(LAS u32x4*)(hist + 4 * F.lane) = (u32x4){0u, 0u, 0u, 0u};
        LDS_WAIT(); asm volatile("" ::: "memory");
#pragma unroll 4
        for (int k = 0; k < nk; ++k) { const unsigned key = keys[F.lane + 64 * k]; if ((key & mask) == prefix) __hip_atomic_fetch_add(hist + ((key >> shift) & 255u), 1u, __ATOMIC_RELAXED, __HIP_MEMORY_SCOPE_WORKGROUP); }
        LDS_WAIT(); asm volatile("" ::: "memory");
        const u32x4 c = *(const LAS u32x4*)(hist + 4 * F.lane);
        const int s = (int)(c[0] + c[1] + c[2] + c[3]);
        int suf = s;
#pragma unroll
        for (int o = 1; o < 64; o <<= 1) { const int t = __shfl_down(suf, o); if (F.lane + o < 64) suf += t; }
        int cum = suf - s;
        int fbin = -1, fk = 0;
#pragma unroll
        for (int q = 3; q >= 0; --q) { const int cq = (int)c[q]; if (fbin < 0 && cum < krem && cum + cq >= krem) { fbin = 4 * F.lane + q; fk = krem - cum; } cum += cq; }
        const unsigned long long bal = __ballot(fbin >= 0); const int src = bal ? __ffsll((long long)bal) - 1 : 0;
        const int bin = __shfl(fbin, src), nkk = __shfl(fk, src);
        prefix |= (unsigned)bin << shift; mask |= 0xffu << shift; krem = nkk;
        asm volatile("" ::: "memory");
    }
    int nsel = 0, neq = 0;
    const unsigned long long lt = (1ull << F.lane) - 1ull;
#pragma unroll 2
    for (int k = 0; k < nk; ++k) { const unsigned key = keys[F.lane + 64 * k]; const bool gt = key > prefix, eq = key == prefix;
        const unsigned long long be = __ballot(eq); const int eqb = neq + __popcll(be & lt); const bool sel = gt || (eq && eqb < krem);
        const unsigned long long bs = __ballot(sel); const int pos = nsel + __popcll(bs & lt);
        if (sel && pos < cap) { const int row = row0 + F.lane + 64 * k, slot = slot0 + pos; STOK[slot] = row; INV[(size_t)row * NE + e] = slot; }
        nsel += __popcll(bs); neq += __popcll(be); }
    LDS_WAIT(); asm volatile("" ::: "memory");
}
__device__ __forceinline__ void phase_topk_conv(Frame& F, int li, bool skipctx) {
    LAS unsigned* hist = (LAS unsigned*)(F.lds + 8 * 9216 + F.wave * 1024);
#if TOPK_DYN
    LAS unsigned* ctr = (LAS unsigned*)(F.lds + MISC_OFF + 64);
    if (F.tid == 0) *ctr = 0u;
    __syncthreads();
#endif
    if (F.wave < 4) for (int it = F.vcu * 4 + F.wave; it < (skipctx ? 512 : 1024); it += F.G * 4) { const int set = it >> 9, b = (it >> 4) & 31, e = it & 15; LAS unsigned* keys = (LAS unsigned*)(F.lds + F.wave * 9216);
        if (set == 0) topk_item(F, keys, hist, e, b * TPS + CTXL, SEQ, CAPL, (b * NE + e) * CAPL);
        else topk_item(F, keys, hist, e, b * TPS, CTXL, CAPC, NSLOT_L + (e * 4 + (b >> 3)) * 256 + (b & 7) * CAPC); }
    LAS float* scr = (LAS float*)(F.lds + F.wave * 9216);
#if TOPK_DYN
    for (;;) { unsigned k_ = 0; if (F.lane == 0) k_ = __hip_atomic_fetch_add(ctr, 1u, __ATOMIC_RELAXED, __HIP_MEMORY_SCOPE_WORKGROUP); k_ = __builtin_amdgcn_readfirstlane(k_);
        const int it = F.vcu * NWAVES + (int)(k_ & 7u) + (int)(k_ >> 3) * F.ngw; if (it >= 3 * NE * 512) break;
#else
    for (int it = F.gw; it < 3 * NE * 512; it += F.ngw) {
#endif
        const int which = it / (NE * 512), rem = it - which * (NE * 512), e = rem >> 9, item = rem & 511;
        const size_t eoff = ((size_t)li * NE + e) * D * FF;
        if (which == 0) transpose_item_fp8(in_ptr(I_WG) + eoff, FF, WGU_SCALE, (unsigned char*)(F.ws + WS_WGU) + (size_t)e * 2048 * D, D, 0, 1, scr, item, F.lane);
        else if (which == 1) transpose_item_fp8(in_ptr(I_WU) + eoff, FF, WGU_SCALE, (unsigned char*)(F.ws + WS_WGU) + (size_t)e * 2048 * D, D, 128, 1, scr, item, F.lane);
        else transpose_item_fp8(in_ptr(I_WDN) + eoff, D, WDN_SCALE, (unsigned char*)(F.ws + WS_WDN) + (size_t)e * D * FF, FF, 0, 0, scr, item, F.lane); }
}
__device__ __forceinline__ void phase_gather(Frame& F) {
    const bf16_t* H = (const bf16_t*)(F.ws + WS_H); bf16_t* XS = (bf16_t*)(F.ws + WS_R + R_XS); const int* STOK = (const int*)(F.ws + WS_STOK);
    for (int s0 = F.gw * 4; s0 < NSLOT; s0 += F.ngw * 4) { u32x4 v[4][2];
#pragma unroll
        for (int q = 0; q < 4; ++q) { int row = STOK[s0 + q]; row = row < 0 ? 0 : (row >= T ? T - 1 : row); const u32x4* src = (const u32x4*)(H + (size_t)row * D) + F.lane; v[q][0] = src[0]; v[q][1] = src[64]; }
#pragma unroll
        for (int q = 0; q < 4; ++q) { u32x4* dst = (u32x4*)(XS + (size_t)(s0 + q) * D) + F.lane; dst[0] = v[q][0]; dst[64] = v[q][1]; } }
}
template <bool LV, class FN> __device__ __forceinline__ f32x4 ln2_vec(LAS float* VL, int idx4, FN&& fn) { if constexpr (LV) return *((const LAS f32x4*)VL + idx4); else return fn(); }
template <bool LV>
__device__ __forceinline__ void phase_ln2_t(Frame& F, int li, float* xdry, bool skipctx, const float* xin_l, const float* xin_c, const bf16_t* O) {
    const float* mod = (const float*)(F.ws + WS_MOD) + (size_t)li * 33 * MODSZ; const float* modn = mod + (size_t)33 * MODSZ; const bool has_next = li + 1 < NL;
    unsigned char* H8 = (unsigned char*)(F.ws + WS_H); const int* INV = (const int*)(F.ws + WS_INV); const float* AFF = (const float*)(F.ws + WS_AFF); const bf16_t* Y = (const bf16_t*)(F.ws + WS_R + R_XS);
    float* Xl = F.out; float* Xc = (float*)(F.ws + WS_XC); float* Xdl = xdry ? xdry + (size_t)NB * CTXL * D : Xl; float* Xdc = xdry ? xdry : Xc;
#if LN2_LDSV
    LAS float* VL = (LAS float*)F.lds; const int b_wg = (F.vcu * NWAVES) >> 6; constexpr bool ldsv_ok = LV;
    if constexpr (ldsv_ok) { for (int i = F.tid; i < 12 * 256; i += NTHR) { const int id = i >> 8, c4 = i & 255; const float* src;
            if (id == 0) src = in_ptr(I_LMG) + li * D; else if (id == 1) src = in_ptr(I_LMB) + li * D; else if (id == 2) src = in_ptr(I_LFG) + li * D; else if (id == 3) src = in_ptr(I_LFB) + li * D;
            else { const int s_ = (id - 4) >> 2, k_ = (id - 4) & 3; const float* mcur = mod + (size_t)(s_ == 0 ? 32 : b_wg) * MODSZ; const float* mnx = modn + (size_t)(s_ == 0 ? 32 : b_wg) * MODSZ;
                src = k_ == 0 ? mcur + 2 * D : k_ == 1 ? mcur + 5 * D : k_ == 2 ? mnx : mnx + D; if (k_ >= 2 && !has_next) src = mcur; }
            *((LAS f32x4*)VL + i) = *((const f32x4*)src + c4); }
        __syncthreads(); }
#define LN2_VEC(id, j, memexpr) ln2_vec<ldsv_ok>(VL, (id) * 256 + F.lane + 64 * (j), [&]() { return (memexpr); })
#else
#define LN2_VEC(id, j, memexpr) (memexpr)
#endif
#if LN2_NEB > 2 || LN2_LDSV
    const float* pg_ = in_ptr(I_LFG) + li * D; const float* pb_ = in_ptr(I_LFB) + li * D;
#define LN2_LG(j) LN2_VEC(2, j, *((const f32x4*)pg_ + F.lane + 64 * (j)))
#define LN2_LB(j) LN2_VEC(3, j, *((const f32x4*)pb_ + F.lane + 64 * (j)))
#define LN2_G2(j) LN2_VEC(5 + 4 * seg, j, *((const f32x4*)(mv + 5 * D) + F.lane + 64 * (j)))
#else
    f32x4 lg[4], lb[4], g2[4];
    { const float* pg = in_ptr(I_LFG) + li * D; const float* pb = in_ptr(I_LFB) + li * D;
#pragma unroll
      for (int j = 0; j < 4; ++j) { lg[j] = *((const f32x4*)pg + F.lane + 64 * j); lb[j] = *((const f32x4*)pb + F.lane + 64 * j); } }
#define LN2_LG(j) lg[j]
#define LN2_LB(j) lb[j]
#define LN2_G2(j) g2[j]
#endif
    for (int wv = F.gw; wv < 2048; wv += F.ngw) { const int b = wv >> 6, w = wv & 63;
#pragma unroll 1
        for (int seg = skipctx ? 1 : 0; seg < 2; ++seg) { const float* mv = mod + (size_t)(seg == 0 ? 32 : b) * MODSZ; const float* mn = modn + (size_t)(seg == 0 ? 32 : b) * MODSZ;
#if LN2_NEB <= 2 && !LN2_LDSV
#pragma unroll
            for (int j = 0; j < 4; ++j) g2[j] = *((const f32x4*)(mv + 5 * D) + F.lane + 64 * j);
#endif
            const int np = seg == 0 ? 2 : 16, p0 = seg == 0 ? 4 * w : CTXL + 32 * w;
            const float* xio = LN_RECOMP ? (seg == 0 ? xin_c + (size_t)b * CTXL * D : xin_l + ((size_t)b * SEQ - CTXL) * D) : (seg == 0 ? Xc + (size_t)b * CTXL * D : Xl + ((size_t)b * SEQ - CTXL) * D);
            float* xo2 = seg == 0 ? Xdc + (size_t)b * CTXL * D : Xdl + ((size_t)b * SEQ - CTXL) * D;
            int ninv[2]; float naff[2];
#pragma unroll
            for (int q = 0; q < 2; ++q) { ninv[q] = INV[((size_t)b * TPS + p0 + q) * NE + (F.lane & 15)]; naff[q] = AFF[((size_t)b * TPS + p0 + q) * NE + (F.lane & 15)]; }
#pragma unroll 1
            for (int k = 0; k < np; ++k) { const int pA = p0 + 2 * k; const size_t rA = (size_t)b * TPS + pA;
                int myinv[2]; float myaff[2]; f32x4 xv[2][4], f[2][4];
#pragma unroll
                for (int q = 0; q < 2; ++q) { myinv[q] = ninv[q]; myaff[q] = naff[q]; const size_t rn = k + 1 < np ? rA + 2 + q : rA + q; ninv[q] = INV[rn * NE + (F.lane & 15)]; naff[q] = AFF[rn * NE + (F.lane & 15)]; const f32x4* xr = (const f32x4*)(xio + (size_t)(pA + q) * D) + F.lane;
#pragma unroll
                    for (int j = 0; j < 4; ++j) { xv[q][j] = __builtin_nontemporal_load(&xr[64 * j]); f[q][j] = (f32x4){0.f, 0.f, 0.f, 0.f}; } }
                if constexpr (LN_RECOMP != 0) {
                    u32x2 ov[2][4]; float s1[2] = {0.f, 0.f}, s1b[2] = {0.f, 0.f};
#pragma unroll
                    for (int q = 0; q < 2; ++q) { const u32x2* orow = (const u32x2*)(O + (rA + q) * D) + F.lane;
#pragma unroll
                        for (int j = 0; j < 4; ++j) ov[q][j] = __builtin_nontemporal_load(&orow[64 * j]); }
#pragma unroll
                    for (int j = 0; j < 4; ++j) { const f32x4 g1j = LN2_VEC(4 + 4 * seg, j, *((const f32x4*)(mv + 2 * D) + F.lane + 64 * j));
#pragma unroll
                        for (int q = 0; q < 2; ++q) { xv[q][j] = xv[q][j] * ALPHA + g1j * unpack4(ov[q][j]); s1[q] += (xv[q][j][0] + xv[q][j][1]) + (xv[q][j][2] + xv[q][j][3]); } }
#pragma unroll
                    for (int q = 0; q < 2; ++q) { const float mean = wave_sum(s1[q]) * (1.0f / D);
#pragma unroll
                        for (int j = 0; j < 4; ++j) { xv[q][j] = xv[q][j] - mean; s1b[q] += (xv[q][j][0] * xv[q][j][0] + xv[q][j][1] * xv[q][j][1]) + (xv[q][j][2] * xv[q][j][2] + xv[q][j][3] * xv[q][j][3]); } }
                    float rs1[2];
#pragma unroll
                    for (int q = 0; q < 2; ++q) rs1[q] = 1.0f / sqrtf(wave_sum(s1b[q]) * (1.0f / D) + LN_EPS);
#pragma unroll
                    for (int j = 0; j < 4; ++j) { const f32x4 mg = LN2_VEC(0, j, *((const f32x4*)(in_ptr(I_LMG) + li * D) + F.lane + 64 * j)), mb = LN2_VEC(1, j, *((const f32x4*)(in_ptr(I_LMB) + li * D) + F.lane + 64 * j));
#pragma unroll
                        for (int q = 0; q < 2; ++q) xv[q][j] = xv[q][j] * rs1[q] * mg + mb; }
                }
                unsigned msk[2];
#pragma unroll
                for (int q = 0; q < 2; ++q) msk[q] = (unsigned)__ballot(F.lane < 16 && myinv[q] >= 0);
                while (msk[0] | msk[1]) {
                    int sl[2][LN2_NEB]; float gt[2][LN2_NEB]; bool hs[2][LN2_NEB];
#pragma unroll
                    for (int q = 0; q < 2; ++q)
#pragma unroll
                        for (int i = 0; i < LN2_NEB; ++i) { const bool has = msk[q] != 0u; const int e = has ? __builtin_ctz(msk[q]) : 0; msk[q] &= msk[q] - 1u;
                            const int s_ = __builtin_amdgcn_readlane(myinv[q], e); const float g_ = __uint_as_float(__builtin_amdgcn_readlane(__float_as_uint(myaff[q]), e));
                            sl[q][i] = has ? s_ : 0; gt[q][i] = has ? g_ : 0.f; hs[q][i] = has; }
                    u32x2 yv[2][LN2_NEB][4];
#pragma unroll
                    for (int q = 0; q < 2; ++q)
#pragma unroll
                        for (int i = 0; i < LN2_NEB; ++i) { const u32x2* yr = (const u32x2*)(Y + (size_t)sl[q][i] * D) + F.lane;
#if LN2_SKIP
                            if (hs[q][i]) {
#pragma unroll
                            for (int j = 0; j < 4; ++j) yv[q][i][j] = __builtin_nontemporal_load(&yr[64 * j]); }
                            else {
#pragma unroll
                            for (int j = 0; j < 4; ++j) yv[q][i][j] = (u32x2){0u, 0u}; }
#else
#pragma unroll
                            for (int j = 0; j < 4; ++j) yv[q][i][j] = __builtin_nontemporal_load(&yr[64 * j]);
#endif
                        }
#pragma unroll
                    for (int q = 0; q < 2; ++q)
#pragma unroll
                        for (int i = 0; i < LN2_NEB; ++i)
#pragma unroll
                            for (int j = 0; j < 4; ++j) f[q][j] += unpack4(yv[q][i][j]) * gt[q][i];
                }
                f32x4 v[2][4]; float s[2] = {0.f, 0.f}, s2[2] = {0.f, 0.f};
#pragma unroll
                for (int q = 0; q < 2; ++q)
#pragma unroll
                    for (int j = 0; j < 4; ++j) { v[q][j] = xv[q][j] * ALPHA + LN2_G2(j) * f[q][j]; s[q] += (v[q][j][0] + v[q][j][1]) + (v[q][j][2] + v[q][j][3]); }
#pragma unroll
                for (int q = 0; q < 2; ++q) { const float mean = wave_sum(s[q]) * (1.0f / D);
#pragma unroll
                    for (int j = 0; j < 4; ++j) { v[q][j] = v[q][j] - mean; s2[q] += (v[q][j][0] * v[q][j][0] + v[q][j][1] * v[q][j][1]) + (v[q][j][2] * v[q][j][2] + v[q][j][3] * v[q][j][3]); } }
#pragma unroll
                for (int q = 0; q < 2; ++q) { const float rstd = 1.0f / sqrtf(wave_sum(s2[q]) * (1.0f / D) + LN_EPS);
                    f32x4* xw = (f32x4*)(xo2 + (size_t)(pA + q) * D) + F.lane; unsigned* hr = (unsigned*)(H8 + (rA + q) * D) + F.lane;
#pragma unroll
                    for (int j = 0; j < 4; ++j) { v[q][j] = v[q][j] * rstd * LN2_LG(j) + LN2_LB(j); __builtin_nontemporal_store(v[q][j], &xw[64 * j]); if (has_next) { const f32x4 sh1 = LN2_VEC(6 + 4 * seg, j, *((const f32x4*)mn + F.lane + 64 * j)), sc1 = LN2_VEC(7 + 4 * seg, j, *((const f32x4*)(mn + D) + F.lane + 64 * j)); const f32x4 hv = v[q][j] * (1.0f + sc1) + sh1; hr[64 * j] = cvt4_fp8(hv[0], hv[1], hv[2], hv[3]); } } }
            } } }
}
__device__ __forceinline__ void phase_ln2(Frame& F, int li, float* xdry, bool skipctx, const float* xin_l, const float* xin_c, const bf16_t* O) {
#if LN2_LDSV
    if (F.G == 256) phase_ln2_t<true>(F, li, xdry, skipctx, xin_l, xin_c, O); else
#endif
    phase_ln2_t<false>(F, li, xdry, skipctx, xin_l, xin_c, O);
}
#ifndef ATT_V2
#define ATT_V2 0
#endif
template <int DQK, int SD>
__device__ __forceinline__ void phase_attn(Frame& F, int jg, bool skipctx, unsigned long long& pacc) {
    char* lds = (char*)F.lds;
    for (int u = F.vcu; u < (skipctx ? 2048 : 2048 + 256); u += F.G) {
        int b, h, prow, seq;
        if (u < 2048) { b = u >> 6; h = (u >> 3) & 7; prow = CTXL + (u & 7) * 256; seq = TPS; } else { const int q = u - 2048; b = q >> 3; h = q & 7; prow = 0; seq = CTXL; }
        const size_t row0 = (size_t)b * TPS;
        if constexpr (DQK == 128) {
            const bf16_t* QKV = (const bf16_t*)(F.ws + WS_R + R_QKV); unsigned char* AO = (unsigned char*)(F.ws + WS_R + R_AOG);
            const bf16_t* K = QKV + row0 * 1536 + 1024 + (h >> 2) * 128;
#if ATT_V2
            att2::attn_body2<128, 1536, 1536, 64, 1536, D>(QKV + (row0 + prow) * 1536 + h * 128, K, nullptr, K + 256, AO + (row0 + prow) * D + h * 128, seq, F.lds, prow - CTXL, (const float*)(F.ws + WS_ROPE), in_ptr(I_GQG) + jg * 128, pacc);
#else
            att::attn_body<128, SD, 1536, 1536, 64, 1536, D>(QKV + (row0 + prow) * 1536 + h * 128, K, nullptr, K + 256, AO + (row0 + prow) * D + h * 128, seq, lds, prow - CTXL, (const float*)(F.ws + WS_ROPE), in_ptr(I_GQG) + jg * 128);
#endif
        } else {
            const bf16_t* Q = (const bf16_t*)(F.ws + WS_R + R_Q); const bf16_t* KV = (const bf16_t*)(F.ws + WS_R + R_KV); const bf16_t* KR = (const bf16_t*)(F.ws + WS_KR); unsigned char* AO = (unsigned char*)(F.ws + WS_R + R_AOM);
            const bf16_t* K = KV + row0 * 2048 + h * 256;
#if ATT_V2
            att2::attn_body2<192, 1536, 2048, 64, 2048, D>(Q + (row0 + prow) * 1536 + h * 192, K, KR + row0 * 64, K + 128, AO + (row0 + prow) * D + h * 128, seq, F.lds, prow - CTXL, (const float*)(F.ws + WS_ROPE) + 4096, nullptr, pacc);
#else
            att::attn_body<192, SD, 1536, 2048, 64, 2048, D>(Q + (row0 + prow) * 1536 + h * 192, K, KR + row0 * 64, K + 128, AO + (row0 + prow) * D + h * 128, seq, lds, prow - CTXL, (const float*)(F.ws + WS_ROPE) + 4096, nullptr);
#endif
        }
        __syncthreads();
    }
}

#ifndef REP_DENSE
#define REP_DENSE 1
#endif
#ifndef REP_MOE
#define REP_MOE 1
#endif
#ifndef REP_ATTN
#define REP_ATTN 1
#endif
#ifndef REP_THIN
#define REP_THIN 1
#endif
#ifndef REP_LN1
#define REP_LN1 1
#endif
#ifndef REP_LN2
#define REP_LN2 1
#endif
#ifndef REP_QK
#define REP_QK 1
#endif
#ifndef REP_BAR
#define REP_BAR 1
#endif
#ifndef REP_ATTN_M
#define REP_ATTN_M REP_ATTN
#endif
#ifndef REP_ATTN_G
#define REP_ATTN_G REP_ATTN
#endif
#ifndef EN_ALL
#define EN_ALL 1
#endif
#ifndef EN_ATTN_MLA
#define EN_ATTN_MLA 1
#endif
#ifndef EN_ATTN_GQA
#define EN_ATTN_GQA 1
#endif
#ifndef ATT_SD_GQA
#define ATT_SD_GQA 1
#endif
#ifndef EN_UQ
#define EN_UQ 1
#endif
#ifndef EN_UKV
#define EN_UKV 1
#endif
#ifndef EN_P0A
#define EN_P0A EN_ALL
#endif
#ifndef EN_P0B
#define EN_P0B EN_ALL
#endif
#ifndef EN_P0C
#define EN_P0C EN_ALL
#endif
#ifndef EN_PROJ
#define EN_PROJ EN_ALL
#endif
#ifndef EN_THIN1
#define EN_THIN1 EN_ALL
#endif
#ifndef EN_UQKV
#define EN_UQKV EN_ALL
#endif
#ifndef EN_ATTN
#define EN_ATTN EN_ALL
#endif
#ifndef EN_OPROJ
#define EN_OPROJ EN_ALL
#endif
#ifndef EN_LN1
#define EN_LN1 EN_ALL
#endif
#ifndef EN_TOPK
#define EN_TOPK EN_ALL
#endif
#ifndef EN_GATHER
#define EN_GATHER 0
#endif
#ifndef EN_GU
#define EN_GU EN_ALL
#endif
#ifndef EN_DN
#define EN_DN EN_ALL
#endif
#ifndef EN_LN2
#define EN_LN2 EN_ALL
#endif
constexpr int NPH = 3 + NL * 11;
struct Args { const float* in[25]; float* out; unsigned char* ws; int ph_lo, ph_hi; };
__global__ void __launch_bounds__(NTHR, 2) mk_fwd(Args args) {
    extern __shared__ __attribute__((aligned(16))) unsigned char lds_raw[];
    Frame F;
    F.lds = (LAS unsigned char*)lds_raw;
    F.tid = threadIdx.x; F.lane = F.tid & 63; F.wave = __builtin_amdgcn_readfirstlane(F.tid >> 6);
    F.G = gridDim.x; { const int bx = blockIdx.x; F.vcu = (F.G % 8 == 0) ? (bx % 8) * (F.G / 8) + bx / 8 : bx; }
    F.gw = F.vcu * NWAVES + F.wave; F.ngw = F.G * NWAVES;
    F.out = args.out; F.ws = args.ws;
    volatile LAS unsigned* MISC = (volatile LAS unsigned*)(F.lds + MISC_OFF);
    if (F.tid < 4) MISC[F.tid] = 0u;
    __syncthreads();
    const int lo = args.ph_lo, hi = args.ph_hi;
    XcdBarrier bar; bar.bar = (unsigned*)(F.ws + WS_CTL) + CW_BAR; bar.x = 0; bar.st = MISC;
    if (hi - lo > 1) bar = xcd_barrier_post((unsigned*)(F.ws + WS_CTL) + CW_BAR, MISC);
#define IN(k) (lo <= (k) && (k) < hi)
#ifdef PROBE_SEL
#ifndef PROBE_WG
#define PROBE_WG 0
#endif
    unsigned long long pr_acc = 0ull, pr_t0 = 0ull; const bool pr_on = (int)blockIdx.x == PROBE_WG && F.wave == 0;
#define PSTART(g) do { if ((g) == PROBE_SEL && pr_on) pr_t0 = __builtin_amdgcn_s_memrealtime(); } while (0)
#define PEND(g) do { if ((g) == PROBE_SEL && pr_on) pr_acc += __builtin_amdgcn_s_memrealtime() - pr_t0; } while (0)
#else
#define PSTART(g) do { } while (0)
#define PEND(g) do { } while (0)
#endif
#define SEAM(k) do { if ((k) + 1 < hi) { PSTART(11); for (int rb_ = 0; rb_ < REP_BAR; ++rb_) xcd_barrier(bar); PEND(11); } } while (0)
#define SEAMG(k, g) do { if ((k) + 1 < hi) { PSTART(11); PSTART(20 + (g)); for (int rb_ = 0; rb_ < REP_BAR; ++rb_) xcd_barrier(bar); PEND(11); PEND(20 + (g)); } } while (0)
#define PB() do { F.lane = opaque_v(F.lane); F.tid = opaque_v(F.tid); F.gw = opaque_s(F.gw); F.wave = opaque_s(F.wave); F.vcu = opaque_s(F.vcu); } while (0)

#if EN_P0A
    if (IN(0)) { PB(); PSTART(0); _Pragma("unroll 1") for (int rep_ = 0; rep_ < REP_THIN; ++rep_) { phase_p0a(F); __syncthreads(); } PEND(0); SEAMG(0, 0); }
#endif
#if EN_P0B
    if (IN(1)) { PB(); PSTART(0); _Pragma("unroll 1") for (int rep_ = 0; rep_ < REP_THIN; ++rep_) { phase_p0b(F); __syncthreads(); } PEND(0); SEAMG(1, 0); }
#endif
#if EN_P0C
    if (IN(2)) { PB(); PSTART(0); _Pragma("unroll 1") for (int rep_ = 0; rep_ < REP_THIN; ++rep_) { phase_p0c(F); __syncthreads(); } PEND(0); SEAMG(2, 0); }
#endif

#pragma unroll 1
    for (int li = 0; li < NL; ++li) {
        const int pb = 3 + li * 11, j = li >> 1; const bool mla = (li & 1) != 0, lastl = li == NL - 1;
#if EN_PROJ
        if (IN(pb + 0)) { PB(); PSTART(1);
            const int N = mla ? 1280 : 1536;
            pg8::Gemm g{(const bf16_t*)(F.ws + WS_H), (const bf16_t*)(mla ? F.ws + WS_WD + (size_t)j * 1280 * 1024 : F.ws + WS_WQKV + (size_t)j * 1536 * 1024), D / 2, D / 2, D / 2, 0x7a7a7a7a  , (const int*)(F.ws + WS_GVAL)  };
            pg8::StaticOrder S; S.init(T, N, F.G, (int)blockIdx.x); S.rep = REP_DENSE;
            pg8::EpiStore E{(bf16_t*)(F.ws + WS_R), N, 0xffff};
            pg8::gemm_phase<pg8::EpiStore, pg8::StaticOrder, false, true, true>(F.lds, g, S, E, nullptr);
            PEND(1); SEAMG(pb + 0, 1);
        }
#endif
#if EN_THIN1
        if (IN(pb + 1)) { PB(); PSTART(2); _Pragma("unroll 1") for (int rp_ = 0; rp_ < REP_QK; ++rp_) { bf16_t* dry_ = rp_ + 1 < REP_QK ? (bf16_t*)(F.ws + WS_R + 396 * MiB) : nullptr; if (mla) phase_mla_stats(F, dry_); else phase_qknorm(F, j, dry_); __syncthreads(); } PEND(2); SEAMG(pb + 1, 2); }
#endif
#if EN_UQKV
        if (mla && IN(pb + 2)) { PB(); PSTART(3);
#if EN_UQ
            { pg8::Gemm g{(const bf16_t*)(F.ws + WS_CQ8), (const bf16_t*)(F.ws + WS_WUQ + (size_t)j * 1536 * 768), 384, 384, 384, 0x7a7a7a7a  , (const int*)(F.ws + WS_GVAL)  };
              pg8::StaticOrder S; S.init(lastl ? NB * SEQ : T, 1536, F.G, (int)blockIdx.x); S.rep = REP_DENSE; S.skipctx = lastl;
              pg8::EpiStore E{(bf16_t*)(F.ws + WS_R + R_Q), 1536, 0xffff};
              pg8::gemm_phase<pg8::EpiStore, pg8::StaticOrder, false, true, true>(F.lds, g, S, E, nullptr); }
#endif
#if EN_UKV
            { pg8::Gemm g{(const bf16_t*)(F.ws + WS_R + R_CQ) + 768, (const bf16_t*)(F.ws + WS_WUKV) + (size_t)j * 2048 * 256, 1280, 256, 256, 0};
              pg8::StaticOrder S; S.init(T, 2048, F.G, (int)blockIdx.x); S.rep = REP_DENSE;
              pg8::EpiStore E{(bf16_t*)(F.ws + WS_R + R_KV), 2048, 0xffff};
              pg8::gemm_phase<pg8::EpiStore, pg8::StaticOrder>(F.lds, g, S, E, nullptr); }
#endif
            PEND(3); SEAMG(pb + 2, 3);
        }
#endif
#if EN_ATTN
        if (IN(pb + 3)) { PB(); PSTART(4); unsigned long long pa_ = 0ull;
#if EN_ATTN_MLA
            _Pragma("unroll 1") for (int rep_ = 0; rep_ < REP_ATTN_M; ++rep_) { if (mla) phase_attn<192, ATT_SD_MLA>(F, j, lastl, pa_); __syncthreads(); }
#endif
#if EN_ATTN_GQA
            _Pragma("unroll 1") for (int rep_ = 0; rep_ < REP_ATTN_G; ++rep_) { if (!mla) phase_attn<128, ATT_SD_GQA>(F, j, lastl, pa_); __syncthreads(); }
#endif
#if defined(PROBE_SEL) && PROBE_SEL >= 50 && PROBE_SEL <= 59
            if (pr_on) pr_acc += pa_;
#endif
            PEND(4); SEAMG(pb + 3, 4); }
#endif
#if EN_OPROJ
        if (IN(pb + 4)) { PB(); PSTART(5);
            pg8::Gemm g{(const bf16_t*)(F.ws + WS_R + (mla ? R_AOM : R_AOG)), (const bf16_t*)(F.ws + (mla ? WS_WOM : WS_WOG) + (size_t)j * 1024 * 1024), D / 2, D / 2, D / 2, 0x75757575  , (const int*)(F.ws + WS_GVAL)  };
            pg8::StaticOrder S; S.init(lastl ? NB * SEQ : T, D, F.G, (int)blockIdx.x); S.rep = REP_DENSE; S.skipctx = lastl;
            pg8::EpiStore E{(bf16_t*)(F.ws + WS_R + (LN_RECOMP ? R_O2 : (mla ? R_OM : R_OG))), D, 0xffff};
            pg8::gemm_phase<pg8::EpiStore, pg8::StaticOrder, false, true, true>(F.lds, g, S, E, nullptr);
            PEND(5); SEAMG(pb + 4, 5);
        }
#endif
#if EN_LN1
        if (IN(pb + 5)) { PB(); PSTART(6); phase_ln1(F, li, li == 0 ? in_ptr(I_X) : F.out, li == 0 ? in_ptr(I_CTX) : (const float*)(F.ws + WS_XC), (const bf16_t*)(F.ws + WS_R + (LN_RECOMP ? R_O2 : (mla ? R_OM : R_OG))), (float*)(F.ws + WS_R + 396 * MiB), lastl); PEND(6); SEAMG(pb + 5, 6); }
#endif
#if EN_TOPK
        if (IN(pb + 6)) { PB(); PSTART(7); _Pragma("unroll 1") for (int rep_ = 0; rep_ < REP_THIN; ++rep_) { phase_topk_conv(F, li, lastl); __syncthreads(); } PEND(7); SEAMG(pb + 6, 7); }
#endif
#if EN_GATHER
        if (IN(pb + 7)) { PB(); PSTART(12); _Pragma("unroll 1") for (int rep_ = 0; rep_ < REP_THIN; ++rep_) { phase_gather(F); __syncthreads(); } PEND(12); SEAMG(pb + 7, 12); }
#endif
#if EN_GU
        if (IN(pb + 8)) { PB(); PSTART(8);
            pg8::Gemm g{(const bf16_t*)(F.ws + WS_H), (const bf16_t*)(F.ws + WS_WGU), D / 2, D / 2, D / 2, 0x7a7a7a7a  , (const int*)(F.ws + WS_STOK)};
            pg8::MoeOrder S; S.init(8, F.G, (int)blockIdx.x); S.rep = REP_MOE; if (lastl) S.nunits = 512 * 8;
            pg8::EpiSwiGlu E{(unsigned char*)(F.ws + WS_R + R_ACT)};
#if defined(PROBE_SEL) && (PROBE_SEL == 40 || PROBE_SEL == 41)
            { unsigned long long qk_ = 0, qe_ = 0; pg8::gemm_phase_x<pg8::EpiSwiGlu, pg8::MoeOrder, false, true, true, true>(F.lds, g, S, E, nullptr, qk_, qe_); if (pr_on) pr_acc += (PROBE_SEL == 40 ? qk_ : qe_); }
#else
            pg8::gemm_phase<pg8::EpiSwiGlu, pg8::MoeOrder, false, true, true>(F.lds, g, S, E, nullptr);
#endif
            PEND(8); SEAMG(pb + 8, 8);
        }
#endif
#if EN_DN
        if (IN(pb + 9)) { PB(); PSTART(9);
            pg8::Gemm g{(const bf16_t*)(F.ws + WS_R + R_ACT), (const bf16_t*)(F.ws + WS_WDN), FF / 2, FF / 2, FF / 2, 0x79797979  , (const int*)(F.ws + WS_GVAL)  };
            pg8::MoeOrder S; S.init(4, F.G, (int)blockIdx.x); S.rep = REP_MOE; if (lastl) S.nunits = 512 * 4;
            pg8::EpiStore E{(bf16_t*)(F.ws + WS_R + R_XS), D, 3};
#if defined(PROBE_SEL) && (PROBE_SEL == 42 || PROBE_SEL == 43)
            { unsigned long long qk_ = 0, qe_ = 0; pg8::gemm_phase_x<pg8::EpiStore, pg8::MoeOrder, false, true, true, true>(F.lds, g, S, E, nullptr, qk_, qe_); if (pr_on) pr_acc += (PROBE_SEL == 42 ? qk_ : qe_); }
#else
            pg8::gemm_phase<pg8::EpiStore, pg8::MoeOrder, false, true, true>(F.lds, g, S, E, nullptr);
#endif
            PEND(9); SEAMG(pb + 9, 9);
        }
#endif
#if EN_LN2
        if (IN(pb + 10)) { PB(); PSTART(10); _Pragma("unroll 1") for (int rp_ = 0; rp_ < REP_LN2; ++rp_) { phase_ln2(F, li, rp_ + 1 < REP_LN2 ? (float*)(F.ws + WS_R + 288 * MiB) : nullptr, lastl, li == 0 ? in_ptr(I_X) : F.out, li == 0 ? in_ptr(I_CTX) : (const float*)(F.ws + WS_XC), (const bf16_t*)(F.ws + WS_R + R_O2)); __syncthreads(); } PEND(10); SEAMG(pb + 10, 10); }
#endif
    }
#ifdef PROBE_SEL
    if (pr_on) { const unsigned long long tgt = __builtin_amdgcn_s_memrealtime() + pr_acc; while (__builtin_amdgcn_s_memrealtime() < tgt) __builtin_amdgcn_s_sleep(64); }
#endif
#undef IN
#undef SEAM
}

extern "C" void kernel_launch(void* const* d_in, const int* in_sizes, int n_in, void* d_out, int out_size, void* d_ws, size_t ws_size, hipStream_t stream) {
    static int grid = 0;
    if (grid == 0) {
        if (n_in != 25 || out_size != NB * SEQ * D || ws_size < WS_END) { fprintf(stderr, "kernel_launch: shape/workspace mismatch (n_in %d out %d ws %zu need %zu); nothing launched\n", n_in, out_size, ws_size, (size_t)WS_END); grid = -1; return; }
        int dev = 0, cus = 0, per_cu = 0;
        if (hipGetDevice(&dev) != hipSuccess || hipDeviceGetAttribute(&cus, hipDeviceAttributeMultiprocessorCount, dev) != hipSuccess) { grid = -1; return; }
        if (hipFuncSetAttribute((const void*)mk_fwd, hipFuncAttributeMaxDynamicSharedMemorySize, LDS_BYTES) != hipSuccess) { fprintf(stderr, "kernel_launch: hipFuncSetAttribute failed\n"); grid = -1; return; }
        if (hipOccupancyMaxActiveBlocksPerMultiprocessor(&per_cu, (const void*)mk_fwd, NTHR, LDS_BYTES) != hipSuccess || per_cu < 1) { fprintf(stderr, "kernel_launch: occupancy query says %d\n", per_cu); (void)hipGetLastError(); grid = -1; return; }
        grid = cus < 256 ? cus : 256;
    }
    if (grid < 0) return;
    (void)hipMemsetAsync((char*)d_ws + WS_CTL, 0, CTL_ZERO_BYTES, stream);
    Args a{};
    for (int i = 0; i < 25; ++i) a.in[i] = (const float*)d_in[i];
    a.out = (float*)d_out; a.ws = (unsigned char*)d_ws;
#if MK_ONE_LAUNCH
    a.ph_lo = 0; a.ph_hi = NPH;
    hipLaunchKernelGGL(mk_fwd, dim3(grid), dim3(NTHR), LDS_BYTES, stream, a);
#else
    for (int p = 0; p < NPH; ++p) {
        if (p >= 3 && ((p - 3) % 11) == 2 && (((p - 3) / 11) & 1) == 0) continue;
        a.ph_lo = p; a.ph_hi = p + 1;
        hipLaunchKernelGGL(mk_fwd, dim3(grid), dim3(NTHR), LDS_BYTES, stream, a);
    }
#endif
    const hipError_t le = hipPeekAtLastError();
    if (le != hipSuccess) fprintf(stderr, "kernel_launch: launch failed: %s\n", hipGetErrorName(le));
}
```

```cpp
#define MK_ONE_LAUNCH 1
#define ATT_V2 1
#include <hip/hip_runtime.h>
#include <cstdio>
#include <cstdint>

#define LAS __attribute__((address_space(3)))
#define GAS __attribute__((address_space(1)))
typedef unsigned short bf16_t;
typedef short bf16x8 __attribute__((ext_vector_type(8)));
typedef short s16x4 __attribute__((ext_vector_type(4)));
typedef float f32x2 __attribute__((ext_vector_type(2)));
typedef float f32x4 __attribute__((ext_vector_type(4)));
typedef float f32x16 __attribute__((ext_vector_type(16)));
typedef unsigned u32x2 __attribute__((ext_vector_type(2)));
typedef unsigned u32x4 __attribute__((ext_vector_type(4)));

#ifndef REP_LN1
#define REP_LN1 1
#endif
#ifndef MK_ONE_LAUNCH
#define MK_ONE_LAUNCH 1
#endif

constexpr int D = 1024, NB = 32, SEQ = 2048, CTXL = 256, TPS = SEQ + CTXL  , T = NB * TPS  , NL = 4;
constexpr int NE = 16, FF = 1024, CAPL = 256, CAPC = 32;
constexpr int NSLOT_L = NB * NE * CAPL  , NSLOT = NSLOT_L + NB * NE * CAPC  , NPANEL = NSLOT / 256  ;
constexpr float ALPHA = 1.6817928305074292f, LN_EPS = 1e-6f;
constexpr int NWAVES = 8, NTHR = 512;
constexpr int MODSZ = 6 * D;
constexpr int MOD_KC = 16;

constexpr size_t MiB = 1u << 20;
constexpr size_t WS_CTL = 0, CTL_ZERO_BYTES = 64 * 1024;
constexpr size_t WS_MOD = 1 * MiB;
constexpr size_t WS_ROPE = 5 * MiB;
constexpr size_t WS_WQKV = 6 * MiB;
constexpr size_t WS_WOG = 12 * MiB;
constexpr size_t WS_WD = 16 * MiB;
constexpr size_t WS_WUQ = 21 * MiB;
constexpr size_t WS_WUKV = 26 * MiB;
constexpr size_t WS_WOM = 28 * MiB;
constexpr size_t WS_WGU = 32 * MiB;
constexpr size_t WS_WDN = 96 * MiB;
constexpr size_t WS_XC = 128 * MiB;
constexpr size_t WS_H = 160 * MiB;
constexpr size_t WS_CQ8 = WS_H + 72 * MiB;
constexpr size_t WS_AFF = 304 * MiB;
constexpr size_t WS_INV = 309 * MiB;
constexpr size_t WS_GVAL = 314 * MiB;
constexpr size_t WS_STOK = 315 * MiB;
constexpr size_t WS_RS = 316 * MiB;
constexpr size_t WS_KR = 317 * MiB;
constexpr size_t WS_R = 326 * MiB;
constexpr size_t R_QKV = 0, R_AOG = 216 * MiB, R_OG = 0;
constexpr size_t R_CQ = 0, R_Q = 180 * MiB, R_KV = 396 * MiB, R_AOM = 0, R_OM = 180 * MiB;
constexpr size_t R_O2 = 432 * MiB;
constexpr size_t R_XS = 0, R_ACT = 288 * MiB;
constexpr size_t R_MODP = 0;
constexpr size_t WS_END = WS_R + 684 * MiB;
static_assert((size_t)T * 2048 * 2 == 288 * MiB && (size_t)NSLOT * 1024 * 2 == 288 * MiB && (size_t)T * 1536 * 2 == 216 * MiB && (size_t)T * 1280 * 2 == 180 * MiB, "sizes");
constexpr int CW_BAR = 4096;

constexpr int RING_BYTES = 131072;
constexpr int LDS_BYTES = 163840;
constexpr int MISC_OFF = LDS_BYTES - 256;

__device__ __forceinline__ float bf2f(unsigned b) { return __uint_as_float(b << 16); }
__device__ __forceinline__ unsigned cvt_pk_bf16(float lo, float hi) { unsigned r; asm volatile("v_cvt_pk_bf16_f32 %0, %1, %2" : "=v"(r) : "v"(lo), "v"(hi)); return r; }
#define DPP_MOV(v, ctrl) __builtin_bit_cast(float, __builtin_amdgcn_update_dpp(0, __builtin_bit_cast(int, (float)(v)), (ctrl), 0xf, 0xf, true))
__device__ __forceinline__ float lane_xor16(float v) { return __builtin_bit_cast(float, __builtin_amdgcn_ds_swizzle(__builtin_bit_cast(int, v), 0x401F)); }
__device__ __forceinline__ float wave_sum(float v) {
    v += DPP_MOV(v, 0xB1);
    v += DPP_MOV(v, 0x4E);
    v += DPP_MOV(v, 0x141);
    v += DPP_MOV(v, 0x140);
    v += lane_xor16(v);
    { auto rr = __builtin_amdgcn_permlane32_swap(__float_as_uint(v), __float_as_uint(v), false, false); v = __uint_as_float(rr[0]) + __uint_as_float(rr[1]); }
    return v;
}
#define LDS_WAIT() asm volatile("s_waitcnt lgkmcnt(0)" ::: "memory")
#define VM_WAIT() asm volatile("s_waitcnt vmcnt(0)" ::: "memory")
__device__ __forceinline__ int opaque_v(int x) { asm volatile("" : "+v"(x)); return x; }
__device__ __forceinline__ int opaque_s(int x) { asm volatile("" : "+s"(x)); return x; }
__device__ __forceinline__ const float* in_ptr(int i) {
    const __attribute__((address_space(4))) char* kp = (const __attribute__((address_space(4))) char*)__builtin_amdgcn_kernarg_segment_ptr();
    const int off = opaque_s(i * 8);
    return *(const float* const __attribute__((address_space(4)))*)(kp + off);
}
__device__ __forceinline__ unsigned cvt4_fp8(float a, float b, float c, float d) {
    a = __builtin_fminf(__builtin_fmaxf(a, -448.f), 448.f); b = __builtin_fminf(__builtin_fmaxf(b, -448.f), 448.f); c = __builtin_fminf(__builtin_fmaxf(c, -448.f), 448.f); d = __builtin_fminf(__builtin_fmaxf(d, -448.f), 448.f);
    int w = 0; w = __builtin_amdgcn_cvt_pk_fp8_f32(a, b, w, false); w = __builtin_amdgcn_cvt_pk_fp8_f32(c, d, w, true); return (unsigned)w;
}
constexpr float WGU_SCALE = 32.f, WDN_SCALE = 64.f, WP_SCALE = 32.f, WO_SCALE = 64.f, AO_SCALE = 16.f;
#ifndef ATT_SD_MLA
#define ATT_SD_MLA 1
#endif
#define XB_TMO      128
#define XB_XCNT(j)  (256  + 64 * (j))
#define XB_XSUB(j)  (1280 + 64 * (j))
#define XB_XGEN(j)  (2304 + 64 * (j))
#define XB_TOP      3328
#define XB_TOPGEN   3392
#define XCD_BAR_WORDS 3456
#define XB_SPIN_CAP (1u << 18)

__device__ __forceinline__ unsigned xb_ld(unsigned* p)              { return __hip_atomic_load(p, __ATOMIC_RELAXED, __HIP_MEMORY_SCOPE_AGENT); }
__device__ __forceinline__ unsigned xb_add(unsigned* p, unsigned v) { return __hip_atomic_fetch_add(p, v, __ATOMIC_RELAXED, __HIP_MEMORY_SCOPE_AGENT); }
__device__ __forceinline__ unsigned xb_xcc_id() { return (unsigned)__builtin_amdgcn_s_getreg((3 << 11) | 20) & 0xFu; }
#define XB_SPIN(cond, bar) do { unsigned _sp = 0; while (cond) { __builtin_amdgcn_s_sleep(1); \
    if ((++_sp & 255u) == 0u) { if (xb_ld(&(bar)[XB_TMO])) break; if (_sp > XB_SPIN_CAP) { atomicAdd(&(bar)[XB_TMO], 1u); break; } } } } while (0)

struct XcdBarrier {
    unsigned* bar; unsigned x;
    volatile LAS unsigned* st;
};

__device__ __forceinline__ XcdBarrier xcd_barrier_post(unsigned* bar, volatile LAS unsigned* st) {
    XcdBarrier b; b.bar = bar; b.x = xb_xcc_id(); b.st = st;
    if (threadIdx.x == 0) (void)xb_add(&bar[XB_XCNT(b.x)], 1u);
    return b;
}
__device__ __forceinline__ void xcd_barrier_complete(unsigned* bar, unsigned x, unsigned& nloc, unsigned& nx) {
    const unsigned G = gridDim.x * gridDim.y * gridDim.z;
    unsigned sum, cnt, mine, sp = 0u;
    for (;;) {
        sum = 0u; cnt = 0u; mine = 0u;
#pragma unroll
        for (unsigned j = 0; j < 16; ++j) { const unsigned c = xb_ld(&bar[XB_XCNT(j)]); sum += c; cnt += (c > 0u) ? 1u : 0u; mine = (j == x) ? c : mine; }
        if (sum == G) break;
        __builtin_amdgcn_s_sleep(1);
        if ((++sp & 255u) == 0u) { if (xb_ld(&bar[XB_TMO])) break; if (sp > XB_SPIN_CAP) { atomicAdd(&bar[XB_TMO], 1u); break; } }
    }
    nloc = mine > 0u ? mine : 1u; nx = cnt > 0u ? cnt : 1u;
}

__device__ __forceinline__ void xcd_barrier(const XcdBarrier& b) {
    asm volatile("s_waitcnt vmcnt(0)" ::: "memory");
    __syncthreads();
    if (threadIdx.x == 0) {
        unsigned* bar = b.bar;
        __builtin_amdgcn_s_waitcnt(0);
        unsigned nloc = b.st[0], nx = b.st[1];
        if (nloc == 0u) { xcd_barrier_complete(bar, b.x, nloc, nx); b.st[0] = nloc; b.st[1] = nx; }
        const unsigned old = xb_add(&bar[XB_XSUB(b.x)], 1u);
        const unsigned gen = old / nloc;
        if (old + 1u == (gen + 1u) * nloc) {
            __builtin_amdgcn_fence(__ATOMIC_RELEASE, "agent");
            asm volatile("s_waitcnt vmcnt(0)" ::: "memory");
            const unsigned og = xb_add(&bar[XB_TOP], 1u);
            const unsigned tg = og / nx;
            if (og + 1u == (tg + 1u) * nx) xb_add(&bar[XB_TOPGEN], 1u);
            else XB_SPIN(xb_ld(&bar[XB_TOPGEN]) == tg, bar);
            __builtin_amdgcn_fence(__ATOMIC_ACQUIRE, "agent");
            xb_add(&bar[XB_XGEN(b.x)], 1u);
            asm volatile("s_waitcnt vmcnt(0)" ::: "memory");
        } else {
            XB_SPIN(xb_ld(&bar[XB_XGEN(b.x)]) == gen, bar);
            __builtin_amdgcn_fence(__ATOMIC_ACQUIRE, "agent");
            asm volatile("s_waitcnt vmcnt(0)" ::: "memory");
        }
    }
    __syncthreads();
}

namespace pg8 {
#define PG8_LAS __attribute__((address_space(3)))
constexpr int BM = 256, BK = 64, HALF = 128, HTB = HALF * BK * 2  , STAGE_BYTES = 8 * HTB, NXCD = 8, WGM = 8;

__host__ __device__ __forceinline__ int lds_byte(int r, int c) { const int st = (r >> 4) * 2 + (c >> 5), rr = r & 15, cc = c & 31, ob = rr * 64 + cc * 2; return st * 1024 + (ob ^ (((ob >> 9) & 1) << 5)); }
__host__ __device__ __forceinline__ void stage_rc(int b, int& R, int& C) { const int st = b / 1024, sb = b % 1024, swz = sb ^ (((sb >> 9) & 1) << 5); R = (st >> 1) * 16 + swz / 64; C = (st & 1) * 32 + (swz % 64) / 2; }
__host__ __device__ __forceinline__ int perm32(int rho) { const int n = rho >> 4, i = rho & 15; return 8 * (i >> 2) + 4 * n + (i & 3); }

struct Unit { int pm, pn; };
struct Gemm { const bf16_t* A; const bf16_t* Bt; int lda, ldb, K; int pad; const int* ridx = nullptr; };

struct StaticOrder {
    int nM, nN, nwg, G, c, rep; bool skipctx;
    __host__ __device__ void init(int M, int N, int G_, int c_) { nM = M / BM; nN = N / BM; nwg = nM * nN; G = G_; c = c_; rep = 1; skipctx = false; }
    __host__ __device__ bool next(int i, Unit& u) const {
        const long L = (long)(i / rep) * G + c; if (L >= nwg) return false;
        int wgid = (int)L; { const int q = nwg / NXCD, r = nwg % NXCD, xcd = wgid % NXCD, off = wgid / NXCD; wgid = (xcd < r ? xcd * (q + 1) : r * (q + 1) + (xcd - r) * q) + off; }
        const int nig = WGM * nN, gid = wgid / nig, fm = gid * WGM, gsz = (nM - fm) < WGM ? (nM - fm) : WGM;
        u.pm = fm + ((wgid % nig) % gsz); u.pn = (wgid % nig) / gsz; if (skipctx) u.pm = (u.pm >> 3) * 9 + 1 + (u.pm & 7); return true;
    }
    __device__ __forceinline__ void a_ready(const Unit&) const {}
    __device__ __forceinline__ void done(const Unit&) const {}
};
typedef int pg8_v8i __attribute__((ext_vector_type(8)));
#ifdef PROBE_CLK
#define PG8_PROBE_NOW() (__builtin_amdgcn_s_memtime() / 20ull)
#else
#define PG8_PROBE_NOW() __builtin_amdgcn_s_memrealtime()
#endif
#ifndef PG8_DMAMMA
#define PG8_DMAMMA 0
#endif
#ifndef PG8_BUF
#define PG8_BUF 0
#endif
__device__ __forceinline__ __amdgpu_buffer_rsrc_t pg8_rsrc(const void* p) {
    const unsigned long long v = (unsigned long long)(size_t)p; const unsigned lo = __builtin_amdgcn_readfirstlane((unsigned)v), hi = __builtin_amdgcn_readfirstlane((unsigned)(v >> 32));
    return __builtin_amdgcn_make_buffer_rsrc((void*)(size_t)(((unsigned long long)hi << 32) | lo), 0, -1, 0x00020000);
}
template <class Epi, class Sched, bool STAMP, bool GATHER, bool FP8, bool PRB>
__device__ __forceinline__ void gemm_phase_x(PG8_LAS unsigned char* lds, const Gemm g, const Sched& S, const Epi& E, unsigned long long* stamps, unsigned long long& pk, unsigned long long& pe);
template <class Epi, class Sched, bool STAMP = false, bool GATHER = false, bool FP8 = false>
__device__ __forceinline__ void gemm_phase(PG8_LAS unsigned char* lds, const Gemm g, const Sched& S, const Epi& E, unsigned long long* stamps) { unsigned long long a_ = 0, b_ = 0; gemm_phase_x<Epi, Sched, STAMP, GATHER, FP8, false>(lds, g, S, E, stamps, a_, b_); }
template <class Epi, class Sched, bool STAMP, bool GATHER, bool FP8, bool PRB>
__device__ __forceinline__ void gemm_phase_x(PG8_LAS unsigned char* lds, const Gemm g, const Sched& S, const Epi& E, unsigned long long* stamps, unsigned long long& pk, unsigned long long& pe) {
    unsigned long long pt_ = 0;
    const int tid = opaque_v((int)threadIdx.x), wid = __builtin_amdgcn_readfirstlane(tid >> 6), lane = tid & 63, wr = wid >> 2, wc = wid & 3, fr = lane & 15, fq = lane >> 4;
    const int K = g.K, nt = K / BK;
    const int wscale = g.pad;
    int ts_lo = 0, ts_hi = 0, nts = 0; const unsigned long long rt_entry = STAMP ? (unsigned long long)wall_clock64() : 0ull;
#define PG8_STAMP() do { if (STAMP && wid == 0 && nts < 64) { const unsigned long long _c = (unsigned long long)clock64(); \
        ts_lo = (lane == nts) ? (int)(unsigned)_c : ts_lo; ts_hi = (lane == nts) ? (int)(unsigned)(_c >> 32) : ts_hi; ++nts; } } while (0)
    PG8_STAMP();
    unsigned voffA[2], voffB[2];
#pragma unroll
    for (int i = 0; i < 2; ++i) { int R, C; stage_rc(tid * 16 + i * 8192, R, C); const int Rb = Epi::PERM ? ((R & ~31) + perm32(R & 31)) : R;
        voffA[i] = GATHER ? (unsigned)C * 2u : (unsigned)(R * g.lda + C) * 2u; voffB[i] = (unsigned)(Rb * g.ldb + C) * 2u; }
    unsigned vs[2][2];
#define PG8_LDRAW(pm_) do { if (wid < 4) __builtin_amdgcn_global_load_lds((const unsigned*)(g.ridx + ((pm_) * BM + wid * 64 + lane)), (PG8_LAS unsigned*)(lds + STAGE_BYTES + wid * 256), 4, 0, 0); } while (0)
#define PG8_CONV(vo) do { _Pragma("unroll") for (int _h = 0; _h < 2; ++_h) _Pragma("unroll") for (int _i = 0; _i < 2; ++_i) { int _R, _C; stage_rc(tid * 16 + _i * 8192, _R, _C); \
        int _v = *(const PG8_LAS int*)(lds + STAGE_BYTES + (_h * HALF + _R) * 4); _v = _v < 0 ? 0 : _v; (vo)[_h][_i] = (unsigned)_v * (unsigned)(g.lda * 2) + voffA[_i]; } } while (0)
    const size_t kstep = (size_t)(BK * 2);
    const size_t hstepA = (size_t)HALF * g.lda * 2, hstepB = (size_t)HALF * g.ldb * 2;
    const size_t tstepA = GATHER ? 0 : 2 * hstepA, tstepB = 2 * hstepB;
    const unsigned ldsw = (unsigned)wid * 1024u;
    const int aoff = lds_byte(wr * 64 + fr, fq * 8), boff = lds_byte(wc * 32 + fr, fq * 8);
#define PG8_SA(b, h) (((b) * 2 + (h)) * HTB)
#define PG8_SB(b, h) ((4 + (b) * 2 + (h)) * HTB)
#if PG8_BUF
    const __amdgpu_buffer_rsrc_t rsA = pg8_rsrc(g.A), rsB = pg8_rsrc(g.Bt);
#define PG8_STAGE_R(rs, base0, bufoff, gbase, voff) do { const int _so = __builtin_amdgcn_readfirstlane((int)(unsigned)((const char*)(gbase) - (const char*)(base0))); _Pragma("unroll") for (int _i = 0; _i < 2; ++_i) \
        __builtin_amdgcn_raw_ptr_buffer_load_lds(rs, (PG8_LAS void*)(lds + (bufoff) + ldsw + _i * 8192), 16, (int)(voff)[_i], _so, 0, 0); } while (0)
#define PG8_STAGE(bufoff, gbase, voff) PG8_STAGE_R(rsB, g.Bt, bufoff, gbase, voff)
#define PG8_STAGEA(bufoff, base, half, vsel) do { if constexpr (GATHER) PG8_STAGE_R(rsA, g.A, bufoff, base, vsel[half]); else PG8_STAGE_R(rsA, g.A, bufoff, (base) + (half) * hstepA, voffA); } while (0)
#else
#define PG8_STAGE(bufoff, gbase, voff) do { _Pragma("unroll") for (int _i = 0; _i < 2; ++_i) \
        __builtin_amdgcn_global_load_lds((const unsigned*)((const char*)(gbase) + (voff)[_i]), (PG8_LAS unsigned*)(lds + (bufoff) + ldsw + _i * 8192), 16, 0, 0); } while (0)
#define PG8_STAGEA(bufoff, base, half, vsel) do { if constexpr (GATHER) PG8_STAGE(bufoff, base, vsel[half]); else PG8_STAGE(bufoff, (base) + (half) * hstepA, voffA); } while (0)
#endif
#define PG8_LDA(dst, b, h) do { if constexpr (FP8) { _Pragma("unroll") for (int m = 0; m < 4; ++m) { const u32x4 lo_ = *(const PG8_LAS u32x4*)(lds + PG8_SA(b, h) + aoff + m * 2048), hi_ = *(const PG8_LAS u32x4*)(lds + PG8_SA(b, h) + aoff + m * 2048 + 1024); \
        dst##8[m] = __builtin_bit_cast(pg8_v8i, __builtin_shufflevector(lo_, hi_, 0, 1, 2, 3, 4, 5, 6, 7)); } } \
    else { _Pragma("unroll") for (int m = 0; m < 4; ++m) _Pragma("unroll") for (int k = 0; k < 2; ++k) dst[m][k] = *(const PG8_LAS bf16x8*)(lds + PG8_SA(b, h) + aoff + m * 2048 + k * 1024); } } while (0)
#define PG8_LDB(dst, b, h) do { if constexpr (FP8) { _Pragma("unroll") for (int n = 0; n < 2; ++n) { const u32x4 lo_ = *(const PG8_LAS u32x4*)(lds + PG8_SB(b, h) + boff + n * 2048), hi_ = *(const PG8_LAS u32x4*)(lds + PG8_SB(b, h) + boff + n * 2048 + 1024); \
        dst##8[n] = __builtin_bit_cast(pg8_v8i, __builtin_shufflevector(lo_, hi_, 0, 1, 2, 3, 4, 5, 6, 7)); } } \
    else { _Pragma("unroll") for (int n = 0; n < 2; ++n) _Pragma("unroll") for (int k = 0; k < 2; ++k) dst[n][k] = *(const PG8_LAS bf16x8*)(lds + PG8_SB(b, h) + boff + n * 2048 + k * 1024); } } while (0)
#define PG8_MMA(ai, bj, At, Bt) do { __builtin_amdgcn_s_setprio(1); _Pragma("unroll") for (int m = 0; m < 4; ++m) _Pragma("unroll") for (int n = 0; n < 2; ++n) _Pragma("unroll") for (int k = 0; k < 2; ++k) \
        acc[ai][bj][m][n] = __builtin_amdgcn_mfma_f32_16x16x32_bf16(Bt[n][k], At[m][k], acc[ai][bj][m][n], 0, 0, 0); __builtin_amdgcn_s_setprio(0); } while (0)
#define PG8_MMA8(ai, bj, At, Bt) do { __builtin_amdgcn_s_setprio(1); _Pragma("unroll") for (int m = 0; m < 4; ++m) _Pragma("unroll") for (int n = 0; n < 2; ++n) \
        acc[ai][bj][m][n] = __builtin_amdgcn_mfma_scale_f32_16x16x128_f8f6f4(Bt##8[n], At##8[m], acc[ai][bj][m][n], 0, 0, 0, wscale, 0, 0x7f7f7f7f); \
        __builtin_amdgcn_s_setprio(0); } while (0)
#define PG8_MMX(ai, bj, At, Bt) do { if constexpr (FP8) PG8_MMA8(ai, bj, At, Bt); else PG8_MMA(ai, bj, At, Bt); } while (0)
#define PG8_PIECE(bufoff, gbase, voff, i) __builtin_amdgcn_global_load_lds((const unsigned*)((const char*)(gbase) + (voff)[i]), (PG8_LAS unsigned*)(lds + (bufoff) + ldsw + (i) * 8192), 16, 0, 0)
#define PG8_PIECEB(bufoff, gbase, i) PG8_PIECE(bufoff, gbase, voffB, i)
#define PG8_PIECEA(bufoff, base, half, i) do { if constexpr (GATHER) PG8_PIECE(bufoff, base, vs[half], i); else PG8_PIECE(bufoff, (base) + (half) * hstepA, voffA, i); } while (0)
#define PG8_MF8(ai, bj, At, Bt, m, n) acc[ai][bj][m][n] = __builtin_amdgcn_mfma_scale_f32_16x16x128_f8f6f4(Bt##8[n], At##8[m], acc[ai][bj][m][n], 0, 0, 0, wscale, 0, 0x7f7f7f7f)
#define PG8_MF16(ai, bj, At, Bt, m, n) do { acc[ai][bj][m][n] = __builtin_amdgcn_mfma_f32_16x16x32_bf16(Bt[n][0], At[m][0], acc[ai][bj][m][n], 0, 0, 0); acc[ai][bj][m][n] = __builtin_amdgcn_mfma_f32_16x16x32_bf16(Bt[n][1], At[m][1], acc[ai][bj][m][n], 0, 0, 0); } while (0)
#define PG8_MF(ai, bj, At, Bt, m, n) do { if constexpr (FP8) PG8_MF8(ai, bj, At, Bt, m, n); else PG8_MF16(ai, bj, At, Bt, m, n); } while (0)
#define PG8_MMXS(ai, bj, At, Bt, S0, S1) do { __builtin_amdgcn_s_setprio(1); PG8_MF(ai, bj, At, Bt, 0, 0); PG8_MF(ai, bj, At, Bt, 0, 1); PG8_SCHED; S0; PG8_SCHED; \
        PG8_MF(ai, bj, At, Bt, 1, 0); PG8_MF(ai, bj, At, Bt, 1, 1); PG8_MF(ai, bj, At, Bt, 2, 0); PG8_SCHED; S1; PG8_SCHED; PG8_MF(ai, bj, At, Bt, 2, 1); PG8_MF(ai, bj, At, Bt, 3, 0); PG8_MF(ai, bj, At, Bt, 3, 1); \
        __builtin_amdgcn_s_setprio(0); } while (0)
#define PG8_WAIT_V(n) asm volatile("s_waitcnt vmcnt(" #n ")" ::: "memory")
#define PG8_WAIT_L(n) asm volatile("s_waitcnt lgkmcnt(" #n ")" ::: "memory")
#define PG8_BAR __builtin_amdgcn_s_barrier()
#define PG8_SCHED __builtin_amdgcn_sched_barrier(0)
    Unit cur, nxt; int ui = 0;
    if (!S.next(0, cur)) return;
    f32x4 acc[2][2][4][2];
#pragma unroll
    for (int a = 0; a < 2; ++a)
#pragma unroll
        for (int b = 0; b < 2; ++b)
#pragma unroll
            for (int m = 0; m < 4; ++m)
#pragma unroll
                for (int n = 0; n < 2; ++n) acc[a][b][m][n] = (f32x4){0.f, 0.f, 0.f, 0.f};
    bf16x8 At[4][2], B0[2][2], B1[2][2]; pg8_v8i At8[4], B08[2], B18[2];
    const char* cA = (const char*)g.A + (size_t)cur.pm * tstepA; const char* cB = (const char*)g.Bt + (size_t)cur.pn * tstepB;
    S.a_ready(cur);
    if constexpr (GATHER) { PG8_LDRAW(cur.pm); asm volatile("s_waitcnt vmcnt(0)" ::: "memory"); __builtin_amdgcn_s_barrier(); asm volatile("" ::: "memory"); PG8_CONV(vs); asm volatile("s_waitcnt lgkmcnt(0)" ::: "memory"); __builtin_amdgcn_s_barrier(); }
    PG8_STAGE(PG8_SB(0, 0), cB, voffB); PG8_STAGEA(PG8_SA(0, 0), cA, 0, vs); PG8_STAGE(PG8_SB(0, 1), cB + hstepB, voffB); PG8_STAGEA(PG8_SA(0, 1), cA, 1, vs);
    if (wr == 1) PG8_BAR;
    PG8_WAIT_V(4); PG8_BAR;
    PG8_STAGE(PG8_SB(1, 0), cB + kstep, voffB); PG8_STAGEA(PG8_SA(1, 0), cA + kstep, 0, vs); PG8_STAGE(PG8_SB(1, 1), cB + hstepB + kstep, voffB);
    PG8_WAIT_V(6); PG8_BAR;
    PG8_STAMP();
    for (;;) {
        if constexpr (PRB) { if (wid == 0) pt_ = PG8_PROBE_NOW(); }
        const bool has_next = S.next(ui + 1, nxt);
        if constexpr (GATHER) { if (has_next) PG8_LDRAW(nxt.pm); }
        const char* nA = has_next ? (const char*)g.A + (size_t)nxt.pm * tstepA : cA; const char* nB = has_next ? (const char*)g.Bt + (size_t)nxt.pn * tstepB : cB;
#pragma unroll 1
        for (int t = 0; t < nt; t += 2) {
            const bool last = (t == nt - 2);
            const char* a1 = cA + (size_t)(t + 1) * kstep;
            const char* a2 = last ? nA : cA + (size_t)(t + 2) * kstep; const char* b2 = last ? nB : cB + (size_t)(t + 2) * kstep;
            const char* a3 = a2 + kstep; const char* b3 = b2 + kstep;
            if (last && has_next) S.a_ready(nxt);
#if PG8_DMAMMA
            PG8_LDB(B0, 0, 0); PG8_SCHED; PG8_LDA(At, 0, 0);
            PG8_WAIT_L(8); PG8_BAR; PG8_WAIT_L(0); PG8_MMXS(0, 0, At, B0, PG8_PIECEA(PG8_SA(1, 1), a1, 1, 0), PG8_PIECEA(PG8_SA(1, 1), a1, 1, 1)); PG8_BAR; PG8_SCHED;
            PG8_LDB(B1, 0, 1);
            if constexpr (GATHER) { if (last && has_next) { PG8_CONV(vs); asm volatile("" : "+v"(vs[0][0]), "+v"(vs[0][1]), "+v"(vs[1][0]), "+v"(vs[1][1])); } }
            PG8_BAR; PG8_WAIT_L(0); PG8_MMXS(0, 1, At, B1, PG8_PIECEB(PG8_SB(0, 0), b2, 0), PG8_PIECEB(PG8_SB(0, 0), b2, 1)); PG8_BAR;
            PG8_LDA(At, 0, 1);
            PG8_BAR; PG8_WAIT_L(0); PG8_MMXS(1, 0, At, B0, PG8_PIECEA(PG8_SA(0, 0), a2, 0, 0), PG8_PIECEA(PG8_SA(0, 0), a2, 0, 1)); PG8_BAR; PG8_SCHED;
            PG8_WAIT_V(4); PG8_BAR; PG8_MMXS(1, 1, At, B1, PG8_PIECEB(PG8_SB(0, 1), b2 + hstepB, 0), PG8_PIECEB(PG8_SB(0, 1), b2 + hstepB, 1)); PG8_BAR;
            PG8_LDB(B0, 1, 0); PG8_SCHED; PG8_LDA(At, 1, 0);
            PG8_WAIT_L(8); PG8_BAR; PG8_WAIT_L(0); PG8_MMXS(0, 0, At, B0, PG8_PIECEA(PG8_SA(0, 1), a2, 1, 0), PG8_PIECEA(PG8_SA(0, 1), a2, 1, 1)); PG8_BAR; PG8_SCHED;
            PG8_LDB(B1, 1, 1);
            PG8_BAR; PG8_WAIT_L(0); PG8_MMXS(0, 1, At, B1, PG8_PIECEB(PG8_SB(1, 0), b3, 0), PG8_PIECEB(PG8_SB(1, 0), b3, 1)); PG8_BAR;
            PG8_LDA(At, 1, 1);
            PG8_BAR; PG8_WAIT_L(0); PG8_MMXS(1, 0, At, B0, PG8_PIECEA(PG8_SA(1, 0), a3, 0, 0), PG8_PIECEA(PG8_SA(1, 0), a3, 0, 1)); PG8_BAR; PG8_SCHED;
            PG8_WAIT_V(4); PG8_BAR; PG8_MMXS(1, 1, At, B1, PG8_PIECEB(PG8_SB(1, 1), b3 + hstepB, 0), PG8_PIECEB(PG8_SB(1, 1), b3 + hstepB, 1)); PG8_BAR;
#else
            PG8_LDB(B0, 0, 0); PG8_SCHED; PG8_LDA(At, 0, 0); PG8_STAGEA(PG8_SA(1, 1), a1, 1, vs);
            if constexpr (GATHER) { if (last && has_next) { PG8_CONV(vs); asm volatile("" : "+v"(vs[0][0]), "+v"(vs[0][1]), "+v"(vs[1][0]), "+v"(vs[1][1])); } }
            PG8_WAIT_L(8); PG8_BAR; PG8_WAIT_L(0); PG8_MMX(0, 0, At, B0); PG8_BAR; PG8_SCHED;
            PG8_LDB(B1, 0, 1); PG8_STAGE(PG8_SB(0, 0), b2, voffB);
            PG8_BAR; PG8_WAIT_L(0); PG8_MMX(0, 1, At, B1); PG8_BAR;
            PG8_LDA(At, 0, 1); PG8_STAGEA(PG8_SA(0, 0), a2, 0, vs);
            PG8_BAR; PG8_WAIT_L(0); PG8_MMX(1, 0, At, B0); PG8_BAR; PG8_SCHED;
            PG8_STAGE(PG8_SB(0, 1), b2 + hstepB, voffB);
            PG8_WAIT_V(6); PG8_BAR; PG8_MMX(1, 1, At, B1); PG8_BAR;
            PG8_LDB(B0, 1, 0); PG8_SCHED; PG8_LDA(At, 1, 0); PG8_STAGEA(PG8_SA(0, 1), a2, 1, vs);
            PG8_WAIT_L(8); PG8_BAR; PG8_WAIT_L(0); PG8_MMX(0, 0, At, B0); PG8_BAR; PG8_SCHED;
            PG8_LDB(B1, 1, 1); PG8_STAGE(PG8_SB(1, 0), b3, voffB);
            PG8_BAR; PG8_WAIT_L(0); PG8_MMX(0, 1, At, B1); PG8_BAR;
            PG8_LDA(At, 1, 1); PG8_STAGEA(PG8_SA(1, 0), a3, 0, vs);
            PG8_BAR; PG8_WAIT_L(0); PG8_MMX(1, 0, At, B0); PG8_BAR; PG8_SCHED;
            PG8_STAGE(PG8_SB(1, 1), b3 + hstepB, voffB);
            PG8_WAIT_V(6); PG8_BAR; PG8_MMX(1, 1, At, B1); PG8_BAR;
#endif
        }
        PG8_STAMP();
        if constexpr (PRB) { if (wid == 0) { const unsigned long long n_ = PG8_PROBE_NOW(); pk += n_ - pt_; pt_ = n_; } }
        if constexpr (!Epi::AFTER_DRAIN) { E(acc, cur, wr, wc, fr, fq); S.done(cur); }
        if constexpr (PRB) { if (wid == 0) { const unsigned long long n_ = PG8_PROBE_NOW(); pe += n_ - pt_; } }
        PG8_STAMP();
        if (!has_next) break;
#pragma unroll
        for (int a = 0; a < 2; ++a)
#pragma unroll
            for (int b = 0; b < 2; ++b)
#pragma unroll
                for (int m = 0; m < 4; ++m)
#pragma unroll
                    for (int n = 0; n < 2; ++n) acc[a][b][m][n] = (f32x4){0.f, 0.f, 0.f, 0.f};
        cur = nxt; cA = nA; cB = nB; ++ui;
    }
    PG8_WAIT_V(0);
    if (wr == 0) PG8_BAR;
    PG8_BAR;
    if constexpr (Epi::AFTER_DRAIN) { E.fused(acc, cur, wr, wc, fr, fq, lds, wid, lane); S.done(cur); }
    PG8_STAMP();
    if (STAMP && wid == 0) { stamps[lane] = lane < nts ? (((unsigned long long)(unsigned)ts_hi << 32) | (unsigned)ts_lo) : 0ull;
        if (lane == 62) stamps[62] = rt_entry; if (lane == 63) stamps[63] = (unsigned long long)wall_clock64(); }
#undef PG8_STAMP
#undef PG8_SA
#undef PG8_SB
#undef PG8_STAGE
#undef PG8_STAGEA
#undef PG8_LDRAW
#undef PG8_CONV
#undef PG8_LDA
#undef PG8_LDB
#undef PG8_MMA
#undef PG8_MMA8
#undef PG8_MMX
#undef PG8_WAIT_V
#undef PG8_WAIT_L
#undef PG8_BAR
#undef PG8_SCHED
}
}
namespace pg8 {
struct MoeOrder {
    int NT, G, c, nunits, rep;
    __device__ void init(int NT_, int G_, int c_) { NT = NT_; G = G_; c = c_; nunits = NPANEL * NT_; rep = 1; }
    __device__ bool next(int i, Unit& u) const {
        const long L0 = (long)(i / rep) * G + c; if (L0 >= nunits) return false;
        int pr, pnl;
        if (G == 256) { const int x = c & 7, jj = c >> 3, PX = 32 / NT; pr = (i / rep) * (256 / NT) + x * PX + jj / NT; pnl = jj % NT; }
        else { pr = (int)L0 / NT; pnl = (int)L0 % NT; }
        int pm, e;
        if (pr < 512) { e = pr >> 5; pm = (pr & 31) * 16 + e; } else { pm = pr; e = (pr - 512) >> 2; }
        u.pm = pm; u.pn = e * NT + pnl; return true;
    }
    __device__ __forceinline__ void a_ready(const Unit&) const {}
    __device__ __forceinline__ void done(const Unit&) const {}
};

__device__ __forceinline__ u32x4 pack8(const f32x4 a, const f32x4 b) { u32x4 w; w.x = cvt_pk_bf16(a[0], a[1]); w.y = cvt_pk_bf16(a[2], a[3]); w.z = cvt_pk_bf16(b[0], b[1]); w.w = cvt_pk_bf16(b[2], b[3]); return w; }

struct EpiStore {
    static constexpr bool PERM = true, AFTER_DRAIN = false;
    bf16_t* O; int ldc; int pnmask;
    __device__ __forceinline__ void operator()(const f32x4 (&acc)[2][2][4][2], const Unit& u, int wr, int wc, int fr, int fq) const {
        const int row0 = u.pm * BM + wr * 64 + fr, col0 = (u.pn & pnmask) * BM + wc * 32 + 8 * fq;
#pragma unroll
        for (int ai = 0; ai < 2; ++ai)
#pragma unroll
            for (int m = 0; m < 4; ++m) { const int row = row0 + ai * HALF + m * 16; bf16_t* rowp = O + (size_t)row * ldc + col0;
#pragma unroll
                for (int bj = 0; bj < 2; ++bj) *(u32x4*)(rowp + bj * HALF) = pack8(acc[ai][bj][m][0], acc[ai][bj][m][1]);
                __builtin_amdgcn_sched_barrier(0); }
    }
};
struct EpiUq {
    static constexpr bool PERM = true, AFTER_DRAIN = false;
    bf16_t* O; const float* rcos; const float* rsin;
    __device__ __forceinline__ void operator()(const f32x4 (&acc)[2][2][4][2], const Unit& u, int wr, int wc, int fr, int fq) const {
        const int row0 = u.pm * BM + wr * 64 + fr, col0 = u.pn * BM + wc * 32 + 8 * fq;
        const int bsmp = u.pm / 9, ptile = u.pm - bsmp * 9; const bool latent = ptile != 0;
        int j0[2]; bool inr[2];
#pragma unroll
        for (int bj = 0; bj < 2; ++bj) { const int c = col0 + bj * HALF, hd = c / 192, off = c - hd * 192; inr[bj] = latent && off >= 128; j0[bj] = (off - 128) >> 1; }
#pragma unroll
        for (int ai = 0; ai < 2; ++ai)
#pragma unroll
            for (int m = 0; m < 4; ++m) { const int row = row0 + ai * HALF + m * 16; bf16_t* rowp = O + (size_t)row * 1536 + col0;
                const int t = row - bsmp * TPS - CTXL, trow = (t >> 6) & 31, tcol = t & 63;
#pragma unroll
                for (int bj = 0; bj < 2; ++bj) { f32x4 a = acc[ai][bj][m][0], b = acc[ai][bj][m][1];
                    if (inr[bj]) { const int pos = j0[bj] < 16 ? trow : tcol, ti = pos * 16 + (j0[bj] & 15);
                        const f32x4 cs = *(const f32x4*)(rcos + ti), sn = *(const f32x4*)(rsin + ti);
                        const f32x4 a2 = {a[0] * cs[0] - a[1] * sn[0], a[0] * sn[0] + a[1] * cs[0], a[2] * cs[1] - a[3] * sn[1], a[2] * sn[1] + a[3] * cs[1]};
                        const f32x4 b2 = {b[0] * cs[2] - b[1] * sn[2], b[0] * sn[2] + b[1] * cs[2], b[2] * cs[3] - b[3] * sn[3], b[2] * sn[3] + b[3] * cs[3]};
                        a = a2; b = b2; }
                    *(u32x4*)(rowp + bj * HALF) = pack8(a, b); } }
    }
};
struct EpiSwiGlu {
    static constexpr bool PERM = true, AFTER_DRAIN = false;
    unsigned char* O;
    __device__ __forceinline__ void operator()(const f32x4 (&acc)[2][2][4][2], const Unit& u, int wr, int wc, int fr, int fq) const {
        const int row0 = u.pm * BM + wr * 64 + fr, col0 = (u.pn & 7) * HALF + wc * 32 + 8 * fq;
#pragma unroll
        for (int ai = 0; ai < 2; ++ai)
#pragma unroll
            for (int m = 0; m < 4; ++m) { unsigned char* rowp = O + (size_t)(row0 + ai * HALF + m * 16) * FF + col0; f32x4 r[2];
#pragma unroll
                for (int n = 0; n < 2; ++n) { const f32x4 g = acc[ai][0][m][n], up = acc[ai][1][m][n];
#pragma unroll
                    for (int j = 0; j < 4; ++j) r[n][j] = g[j] * __builtin_amdgcn_rcpf(1.0f + __builtin_amdgcn_exp2f(-1.4426950408889634f * g[j])) * up[j]; }
                u32x2 w; w.x = cvt4_fp8(r[0][0], r[0][1], r[0][2], r[0][3]); w.y = cvt4_fp8(r[1][0], r[1][1], r[1][2], r[1][3]);
                *(u32x2*)rowp = w; __builtin_amdgcn_sched_barrier(0); }
    }
};
struct EpiDown {
    static constexpr bool PERM = true, AFTER_DRAIN = false;
    bf16_t* O; const float* gv;
    __device__ __forceinline__ void operator()(const f32x4 (&acc)[2][2][4][2], const Unit& u, int wr, int wc, int fr, int fq) const {
        const int row0 = u.pm * BM + wr * 64 + fr, col0 = (u.pn & 3) * BM + wc * 32 + 8 * fq;
#pragma unroll
        for (int ai = 0; ai < 2; ++ai)
#pragma unroll
            for (int m = 0; m < 4; ++m) { const int row = row0 + ai * HALF + m * 16; const float s = gv[row]; bf16_t* rowp = O + (size_t)row * D + col0;
#pragma unroll
                for (int bj = 0; bj < 2; ++bj) *(u32x4*)(rowp + bj * HALF) = pack8(acc[ai][bj][m][0] * s, acc[ai][bj][m][1] * s); }
    }
};
}
namespace att {
constexpr int NW = 8, QBLK = 32, KVBLK = 64, DV = 128;
constexpr float THR = 8.f;
#ifndef ATT_QKPIPE_GQA
#define ATT_QKPIPE_GQA 0
#endif
#ifndef ATT_QKPIPE_MLA
#define ATT_QKPIPE_MLA 0
#endif
#ifndef MLA_QREG
#define MLA_QREG 4
#endif
#define SBAR() __builtin_amdgcn_sched_barrier(0)
__device__ __forceinline__ int crow(int r, int hi) { return (r & 3) + 8 * (r >> 2) + 4 * hi; }
__device__ __forceinline__ unsigned cvtpk(float lo, float hi) { unsigned r; asm volatile("v_cvt_pk_bf16_f32 %0, %1, %2" : "=v"(r) : "v"(lo), "v"(hi)); return r; }

template <int DQK> struct Cfg {
    static constexpr float SCALE = DQK == 128 ? 0.088388347648318440f : 0.072168783648703220f;
    static constexpr float C = SCALE * 1.4426950408889634f;
    static constexpr int ROWB = DQK * 2;
    static constexpr int SHM_K = KVBLK * DQK * 2, SHM_V = KVBLK * DV * 2;
    static constexpr int QREG = DQK == 128 ? 8 : MLA_QREG;
    static constexpr int SHM_ATTN = 2 * SHM_V + 2 * SHM_K + NW * 64 * 4 + NW * (DQK / 16 - QREG) * 1024;
};
#define KSWZ(row, colB) ((row) * ROWB + ((colB) ^ ((((colB) < 256) ? ((row) & 15) : ((row) & 7)) << 4)))

template <int DQK>
__device__ __forceinline__ void partialSM(f32x16& p0, f32x16& p1, float& m_reg, float& mn, float& alpha) {
  constexpr float C = Cfg<DQK>::C, SCALE = Cfg<DQK>::SCALE;
  float pmax = p0[0];
#pragma unroll
  for (int r = 1; r < 16; ++r) pmax = fmaxf(pmax, p0[r]);
#pragma unroll
  for (int r = 0; r < 16; ++r) pmax = fmaxf(pmax, p1[r]);
  { auto rr = __builtin_amdgcn_permlane32_swap(__float_as_uint(pmax), __float_as_uint(pmax), false, false);
    pmax = fmaxf(__uint_as_float(rr[0]), __uint_as_float(rr[1])); }
  if (__builtin_expect(__all(pmax - m_reg <= THR / SCALE), 1)) { mn = m_reg; alpha = 1.f; }
  else { mn = fmaxf(m_reg, pmax); alpha = __builtin_amdgcn_exp2f((m_reg - mn) * C); m_reg = mn; }
  float mnC = -mn * C;
#pragma unroll
  for (int r = 0; r < 16; ++r) p0[r] = fmaf(p0[r], C, mnC);
#pragma unroll
  for (int r = 0; r < 16; ++r) p1[r] = fmaf(p1[r], C, mnC);
#pragma unroll
  for (int r = 0; r < 16; ++r) p0[r] = __builtin_amdgcn_exp2f(p0[r]);
}
__device__ __forceinline__ void finishSM(f32x16& p0, f32x16& p1, float alpha, float& l_reg, bf16x8& pa0, bf16x8& pa1, bf16x8& pa2, bf16x8& pa3) {
#pragma unroll
  for (int r = 0; r < 16; ++r) p1[r] = __builtin_amdgcn_exp2f(p1[r]);
  float ps = 0;
#pragma unroll
  for (int r = 0; r < 16; ++r) ps += p0[r];
#pragma unroll
  for (int r = 0; r < 16; ++r) ps += p1[r];
  { auto rr = __builtin_amdgcn_permlane32_swap(__float_as_uint(ps), __float_as_uint(ps), false, false);
    ps = __uint_as_float(rr[0]) + __uint_as_float(rr[1]); }
  l_reg = l_reg * alpha + ps;
#define PK4(P, BASE, OUT) do { unsigned a0 = cvtpk(P[BASE + 0], P[BASE + 1]), a1 = cvtpk(P[BASE + 2], P[BASE + 3]);   \
    unsigned b0 = cvtpk(P[BASE + 4], P[BASE + 5]), b1 = cvtpk(P[BASE + 6], P[BASE + 7]);                              \
    auto r0 = __builtin_amdgcn_permlane32_swap(a0, b0, false, false); auto r1 = __builtin_amdgcn_permlane32_swap(a1, b1, false, false); \
    u32x4 w = {r0[0], r1[0], r0[1], r1[1]}; OUT = *reinterpret_cast<bf16x8*>(&w); } while (0)
  PK4(p0, 0, pa0); PK4(p0, 8, pa1); PK4(p1, 0, pa2); PK4(p1, 8, pa3);
#undef PK4
}
template <int DQK, int QREG>
__device__ __forceinline__ void qkt_plain(f32x16& p0, f32x16& p1, const char* Ks, const bf16x8* qr, const char* qx, int r32, int hi) {
  constexpr int ROWB = Cfg<DQK>::ROWB;
  p0 = f32x16{}; p1 = f32x16{};
#pragma unroll
  for (int d0 = 0; d0 < DQK / 16; ++d0) { int cb = (d0 * 16 + hi * 8) * 2;
    bf16x8 b0 = *reinterpret_cast<const bf16x8*>(Ks + KSWZ(r32, cb));
    bf16x8 b1 = *reinterpret_cast<const bf16x8*>(Ks + KSWZ(32 + r32, cb));
    bf16x8 q; if (d0 < QREG) q = qr[d0]; else q = *reinterpret_cast<const bf16x8*>(qx + (d0 - QREG) * 1024);
    p0 = __builtin_amdgcn_mfma_f32_32x32x16_bf16(b0, q, p0, 0, 0, 0);
    p1 = __builtin_amdgcn_mfma_f32_32x32x16_bf16(b1, q, p1, 0, 0, 0); }
}
template <int DQK, int QREG, int D0>
__device__ __forceinline__ void qk_issue(bf16x8 (&kl)[3], bf16x8 (&kh)[3], bf16x8 (&qf)[3], int kb, int s4, int s3, int hi16, int qxa) {
  constexpr int ROWB = Cfg<DQK>::ROWB;
  const int ad = kb + ((D0 * 32 + hi16) ^ (D0 < 8 ? s4 : s3));
  asm volatile("ds_read_b128 %0, %1" : "=v"(kl[D0 % 3]) : "v"(ad) : "memory");
  asm volatile("ds_read_b128 %0, %1 offset:%2" : "=v"(kh[D0 % 3]) : "v"(ad), "n"(32 * ROWB) : "memory");
  if constexpr (D0 >= QREG) asm volatile("ds_read_b128 %0, %1 offset:%2" : "=v"(qf[D0 % 3]) : "v"(qxa), "n"((D0 - QREG) * 1024) : "memory");
}
template <int DQK, int QREG, int D0>
__device__ __forceinline__ void qk_steps(f32x16& p0, f32x16& p1, bf16x8 (&kl)[3], bf16x8 (&kh)[3], bf16x8 (&qf)[3], const bf16x8* qr, int kb, int s4, int s3, int hi16, int qxa) {
  constexpr int ND = DQK / 16;
  if constexpr (D0 < ND) {
    constexpr int R1 = D0 + 1 < ND ? 2 + (D0 + 1 >= QREG ? 1 : 0) : 0, R2 = D0 + 2 < ND ? 2 + (D0 + 2 >= QREG ? 1 : 0) : 0;
    if constexpr (D0 >= QREG) asm volatile("s_waitcnt lgkmcnt(%3)" : "+v"(kl[D0 % 3]), "+v"(kh[D0 % 3]), "+v"(qf[D0 % 3]) : "n"(R1 + R2));
    else asm volatile("s_waitcnt lgkmcnt(%2)" : "+v"(kl[D0 % 3]), "+v"(kh[D0 % 3]) : "n"(R1 + R2));
    bf16x8 q; if constexpr (D0 < QREG) q = qr[D0]; else q = qf[D0 % 3];
    if constexpr (D0 == 0) { p0 = __builtin_amdgcn_mfma_f32_32x32x16_bf16(kl[0], q, f32x16{}, 0, 0, 0); p1 = __builtin_amdgcn_mfma_f32_32x32x16_bf16(kh[0], q, f32x16{}, 0, 0, 0); }
    else { p0 = __builtin_amdgcn_mfma_f32_32x32x16_bf16(kl[D0 % 3], q, p0, 0, 0, 0); p1 = __builtin_amdgcn_mfma_f32_32x32x16_bf16(kh[D0 % 3], q, p1, 0, 0, 0); }
    if constexpr (D0 + 3 < ND) qk_issue<DQK, QREG, D0 + 3>(kl, kh, qf, kb, s4, s3, hi16, qxa);
    qk_steps<DQK, QREG, D0 + 1>(p0, p1, kl, kh, qf, qr, kb, s4, s3, hi16, qxa);
  }
}
template <int DQK, int QREG>
__device__ __forceinline__ void qkt(f32x16& p0, f32x16& p1, const char* Ks, const bf16x8* qr, const char* qx, int r32, int hi) {
  constexpr int ROWB = Cfg<DQK>::ROWB;
  if constexpr ((DQK == 128 && !ATT_QKPIPE_GQA) || (DQK == 192 && !ATT_QKPIPE_MLA)) { qkt_plain<DQK, QREG>(p0, p1, Ks, qr, qx, r32, hi); return; }
  const int kb = (int)(unsigned)(uintptr_t)Ks + r32 * ROWB, s4 = (r32 & 15) << 4, s3 = (r32 & 7) << 4, hi16 = hi * 16, qxa = (int)(unsigned)(uintptr_t)qx;
  bf16x8 kl[3], kh[3], qf[3];
  qk_issue<DQK, QREG, 0>(kl, kh, qf, kb, s4, s3, hi16, qxa); qk_issue<DQK, QREG, 1>(kl, kh, qf, kb, s4, s3, hi16, qxa); qk_issue<DQK, QREG, 2>(kl, kh, qf, kb, s4, s3, hi16, qxa);
  qk_steps<DQK, QREG, 0>(p0, p1, kl, kh, qf, qr, kb, s4, s3, hi16, qxa);
}
__device__ __forceinline__ int v_st(int k, int c) { const int kk = (k & ~0xC) | ((k & 4) << 1) | ((k & 8) >> 1); return ((kk >> 3) * 4 + (c >> 5)) * 512 + ((kk & 7) * 32 + (c & 31)) * 2; }
__device__ __forceinline__ int v_rd_base(int lane) { return ((lane & 3) << 3) | (((lane >> 2) & 3) << 6) | (((lane >> 4) & 1) << 5) | (((lane >> 5) & 1) << 8); }
constexpr int v_rd_off(int d0, int ks, int half) { return d0 * 512 + ks * 4096 + half * 2048; }
template <int OFF> __device__ __forceinline__ s16x4 tr_read(int vb) {
  s16x4 r; asm volatile("ds_read_b64_tr_b16 %0, %1 offset:%2" : "=&v"(r) : "v"(vb), "i"(OFF) : "memory"); return r;
}
template <int D0> __device__ __forceinline__ void pv_one(f32x16& od, int vb, bf16x8 pa0, bf16x8 pa1, bf16x8 pa2, bf16x8 pa3) {
  const s16x4 l0 = tr_read<v_rd_off(D0, 0, 0)>(vb), h0 = tr_read<v_rd_off(D0, 0, 1)>(vb), l1 = tr_read<v_rd_off(D0, 1, 0)>(vb), h1 = tr_read<v_rd_off(D0, 1, 1)>(vb);
  const s16x4 l2 = tr_read<v_rd_off(D0, 2, 0)>(vb), h2 = tr_read<v_rd_off(D0, 2, 1)>(vb), l3 = tr_read<v_rd_off(D0, 3, 0)>(vb), h3 = tr_read<v_rd_off(D0, 3, 1)>(vb);
  asm volatile("s_waitcnt lgkmcnt(0)" ::: "memory"); SBAR();
#define PK(L, H) (bf16x8){L[0], L[1], L[2], L[3], H[0], H[1], H[2], H[3]}
  od = __builtin_amdgcn_mfma_f32_32x32x16_bf16(pa0, PK(l0, h0), od, 0, 0, 0);
  od = __builtin_amdgcn_mfma_f32_32x32x16_bf16(pa1, PK(l1, h1), od, 0, 0, 0);
  od = __builtin_amdgcn_mfma_f32_32x32x16_bf16(pa2, PK(l2, h2), od, 0, 0, 0);
  od = __builtin_amdgcn_mfma_f32_32x32x16_bf16(pa3, PK(l3, h3), od, 0, 0, 0);
#undef PK
}
__device__ __forceinline__ void pv_d0(f32x16* o, int vb, bf16x8 pa0, bf16x8 pa1, bf16x8 pa2, bf16x8 pa3) {
  pv_one<0>(o[0], vb, pa0, pa1, pa2, pa3); pv_one<1>(o[1], vb, pa0, pa1, pa2, pa3); pv_one<2>(o[2], vb, pa0, pa1, pa2, pa3); pv_one<3>(o[3], vb, pa0, pa1, pa2, pa3);
}

template <int DQK, int SDEPTH, int ldq, int ldk, int ldkr, int ldv, int ldo>
__device__ __forceinline__ void attn_body(const bf16_t* __restrict__ Qb, const bf16_t* __restrict__ Kh, const bf16_t* __restrict__ Kr,
                                          const bf16_t* __restrict__ Vh, unsigned char* __restrict__ Ob, int seq, char* lds, int qt0, const float* __restrict__ rt, const float* __restrict__ qg) {
  constexpr int ROWB = Cfg<DQK>::ROWB, SHM_K = Cfg<DQK>::SHM_K, SHM_V = Cfg<DQK>::SHM_V;
  constexpr bool X = DQK == 192; constexpr int QREG = Cfg<DQK>::QREG, QLDS = DQK / 16 - QREG;
  const int tid = opaque_v((int)threadIdx.x), wid = tid >> 6, lane = tid & 63, r32 = lane & 31, hi = lane >> 5;
  char* V_lds = lds; char* K_lds = lds + 2 * SHM_V;
  float* ws = (float*)(lds + 2 * SHM_V + 2 * SHM_K) + wid * 64; float* li_l = ws; float* al_l = ws + 32;
  float m_reg = -1e30f, l_reg = 0; f32x16 o[4] = {}; bf16x8 qr[QREG];
  const bf16_t* Qw = Qb + (long)(wid * QBLK + r32) * ldq + hi * 8;
  char* qx = lds + 2 * SHM_V + 2 * SHM_K + NW * 64 * 4 + wid * (QLDS * 1024) + lane * 16;
#pragma unroll
  for (int d0 = 0; d0 < QREG; ++d0) qr[d0] = *reinterpret_cast<const bf16x8*>(Qw + d0 * 16);
  if constexpr (X) {
#pragma unroll
    for (int d0 = QREG; d0 < 8; ++d0) *reinterpret_cast<bf16x8*>(qx + (d0 - QREG) * 1024) = *reinterpret_cast<const bf16x8*>(Qw + d0 * 16);
  }
  if constexpr (!X) {
    float ss = 0.f;
#pragma unroll
    for (int d0 = 0; d0 < 8; ++d0) { const u32x4 w = *reinterpret_cast<const u32x4*>(&qr[d0]);
#pragma unroll
      for (int q = 0; q < 4; ++q) { const float x0 = __uint_as_float(w[q] << 16), x1 = __uint_as_float(w[q] & 0xffff0000u); ss += x0 * x0 + x1 * x1; } }
    ss += __shfl_xor(ss, 32);
    const float rstd = 1.0f / sqrtf(ss * (1.0f / 128.0f) + 1e-6f);
    const int t = qt0 >= 0 ? qt0 + wid * QBLK + r32 : 0;
#pragma unroll
    for (int d0 = 0; d0 < 8; ++d0) { u32x4 w = *reinterpret_cast<const u32x4*>(&qr[d0]);
      const f32x4 g0 = *reinterpret_cast<const f32x4*>(qg + d0 * 16 + hi * 8), g1 = *reinterpret_cast<const f32x4*>(qg + d0 * 16 + hi * 8 + 4);
      const int pos = d0 < 4 ? (t >> 6) : (t & 63), ti = pos * 32 + (d0 & 3) * 8 + hi * 4; const f32x4 cs = *reinterpret_cast<const f32x4*>(rt + ti), sn = *reinterpret_cast<const f32x4*>(rt + 2048 + ti);
      const float gg[8] = {g0[0], g0[1], g0[2], g0[3], g1[0], g1[1], g1[2], g1[3]};
#pragma unroll
      for (int q = 0; q < 4; ++q) { const float x0 = __uint_as_float(w[q] << 16) * rstd * gg[2 * q], x1 = __uint_as_float(w[q] & 0xffff0000u) * rstd * gg[2 * q + 1]; w[q] = cvtpk(x0 * cs[q] - x1 * sn[q], x0 * sn[q] + x1 * cs[q]); }
      qr[d0] = *reinterpret_cast<const bf16x8*>(&w); }
  }
  if constexpr (X) {
#pragma unroll
    for (int d0 = 8; d0 < 12; ++d0) {
      u32x4 w = *reinterpret_cast<const u32x4*>(Qw + d0 * 16);
      { const int t = qt0 >= 0 ? qt0 + wid * QBLK + r32 : 0, j0 = (d0 - 8) * 8 + hi * 4, pos = d0 < 10 ? (t >> 6) : (t & 63), ti = pos * 16 + (j0 & 15);
        const f32x4 cs = *reinterpret_cast<const f32x4*>(rt + ti), sn = *reinterpret_cast<const f32x4*>(rt + 1024 + ti);
#pragma unroll
        for (int q = 0; q < 4; ++q) { const float x0 = __uint_as_float(w[q] << 16), x1 = __uint_as_float(w[q] & 0xffff0000u); w[q] = cvtpk(x0 * cs[q] - x1 * sn[q], x0 * sn[q] + x1 * cs[q]); } }
      *reinterpret_cast<u32x4*>(qx + (d0 - QREG) * 1024) = w; }
  }
  const int sr = tid >> 4, sc = (tid & 15) * 8, vst0 = v_st(sr, sc), vst1 = v_st(32 + sr, sc);
  const int xr = tid >> 3, xc = (tid & 7) * 8;
  const int vb0 = (int)(uintptr_t)V_lds + v_rd_base(lane);
  struct { bf16x8 vs0, vs1, ks0, ks1, kx; } sr_[SDEPTH];
#define LD8(p) (*reinterpret_cast<const bf16x8*>(p))
#define SLOAD(i, k0) do { sr_[i].vs0 = LD8(&Vh[(long)((k0) + sr) * ldv + sc]); sr_[i].vs1 = LD8(&Vh[(long)((k0) + 32 + sr) * ldv + sc]); \
    sr_[i].ks0 = LD8(&Kh[(long)((k0) + sr) * ldk + sc]); sr_[i].ks1 = LD8(&Kh[(long)((k0) + 32 + sr) * ldk + sc]); \
    if constexpr (X) sr_[i].kx = LD8(&Kr[(long)((k0) + xr) * ldkr + xc]); } while (0)
#define SWRITE(b, i) do { *(bf16x8*)(V_lds + (b) * SHM_V + vst0) = sr_[i].vs0;          \
    *(bf16x8*)(V_lds + (b) * SHM_V + vst1) = sr_[i].vs1; int kc = sc * 2;               \
    *(bf16x8*)(K_lds + (b) * SHM_K + KSWZ(sr, kc)) = sr_[i].ks0;                       \
    *(bf16x8*)(K_lds + (b) * SHM_K + KSWZ(32 + sr, kc)) = sr_[i].ks1;                  \
    if constexpr (X) { int kx_ = 256 + xc * 2; *(bf16x8*)(K_lds + (b) * SHM_K + KSWZ(xr, kx_)) = sr_[i].kx; } } while (0)
#define SWAIT() do { if constexpr (SDEPTH == 2) { if constexpr (X) asm volatile("s_waitcnt vmcnt(5)" ::: "memory"); else asm volatile("s_waitcnt vmcnt(4)" ::: "memory"); } else asm volatile("s_waitcnt vmcnt(0)" ::: "memory"); } while (0)
#define RESC(a) do { if (__any((a) < 1.f)) { if (hi == 0) al_l[r32] = (a); asm volatile("s_waitcnt lgkmcnt(0)" ::: "memory"); \
    _Pragma("unroll") for (int d = 0; d < 4; ++d) _Pragma("unroll") for (int r = 0; r < 16; ++r) o[d][r] *= al_l[crow(r, hi)]; } } while (0)
  f32x16 pA0, pA1, pB0, pB1; float mnA, mnB, alA, alB; bf16x8 pa0, pa1, pa2, pa3; const int NT = seq / KVBLK;
  constexpr int SE = 0, SO = SDEPTH - 1;
  SLOAD(SE, 0); asm volatile("s_waitcnt vmcnt(0)" ::: "memory"); SWRITE(0, SE); __syncthreads();
  qkt<DQK, QREG>(pA0, pA1, K_lds, qr, qx, r32, hi); partialSM<DQK>(pA0, pA1, m_reg, mnA, alA);
  SLOAD(SO, KVBLK); if constexpr (SDEPTH == 2) { if (2 < NT) SLOAD(SE, 2 * KVBLK); }
  SWAIT(); SWRITE(1, SO); __syncthreads();
  for (int j = 1; j + 1 < NT; j += 2) {
    SBAR(); qkt<DQK, QREG>(pB0, pB1, K_lds + SHM_K, qr, qx, r32, hi);
    finishSM(pA0, pA1, alA, l_reg, pa0, pa1, pa2, pa3); SBAR();
    SLOAD(SO, (j + SDEPTH) * KVBLK); SBAR();
    pv_d0(o, vb0, pa0, pa1, pa2, pa3); partialSM<DQK>(pB0, pB1, m_reg, mnB, alB);
    __syncthreads(); SWAIT(); SWRITE(0, SE);
    RESC(alB); __syncthreads();
    SBAR(); qkt<DQK, QREG>(pA0, pA1, K_lds, qr, qx, r32, hi);
    finishSM(pB0, pB1, alB, l_reg, pa0, pa1, pa2, pa3); SBAR();
    if (SDEPTH == 1 || j + 3 < NT) SLOAD(SE, (j + 1 + SDEPTH) * KVBLK); SBAR();
    pv_d0(o, vb0 + (int)SHM_V, pa0, pa1, pa2, pa3); partialSM<DQK>(pA0, pA1, m_reg, mnA, alA);
    __syncthreads(); SWAIT(); SWRITE(1, SO);
    RESC(alA); __syncthreads();
  }
  SBAR(); qkt<DQK, QREG>(pB0, pB1, K_lds + SHM_K, qr, qx, r32, hi);
  finishSM(pA0, pA1, alA, l_reg, pa0, pa1, pa2, pa3); SBAR();
  pv_d0(o, vb0, pa0, pa1, pa2, pa3); partialSM<DQK>(pB0, pB1, m_reg, mnB, alB);
  __syncthreads(); RESC(alB);
  finishSM(pB0, pB1, alB, l_reg, pa0, pa1, pa2, pa3); SBAR();
  pv_d0(o, vb0 + (int)SHM_V, pa0, pa1, pa2, pa3);
  if (hi == 0) li_l[r32] = l_reg; asm volatile("s_waitcnt lgkmcnt(0)" ::: "memory");
  float rli[16];
#pragma unroll
  for (int r = 0; r < 16; ++r) rli[r] = __builtin_amdgcn_rcpf(li_l[crow(r, hi)]);
  unsigned char* Ow = Ob + (long)(wid * QBLK) * ldo;
#pragma unroll
  for (int r = 0; r < 16; ++r) { int orow = crow(r, hi);
#pragma unroll
    for (int d0 = 0; d0 < 4; ++d0) { const float ov = __builtin_fminf(__builtin_fmaxf(o[d0][r] * rli[r] * AO_SCALE, -448.f), 448.f); Ow[(long)orow * ldo + d0 * 32 + r32] = (unsigned char)(__builtin_amdgcn_cvt_pk_fp8_f32(ov, 0.f, 0, false) & 0xff); } }
#undef LD8
#undef SLOAD
#undef SWRITE
#undef SWAIT
#undef RESC
}
#undef KSWZ
}
#ifndef A2_RS_GQA
#define A2_RS_GQA 0
#endif
#ifndef A2_SPREAD
#define A2_SPREAD 0
#endif
#ifndef A2_SHADOW_GQA
#define A2_SHADOW_GQA 0
#endif
#ifndef A2_SHADOW_MLA
#define A2_SHADOW_MLA 0
#endif
#ifndef A2_PKSM
#define A2_PKSM 0
#endif
#ifndef A2_BUF
#define A2_BUF 1
#endif
#ifndef A2_RS_MLA
#define A2_RS_MLA 0
#endif
namespace att2 {
#if defined(PROBE_SEL) && PROBE_SEL >= 50 && PROBE_SEL <= 59
#define A2_T(n) do { if (wid == 0) { const unsigned long long t_ = __builtin_amdgcn_s_memrealtime(); if ((n) == PROBE_SEL - 49) pacc += t_ - a2_t; a2_t = t_; } } while (0)
#define A2_TDECL unsigned long long a2_t = 0ull;
#if PROBE_SEL == 54
#define A2_TQ() do { __builtin_amdgcn_sched_barrier(0); if (wid == 0) { pacc += __builtin_amdgcn_s_memrealtime() - a2_t; } } while (0)
#else
#define A2_TQ() do { } while (0)
#endif
#if PROBE_SEL >= 56
#define A2_TX(n) A2_T(n)
#define A2_T3() A2_T(9)
#else
#define A2_TX(n) do { } while (0)
#define A2_T3() A2_T(3)
#endif
#else
#define A2_TX(n) do { } while (0)
#define A2_T3() do { } while (0)
#define A2_TQ() do { } while (0)
#define A2_T(n) do { } while (0)
#define A2_TDECL
#endif
using att::Cfg; using att::crow; using att::cvtpk; using att::v_rd_base; using att::pv_d0;
typedef LAS char LASc; typedef LAS bf16x8 LASv;
constexpr int NW = 8, QBLK = 32, KVBLK = 64;
constexpr float THR = 8.f;
#define KSWZ2(row, colB) ((row) * ROWB + ((colB) ^ (((row) & 7) << 4)))
#define A2_BAR() do { asm volatile("" ::: "memory"); __builtin_amdgcn_sched_barrier(0); __builtin_amdgcn_s_barrier(); __builtin_amdgcn_sched_barrier(0); asm volatile("" ::: "memory"); } while (0)

template <int DQK>
__device__ __forceinline__ void qk_tile(f32x16& p0, f32x16& p1, const LASc* Ks, const bf16x8* qr, int r32, int hi) {
  constexpr int ROWB = Cfg<DQK>::ROWB;
  const int kb = (int)(unsigned)(size_t)Ks + r32 * ROWB, s3 = (r32 & 7) << 4, hi16 = hi * 16;
  bf16x8 kl[3], kh[3], qf[3];
  att::qk_issue<DQK, DQK / 16, 0>(kl, kh, qf, kb, s3, s3, hi16, 0); att::qk_issue<DQK, DQK / 16, 1>(kl, kh, qf, kb, s3, s3, hi16, 0); att::qk_issue<DQK, DQK / 16, 2>(kl, kh, qf, kb, s3, s3, hi16, 0);
  att::qk_steps<DQK, DQK / 16, 0>(p0, p1, kl, kh, qf, qr, kb, s3, s3, hi16, 0);
}
template <int DQK, class HOOK>
__device__ __forceinline__ void softmax_tile(f32x16& p0, f32x16& p1, float& m_reg, float& l_reg, float& alpha, bf16x8& pa0, bf16x8& pa1, bf16x8& pa2, bf16x8& pa3, HOOK&& hook) {
  constexpr float C = Cfg<DQK>::C, SCALE = Cfg<DQK>::SCALE;
  float pmax = p0[0];
#pragma unroll
  for (int r = 1; r < 16; ++r) pmax = fmaxf(pmax, p0[r]);
#pragma unroll
  for (int r = 0; r < 16; ++r) pmax = fmaxf(pmax, p1[r]);
  { auto rr = __builtin_amdgcn_permlane32_swap(__float_as_uint(pmax), __float_as_uint(pmax), false, false);
    pmax = fmaxf(__uint_as_float(rr[0]), __uint_as_float(rr[1])); }
  float mn;
  if (__builtin_expect(__all(pmax - m_reg <= THR / SCALE), 1)) { mn = m_reg; alpha = 1.f; }
  else { mn = fmaxf(m_reg, pmax); alpha = __builtin_amdgcn_exp2f((m_reg - mn) * C); m_reg = mn; }
  const float mnC = -mn * C;
#if A2_PKSM
  const f32x2 Cv = {C, C}, Mv = {mnC, mnC}; f32x2 ps2 = {0.f, 0.f};
#pragma unroll
  for (int r = 0; r < 16; r += 2) { f32x2 t = {p0[r], p0[r + 1]}; t = __builtin_elementwise_fma(t, Cv, Mv); p0[r] = __builtin_amdgcn_exp2f(t[0]); p0[r + 1] = __builtin_amdgcn_exp2f(t[1]); }
#pragma unroll
  for (int r = 0; r < 16; r += 2) { f32x2 t = {p1[r], p1[r + 1]}; t = __builtin_elementwise_fma(t, Cv, Mv); p1[r] = __builtin_amdgcn_exp2f(t[0]); p1[r + 1] = __builtin_amdgcn_exp2f(t[1]); }
#pragma unroll
  for (int r = 0; r < 16; r += 2) { const f32x2 t = {p0[r], p0[r + 1]}; ps2 += t; }
#pragma unroll
  for (int r = 0; r < 16; r += 2) { const f32x2 t = {p1[r], p1[r + 1]}; ps2 += t; }
  float ps = ps2[0] + ps2[1];
#else
  hook(0);
#pragma unroll
  for (int r = 0; r < 8; ++r) p0[r] = __builtin_amdgcn_exp2f(fmaf(p0[r], C, mnC));
  hook(1);
#pragma unroll
  for (int r = 8; r < 16; ++r) p0[r] = __builtin_amdgcn_exp2f(fmaf(p0[r], C, mnC));
  hook(2);
#pragma unroll
  for (int r = 0; r < 8; ++r) p1[r] = __builtin_amdgcn_exp2f(fmaf(p1[r], C, mnC));
  hook(3);
#pragma unroll
  for (int r = 8; r < 16; ++r) p1[r] = __builtin_amdgcn_exp2f(fmaf(p1[r], C, mnC));
  hook(4);
  float ps = 0;
#pragma unroll
  for (int r = 0; r < 16; ++r) ps += p0[r];
#pragma unroll
  for (int r = 0; r < 16; ++r) ps += p1[r];
#endif
  { auto rr = __builtin_amdgcn_permlane32_swap(__float_as_uint(ps), __float_as_uint(ps), false, false);
    ps = __uint_as_float(rr[0]) + __uint_as_float(rr[1]); }
  l_reg = l_reg * alpha + ps;
#define PK4(P, BASE, OUT) do { unsigned a0 = cvtpk(P[BASE + 0], P[BASE + 1]), a1 = cvtpk(P[BASE + 2], P[BASE + 3]);   \
    unsigned b0 = cvtpk(P[BASE + 4], P[BASE + 5]), b1 = cvtpk(P[BASE + 6], P[BASE + 7]);                              \
    auto r0 = __builtin_amdgcn_permlane32_swap(a0, b0, false, false); auto r1 = __builtin_amdgcn_permlane32_swap(a1, b1, false, false); \
    u32x4 w = {r0[0], r1[0], r0[1], r1[1]}; OUT = *reinterpret_cast<bf16x8*>(&w); } while (0)
  PK4(p0, 0, pa0); PK4(p0, 8, pa1); PK4(p1, 0, pa2); PK4(p1, 8, pa3);
#undef PK4
}

struct VFrag { s16x4 l0, h0, l1, h1, l2, h2, l3, h3; };
template <int D0> __device__ __forceinline__ void pv_reads(VFrag& f, int vb) {
  using att::tr_read; using att::v_rd_off;
  f.l0 = tr_read<v_rd_off(D0, 0, 0)>(vb); f.h0 = tr_read<v_rd_off(D0, 0, 1)>(vb); f.l1 = tr_read<v_rd_off(D0, 1, 0)>(vb); f.h1 = tr_read<v_rd_off(D0, 1, 1)>(vb);
  f.l2 = tr_read<v_rd_off(D0, 2, 0)>(vb); f.h2 = tr_read<v_rd_off(D0, 2, 1)>(vb); f.l3 = tr_read<v_rd_off(D0, 3, 0)>(vb); f.h3 = tr_read<v_rd_off(D0, 3, 1)>(vb);
}
__device__ __forceinline__ void pv_mma(f32x16& od, const VFrag& f, bf16x8 pa0, bf16x8 pa1, bf16x8 pa2, bf16x8 pa3) {
#define PK(L, H) (bf16x8){L[0], L[1], L[2], L[3], H[0], H[1], H[2], H[3]}
  od = __builtin_amdgcn_mfma_f32_32x32x16_bf16(pa0, PK(f.l0, f.h0), od, 0, 0, 0);
  od = __builtin_amdgcn_mfma_f32_32x32x16_bf16(pa1, PK(f.l1, f.h1), od, 0, 0, 0);
  od = __builtin_amdgcn_mfma_f32_32x32x16_bf16(pa2, PK(f.l2, f.h2), od, 0, 0, 0);
  od = __builtin_amdgcn_mfma_f32_32x32x16_bf16(pa3, PK(f.l3, f.h3), od, 0, 0, 0);
#undef PK
}
__device__ __forceinline__ void pv_pipe(f32x16* o, int vb, bf16x8 pa0, bf16x8 pa1, bf16x8 pa2, bf16x8 pa3) {
  VFrag fa, fb;
  pv_reads<0>(fa, vb); pv_reads<1>(fb, vb);
  asm volatile("s_waitcnt lgkmcnt(8)" ::: "memory"); __builtin_amdgcn_sched_barrier(0); pv_mma(o[0], fa, pa0, pa1, pa2, pa3); __builtin_amdgcn_sched_barrier(0);
  pv_reads<2>(fa, vb);
  asm volatile("s_waitcnt lgkmcnt(8)" ::: "memory"); __builtin_amdgcn_sched_barrier(0); pv_mma(o[1], fb, pa0, pa1, pa2, pa3); __builtin_amdgcn_sched_barrier(0);
  pv_reads<3>(fb, vb);
  asm volatile("s_waitcnt lgkmcnt(8)" ::: "memory"); __builtin_amdgcn_sched_barrier(0); pv_mma(o[2], fa, pa0, pa1, pa2, pa3); __builtin_amdgcn_sched_barrier(0);
  asm volatile("s_waitcnt lgkmcnt(0)" ::: "memory"); __builtin_amdgcn_sched_barrier(0); pv_mma(o[3], fb, pa0, pa1, pa2, pa3);
}

#if A2_NOSGB
#define A2_SGB4(nv) do { } while (0)
#else
#define A2_SGB4(nv) do { _Pragma("unroll") for (int g_ = 0; g_ < 4; ++g_) { __builtin_amdgcn_sched_group_barrier(0x008, 1, 0); __builtin_amdgcn_sched_group_barrier(0x002, (nv), 0); } } while (0)
#endif
#define A2_SGB4X() do { _Pragma("unroll") for (int g_ = 0; g_ < 4; ++g_) { __builtin_amdgcn_sched_group_barrier(0x008, 1, 0); __builtin_amdgcn_sched_group_barrier(0x002, 2, 0); __builtin_amdgcn_sched_group_barrier(0x400, 2, 0); } } while (0)
template <int DQK, bool PV>
__device__ __forceinline__ void pv_pipe_s1(f32x16* o, int vb, bf16x8 pa0, bf16x8 pa1, bf16x8 pa2, bf16x8 pa3, f32x16& p0, f32x16& p1, float& m_reg, float& alpha, float& mnC) {
  constexpr float C = Cfg<DQK>::C, SCALE = Cfg<DQK>::SCALE;
  VFrag fa, fb;
  if constexpr (PV) { pv_reads<0>(fa, vb); pv_reads<1>(fb, vb); asm volatile("s_waitcnt lgkmcnt(8)" ::: "memory"); }
  __builtin_amdgcn_sched_barrier(0);
  if constexpr (PV) pv_mma(o[0], fa, pa0, pa1, pa2, pa3);
  float ma = fmaxf(p0[0], p0[1]), mb = fmaxf(p1[0], p1[1]);
#pragma unroll
  for (int r = 2; r < 16; r += 2) { ma = fmaxf(fmaxf(ma, p0[r]), p0[r + 1]); mb = fmaxf(fmaxf(mb, p1[r]), p1[r + 1]); }
  if constexpr (PV) A2_SGB4(4);
  __builtin_amdgcn_sched_barrier(0);
  if constexpr (PV) { pv_reads<2>(fa, vb); asm volatile("s_waitcnt lgkmcnt(8)" ::: "memory"); }
  __builtin_amdgcn_sched_barrier(0);
  if constexpr (PV) pv_mma(o[1], fb, pa0, pa1, pa2, pa3);
  { float pmax = fmaxf(ma, mb);
    auto rr = __builtin_amdgcn_permlane32_swap(__float_as_uint(pmax), __float_as_uint(pmax), false, false);
    pmax = fmaxf(__uint_as_float(rr[0]), __uint_as_float(rr[1]));
    const bool keep = __all(pmax - m_reg <= THR / SCALE);
    const float mn = keep ? m_reg : fmaxf(m_reg, pmax);
    alpha = __builtin_amdgcn_exp2f((m_reg - mn) * C); m_reg = mn; mnC = -mn * C; }
  if constexpr (PV) A2_SGB4(3);
  __builtin_amdgcn_sched_barrier(0);
  if constexpr (PV) { pv_reads<3>(fb, vb); asm volatile("s_waitcnt lgkmcnt(8)" ::: "memory"); }
  __builtin_amdgcn_sched_barrier(0);
  if constexpr (PV) pv_mma(o[2], fa, pa0, pa1, pa2, pa3);
#pragma unroll
  for (int r = 0; r < 8; ++r) p0[r] = __builtin_amdgcn_exp2f(fmaf(p0[r], C, mnC));
  if constexpr (PV) A2_SGB4X();
  __builtin_amdgcn_sched_barrier(0);
  if constexpr (PV) asm volatile("s_waitcnt lgkmcnt(0)" ::: "memory");
  __builtin_amdgcn_sched_barrier(0);
  if constexpr (PV) pv_mma(o[3], fb, pa0, pa1, pa2, pa3);
#pragma unroll
  for (int r = 8; r < 16; ++r) p0[r] = __builtin_amdgcn_exp2f(fmaf(p0[r], C, mnC));
  if constexpr (PV) A2_SGB4X();
  __builtin_amdgcn_sched_barrier(0);
}
template <int DQK>
__device__ __forceinline__ void softmax_p2(f32x16& p0, f32x16& p1, float mnC, float alpha, float& l_reg, bf16x8& pa0, bf16x8& pa1, bf16x8& pa2, bf16x8& pa3) {
  constexpr float C = Cfg<DQK>::C;
#pragma unroll
  for (int r = 0; r < 16; ++r) p1[r] = __builtin_amdgcn_exp2f(fmaf(p1[r], C, mnC));
  float ps = 0;
#pragma unroll
  for (int r = 0; r < 16; ++r) ps += p0[r];
#pragma unroll
  for (int r = 0; r < 16; ++r) ps += p1[r];
  { auto rr = __builtin_amdgcn_permlane32_swap(__float_as_uint(ps), __float_as_uint(ps), false, false);
    ps = __uint_as_float(rr[0]) + __uint_as_float(rr[1]); }
  l_reg = l_reg * alpha + ps;
#define PK4(P, BASE, OUT) do { unsigned a0 = cvtpk(P[BASE + 0], P[BASE + 1]), a1 = cvtpk(P[BASE + 2], P[BASE + 3]);   \
    unsigned b0 = cvtpk(P[BASE + 4], P[BASE + 5]), b1 = cvtpk(P[BASE + 6], P[BASE + 7]);                              \
    auto r0 = __builtin_amdgcn_permlane32_swap(a0, b0, false, false); auto r1 = __builtin_amdgcn_permlane32_swap(a1, b1, false, false); \
    u32x4 w = {r0[0], r1[0], r0[1], r1[1]}; OUT = *reinterpret_cast<bf16x8*>(&w); } while (0)
  PK4(p0, 0, pa0); PK4(p0, 8, pa1); PK4(p1, 0, pa2); PK4(p1, 8, pa3);
#undef PK4
}

template <int DQK, int ldq, int ldk, int ldkr, int ldv, int ldo>
__device__ __forceinline__ void attn_body2(const bf16_t* __restrict__ Qb, const bf16_t* __restrict__ Kh, const bf16_t* __restrict__ Kr, const bf16_t* __restrict__ Vh,
                                           unsigned char* __restrict__ Ob, int seq, LAS unsigned char* lds, int qt0, const float* __restrict__ rt, const float* __restrict__ qg, unsigned long long& pacc) {
  constexpr int ROWB = Cfg<DQK>::ROWB, SHM_K = Cfg<DQK>::SHM_K, SHM_V = Cfg<DQK>::SHM_V, NKI = SHM_K / 8192, NVI = SHM_V / 8192, NDMA = NKI + NVI, NQ = DQK / 16;
  constexpr bool X = DQK == 192;
  constexpr bool A2_SHADOW_ = X ? (A2_SHADOW_MLA != 0) : (A2_SHADOW_GQA != 0);
  constexpr bool A2_REGSTAGE = X ? (A2_RS_MLA != 0) : (A2_RS_GQA != 0);
  constexpr int NSK = A2_REGSTAGE ? 3 : 4, NSV = A2_REGSTAGE ? 3 : (X ? 3 : 4);
  constexpr int NW_K = (NSK - 3) * NDMA, NW_V = (NSV - 3) * NDMA + NKI, NWAIT_M = NW_K < NW_V ? NW_K : NW_V, NWAIT_V = NWAIT_M + NDMA;
  static_assert(A2_REGSTAGE || (NSK >= 4 && NSV >= 3), "ring depths");
  static_assert(NSK == NSV || NSK == NSV + 1, "ring depths");
  constexpr int K_OFF = 0, V_OFF = NSK * SHM_K, WS_OFF = V_OFF + NSV * SHM_V;
  const int tid = opaque_v((int)threadIdx.x), wid = __builtin_amdgcn_readfirstlane(tid >> 6), lane = tid & 63, r32 = lane & 31, hi = lane >> 5, grp = wid >> 2;
  LAS float* ws = (LAS float*)(lds + WS_OFF) + wid * 64; LAS float* li_l = ws; LAS float* al_l = ws + 32;
  const char* srcK[NKI]; int stepK[NKI];
#pragma unroll
  for (int i = 0; i < NKI; ++i) { const int P = i * 8192 + wid * 1024 + lane * 16, row = P / ROWB, cbs = P - row * ROWB, cb = cbs ^ ((row & 7) << 4);
    if (X && cb >= 256) { srcK[i] = (const char*)Kr + (size_t)row * (ldkr * 2) + (cb - 256); stepK[i] = KVBLK * ldkr * 2; }
    else { srcK[i] = (const char*)Kh + (size_t)row * (ldk * 2) + cb; stepK[i] = KVBLK * ldk * 2; } }
  const char* srcV[NVI];
#pragma unroll
  for (int i = 0; i < NVI; ++i) { const int P = i * 8192 + wid * 1024 + lane * 16, sub = P >> 9, kkh = sub >> 2, cblk = sub & 3, win = P & 511, kkl = win >> 6, cl = (win & 63) >> 1;
    const int kk = kkh * 8 + kkl, k = (kk & ~0xC) | ((kk & 4) << 1) | ((kk & 8) >> 1), c = cblk * 32 + cl;
    srcV[i] = (const char*)Vh + (size_t)k * (ldv * 2) + c * 2; }
#if A2_BUF
  unsigned long long b0_ = (unsigned long long)(size_t)Kh; { const unsigned long long v_ = (unsigned long long)(size_t)Vh, r_ = X ? (unsigned long long)(size_t)Kr : b0_; b0_ = b0_ < v_ ? b0_ : v_; b0_ = b0_ < r_ ? b0_ : r_; }
  const unsigned b0lo = __builtin_amdgcn_readfirstlane((unsigned)b0_), b0hi = __builtin_amdgcn_readfirstlane((unsigned)(b0_ >> 32));
  const char* B0 = (const char*)(size_t)(((unsigned long long)b0hi << 32) | b0lo);
  const __amdgpu_buffer_rsrc_t rsrc = __builtin_amdgcn_make_buffer_rsrc((void*)B0, 0, -1, 0x00020000);
  unsigned offK[NKI], offV[NVI];
#pragma unroll
  for (int i = 0; i < NKI; ++i) offK[i] = (unsigned)(srcK[i] - B0);
#pragma unroll
  for (int i = 0; i < NVI; ++i) offV[i] = (unsigned)(srcV[i] - B0);
#define A2_ISSUE_K(t, st) do { _Pragma("unroll") for (int _i = 0; _i < NKI; ++_i) \
    __builtin_amdgcn_raw_ptr_buffer_load_lds(rsrc, (LAS void*)(lds + K_OFF + (st) * SHM_K + _i * 8192 + wid * 1024), 16, (int)(offK[_i] + __umul24((unsigned)(t), (unsigned)stepK[_i])), 0, 0, 0); } while (0)
#define A2_ISSUE_V(t, st) do { _Pragma("unroll") for (int _i = 0; _i < NVI; ++_i) \
    __builtin_amdgcn_raw_ptr_buffer_load_lds(rsrc, (LAS void*)(lds + V_OFF + (st) * SHM_V + _i * 8192 + wid * 1024), 16, (int)offV[_i], (int)((t) * (KVBLK * ldv * 2)), 0, 0); } while (0)
#else
#define A2_ISSUE_K(t, st) do { _Pragma("unroll") for (int _i = 0; _i < NKI; ++_i) \
    __builtin_amdgcn_global_load_lds((const unsigned*)(srcK[_i] + (size_t)(t) * stepK[_i]), (LAS unsigned*)(lds + K_OFF + (st) * SHM_K + _i * 8192 + wid * 1024), 16, 0, 0); } while (0)
#define A2_ISSUE_V(t, st) do { _Pragma("unroll") for (int _i = 0; _i < NVI; ++_i) \
    __builtin_amdgcn_global_load_lds((const unsigned*)(srcV[_i] + (size_t)(t) * (KVBLK * ldv * 2)), (LAS unsigned*)(lds + V_OFF + (st) * SHM_V + _i * 8192 + wid * 1024), 16, 0, 0); } while (0)
#endif
  u32x4 rgK[NKI], rgV[NVI];
#define A2_LOAD_K(t) do { _Pragma("unroll") for (int _i = 0; _i < NKI; ++_i) rgK[_i] = *(const u32x4*)(srcK[_i] + (size_t)(t) * stepK[_i]); } while (0)
#define A2_LOAD_V(t) do { _Pragma("unroll") for (int _i = 0; _i < NVI; ++_i) rgV[_i] = *(const u32x4*)(srcV[_i] + (size_t)(t) * (KVBLK * ldv * 2)); } while (0)
#define A2_WRITE_K(st) do { _Pragma("unroll") for (int _i = 0; _i < NKI; ++_i) *(LAS u32x4*)(lds + K_OFF + (st) * SHM_K + _i * 8192 + wid * 1024 + lane * 16) = rgK[_i]; } while (0)
#define A2_WRITE_V(st) do { _Pragma("unroll") for (int _i = 0; _i < NVI; ++_i) *(LAS u32x4*)(lds + V_OFF + (st) * SHM_V + _i * 8192 + wid * 1024 + lane * 16) = rgV[_i]; } while (0)
  const int NT = seq / KVBLK; A2_TDECL
  asm volatile("s_waitcnt vmcnt(0) lgkmcnt(0)" ::: "memory"); A2_BAR();
  if constexpr (A2_REGSTAGE) {
    A2_LOAD_K(0); A2_LOAD_V(0); A2_WRITE_K(0); A2_WRITE_V(0);
    A2_LOAD_K(NT > 1 ? 1 : 0); A2_WRITE_K(1);
    A2_LOAD_K(NT > 2 ? 2 : NT - 1); A2_LOAD_V(NT > 1 ? 1 : 0);
  } else {
#pragma unroll
  for (int t = 0; t < NSV - 2; ++t) A2_ISSUE_V(t < NT ? t : NT - 1, t);
#pragma unroll
  for (int t = 0; t < NSK - 1; ++t) A2_ISSUE_K(t < NT ? t : NT - 1, t);
  }
  float m_reg = -1e30f, l_reg = 0; f32x16 o[4] = {}; bf16x8 qr[NQ];
  const bf16_t* Qw = Qb + (long)(wid * QBLK + r32) * ldq + hi * 8;
#pragma unroll
  for (int d0 = 0; d0 < NQ; ++d0) qr[d0] = *reinterpret_cast<const bf16x8*>(Qw + d0 * 16);
  if constexpr (!X) {
    float ss = 0.f;
#pragma unroll
    for (int d0 = 0; d0 < 8; ++d0) { const u32x4 w = *reinterpret_cast<const u32x4*>(&qr[d0]);
#pragma unroll
      for (int q = 0; q < 4; ++q) { const float x0 = __uint_as_float(w[q] << 16), x1 = __uint_as_float(w[q] & 0xffff0000u); ss += x0 * x0 + x1 * x1; } }
    ss += __shfl_xor(ss, 32);
    const float rstd = 1.0f / sqrtf(ss * (1.0f / 128.0f) + 1e-6f);
    const int t = qt0 >= 0 ? qt0 + wid * QBLK + r32 : 0;
#pragma unroll
    for (int d0 = 0; d0 < 8; ++d0) { u32x4 w = *reinterpret_cast<const u32x4*>(&qr[d0]);
      const f32x4 g0 = *reinterpret_cast<const f32x4*>(qg + d0 * 16 + hi * 8), g1 = *reinterpret_cast<const f32x4*>(qg + d0 * 16 + hi * 8 + 4);
      const int pos = d0 < 4 ? (t >> 6) : (t & 63), ti = pos * 32 + (d0 & 3) * 8 + hi * 4; const f32x4 cs = *reinterpret_cast<const f32x4*>(rt + ti), sn = *reinterpret_cast<const f32x4*>(rt + 2048 + ti);
      const float gg[8] = {g0[0], g0[1], g0[2], g0[3], g1[0], g1[1], g1[2], g1[3]};
#pragma unroll
      for (int q = 0; q < 4; ++q) { const float x0 = __uint_as_float(w[q] << 16) * rstd * gg[2 * q], x1 = __uint_as_float(w[q] & 0xffff0000u) * rstd * gg[2 * q + 1]; w[q] = cvtpk(x0 * cs[q] - x1 * sn[q], x0 * sn[q] + x1 * cs[q]); }
      qr[d0] = *reinterpret_cast<const bf16x8*>(&w); }
  } else {
    { const int t = qt0 >= 0 ? qt0 + wid * QBLK + r32 : 0;
#pragma unroll
      for (int d0 = 8; d0 < 12; ++d0) { u32x4 w = *reinterpret_cast<const u32x4*>(&qr[d0]);
        const int j0 = (d0 - 8) * 8 + hi * 4, pos = d0 < 10 ? (t >> 6) : (t & 63), ti = pos * 16 + (j0 & 15);
        const f32x4 cs = *reinterpret_cast<const f32x4*>(rt + ti), sn = *reinterpret_cast<const f32x4*>(rt + 1024 + ti);
#pragma unroll
        for (int q = 0; q < 4; ++q) { const float x0 = __uint_as_float(w[q] << 16), x1 = __uint_as_float(w[q] & 0xffff0000u); w[q] = cvtpk(x0 * cs[q] - x1 * sn[q], x0 * sn[q] + x1 * cs[q]); }
        qr[d0] = *reinterpret_cast<const bf16x8*>(&w); } }
  }
  asm volatile("s_waitcnt vmcnt(0) lgkmcnt(0)" ::: "memory"); A2_BAR();
  if (grp == 1) A2_BAR();
  const int vb0 = (int)(unsigned)(size_t)(lds + V_OFF) + v_rd_base(lane);
  f32x16 s0, s1; bf16x8 pa0, pa1, pa2, pa3; float alpha, mnC_ = 0.f;
  if constexpr (A2_SHADOW_) { pa0 = (bf16x8){}; pa1 = pa0; pa2 = pa0; pa3 = pa0; }
  int kst = 0, kis = NSK - 1, vst = NSV - 1, vis = NSV - 2;
#pragma unroll 1
  for (int i = 0; i < NT; ++i) {
    A2_T(0);
    __builtin_amdgcn_s_setprio(1);
    qk_tile<DQK>(s0, s1, (const LASc*)(lds + K_OFF + kst * SHM_K), qr, r32, hi);
    A2_TQ();
    if constexpr (A2_SHADOW_) { pv_pipe_s1<DQK, true>(o, vb0 + (i > 0 ? vst : 0) * SHM_V, pa0, pa1, pa2, pa3, s0, s1, m_reg, alpha, mnC_); }
    else { if (i > 0) pv_pipe(o, vb0 + vst * SHM_V, pa0, pa1, pa2, pa3); }
    __builtin_amdgcn_s_setprio(0);
    A2_T(1);
    if constexpr (!A2_REGSTAGE) asm volatile("s_waitcnt vmcnt(%0)" :: "n"(NWAIT_M) : "memory");
    A2_BAR();
    A2_T(2);
    const int tv_ = i + NSV - 2 < NT ? i + NSV - 2 : NT - 1, tk_ = i + NSK - 1 < NT ? i + NSK - 1 : NT - 1;
    if constexpr (A2_SHADOW_) softmax_p2<DQK>(s0, s1, mnC_, alpha, l_reg, pa0, pa1, pa2, pa3);
    else
    softmax_tile<DQK>(s0, s1, m_reg, l_reg, alpha, pa0, pa1, pa2, pa3, [&](const int k) {
      if constexpr (!A2_REGSTAGE && A2_SPREAD) {
        __builtin_amdgcn_sched_barrier(0);
        if (k < NVI) __builtin_amdgcn_global_load_lds((const unsigned*)(srcV[k] + (size_t)tv_ * (KVBLK * ldv * 2)), (LAS unsigned*)(lds + V_OFF + vis * SHM_V + k * 8192 + wid * 1024), 16, 0, 0);
        else if (k - NVI < NKI) __builtin_amdgcn_global_load_lds((const unsigned*)(srcK[k - NVI] + (size_t)tk_ * stepK[k - NVI]), (LAS unsigned*)(lds + K_OFF + kis * SHM_K + (k - NVI) * 8192 + wid * 1024), 16, 0, 0);
        __builtin_amdgcn_sched_barrier(0);
      } });
    A2_TX(7);
    if (__any(alpha < 1.f)) { if (hi == 0) al_l[r32] = alpha; asm volatile("s_waitcnt lgkmcnt(0)" ::: "memory");
#pragma unroll
      for (int d = 0; d < 4; ++d)
#pragma unroll
        for (int r = 0; r < 16; ++r) o[d][r] *= al_l[crow(r, hi)]; }
    __builtin_amdgcn_sched_barrier(0);
    A2_TX(8);
    if constexpr (A2_REGSTAGE) {
      A2_WRITE_V(vis); A2_WRITE_K(kis);
      __builtin_amdgcn_sched_barrier(0);
      { const int tv = i + 2 < NT ? i + 2 : NT - 1, tk = i + 3 < NT ? i + 3 : NT - 1; A2_LOAD_V(tv); A2_LOAD_K(tk); }
      A2_T3();
      asm volatile("s_waitcnt lgkmcnt(0)" ::: "memory"); A2_BAR();
    } else {
    if constexpr (!A2_SPREAD) { A2_ISSUE_V(tv_, vis); A2_ISSUE_K(tk_, kis); }
    A2_T3();
    asm volatile("s_waitcnt vmcnt(%0)" :: "n"(NWAIT_V) : "memory"); A2_BAR();
    }
    A2_T(4);
    kst = kst == NSK - 1 ? 0 : kst + 1; kis = kis == NSK - 1 ? 0 : kis + 1; vst = vst == NSV - 1 ? 0 : vst + 1; vis = vis == NSV - 1 ? 0 : vis + 1;
  }
  if (grp == 0) A2_BAR();
  pv_pipe(o, vb0 + vst * SHM_V, pa0, pa1, pa2, pa3);
  if (hi == 0) li_l[r32] = l_reg; asm volatile("s_waitcnt lgkmcnt(0)" ::: "memory");
  float rli[16];
#pragma unroll
  for (int r = 0; r < 16; ++r) rli[r] = __builtin_amdgcn_rcpf(li_l[crow(r, hi)]);
  unsigned char* Ow = Ob + (long)(wid * QBLK) * ldo;
#pragma unroll
  for (int r = 0; r < 16; ++r) { const int orow = crow(r, hi);
#pragma unroll
    for (int d0 = 0; d0 < 4; ++d0) { const float ov = __builtin_fminf(__builtin_fmaxf(o[d0][r] * rli[r] * AO_SCALE, -448.f), 448.f); Ow[(long)orow * ldo + d0 * 32 + r32] = (unsigned char)(__builtin_amdgcn_cvt_pk_fp8_f32(ov, 0.f, 0, false) & 0xff); } }
#undef A2_ISSUE_K
#undef A2_ISSUE_V
#undef A2_LOAD_K
#undef A2_LOAD_V
#undef A2_WRITE_K
#undef A2_WRITE_V
}
#undef KSWZ2
#undef A2_BAR
}
#ifndef TOPK_DYN
#define TOPK_DYN 0
#endif
#ifndef PERM_OY
#define PERM_OY 1
#endif
#ifndef PERM_HK
#define PERM_HK 1
#endif
#ifndef LN2_LDSV
#define LN2_LDSV 1
#endif
#ifndef LN2_SKIP
#define LN2_SKIP 1
#endif
#ifndef LN2_NEB
#define LN2_NEB 2
#endif
#ifndef LN_RECOMP
#define LN_RECOMP 1
#endif
struct Frame {
    LAS unsigned char* lds;
    int tid, lane, wave, vcu, G, gw, ngw;
    float* out;
    unsigned char* ws;
};
enum { I_X = 0, I_C, I_CTX, I_CCTX, I_ADAW, I_ADAB, I_LMG, I_LMB, I_LFG, I_LFB, I_RW, I_WG, I_WU, I_WDN, I_GQKV, I_GQG, I_GKG, I_GWO, I_MDQ, I_MQG, I_MUQ, I_MDKV, I_MKVG, I_MUKV, I_MWO };

__device__ __forceinline__ u32x2 pack4(const f32x4 v) { u32x2 w; w.x = cvt_pk_bf16(v[0], v[1]); w.y = cvt_pk_bf16(v[2], v[3]); return w; }
__device__ __forceinline__ f32x4 unpack4(const u32x2 w) { return (f32x4){__uint_as_float(w.x << 16), __uint_as_float(w.x & 0xffff0000u), __uint_as_float(w.y << 16), __uint_as_float(w.y & 0xffff0000u)}; }
__device__ __forceinline__ float silu_f(float x) { return x / (1.0f + __expf(-x)); }

__device__ __forceinline__ void transpose_item(const float* W, int N, const float* g, bf16_t* dst, int ldd, int row_off, int il, LAS float* scr, int item, int lane) {
    const int nblk = N / 32, kb = item / nblk, nb = item % nblk, k0 = 64 * kb, n0 = 32 * nb;
#pragma unroll 8
    for (int i = 0; i < 32; ++i) { const int kk = 2 * i + (lane >> 5); float v = __builtin_nontemporal_load(&W[(size_t)(k0 + kk) * N + n0 + (lane & 31)]); if (g) v *= g[k0 + kk]; scr[kk * 33 + (lane & 31)] = v; }
    LDS_WAIT(); asm volatile("" ::: "memory");
    const int c = lane & 7;
#pragma unroll
    for (int j = 0; j < 4; ++j) { const int n = (lane >> 3) + 8 * j; const LAS float* s = scr + (8 * c) * 33 + n;
        u32x4 o; o.x = cvt_pk_bf16(s[0 * 33], s[1 * 33]); o.y = cvt_pk_bf16(s[2 * 33], s[3 * 33]); o.z = cvt_pk_bf16(s[4 * 33], s[5 * 33]); o.w = cvt_pk_bf16(s[6 * 33], s[7 * 33]);
        const int nn = n0 + n, dr = row_off + (il ? ((nn >> 7) << 8) + (nn & 127) : nn);
        *(u32x4*)(dst + (size_t)dr * ldd + k0 + 8 * c) = o; }
    LDS_WAIT(); asm volatile("" ::: "memory");
}

__device__ __forceinline__ int perm_oy(int c) { const int ch = c >> 2, e = c & 3, L = ch & 63, j = ch >> 6; return 8 * (L + 64 * (j >> 1)) + 4 * (j & 1) + e; }
__device__ __forceinline__ void transpose_item_fp8(const float* W, int N, float scale, unsigned char* dst, int ldd, int row_off, int il, LAS float* scr, int item, int lane, const float* g = nullptr, bool kp = false) {
    const int nblk = N / 32, kb = item / nblk, nb = item % nblk, k0 = 64 * kb, n0 = 32 * nb;
    { f32x4 wv[8];
#pragma unroll
      for (int i = 0; i < 8; ++i) { const int kk = 8 * i + (lane >> 3), ks = kp ? 4 * (4 * kb + (kk >> 4)) + (kk & 3) + 256 * ((kk >> 2) & 3) : k0 + kk; wv[i] = __builtin_nontemporal_load((const f32x4*)&W[(size_t)ks * N + n0 + 4 * (lane & 7)]); }
#pragma unroll
      for (int i = 0; i < 8; ++i) { const int kk = 8 * i + (lane >> 3); float sc = scale; if (g) sc *= g[k0 + kk]; LAS float* d = scr + kk * 33 + 4 * (lane & 7);
        d[0] = wv[i][0] * sc; d[1] = wv[i][1] * sc; d[2] = wv[i][2] * sc; d[3] = wv[i][3] * sc; } }
    LDS_WAIT(); asm volatile("" ::: "memory");
    const int n = lane >> 1, kh = (lane & 1) * 32; const LAS float* s = scr + kh * 33 + n;
    u32x4 o0, o1;
#pragma unroll
    for (int q = 0; q < 4; ++q) { o0[q] = cvt4_fp8(s[(4 * q + 0) * 33], s[(4 * q + 1) * 33], s[(4 * q + 2) * 33], s[(4 * q + 3) * 33]); o1[q] = cvt4_fp8(s[(16 + 4 * q + 0) * 33], s[(16 + 4 * q + 1) * 33], s[(16 + 4 * q + 2) * 33], s[(16 + 4 * q + 3) * 33]); }
    const int nn = n0 + n, dr = row_off + (il == 2 ? perm_oy(nn) : il ? ((nn >> 7) << 8) + (nn & 127) : nn);
    u32x4* dp = (u32x4*)(dst + (size_t)dr * ldd + k0 + kh); dp[0] = o0; dp[1] = o1;
    LDS_WAIT(); asm volatile("" ::: "memory");
}

__device__ __forceinline__ void phase_p0a(Frame& F) {
    LAS float* scr = (LAS float*)(F.lds + F.wave * 9216);
    constexpr int I_QKV = 16 * 48, I_WO = 16 * 32, I_DQ = 16 * 24, I_DKV = 16 * 10, I_UQ = 12 * 48, I_UKV = 4 * 64;
    constexpr int PERJ = I_QKV + I_WO + I_DQ + I_DKV + I_UQ + I_UKV + I_WO;
    for (int it = F.gw; it < 2 * PERJ; it += F.ngw) {
        const int j = it / PERJ; int r = it - j * PERJ;
        if (r < I_QKV) { transpose_item_fp8(in_ptr(I_GQKV) + (size_t)j * 1024 * 1536, 1536, WP_SCALE, (unsigned char*)(F.ws + WS_WQKV) + (size_t)j * 1536 * 1024, 1024, 0, 0, scr, r, F.lane, nullptr, PERM_HK != 0); continue; } r -= I_QKV;
        if (r < I_WO) { transpose_item_fp8(in_ptr(I_GWO) + (size_t)j * 1024 * 1024, 1024, WO_SCALE, (unsigned char*)(F.ws + WS_WOG) + (size_t)j * 1024 * 1024, 1024, 0, PERM_OY ? 2 : 0, scr, r, F.lane); continue; } r -= I_WO;
        if (r < I_DQ) { transpose_item_fp8(in_ptr(I_MDQ) + (size_t)j * 1024 * 768, 768, WP_SCALE, (unsigned char*)(F.ws + WS_WD) + (size_t)j * 1280 * 1024, 1024, 0, 0, scr, r, F.lane, nullptr, PERM_HK != 0); continue; } r -= I_DQ;
        if (r < I_DKV) { transpose_item_fp8(in_ptr(I_MDKV) + (size_t)j * 1024 * 320, 320, WP_SCALE, (unsigned char*)(F.ws + WS_WD) + (size_t)j * 1280 * 1024, 1024, 768, 0, scr, r, F.lane, nullptr, PERM_HK != 0); continue; } r -= I_DKV;
        if (r < I_UQ) { transpose_item_fp8(in_ptr(I_MUQ) + (size_t)j * 768 * 1536, 1536, WP_SCALE, (unsigned char*)(F.ws + WS_WUQ) + (size_t)j * 1536 * 768, 768, 0, 0, scr, r, F.lane, in_ptr(I_MQG) + j * 768); continue; } r -= I_UQ;
        if (r < I_UKV) { transpose_item(in_ptr(I_MUKV) + (size_t)j * 256 * 2048, 2048, in_ptr(I_MKVG) + j * 256, (bf16_t*)(F.ws + WS_WUKV) + (size_t)j * 2048 * 256, 256, 0, 0, scr, r, F.lane); continue; } r -= I_UKV;
        transpose_item_fp8(in_ptr(I_MWO) + (size_t)j * 1024 * 1024, 1024, WO_SCALE, (unsigned char*)(F.ws + WS_WOM) + (size_t)j * 1024 * 1024, 1024, 0, PERM_OY ? 2 : 0, scr, r, F.lane);
    }
    for (int i = blockIdx.x * NTHR + F.tid; i < 2 * 12288; i += F.G * NTHR) { const int j = i / 12288, q = i - j * 12288;
        *((u32x4*)((unsigned char*)(F.ws + WS_WD) + (size_t)j * 1280 * 1024 + (size_t)1088 * 1024) + q) = (u32x4){0u, 0u, 0u, 0u}; }
    { int* idn = (int*)(F.ws + WS_GVAL); for (int i = blockIdx.x * NTHR + F.tid; i < NSLOT; i += F.G * NTHR) idn[i] = i; }
    { float* rt = (float*)(F.ws + WS_ROPE); const int i = blockIdx.x * NTHR + F.tid;
        if (i < 2048) { const int pos = i >> 5, m = i & 31; const float fr = powf(10000.0f, -(float)(2 * m) / 64.0f), a = (float)pos * fr; rt[i] = cosf(a); rt[2048 + i] = sinf(a); }
        else if (i < 3072) { const int q = i - 2048, pos = q >> 4, m = q & 15; const float fr = powf(10000.0f, -(float)(2 * m) / 32.0f), a = (float)pos * fr; rt[4096 + q] = cosf(a); rt[5120 + q] = sinf(a); } }
    { float* modp = (float*)(F.ws + WS_R + R_MODP); LAS float* s = (LAS float*)(F.lds + F.wave * 9216);
        for (int it = F.gw; it < NL * 96 * MOD_KC; it += F.ngw) {
            const int kc = it % MOD_KC, cg = (it / MOD_KC) % 96, li = it / (MOD_KC * 96);
            for (int q = F.lane; q < 33 * 64; q += 64) { const int b = q >> 6, kk = q & 63; const float cv = b < 32 ? in_ptr(I_C)[b * D + kc * 64 + kk] : in_ptr(I_CCTX)[kc * 64 + kk]; s[kk * 36 + b] = silu_f(cv); }
            LDS_WAIT(); asm volatile("" ::: "memory");
            float acc[33];
#pragma unroll
            for (int b = 0; b < 33; ++b) acc[b] = 0.f;
            const float* wp = in_ptr(I_ADAW) + ((size_t)li * D + kc * 64) * MODSZ + cg * 64 + F.lane;
#pragma unroll 1
            for (int k8 = 0; k8 < 64; k8 += 16) { float wv[16];
#pragma unroll
                for (int q = 0; q < 16; ++q) wv[q] = __builtin_nontemporal_load(&wp[(size_t)(k8 + q) * MODSZ]);
#pragma unroll
                for (int q = 0; q < 16; ++q) { const int kk = k8 + q; const float w = wv[q];
#pragma unroll
                    for (int b4 = 0; b4 < 8; ++b4) { const f32x4 sv = *(const LAS f32x4*)(s + kk * 36 + b4 * 4); acc[b4 * 4 + 0] += sv[0] * w; acc[b4 * 4 + 1] += sv[1] * w; acc[b4 * 4 + 2] += sv[2] * w; acc[b4 * 4 + 3] += sv[3] * w; }
                    acc[32] += s[kk * 36 + 32] * w; } }
            float* op = modp + ((size_t)(kc * NL + li) * 33) * MODSZ + cg * 64 + F.lane;
#pragma unroll
            for (int b = 0; b < 33; ++b) op[(size_t)b * MODSZ] = acc[b];
            LDS_WAIT(); asm volatile("" ::: "memory");
        } }
}
__device__ __forceinline__ void phase_p0b(Frame& F) {
    const float* modp = (const float*)(F.ws + WS_R + R_MODP); float* mod = (float*)(F.ws + WS_MOD);
    for (int i = blockIdx.x * NTHR + F.tid; i < NL * 33 * MODSZ; i += F.G * NTHR) { const int n = i % MODSZ, li = i / (33 * MODSZ); float a = in_ptr(I_ADAB)[li * MODSZ + n];
#pragma unroll
        for (int kc = 0; kc < MOD_KC; ++kc) a += modp[(size_t)kc * NL * 33 * MODSZ + i];
        mod[i] = a; }
}
__device__ __forceinline__ const float* xrow_in(const float* xl, const float* xc, int b, int p) { return p < CTXL ? xc + ((size_t)b * CTXL + p) * D : xl + ((size_t)b * SEQ + (p - CTXL)) * D; }

__device__ __forceinline__ void phase_p0c(Frame& F) {
    const float* mod = (const float*)(F.ws + WS_MOD); unsigned char* H8 = (unsigned char*)(F.ws + WS_H);
    for (int r2 = F.gw * 2; r2 < T; r2 += F.ngw * 2) {
        f32x4 xa[2][4];
#pragma unroll
        for (int i = 0; i < 2; ++i) { const int r = r2 + i, b = r / TPS, p = r - b * TPS; const f32x4* xr = (const f32x4*)xrow_in(in_ptr(I_X), in_ptr(I_CTX), b, p) + F.lane;
#pragma unroll
            for (int j = 0; j < 4; ++j) xa[i][j] = __builtin_nontemporal_load(&xr[64 * j]); }
#pragma unroll
        for (int i = 0; i < 2; ++i) { const int r = r2 + i, b = r / TPS, p = r - b * TPS; const float* mv = mod + (size_t)(p < CTXL ? 32 : b) * MODSZ; unsigned* hr = (unsigned*)(H8 + (size_t)r * D) + F.lane; u32x4 hw;
#pragma unroll
            for (int j = 0; j < 4; ++j) { const f32x4 sh = *((const f32x4*)mv + F.lane + 64 * j), sc = *((const f32x4*)(mv + D) + F.lane + 64 * j); const f32x4 hv = xa[i][j] * (1.0f + sc) + sh; hw[j] = cvt4_fp8(hv[0], hv[1], hv[2], hv[3]); if (!PERM_HK) hr[64 * j] = hw[j]; }
            if (PERM_HK) *((u32x4*)(H8 + (size_t)r * D) + F.lane) = hw; } }
}

__device__ __forceinline__ void phase_qknorm(Frame& F, int j, bf16_t* dry) {
    bf16_t* QKV = (bf16_t*)(F.ws + WS_R + R_QKV); const ptrdiff_t dofs = dry ? dry - QKV : 0; const float* rt = (const float*)(F.ws + WS_ROPE);
    const float* kg = in_ptr(I_GKG) + j * 128;
    const int l16 = F.lane & 15, hd = (F.lane >> 4) & 1, rsel = F.lane >> 5;
    const f32x4 gk0 = *(const f32x4*)(kg + l16 * 8), gk1 = *(const f32x4*)(kg + l16 * 8 + 4);
    for (int r2 = F.gw; r2 < T / 2; r2 += F.ngw) { const int r = 2 * r2 + rsel; const int b = r / TPS, p = r - b * TPS; const int t = p >= CTXL ? p - CTXL : 0, trow = t >> 6, tcol = t & 63;
        const int j0 = l16 * 4, pos = j0 < 32 ? trow : tcol, ti = pos * 32 + (j0 & 31);
        const f32x4 cs = *(const f32x4*)(rt + ti), sn = *(const f32x4*)(rt + 2048 + ti);
        u32x4* ptr = (u32x4*)(QKV + (size_t)r * 1536 + 1024 + hd * 128 + l16 * 8); const u32x4 w = *ptr;
        f32x4 a = {__uint_as_float(w.x << 16), __uint_as_float(w.x & 0xffff0000u), __uint_as_float(w.y << 16), __uint_as_float(w.y & 0xffff0000u)};
        f32x4 c = {__uint_as_float(w.z << 16), __uint_as_float(w.z & 0xffff0000u), __uint_as_float(w.w << 16), __uint_as_float(w.w & 0xffff0000u)};
        float ss = (a[0] * a[0] + a[1] * a[1]) + (a[2] * a[2] + a[3] * a[3]) + (c[0] * c[0] + c[1] * c[1]) + (c[2] * c[2] + c[3] * c[3]);
        ss += __shfl_xor(ss, 1); ss += __shfl_xor(ss, 2); ss += __shfl_xor(ss, 4); ss += __shfl_xor(ss, 8);
        const float rstd = 1.0f / sqrtf(ss * (1.0f / 128.0f) + LN_EPS);
        a = a * rstd * gk0; c = c * rstd * gk1;
        const f32x4 a2 = {a[0] * cs[0] - a[1] * sn[0], a[0] * sn[0] + a[1] * cs[0], a[2] * cs[1] - a[3] * sn[1], a[2] * sn[1] + a[3] * cs[1]};
        const f32x4 c2 = {c[0] * cs[2] - c[1] * sn[2], c[0] * sn[2] + c[1] * cs[2], c[2] * cs[3] - c[3] * sn[3], c[2] * sn[3] + c[3] * cs[3]};
        u32x4 o; o.x = cvt_pk_bf16(a2[0], a2[1]); o.y = cvt_pk_bf16(a2[2], a2[3]); o.z = cvt_pk_bf16(c2[0], c2[1]); o.w = cvt_pk_bf16(c2[2], c2[3]); *(u32x4*)((bf16_t*)ptr + dofs) = o; }
}
__device__ __forceinline__ void phase_mla_stats(Frame& F, bf16_t* dry) {
    bf16_t* CQ = (bf16_t*)(F.ws + WS_R + R_CQ); unsigned char* CQ8 = (unsigned char*)(F.ws + WS_CQ8); bf16_t* KR = (bf16_t*)(F.ws + WS_KR); const ptrdiff_t dofs = dry ? dry - CQ : 0; const float* rt = (const float*)(F.ws + WS_ROPE) + 4096;
    for (int r4 = F.gw * 4; r4 < T; r4 += F.ngw * 4) {
        u32x4 w0a[4], w1a[4], wka[4];
#pragma unroll
        for (int i = 0; i < 4; ++i) { const bf16_t* row = CQ + (size_t)(r4 + i) * 1280; w0a[i] = *(const u32x4*)(row + F.lane * 8); w1a[i] = *(const u32x4*)(row + 512 + F.lane * 8); wka[i] = *(const u32x4*)(row + 1024 + (F.lane & 7) * 8); }
#pragma unroll
        for (int i = 0; i < 4; ++i) { const int r = r4 + i; const int b = r / TPS, p = r - b * TPS; const int t = p >= CTXL ? p - CTXL : 0, trow = t >> 6, tcol = t & 63;
        bf16_t* row = CQ + (size_t)r * 1280; const u32x4 w0 = w0a[i], w1 = w1a[i];
        float s0 = 0.f, s1 = 0.f;
#pragma unroll
        for (int q = 0; q < 4; ++q) { const float a = __uint_as_float(w0[q] << 16), c = __uint_as_float(w0[q] & 0xffff0000u); s0 += a * a + c * c; const float a1 = __uint_as_float(w1[q] << 16), c1 = __uint_as_float(w1[q] & 0xffff0000u); s1 += a1 * a1 + c1 * c1; }
        const float sq = wave_sum(s0 + (F.lane < 32 ? s1 : 0.f)), skv = wave_sum(F.lane >= 32 ? s1 : 0.f);
        const float rq = 1.0f / sqrtf(sq * (1.0f / 768.0f) + LN_EPS), rkv = 1.0f / sqrtf(skv * (1.0f / 256.0f) + LN_EPS);
        { unsigned char* c8 = CQ8 + (size_t)r * 768; u32x2 q0; q0.x = cvt4_fp8(__uint_as_float(w0[0] << 16) * rq, __uint_as_float(w0[0] & 0xffff0000u) * rq, __uint_as_float(w0[1] << 16) * rq, __uint_as_float(w0[1] & 0xffff0000u) * rq);
          q0.y = cvt4_fp8(__uint_as_float(w0[2] << 16) * rq, __uint_as_float(w0[2] & 0xffff0000u) * rq, __uint_as_float(w0[3] << 16) * rq, __uint_as_float(w0[3] & 0xffff0000u) * rq); *(u32x2*)(c8 + F.lane * 8) = q0;
          if (F.lane < 32) { u32x2 q1; q1.x = cvt4_fp8(__uint_as_float(w1[0] << 16) * rq, __uint_as_float(w1[0] & 0xffff0000u) * rq, __uint_as_float(w1[1] << 16) * rq, __uint_as_float(w1[1] & 0xffff0000u) * rq);
            q1.y = cvt4_fp8(__uint_as_float(w1[2] << 16) * rq, __uint_as_float(w1[2] & 0xffff0000u) * rq, __uint_as_float(w1[3] << 16) * rq, __uint_as_float(w1[3] & 0xffff0000u) * rq); *(u32x2*)(c8 + 512 + F.lane * 8) = q1; }
          else { u32x4 o1;
#pragma unroll
            for (int q = 0; q < 4; ++q) o1[q] = cvt_pk_bf16(__uint_as_float(w1[q] << 16) * rkv, __uint_as_float(w1[q] & 0xffff0000u) * rkv);
            *(u32x4*)(row + dofs + 512 + F.lane * 8) = o1; } }
        if (F.lane < 8) { const u32x4 w = wka[i]; u32x4 o = w;
            { const int j0 = F.lane * 4, pos = j0 < 16 ? trow : tcol, ti = pos * 16 + (j0 & 15); const f32x4 cs = *(const f32x4*)(rt + ti), sn = *(const f32x4*)(rt + 1024 + ti);
#pragma unroll
                for (int q = 0; q < 4; ++q) { const float x0 = __uint_as_float(w[q] << 16), x1 = __uint_as_float(w[q] & 0xffff0000u); o[q] = cvt_pk_bf16(x0 * cs[q] - x1 * sn[q], x0 * sn[q] + x1 * cs[q]); } }
            *(u32x4*)(KR + (size_t)r * 64 + F.lane * 8) = o; } } }
}

__device__ __forceinline__ float lane_xor32_sum(float a) { auto rr = __builtin_amdgcn_permlane32_swap(__float_as_uint(a), __float_as_uint(a), false, false); return __uint_as_float(rr[0]) + __uint_as_float(rr[1]); }
__device__ __forceinline__ float lane_xor32_max(float a) { auto rr = __builtin_amdgcn_permlane32_swap(__float_as_uint(a), __float_as_uint(a), false, false); return fmaxf(__uint_as_float(rr[0]), __uint_as_float(rr[1])); }
__device__ __forceinline__ float lane_xor4(float v) {
    const int a = __builtin_amdgcn_update_dpp(0, __builtin_bit_cast(int, v), 0x114, 0xf, 0xA, false);
    return __builtin_bit_cast(float, __builtin_amdgcn_update_dpp(a, __builtin_bit_cast(int, v), 0x104, 0xf, 0x5, false));
}
__device__ __forceinline__ void ln1_reduce16(float (&acc)[16], int lane, float& lg_e) {
#pragma unroll
    for (int e = 0; e < 8; ++e) { auto rr = __builtin_amdgcn_permlane32_swap(__float_as_uint(acc[e]), __float_as_uint(acc[e + 8]), false, false); acc[e] = __uint_as_float(rr[0]) + __uint_as_float(rr[1]); }
#pragma unroll
    for (int e = 0; e < 4; ++e) { const bool up = (lane & 16) != 0; const float send = up ? acc[e] : acc[e + 4], keep = up ? acc[e + 4] : acc[e]; acc[e] = keep + lane_xor16(send); }
#pragma unroll
    for (int e = 0; e < 2; ++e) { const bool up = (lane & 8) != 0; const float send = up ? acc[e] : acc[e + 2], keep = up ? acc[e + 2] : acc[e]; acc[e] = keep + DPP_MOV(send, 0x128); }
    { const bool up = (lane & 2) != 0; const float send = up ? acc[0] : acc[1], keep = up ? acc[1] : acc[0]; acc[0] = keep + DPP_MOV(send, 0x4E); }
    float v = acc[0]; v += DPP_MOV(v, 0xB1); v += lane_xor4(v); lg_e = v;
}
__device__ __forceinline__ void phase_ln1(Frame& F, int li, const float* xin_l, const float* xin_c, const bf16_t* O, float* xdry, bool skipctx) {
    LAS float* Wt = (LAS float*)F.lds;
    { const float* rw = in_ptr(I_RW) + (size_t)li * D * NE; for (int i = F.tid; i < D * NE; i += NTHR) Wt[(i & 15) * D + (i >> 4)] = rw[i]; }
    __syncthreads();
    const float* mod = (const float*)(F.ws + WS_MOD) + (size_t)li * 33 * MODSZ; unsigned char* H8 = (unsigned char*)(F.ws + WS_H); float* AFF = (float*)(F.ws + WS_AFF); int* INV = (int*)(F.ws + WS_INV);
    f32x4 lg[4], lb[4], g1[4], sh2[4], sc2[4];
    { const float* pg = in_ptr(I_LMG) + li * D; const float* pb = in_ptr(I_LMB) + li * D;
#pragma unroll
      for (int j = 0; j < 4; ++j) { lg[j] = *((const f32x4*)pg + F.lane + 64 * j); lb[j] = *((const f32x4*)pb + F.lane + 64 * j); } }
#pragma unroll 1
    for (int rp_ = 0; rp_ < REP_LN1; ++rp_) { float* xd = rp_ + 1 < REP_LN1 ? xdry : nullptr; float* Xl = xd ? xd + (size_t)NB * CTXL * D : F.out; float* Xc = xd ? xd : (float*)(F.ws + WS_XC);
    for (int wv = F.gw; wv < 2048; wv += F.ngw) { const int b = wv >> 6, w = wv & 63;
#pragma unroll 1
        for (int seg = skipctx ? 1 : 0; seg < 2; ++seg) { const float* mv = mod + (size_t)(seg == 0 ? 32 : b) * MODSZ;
#pragma unroll
            for (int j = 0; j < 4; ++j) { g1[j] = *((const f32x4*)(mv + 2 * D) + F.lane + 64 * j); sh2[j] = *((const f32x4*)(mv + 3 * D) + F.lane + 64 * j); sc2[j] = *((const f32x4*)(mv + 4 * D) + F.lane + 64 * j); }
            const int np = seg == 0 ? 2 : 16, p0 = seg == 0 ? 4 * w : CTXL + 32 * w;
            const float* xin = seg == 0 ? xin_c + (size_t)b * CTXL * D : xin_l + ((size_t)b * SEQ - CTXL) * D;
            float* xout = seg == 0 ? Xc + (size_t)b * CTXL * D : Xl + ((size_t)b * SEQ - CTXL) * D;
            f32x4 nx[2][4]; u32x2 no[2][4];
#define LN1_FETCH(pp) do { _Pragma("unroll") for (int q = 0; q < 2; ++q) { const f32x4* xr = (const f32x4*)(xin + (size_t)((pp) + q) * D) + F.lane; const u32x2* orow = (const u32x2*)(O + ((size_t)b * TPS + (pp) + q) * D) + F.lane; \
                _Pragma("unroll") for (int j = 0; j < 4; ++j) { nx[q][j] = __builtin_nontemporal_load(&xr[64 * j]); if (!PERM_OY) no[q][j] = __builtin_nontemporal_load(&orow[64 * j]); } \
                if (PERM_OY) { const u32x4* o4 = (const u32x4*)(O + ((size_t)b * TPS + (pp) + q) * D) + F.lane; const u32x4 w0 = __builtin_nontemporal_load(&o4[0]), w1 = __builtin_nontemporal_load(&o4[64]); \
                    no[q][0] = (u32x2){w0[0], w0[1]}; no[q][1] = (u32x2){w0[2], w0[3]}; no[q][2] = (u32x2){w1[0], w1[1]}; no[q][3] = (u32x2){w1[2], w1[3]}; } } } while (0)
            LN1_FETCH(p0);
#pragma unroll 1
            for (int k = 0; k < np; ++k) { const int pA = p0 + 2 * k; const size_t rA = (size_t)b * TPS + pA;
                f32x4 v[2][4]; float s[2] = {0.f, 0.f};
#pragma unroll
                for (int q = 0; q < 2; ++q)
#pragma unroll
                    for (int j = 0; j < 4; ++j) { v[q][j] = nx[q][j] * ALPHA + g1[j] * unpack4(no[q][j]); s[q] += (v[q][j][0] + v[q][j][1]) + (v[q][j][2] + v[q][j][3]); }
                __builtin_amdgcn_sched_barrier(0);
                if (k + 1 < np) LN1_FETCH(pA + 2);
                __builtin_amdgcn_sched_barrier(0);
                float s2[2] = {0.f, 0.f};
#pragma unroll
                for (int q = 0; q < 2; ++q) { const float mean = wave_sum(s[q]) * (1.0f / D);
#pragma unroll
                    for (int j = 0; j < 4; ++j) { v[q][j] = v[q][j] - mean; s2[q] += (v[q][j][0] * v[q][j][0] + v[q][j][1] * v[q][j][1]) + (v[q][j][2] * v[q][j][2] + v[q][j][3] * v[q][j][3]); } }
#pragma unroll
                for (int q = 0; q < 2; ++q) { const float rstd = 1.0f / sqrtf(wave_sum(s2[q]) * (1.0f / D) + LN_EPS);
                    f32x4* xw = (f32x4*)(xout + (size_t)(pA + q) * D) + F.lane; unsigned* hr = (unsigned*)(H8 + (rA + q) * D) + F.lane; u32x4 hw;
#pragma unroll
                    for (int j = 0; j < 4; ++j) { v[q][j] = v[q][j] * rstd * lg[j] + lb[j]; if (!LN_RECOMP) __builtin_nontemporal_store(v[q][j], &xw[64 * j]); v[q][j] = v[q][j] * (1.0f + sc2[j]) + sh2[j]; hw[j] = cvt4_fp8(v[q][j][0], v[q][j][1], v[q][j][2], v[q][j][3]); if (!PERM_HK) hr[64 * j] = hw[j]; }
                    if (PERM_HK) *((u32x4*)(H8 + (rA + q) * D) + F.lane) = hw; }
                f32x2 hp[4][4];
#pragma unroll
                for (int j = 0; j < 4; ++j)
#pragma unroll
                    for (int c = 0; c < 4; ++c) hp[j][c] = (f32x2){v[0][j][c], v[1][j][c]};
                __builtin_amdgcn_sched_barrier(0);
                float accA[16], accB[16];
#pragma unroll
                for (int e = 0; e < 16; ++e) { f32x2 a2 = {0.f, 0.f};
#pragma unroll
                    for (int j = 0; j < 4; ++j) { const f32x4 wq = *(const LAS f32x4*)(Wt + e * D + 4 * F.lane + 256 * j);
#pragma unroll
                        for (int c = 0; c < 4; ++c) a2 = __builtin_elementwise_fma(hp[j][c], (f32x2){wq[c], wq[c]}, a2); }
                    accA[e] = a2[0]; accB[e] = a2[1]; if (e & 1) __builtin_amdgcn_sched_barrier(0); }
                float lgA, lgB; ln1_reduce16(accA, F.lane, lgA); ln1_reduce16(accB, F.lane, lgB);
#pragma unroll
                for (int q = 0; q < 2; ++q) { const float lg_e = q ? lgB : lgA;
                    float mx = lg_e; mx = fmaxf(mx, DPP_MOV(mx, 0x4E)); mx = fmaxf(mx, DPP_MOV(mx, 0x128)); mx = fmaxf(mx, lane_xor16(mx)); mx = lane_xor32_max(mx);
                    const float ex = __expf(lg_e - mx); float se = ex; se += DPP_MOV(se, 0x4E); se += DPP_MOV(se, 0x128); se += lane_xor16(se); se = lane_xor32_sum(se);
                    const int eidx = ((F.lane >> 5) << 3) | (((F.lane >> 4) & 1) << 2) | (((F.lane >> 3) & 1) << 1) | ((F.lane >> 1) & 1);
                    if ((F.lane & 5) == 0) { AFF[(rA + q) * NE + eidx] = ex / se; INV[(rA + q) * NE + eidx] = -1; } }
            } } } }
}

__device__ __forceinline__ void topk_item(Frame& F, LAS unsigned* keys, LAS unsigned* hist, int e, int row0  , int n, int cap, int slot0) {
    const float* AFF = (const float*)(F.ws + WS_AFF); int* INV = (int*)(F.ws + WS_INV); int* STOK = (int*)(F.ws + WS_STOK);
    const int nk = n >> 6;
#pragma unroll 4
    for (int k = 0; k < nk; ++k) keys[F.lane + 64 * k] = __float_as_uint(AFF[(size_t)(row0 + F.lane + 64 * k) * NE + e]);
    LDS_WAIT(); asm volatile("" ::: "memory");
    unsigned prefix = 0u, mask = 0u; int krem = cap;
#pragma unroll 1
    for (int pass = 0; pass < 4; ++pass) { const int shift = 24 - 8 * pass;
        *(LAS u32x4*)(hist + 4 * F.lane) = (u32x4){0u, 0u, 0u, 0u};
        LDS_WAIT(); asm volatile("" ::: "memory");
#pragma unroll 4
        for (int k = 0; k < nk; ++k) { const unsigned key = keys[F.lane + 64 * k]; if ((key & mask) == prefix) __hip_atomic_fetch_add(hist + ((key >> shift) & 255u), 1u, __ATOMIC_RELAXED, __HIP_MEMORY_SCOPE_WORKGROUP); }
        LDS_WAIT(); asm volatile("" ::: "memory");
        const u32x4 c = *(const LAS u32x4*)(hist + 4 * F.lane);
        const int s = (int)(c[0] + c[1] + c[2] + c[3]);
        int suf = s;
#pragma unroll
        for (int o = 1; o < 64; o <<= 1) { const int t = __shfl_down(suf, o); if (F.lane + o < 64) suf += t; }
        int cum = suf - s;
        int fbin = -1, fk = 0;
#pragma unroll
        for (int q = 3; q >= 0; --q) { const int cq = (int)c[q]; if (fbin < 0 && cum < krem && cum + cq >= krem) { fbin = 4 * F.lane + q; fk = krem - cum; } cum += cq; }
        const unsigned long long bal = __ballot(fbin >= 0); const int src = bal ? __ffsll((long long)bal) - 1 : 0;
        const int bin = __shfl(fbin, src), nkk = __shfl(fk, src);
        prefix |= (unsigned)bin << shift; mask |= 0xffu << shift; krem = nkk;
        asm volatile("" ::: "memory");
    }
    int nsel = 0, neq = 0;
    const unsigned long long lt = (1ull << F.lane) - 1ull;
#pragma unroll 2
    for (int k = 0; k < nk; ++k) { const unsigned key = keys[F.lane + 64 * k]; const bool gt = key > prefix, eq = key == prefix;
        const unsigned long long be = __ballot(eq); const int eqb = neq + __popcll(be & lt); const bool sel = gt || (eq && eqb < krem);
        const unsigned long long bs = __ballot(sel); const int pos = nsel + __popcll(bs & lt);
        if (sel && pos < cap) { const int row = row0 + F.lane + 64 * k, slot = slot0 + pos; STOK[slot] = row; INV[(size_t)row * NE + e] = slot; }
        nsel += __popcll(bs); neq += __popcll(be); }
    LDS_WAIT(); asm volatile("" ::: "memory");
}
__device__ __forceinline__ void phase_topk_conv(Frame& F, int li, bool skipctx) {
    LAS unsigned* hist = (LAS unsigned*)(F.lds + 8 * 9216 + F.wave * 1024);
#if TOPK_DYN
    LAS unsigned* ctr = (LAS unsigned*)(F.lds + MISC_OFF + 64);
    if (F.tid == 0) *ctr = 0u;
    __syncthreads();
#endif
    if (F.wave < 4) for (int it = F.vcu * 4 + F.wave; it < (skipctx ? 512 : 1024); it += F.G * 4) { const int set = it >> 9, b = (it >> 4) & 31, e = it & 15; LAS unsigned* keys = (LAS unsigned*)(F.lds + F.wave * 9216);
        if (set == 0) topk_item(F, keys, hist, e, b * TPS + CTXL, SEQ, CAPL, (b * NE + e) * CAPL);
        else topk_item(F, keys, hist, e, b * TPS, CTXL, CAPC, NSLOT_L + (e * 4 + (b >> 3)) * 256 + (b & 7) * CAPC); }
    LAS float* scr = (LAS float*)(F.lds + F.wave * 9216);
#if TOPK_DYN
    for (;;) { unsigned k_ = 0; if (F.lane == 0) k_ = __hip_atomic_fetch_add(ctr, 1u, __ATOMIC_RELAXED, __HIP_MEMORY_SCOPE_WORKGROUP); k_ = __builtin_amdgcn_readfirstlane(k_);
        const int it = F.vcu * NWAVES + (int)(k_ & 7u) + (int)(k_ >> 3) * F.ngw; if (it >= 3 * NE * 512) break;
#else
    for (int it = F.gw; it < 3 * NE * 512; it += F.ngw) {
#endif
        const int which = it / (NE * 512), rem = it - which * (NE * 512), e = rem >> 9, item = rem & 511;
        const size_t eoff = ((size_t)li * NE + e) * D * FF;
        if (which == 0) transpose_item_fp8(in_ptr(I_WG) + eoff, FF, WGU_SCALE, (unsigned char*)(F.ws + WS_WGU) + (size_t)e * 2048 * D, D, 0, 1, scr, item, F.lane, nullptr, PERM_HK != 0);
        else if (which == 1) transpose_item_fp8(in_ptr(I_WU) + eoff, FF, WGU_SCALE, (unsigned char*)(F.ws + WS_WGU) + (size_t)e * 2048 * D, D, 128, 1, scr, item, F.lane, nullptr, PERM_HK != 0);
        else transpose_item_fp8(in_ptr(I_WDN) + eoff, D, WDN_SCALE, (unsigned char*)(F.ws + WS_WDN) + (size_t)e * D * FF, FF, 0, PERM_OY ? 2 : 0, scr, item, F.lane); }
}
__device__ __forceinline__ void phase_gather(Frame& F) {
    const bf16_t* H = (const bf16_t*)(F.ws + WS_H); bf16_t* XS = (bf16_t*)(F.ws + WS_R + R_XS); const int* STOK = (const int*)(F.ws + WS_STOK);
    for (int s0 = F.gw * 4; s0 < NSLOT; s0 += F.ngw * 4) { u32x4 v[4][2];
#pragma unroll
        for (int q = 0; q < 4; ++q) { int row = STOK[s0 + q]; row = row < 0 ? 0 : (row >= T ? T - 1 : row); const u32x4* src = (const u32x4*)(H + (size_t)row * D) + F.lane; v[q][0] = src[0]; v[q][1] = src[64]; }
#pragma unroll
        for (int q = 0; q < 4; ++q) { u32x4* dst = (u32x4*)(XS + (size_t)(s0 + q) * D) + F.lane; dst[0] = v[q][0]; dst[64] = v[q][1]; } }
}
template <bool LV, class FN> __device__ __forceinline__ f32x4 ln2_vec(LAS float* VL, int idx4, FN&& fn) { if constexpr (LV) return *((const LAS f32x4*)VL + idx4); else return fn(); }
template <bool LV>
__device__ __forceinline__ void phase_ln2_t(Frame& F, int li, float* xdry, bool skipctx, const float* xin_l, const float* xin_c, const bf16_t* O) {
    const float* mod = (const float*)(F.ws + WS_MOD) + (size_t)li * 33 * MODSZ; const float* modn = mod + (size_t)33 * MODSZ; const bool has_next = li + 1 < NL;
    unsigned char* H8 = (unsigned char*)(F.ws + WS_H); const int* INV = (const int*)(F.ws + WS_INV); const float* AFF = (const float*)(F.ws + WS_AFF); const bf16_t* Y = (const bf16_t*)(F.ws + WS_R + R_XS);
    float* Xl = F.out; float* Xc = (float*)(F.ws + WS_XC); float* Xdl = xdry ? xdry + (size_t)NB * CTXL * D : Xl; float* Xdc = xdry ? xdry : Xc;
#if LN2_LDSV
    LAS float* VL = (LAS float*)F.lds; const int b_wg = (F.vcu * NWAVES) >> 6; constexpr bool ldsv_ok = LV;
    if constexpr (ldsv_ok) { for (int i = F.tid; i < 12 * 256; i += NTHR) { const int id = i >> 8, c4 = i & 255; const float* src;
            if (id == 0) src = in_ptr(I_LMG) + li * D; else if (id == 1) src = in_ptr(I_LMB) + li * D; else if (id == 2) src = in_ptr(I_LFG) + li * D; else if (id == 3) src = in_ptr(I_LFB) + li * D;
            else { const int s_ = (id - 4) >> 2, k_ = (id - 4) & 3; const float* mcur = mod + (size_t)(s_ == 0 ? 32 : b_wg) * MODSZ; const float* mnx = modn + (size_t)(s_ == 0 ? 32 : b_wg) * MODSZ;
                src = k_ == 0 ? mcur + 2 * D : k_ == 1 ? mcur + 5 * D : k_ == 2 ? mnx : mnx + D; if (k_ >= 2 && !has_next) src = mcur; }
            *((LAS f32x4*)VL + i) = *((const f32x4*)src + c4); }
        __syncthreads(); }
#define LN2_VEC(id, j, memexpr) ln2_vec<ldsv_ok>(VL, (id) * 256 + F.lane + 64 * (j), [&]() { return (memexpr); })
#else
#define LN2_VEC(id, j, memexpr) (memexpr)
#endif
#if LN2_NEB > 2 || LN2_LDSV
    const float* pg_ = in_ptr(I_LFG) + li * D; const float* pb_ = in_ptr(I_LFB) + li * D;
#define LN2_LG(j) LN2_VEC(2, j, *((const f32x4*)pg_ + F.lane + 64 * (j)))
#define LN2_LB(j) LN2_VEC(3, j, *((const f32x4*)pb_ + F.lane + 64 * (j)))
#define LN2_G2(j) LN2_VEC(5 + 4 * seg, j, *((const f32x4*)(mv + 5 * D) + F.lane + 64 * (j)))
#else
    f32x4 lg[4], lb[4], g2[4];
    { const float* pg = in_ptr(I_LFG) + li * D; const float* pb = in_ptr(I_LFB) + li * D;
#pragma unroll
      for (int j = 0; j < 4; ++j) { lg[j] = *((const f32x4*)pg + F.lane + 64 * j); lb[j] = *((const f32x4*)pb + F.lane + 64 * j); } }
#define LN2_LG(j) lg[j]
#define LN2_LB(j) lb[j]
#define LN2_G2(j) g2[j]
#endif
    for (int wv = F.gw; wv < 2048; wv += F.ngw) { const int b = wv >> 6, w = wv & 63;
#pragma unroll 1
        for (int seg = skipctx ? 1 : 0; seg < 2; ++seg) { const float* mv = mod + (size_t)(seg == 0 ? 32 : b) * MODSZ; const float* mn = modn + (size_t)(seg == 0 ? 32 : b) * MODSZ;
#if LN2_NEB <= 2 && !LN2_LDSV
#pragma unroll
            for (int j = 0; j < 4; ++j) g2[j] = *((const f32x4*)(mv + 5 * D) + F.lane + 64 * j);
#endif
            const int np = seg == 0 ? 2 : 16, p0 = seg == 0 ? 4 * w : CTXL + 32 * w;
            const float* xio = LN_RECOMP ? (seg == 0 ? xin_c + (size_t)b * CTXL * D : xin_l + ((size_t)b * SEQ - CTXL) * D) : (seg == 0 ? Xc + (size_t)b * CTXL * D : Xl + ((size_t)b * SEQ - CTXL) * D);
            float* xo2 = seg == 0 ? Xdc + (size_t)b * CTXL * D : Xdl + ((size_t)b * SEQ - CTXL) * D;
            const int* iab = (F.lane & 32) ? (const int*)AFF : INV; const int iao = ((F.lane >> 4) & 1) * NE + (F.lane & 15);
            int nia = iab[((size_t)b * TPS + p0) * NE + iao];
#pragma unroll 1
            for (int k = 0; k < np; ++k) { const int pA = p0 + 2 * k; const size_t rA = (size_t)b * TPS + pA;
                f32x4 xv[2][4], f[2][4];
                const int mia = nia; nia = iab[(k + 1 < np ? rA + 2 : rA) * NE + iao];
#pragma unroll
                for (int q = 0; q < 2; ++q) { const f32x4* xr = (const f32x4*)(xio + (size_t)(pA + q) * D) + F.lane;
#pragma unroll
                    for (int j = 0; j < 4; ++j) { xv[q][j] = __builtin_nontemporal_load(&xr[64 * j]); f[q][j] = (f32x4){0.f, 0.f, 0.f, 0.f}; } }
                if constexpr (LN_RECOMP != 0) {
                    u32x2 ov[2][4]; float s1[2] = {0.f, 0.f}, s1b[2] = {0.f, 0.f};
#pragma unroll
                    for (int q = 0; q < 2; ++q) { const u32x2* orow = (const u32x2*)(O + (rA + q) * D) + F.lane;
                        if (PERM_OY) { const u32x4* o4 = (const u32x4*)(O + (rA + q) * D) + F.lane; const u32x4 w0 = __builtin_nontemporal_load(&o4[0]), w1 = __builtin_nontemporal_load(&o4[64]);
                            ov[q][0] = (u32x2){w0[0], w0[1]}; ov[q][1] = (u32x2){w0[2], w0[3]}; ov[q][2] = (u32x2){w1[0], w1[1]}; ov[q][3] = (u32x2){w1[2], w1[3]}; }
                        else {
#pragma unroll
                        for (int j = 0; j < 4; ++j) ov[q][j] = __builtin_nontemporal_load(&orow[64 * j]); } }
#pragma unroll
                    for (int j = 0; j < 4; ++j) { const f32x4 g1j = LN2_VEC(4 + 4 * seg, j, *((const f32x4*)(mv + 2 * D) + F.lane + 64 * j));
#pragma unroll
                        for (int q = 0; q < 2; ++q) { xv[q][j] = xv[q][j] * ALPHA + g1j * unpack4(ov[q][j]); s1[q] += (xv[q][j][0] + xv[q][j][1]) + (xv[q][j][2] + xv[q][j][3]); } }
#pragma unroll
                    for (int q = 0; q < 2; ++q) { const float mean = wave_sum(s1[q]) * (1.0f / D);
#pragma unroll
                        for (int j = 0; j < 4; ++j) { xv[q][j] = xv[q][j] - mean; s1b[q] += (xv[q][j][0] * xv[q][j][0] + xv[q][j][1] * xv[q][j][1]) + (xv[q][j][2] * xv[q][j][2] + xv[q][j][3] * xv[q][j][3]); } }
                    float rs1[2];
#pragma unroll
                    for (int q = 0; q < 2; ++q) rs1[q] = 1.0f / sqrtf(wave_sum(s1b[q]) * (1.0f / D) + LN_EPS);
#pragma unroll
                    for (int j = 0; j < 4; ++j) { const f32x4 mg = LN2_VEC(0, j, *((const f32x4*)(in_ptr(I_LMG) + li * D) + F.lane + 64 * j)), mb = LN2_VEC(1, j, *((const f32x4*)(in_ptr(I_LMB) + li * D) + F.lane + 64 * j));
#pragma unroll
                        for (int q = 0; q < 2; ++q) xv[q][j] = xv[q][j] * rs1[q] * mg + mb; }
                }
                unsigned msk[2];
                { const unsigned long long bal_ = __ballot(F.lane < 32 && mia >= 0); msk[0] = (unsigned)bal_ & 0xffffu; msk[1] = (unsigned)(bal_ >> 16) & 0xffffu; }
                while (msk[0] | msk[1]) {
                    int sl[2][LN2_NEB]; float gt[2][LN2_NEB]; bool hs[2][LN2_NEB];
#pragma unroll
                    for (int q = 0; q < 2; ++q)
#pragma unroll
                        for (int i = 0; i < LN2_NEB; ++i) { const bool has = msk[q] != 0u; const int e = has ? __builtin_ctz(msk[q]) : 0; msk[q] &= msk[q] - 1u;
                            const int s_ = __builtin_amdgcn_readlane(mia, 16 * q + e); const float g_ = __uint_as_float((unsigned)__builtin_amdgcn_readlane(mia, 32 + 16 * q + e));
                            sl[q][i] = has ? s_ : 0; gt[q][i] = has ? g_ : 0.f; hs[q][i] = has; }
                    u32x2 yv[2][LN2_NEB][4];
#pragma unroll
                    for (int q = 0; q < 2; ++q)
#pragma unroll
                        for (int i = 0; i < LN2_NEB; ++i) { const u32x2* yr = (const u32x2*)(Y + (size_t)sl[q][i] * D) + F.lane;
#if LN2_SKIP
                            if (hs[q][i]) {
                            if (PERM_OY) { const u32x4* y4 = (const u32x4*)(Y + (size_t)sl[q][i] * D) + F.lane; const u32x4 w0 = __builtin_nontemporal_load(&y4[0]), w1 = __builtin_nontemporal_load(&y4[64]);
                                yv[q][i][0] = (u32x2){w0[0], w0[1]}; yv[q][i][1] = (u32x2){w0[2], w0[3]}; yv[q][i][2] = (u32x2){w1[0], w1[1]}; yv[q][i][3] = (u32x2){w1[2], w1[3]}; }
                            else {
#pragma unroll
                            for (int j = 0; j < 4; ++j) yv[q][i][j] = __builtin_nontemporal_load(&yr[64 * j]); } }
                            else {
#pragma unroll
                            for (int j = 0; j < 4; ++j) yv[q][i][j] = (u32x2){0u, 0u}; }
#else
#pragma unroll
                            for (int j = 0; j < 4; ++j) yv[q][i][j] = __builtin_nontemporal_load(&yr[64 * j]);
#endif
                        }
#pragma unroll
                    for (int q = 0; q < 2; ++q)
#pragma unroll
                        for (int i = 0; i < LN2_NEB; ++i)
#pragma unroll
                            for (int j = 0; j < 4; ++j) f[q][j] += unpack4(yv[q][i][j]) * gt[q][i];
                }
                f32x4 v[2][4]; float s[2] = {0.f, 0.f}, s2[2] = {0.f, 0.f};
#pragma unroll
                for (int q = 0; q < 2; ++q)
#pragma unroll
                    for (int j = 0; j < 4; ++j) { v[q][j] = xv[q][j] * ALPHA + LN2_G2(j) * f[q][j]; s[q] += (v[q][j][0] + v[q][j][1]) + (v[q][j][2] + v[q][j][3]); }
#pragma unroll
                for (int q = 0; q < 2; ++q) { const float mean = wave_sum(s[q]) * (1.0f / D);
#pragma unroll
                    for (int j = 0; j < 4; ++j) { v[q][j] = v[q][j] - mean; s2[q] += (v[q][j][0] * v[q][j][0] + v[q][j][1] * v[q][j][1]) + (v[q][j][2] * v[q][j][2] + v[q][j][3] * v[q][j][3]); } }
#pragma unroll
                for (int q = 0; q < 2; ++q) { const float rstd = 1.0f / sqrtf(wave_sum(s2[q]) * (1.0f / D) + LN_EPS);
                    f32x4* xw = (f32x4*)(xo2 + (size_t)(pA + q) * D) + F.lane; unsigned* hr = (unsigned*)(H8 + (rA + q) * D) + F.lane;
                    u32x4 hw = {0u, 0u, 0u, 0u};
#pragma unroll
                    for (int j = 0; j < 4; ++j) { v[q][j] = v[q][j] * rstd * LN2_LG(j) + LN2_LB(j); __builtin_nontemporal_store(v[q][j], &xw[64 * j]); if (has_next) { const f32x4 sh1 = LN2_VEC(6 + 4 * seg, j, *((const f32x4*)mn + F.lane + 64 * j)), sc1 = LN2_VEC(7 + 4 * seg, j, *((const f32x4*)(mn + D) + F.lane + 64 * j)); const f32x4 hv = v[q][j] * (1.0f + sc1) + sh1; hw[j] = cvt4_fp8(hv[0], hv[1], hv[2], hv[3]); if (!PERM_HK) hr[64 * j] = hw[j]; } }
                    if (PERM_HK && has_next) *((u32x4*)(H8 + (rA + q) * D) + F.lane) = hw; }
            } } }
}
__device__ __forceinline__ void phase_ln2(Frame& F, int li, float* xdry, bool skipctx, const float* xin_l, const float* xin_c, const bf16_t* O) {
#if LN2_LDSV
    if (F.G == 256) phase_ln2_t<true>(F, li, xdry, skipctx, xin_l, xin_c, O); else
#endif
    phase_ln2_t<false>(F, li, xdry, skipctx, xin_l, xin_c, O);
}
#ifndef ATT_V2
#define ATT_V2 0
#endif
template <int DQK, int SD>
__device__ __forceinline__ void phase_attn(Frame& F, int jg, bool skipctx, unsigned long long& pacc) {
    char* lds = (char*)F.lds;
    for (int u = F.vcu; u < (skipctx ? 2048 : 2048 + 256); u += F.G) {
        int b, h, prow, seq;
        if (u < 2048) { b = u >> 6; h = (u >> 3) & 7; prow = CTXL + (u & 7) * 256; seq = TPS; } else { const int q = u - 2048; b = q >> 3; h = q & 7; prow = 0; seq = CTXL; }
        const size_t row0 = (size_t)b * TPS;
        if constexpr (DQK == 128) {
            const bf16_t* QKV = (const bf16_t*)(F.ws + WS_R + R_QKV); unsigned char* AO = (unsigned char*)(F.ws + WS_R + R_AOG);
            const bf16_t* K = QKV + row0 * 1536 + 1024 + (h >> 2) * 128;
#if ATT_V2
            att2::attn_body2<128, 1536, 1536, 64, 1536, D>(QKV + (row0 + prow) * 1536 + h * 128, K, nullptr, K + 256, AO + (row0 + prow) * D + h * 128, seq, F.lds, prow - CTXL, (const float*)(F.ws + WS_ROPE), in_ptr(I_GQG) + jg * 128, pacc);
#else
            att::attn_body<128, SD, 1536, 1536, 64, 1536, D>(QKV + (row0 + prow) * 1536 + h * 128, K, nullptr, K + 256, AO + (row0 + prow) * D + h * 128, seq, lds, prow - CTXL, (const float*)(F.ws + WS_ROPE), in_ptr(I_GQG) + jg * 128);
#endif
        } else {
            const bf16_t* Q = (const bf16_t*)(F.ws + WS_R + R_Q); const bf16_t* KV = (const bf16_t*)(F.ws + WS_R + R_KV); const bf16_t* KR = (const bf16_t*)(F.ws + WS_KR); unsigned char* AO = (unsigned char*)(F.ws + WS_R + R_AOM);
            const bf16_t* K = KV + row0 * 2048 + h * 256;
#if ATT_V2
            att2::attn_body2<192, 1536, 2048, 64, 2048, D>(Q + (row0 + prow) * 1536 + h * 192, K, KR + row0 * 64, K + 128, AO + (row0 + prow) * D + h * 128, seq, F.lds, prow - CTXL, (const float*)(F.ws + WS_ROPE) + 4096, nullptr, pacc);
#else
            att::attn_body<192, SD, 1536, 2048, 64, 2048, D>(Q + (row0 + prow) * 1536 + h * 192, K, KR + row0 * 64, K + 128, AO + (row0 + prow) * D + h * 128, seq, lds, prow - CTXL, (const float*)(F.ws + WS_ROPE) + 4096, nullptr);
#endif
        }
        __syncthreads();
    }
}

#ifndef REP_DENSE
#define REP_DENSE 1
#endif
#ifndef REP_MOE
#define REP_MOE 1
#endif
#ifndef REP_ATTN
#define REP_ATTN 1
#endif
#ifndef REP_THIN
#define REP_THIN 1
#endif
#ifndef REP_LN1
#define REP_LN1 1
#endif
#ifndef REP_LN2
#define REP_LN2 1
#endif
#ifndef REP_QK
#define REP_QK 1
#endif
#ifndef REP_BAR
#define REP_BAR 1
#endif
#ifndef REP_ATTN_M
#define REP_ATTN_M REP_ATTN
#endif
#ifndef REP_ATTN_G
#define REP_ATTN_G REP_ATTN
#endif
#ifndef EN_ALL
#define EN_ALL 1
#endif
#ifndef EN_ATTN_MLA
#define EN_ATTN_MLA 1
#endif
#ifndef EN_ATTN_GQA
#define EN_ATTN_GQA 1
#endif
#ifndef ATT_SD_GQA
#define ATT_SD_GQA 1
#endif
#ifndef EN_UQ
#define EN_UQ 1
#endif
#ifndef EN_UKV
#define EN_UKV 1
#endif
#ifndef EN_P0A
#define EN_P0A EN_ALL
#endif
#ifndef EN_P0B
#define EN_P0B EN_ALL
#endif
#ifndef EN_P0C
#define EN_P0C EN_ALL
#endif
#ifndef EN_PROJ
#define EN_PROJ EN_ALL
#endif
#ifndef EN_THIN1
#define EN_THIN1 EN_ALL
#endif
#ifndef EN_UQKV
#define EN_UQKV EN_ALL
#endif
#ifndef EN_ATTN
#define EN_ATTN EN_ALL
#endif
#ifndef EN_OPROJ
#define EN_OPROJ EN_ALL
#endif
#ifndef EN_LN1
#define EN_LN1 EN_ALL
#endif
#ifndef EN_TOPK
#define EN_TOPK EN_ALL
#endif
#ifndef EN_GATHER
#define EN_GATHER 0
#endif
#ifndef EN_GU
#define EN_GU EN_ALL
#endif
#ifndef EN_DN
#define EN_DN EN_ALL
#endif
#ifndef EN_LN2
#define EN_LN2 EN_ALL
#endif
constexpr int NPH = 3 + NL * 11;
struct Args { const float* in[25]; float* out; unsigned char* ws; int ph_lo, ph_hi; };
__global__ void __launch_bounds__(NTHR, 2) mk_fwd(Args args) {
    extern __shared__ __attribute__((aligned(16))) unsigned char lds_raw[];
    Frame F;
    F.lds = (LAS unsigned char*)lds_raw;
    F.tid = threadIdx.x; F.lane = F.tid & 63; F.wave = __builtin_amdgcn_readfirstlane(F.tid >> 6);
    F.G = gridDim.x; { const int bx = blockIdx.x; F.vcu = (F.G % 8 == 0) ? (bx % 8) * (F.G / 8) + bx / 8 : bx; }
    F.gw = F.vcu * NWAVES + F.wave; F.ngw = F.G * NWAVES;
    F.out = args.out; F.ws = args.ws;
    volatile LAS unsigned* MISC = (volatile LAS unsigned*)(F.lds + MISC_OFF);
    if (F.tid < 4) MISC[F.tid] = 0u;
    __syncthreads();
    const int lo = args.ph_lo, hi = args.ph_hi;
    XcdBarrier bar; bar.bar = (unsigned*)(F.ws + WS_CTL) + CW_BAR; bar.x = 0; bar.st = MISC;
    if (hi - lo > 1) bar = xcd_barrier_post((unsigned*)(F.ws + WS_CTL) + CW_BAR, MISC);
#define IN(k) (lo <= (k) && (k) < hi)
#ifdef PROBE_SEL
#ifndef PROBE_WG
#define PROBE_WG 0
#endif
    unsigned long long pr_acc = 0ull, pr_t0 = 0ull; const bool pr_on = (int)blockIdx.x == PROBE_WG && F.wave == 0;
#define PSTART(g) do { if ((g) == PROBE_SEL && pr_on) pr_t0 = __builtin_amdgcn_s_memrealtime(); } while (0)
#define PEND(g) do { if ((g) == PROBE_SEL && pr_on) pr_acc += __builtin_amdgcn_s_memrealtime() - pr_t0; } while (0)
#else
#define PSTART(g) do { } while (0)
#define PEND(g) do { } while (0)
#endif
#define SEAM(k) do { if ((k) + 1 < hi) { PSTART(11); for (int rb_ = 0; rb_ < REP_BAR; ++rb_) xcd_barrier(bar); PEND(11); } } while (0)
#define SEAMG(k, g) do { if ((k) + 1 < hi) { PSTART(11); PSTART(20 + (g)); for (int rb_ = 0; rb_ < REP_BAR; ++rb_) xcd_barrier(bar); PEND(11); PEND(20 + (g)); } } while (0)
#define PB() do { F.lane = opaque_v(F.lane); F.tid = opaque_v(F.tid); F.gw = opaque_s(F.gw); F.wave = opaque_s(F.wave); F.vcu = opaque_s(F.vcu); } while (0)

#if EN_P0A
    if (IN(0)) { PB(); PSTART(0); _Pragma("unroll 1") for (int rep_ = 0; rep_ < REP_THIN; ++rep_) { phase_p0a(F); __syncthreads(); } PEND(0); SEAMG(0, 0); }
#endif
#if EN_P0B
    if (IN(1)) { PB(); PSTART(0); _Pragma("unroll 1") for (int rep_ = 0; rep_ < REP_THIN; ++rep_) { phase_p0b(F); __syncthreads(); } PEND(0); SEAMG(1, 0); }
#endif
#if EN_P0C
    if (IN(2)) { PB(); PSTART(0); _Pragma("unroll 1") for (int rep_ = 0; rep_ < REP_THIN; ++rep_) { phase_p0c(F); __syncthreads(); } PEND(0); SEAMG(2, 0); }
#endif

#pragma unroll 1
    for (int li = 0; li < NL; ++li) {
        const int pb = 3 + li * 11, j = li >> 1; const bool mla = (li & 1) != 0, lastl = li == NL - 1;
#if EN_PROJ
        if (IN(pb + 0)) { PB(); PSTART(1);
            const int N = mla ? 1280 : 1536;
            pg8::Gemm g{(const bf16_t*)(F.ws + WS_H), (const bf16_t*)(mla ? F.ws + WS_WD + (size_t)j * 1280 * 1024 : F.ws + WS_WQKV + (size_t)j * 1536 * 1024), D / 2, D / 2, D / 2, 0x7a7a7a7a  , (const int*)(F.ws + WS_GVAL)  };
            pg8::StaticOrder S; S.init(T, N, F.G, (int)blockIdx.x); S.rep = REP_DENSE;
            pg8::EpiStore E{(bf16_t*)(F.ws + WS_R), N, 0xffff};
            pg8::gemm_phase<pg8::EpiStore, pg8::StaticOrder, false, true, true>(F.lds, g, S, E, nullptr);
            PEND(1); SEAMG(pb + 0, 1);
        }
#endif
#if EN_THIN1
        if (IN(pb + 1)) { PB(); PSTART(2); _Pragma("unroll 1") for (int rp_ = 0; rp_ < REP_QK; ++rp_) { bf16_t* dry_ = rp_ + 1 < REP_QK ? (bf16_t*)(F.ws + WS_R + 396 * MiB) : nullptr; if (mla) phase_mla_stats(F, dry_); else phase_qknorm(F, j, dry_); __syncthreads(); } PEND(2); SEAMG(pb + 1, 2); }
#endif
#if EN_UQKV
        if (mla && IN(pb + 2)) { PB(); PSTART(3);
#if EN_UQ
            { pg8::Gemm g{(const bf16_t*)(F.ws + WS_CQ8), (const bf16_t*)(F.ws + WS_WUQ + (size_t)j * 1536 * 768), 384, 384, 384, 0x7a7a7a7a  , (const int*)(F.ws + WS_GVAL)  };
              pg8::StaticOrder S; S.init(lastl ? NB * SEQ : T, 1536, F.G, (int)blockIdx.x); S.rep = REP_DENSE; S.skipctx = lastl;
              pg8::EpiStore E{(bf16_t*)(F.ws + WS_R + R_Q), 1536, 0xffff};
              pg8::gemm_phase<pg8::EpiStore, pg8::StaticOrder, false, true, true>(F.lds, g, S, E, nullptr); }
#endif
#if EN_UKV
            { pg8::Gemm g{(const bf16_t*)(F.ws + WS_R + R_CQ) + 768, (const bf16_t*)(F.ws + WS_WUKV) + (size_t)j * 2048 * 256, 1280, 256, 256, 0};
              pg8::StaticOrder S; S.init(T, 2048, F.G, (int)blockIdx.x); S.rep = REP_DENSE;
              pg8::EpiStore E{(bf16_t*)(F.ws + WS_R + R_KV), 2048, 0xffff};
              pg8::gemm_phase<pg8::EpiStore, pg8::StaticOrder>(F.lds, g, S, E, nullptr); }
#endif
            PEND(3); SEAMG(pb + 2, 3);
        }
#endif
#if EN_ATTN
        if (IN(pb + 3)) { PB(); PSTART(4); unsigned long long pa_ = 0ull;
#if EN_ATTN_MLA
            _Pragma("unroll 1") for (int rep_ = 0; rep_ < REP_ATTN_M; ++rep_) { if (mla) phase_attn<192, ATT_SD_MLA>(F, j, lastl, pa_); __syncthreads(); }
#endif
#if EN_ATTN_GQA
            _Pragma("unroll 1") for (int rep_ = 0; rep_ < REP_ATTN_G; ++rep_) { if (!mla) phase_attn<128, ATT_SD_GQA>(F, j, lastl, pa_); __syncthreads(); }
#endif
#if defined(PROBE_SEL) && PROBE_SEL >= 50 && PROBE_SEL <= 59
            if (pr_on) pr_acc += pa_;
#endif
            PEND(4); SEAMG(pb + 3, 4); }
#endif
#if EN_OPROJ
        if (IN(pb + 4)) { PB(); PSTART(5);
            pg8::Gemm g{(const bf16_t*)(F.ws + WS_R + (mla ? R_AOM : R_AOG)), (const bf16_t*)(F.ws + (mla ? WS_WOM : WS_WOG) + (size_t)j * 1024 * 1024), D / 2, D / 2, D / 2, 0x75757575  , (const int*)(F.ws + WS_GVAL)  };
            pg8::StaticOrder S; S.init(lastl ? NB * SEQ : T, D, F.G, (int)blockIdx.x); S.rep = REP_DENSE; S.skipctx = lastl;
            pg8::EpiStore E{(bf16_t*)(F.ws + WS_R + (LN_RECOMP ? R_O2 : (mla ? R_OM : R_OG))), D, 0xffff};
            pg8::gemm_phase<pg8::EpiStore, pg8::StaticOrder, false, true, true>(F.lds, g, S, E, nullptr);
            PEND(5); SEAMG(pb + 4, 5);
        }
#endif
#if EN_LN1
        if (IN(pb + 5)) { PB(); PSTART(6); phase_ln1(F, li, li == 0 ? in_ptr(I_X) : F.out, li == 0 ? in_ptr(I_CTX) : (const float*)(F.ws + WS_XC), (const bf16_t*)(F.ws + WS_R + (LN_RECOMP ? R_O2 : (mla ? R_OM : R_OG))), (float*)(F.ws + WS_R + 396 * MiB), lastl); PEND(6); SEAMG(pb + 5, 6); }
#endif
#if EN_TOPK
        if (IN(pb + 6)) { PB(); PSTART(7); _Pragma("unroll 1") for (int rep_ = 0; rep_ < REP_THIN; ++rep_) { phase_topk_conv(F, li, lastl); __syncthreads(); } PEND(7); SEAMG(pb + 6, 7); }
#endif
#if EN_GATHER
        if (IN(pb + 7)) { PB(); PSTART(12); _Pragma("unroll 1") for (int rep_ = 0; rep_ < REP_THIN; ++rep_) { phase_gather(F); __syncthreads(); } PEND(12); SEAMG(pb + 7, 12); }
#endif
#if EN_GU
        if (IN(pb + 8)) { PB(); PSTART(8);
            pg8::Gemm g{(const bf16_t*)(F.ws + WS_H), (const bf16_t*)(F.ws + WS_WGU), D / 2, D / 2, D / 2, 0x7a7a7a7a  , (const int*)(F.ws + WS_STOK)};
            pg8::MoeOrder S; S.init(8, F.G, (int)blockIdx.x); S.rep = REP_MOE; if (lastl) S.nunits = 512 * 8;
            pg8::EpiSwiGlu E{(unsigned char*)(F.ws + WS_R + R_ACT)};
#if defined(PROBE_SEL) && (PROBE_SEL == 40 || PROBE_SEL == 41)
            { unsigned long long qk_ = 0, qe_ = 0; pg8::gemm_phase_x<pg8::EpiSwiGlu, pg8::MoeOrder, false, true, true, true>(F.lds, g, S, E, nullptr, qk_, qe_); if (pr_on) pr_acc += (PROBE_SEL == 40 ? qk_ : qe_); }
#else
            pg8::gemm_phase<pg8::EpiSwiGlu, pg8::MoeOrder, false, true, true>(F.lds, g, S, E, nullptr);
#endif
            PEND(8); SEAMG(pb + 8, 8);
        }
#endif
#if EN_DN
        if (IN(pb + 9)) { PB(); PSTART(9);
            pg8::Gemm g{(const bf16_t*)(F.ws + WS_R + R_ACT), (const bf16_t*)(F.ws + WS_WDN), FF / 2, FF / 2, FF / 2, 0x79797979  , (const int*)(F.ws + WS_GVAL)  };
            pg8::MoeOrder S; S.init(4, F.G, (int)blockIdx.x); S.rep = REP_MOE; if (lastl) S.nunits = 512 * 4;
            pg8::EpiStore E{(bf16_t*)(F.ws + WS_R + R_XS), D, 3};
#if defined(PROBE_SEL) && (PROBE_SEL == 42 || PROBE_SEL == 43)
            { unsigned long long qk_ = 0, qe_ = 0; pg8::gemm_phase_x<pg8::EpiStore, pg8::MoeOrder, false, true, true, true>(F.lds, g, S, E, nullptr, qk_, qe_); if (pr_on) pr_acc += (PROBE_SEL == 42 ? qk_ : qe_); }
#else
            pg8::gemm_phase<pg8::EpiStore, pg8::MoeOrder, false, true, true>(F.lds, g, S, E, nullptr);
#endif
            PEND(9); SEAMG(pb + 9, 9);
        }
#endif
#if EN_LN2
        if (IN(pb + 10)) { PB(); PSTART(10); _Pragma("unroll 1") for (int rp_ = 0; rp_ < REP_LN2; ++rp_) { phase_ln2(F, li, rp_ + 1 < REP_LN2 ? (float*)(F.ws + WS_R + 288 * MiB) : nullptr, lastl, li == 0 ? in_ptr(I_X) : F.out, li == 0 ? in_ptr(I_CTX) : (const float*)(F.ws + WS_XC), (const bf16_t*)(F.ws + WS_R + R_O2)); __syncthreads(); } PEND(10); SEAMG(pb + 10, 10); }
#endif
    }
#ifdef PROBE_SEL
    if (pr_on) { const unsigned long long tgt = __builtin_amdgcn_s_memrealtime() + pr_acc; while (__builtin_amdgcn_s_memrealtime() < tgt) __builtin_amdgcn_s_sleep(64); }
#endif
#undef IN
#undef SEAM
}

extern "C" void kernel_launch(void* const* d_in, const int* in_sizes, int n_in, void* d_out, int out_size, void* d_ws, size_t ws_size, hipStream_t stream) {
    static int grid = 0;
    if (grid == 0) {
        if (n_in != 25 || out_size != NB * SEQ * D || ws_size < WS_END) { fprintf(stderr, "kernel_launch: shape/workspace mismatch (n_in %d out %d ws %zu need %zu); nothing launched\n", n_in, out_size, ws_size, (size_t)WS_END); grid = -1; return; }
        int dev = 0, cus = 0, per_cu = 0;
        if (hipGetDevice(&dev) != hipSuccess || hipDeviceGetAttribute(&cus, hipDeviceAttributeMultiprocessorCount, dev) != hipSuccess) { grid = -1; return; }
        if (hipFuncSetAttribute((const void*)mk_fwd, hipFuncAttributeMaxDynamicSharedMemorySize, LDS_BYTES) != hipSuccess) { fprintf(stderr, "kernel_launch: hipFuncSetAttribute failed\n"); grid = -1; return; }
        if (hipOccupancyMaxActiveBlocksPerMultiprocessor(&per_cu, (const void*)mk_fwd, NTHR, LDS_BYTES) != hipSuccess || per_cu < 1) { fprintf(stderr, "kernel_launch: occupancy query says %d\n", per_cu); (void)hipGetLastError(); grid = -1; return; }
        grid = cus < 256 ? cus : 256;
    }
    if (grid < 0) return;
    (void)hipMemsetAsync((char*)d_ws + WS_CTL, 0, CTL_ZERO_BYTES, stream);
    Args a{};
    for (int i = 0; i < 25; ++i) a.in[i] = (const float*)d_in[i];
    a.out = (float*)d_out; a.ws = (unsigned char*)d_ws;
#if MK_ONE_LAUNCH
    a.ph_lo = 0; a.ph_hi = NPH;
    hipLaunchKernelGGL(mk_fwd, dim3(grid), dim3(NTHR), LDS_BYTES, stream, a);
#else
    for (int p = 0; p < NPH; ++p) {
        if (p >= 3 && ((p - 3) % 11) == 2 && (((p - 3) / 11) & 1) == 0) continue;
        a.ph_lo = p; a.ph_hi = p + 1;
        hipLaunchKernelGGL(mk_fwd, dim3(grid), dim3(NTHR), LDS_BYTES, stream, a);
    }
#endif
    const hipError_t le = hipPeekAtLastError();
    if (le != hipSuccess) fprintf(stderr, "kernel_launch: launch failed: %s\n", hipGetErrorName(le));
}
```

```cpp
#define MK_ONE_LAUNCH 1
#include <hip/hip_runtime.h>
#include <cstdio>
#include <cstdint>

#ifndef ATT_V2
#define ATT_V2 1
#endif
#define LAS __attribute__((address_space(3)))
#define GAS __attribute__((address_space(1)))
typedef unsigned short bf16_t;
typedef short bf16x8 __attribute__((ext_vector_type(8)));
typedef short s16x4 __attribute__((ext_vector_type(4)));
typedef float f32x2 __attribute__((ext_vector_type(2)));
typedef float f32x4 __attribute__((ext_vector_type(4)));
typedef float f32x16 __attribute__((ext_vector_type(16)));
typedef unsigned u32x2 __attribute__((ext_vector_type(2)));
typedef unsigned u32x4 __attribute__((ext_vector_type(4)));

#ifndef REP_LN1
#define REP_LN1 1
#endif
#ifndef MK_ONE_LAUNCH
#define MK_ONE_LAUNCH 1
#endif

constexpr int D = 1024, NB = 32, SEQ = 2048, CTXL = 256, TPS = SEQ + CTXL  , T = NB * TPS  , NL = 4;
constexpr int NE = 16, FF = 1024, CAPL = 256, CAPC = 32;
constexpr int NSLOT_L = NB * NE * CAPL  , NSLOT = NSLOT_L + NB * NE * CAPC  , NPANEL = NSLOT / 256  ;
constexpr float ALPHA = 1.6817928305074292f, LN_EPS = 1e-6f;
constexpr int NWAVES = 8, NTHR = 512;
constexpr int MODSZ = 6 * D;
constexpr int MOD_KC = 16;

constexpr size_t MiB = 1u << 20;
constexpr size_t WS_CTL = 0, CTL_ZERO_BYTES = 64 * 1024;
constexpr size_t WS_MOD = 1 * MiB;
constexpr size_t WS_ROPE = 5 * MiB;
constexpr size_t WS_RWT = 5 * MiB + 512 * 1024;
constexpr size_t WS_WQKV = 6 * MiB;
constexpr size_t WS_WOG = 12 * MiB;
constexpr size_t WS_WD = 16 * MiB;
constexpr size_t WS_WUQ = 21 * MiB;
constexpr size_t WS_WUKV = 26 * MiB;
constexpr size_t WS_WOM = 28 * MiB;
constexpr size_t WS_WGU = 32 * MiB;
constexpr size_t WS_WDN = 96 * MiB;
constexpr size_t WS_XC = 128 * MiB;
constexpr size_t WS_H = 160 * MiB;
constexpr size_t WS_CQ8 = WS_H + 72 * MiB;
constexpr size_t WS_AFF = 304 * MiB;
constexpr size_t WS_INV = 309 * MiB;
constexpr size_t WS_GVAL = 314 * MiB;
constexpr size_t WS_STOK = 315 * MiB;
constexpr size_t WS_RS = 316 * MiB;
constexpr size_t WS_KR = 317 * MiB;
constexpr size_t WS_R = 326 * MiB;
constexpr size_t R_QKV = 0, R_AOG = 216 * MiB, R_OG = 0;
constexpr size_t R_CQ = 0, R_Q = 180 * MiB, R_KV = 396 * MiB, R_AOM = 0, R_OM = 180 * MiB;
constexpr size_t R_O2 = 432 * MiB;
constexpr size_t R_XS = 0, R_ACT = 288 * MiB;
constexpr size_t R_MODP = 0;
constexpr size_t WS_END = WS_R + 684 * MiB;
static_assert((size_t)T * 2048 * 2 == 288 * MiB && (size_t)NSLOT * 1024 * 2 == 288 * MiB && (size_t)T * 1536 * 2 == 216 * MiB && (size_t)T * 1280 * 2 == 180 * MiB, "sizes");
constexpr int CW_BAR = 4096;

constexpr int RING_BYTES = 131072;
constexpr int LDS_BYTES = 163840;
constexpr int MISC_OFF = LDS_BYTES - 256;

__device__ __forceinline__ float bf2f(unsigned b) { return __uint_as_float(b << 16); }
__device__ __forceinline__ unsigned cvt_pk_bf16(float lo, float hi) { unsigned r; asm volatile("v_cvt_pk_bf16_f32 %0, %1, %2" : "=v"(r) : "v"(lo), "v"(hi)); return r; }
#define DPP_MOV(v, ctrl) __builtin_bit_cast(float, __builtin_amdgcn_update_dpp(0, __builtin_bit_cast(int, (float)(v)), (ctrl), 0xf, 0xf, true))
__device__ __forceinline__ float lane_xor16(float v) { return __builtin_bit_cast(float, __builtin_amdgcn_ds_swizzle(__builtin_bit_cast(int, v), 0x401F)); }
__device__ __forceinline__ float wave_sum(float v) {
    v += DPP_MOV(v, 0xB1);
    v += DPP_MOV(v, 0x4E);
    v += DPP_MOV(v, 0x141);
    v += DPP_MOV(v, 0x140);
    v += lane_xor16(v);
    { auto rr = __builtin_amdgcn_permlane32_swap(__float_as_uint(v), __float_as_uint(v), false, false); v = __uint_as_float(rr[0]) + __uint_as_float(rr[1]); }
    return v;
}
#define LDS_WAIT() asm volatile("s_waitcnt lgkmcnt(0)" ::: "memory")
#define VM_WAIT() asm volatile("s_waitcnt vmcnt(0)" ::: "memory")
__device__ __forceinline__ int opaque_v(int x) { asm volatile("" : "+v"(x)); return x; }
__device__ __forceinline__ int opaque_s(int x) { asm volatile("" : "+s"(x)); return x; }
__device__ __forceinline__ const float* in_ptr(int i) {
    const __attribute__((address_space(4))) char* kp = (const __attribute__((address_space(4))) char*)__builtin_amdgcn_kernarg_segment_ptr();
    const int off = opaque_s(i * 8);
    return *(const float* const __attribute__((address_space(4)))*)(kp + off);
}
__device__ __forceinline__ unsigned cvt4_fp8(float a, float b, float c, float d) {
    a = __builtin_fminf(__builtin_fmaxf(a, -448.f), 448.f); b = __builtin_fminf(__builtin_fmaxf(b, -448.f), 448.f); c = __builtin_fminf(__builtin_fmaxf(c, -448.f), 448.f); d = __builtin_fminf(__builtin_fmaxf(d, -448.f), 448.f);
    int w = 0; w = __builtin_amdgcn_cvt_pk_fp8_f32(a, b, w, false); w = __builtin_amdgcn_cvt_pk_fp8_f32(c, d, w, true); return (unsigned)w;
}
constexpr float WGU_SCALE = 32.f, WDN_SCALE = 64.f, WP_SCALE = 32.f, WO_SCALE = 64.f, AO_SCALE = 16.f;
#ifndef OY8
#define OY8 1
#endif
#ifndef O8F
#define O8F OY8
#endif
#ifndef Y8F
#define Y8F OY8
#endif
constexpr float O8_SCALE = 32.f, Y8_SCALE = 8.f;
#ifndef ACT_PAD
#define ACT_PAD 1
#endif
constexpr int LDACT = (Y8F && ACT_PAD) ? 1152 : 1024;
constexpr size_t R_ACT2 = (Y8F && ACT_PAD) ? 144 * MiB : R_ACT;
static_assert(R_ACT2 + (size_t)NSLOT * LDACT <= 432 * MiB, "ACT overlaps O");
__device__ __forceinline__ f32x4 unpack4_fp8(unsigned w) { const f32x2 lo = __builtin_amdgcn_cvt_pk_f32_fp8((int)w, false), hi = __builtin_amdgcn_cvt_pk_f32_fp8((int)w, true); return (f32x4){lo[0], lo[1], hi[0], hi[1]}; }
#ifndef ATT_SD_MLA
#define ATT_SD_MLA 1
#endif
#define XB_TMO      128
#define XB_XCNT(j)  (256  + 64 * (j))
#define XB_XSUB(j)  (1280 + 64 * (j))
#define XB_XGEN(j)  (2304 + 64 * (j))
#define XB_TOP      3328
#define XB_TOPGEN   3392
#define XCD_BAR_WORDS 3456
#define XB_SPIN_CAP (1u << 18)

__device__ __forceinline__ unsigned xb_ld(unsigned* p)              { return __hip_atomic_load(p, __ATOMIC_RELAXED, __HIP_MEMORY_SCOPE_AGENT); }
__device__ __forceinline__ unsigned xb_add(unsigned* p, unsigned v) { return __hip_atomic_fetch_add(p, v, __ATOMIC_RELAXED, __HIP_MEMORY_SCOPE_AGENT); }
__device__ __forceinline__ unsigned xb_xcc_id() { return (unsigned)__builtin_amdgcn_s_getreg((3 << 11) | 20) & 0xFu; }
#define XB_SPIN(cond, bar) do { unsigned _sp = 0; while (cond) { __builtin_amdgcn_s_sleep(1); \
    if ((++_sp & 255u) == 0u) { if (xb_ld(&(bar)[XB_TMO])) break; if (_sp > XB_SPIN_CAP) { atomicAdd(&(bar)[XB_TMO], 1u); break; } } } } while (0)

struct XcdBarrier {
    unsigned* bar; unsigned x;
    volatile LAS unsigned* st;
};

__device__ __forceinline__ XcdBarrier xcd_barrier_post(unsigned* bar, volatile LAS unsigned* st) {
    XcdBarrier b; b.bar = bar; b.x = xb_xcc_id(); b.st = st;
    if (threadIdx.x == 0) (void)xb_add(&bar[XB_XCNT(b.x)], 1u);
    return b;
}
__device__ __forceinline__ void xcd_barrier_complete(unsigned* bar, unsigned x, unsigned& nloc, unsigned& nx) {
    const unsigned G = gridDim.x * gridDim.y * gridDim.z;
    unsigned sum, cnt, mine, sp = 0u;
    for (;;) {
        sum = 0u; cnt = 0u; mine = 0u;
#pragma unroll
        for (unsigned j = 0; j < 16; ++j) { const unsigned c = xb_ld(&bar[XB_XCNT(j)]); sum += c; cnt += (c > 0u) ? 1u : 0u; mine = (j == x) ? c : mine; }
        if (sum == G) break;
        __builtin_amdgcn_s_sleep(1);
        if ((++sp & 255u) == 0u) { if (xb_ld(&bar[XB_TMO])) break; if (sp > XB_SPIN_CAP) { atomicAdd(&bar[XB_TMO], 1u); break; } }
    }
    nloc = mine > 0u ? mine : 1u; nx = cnt > 0u ? cnt : 1u;
}

__device__ __forceinline__ void xcd_barrier(const XcdBarrier& b) {
    asm volatile("s_waitcnt vmcnt(0)" ::: "memory");
    __syncthreads();
    if (threadIdx.x == 0) {
        unsigned* bar = b.bar;
        __builtin_amdgcn_s_waitcnt(0);
        unsigned nloc = b.st[0], nx = b.st[1];
        if (nloc == 0u) { xcd_barrier_complete(bar, b.x, nloc, nx); b.st[0] = nloc; b.st[1] = nx; }
        const unsigned old = xb_add(&bar[XB_XSUB(b.x)], 1u);
        const unsigned gen = old / nloc;
        if (old + 1u == (gen + 1u) * nloc) {
            __builtin_amdgcn_fence(__ATOMIC_RELEASE, "agent");
            asm volatile("s_waitcnt vmcnt(0)" ::: "memory");
            const unsigned og = xb_add(&bar[XB_TOP], 1u);
            const unsigned tg = og / nx;
            if (og + 1u == (tg + 1u) * nx) xb_add(&bar[XB_TOPGEN], 1u);
            else XB_SPIN(xb_ld(&bar[XB_TOPGEN]) == tg, bar);
            __builtin_amdgcn_fence(__ATOMIC_ACQUIRE, "agent");
            xb_add(&bar[XB_XGEN(b.x)], 1u);
            asm volatile("s_waitcnt vmcnt(0)" ::: "memory");
        } else {
            XB_SPIN(xb_ld(&bar[XB_XGEN(b.x)]) == gen, bar);
            __builtin_amdgcn_fence(__ATOMIC_ACQUIRE, "agent");
            asm volatile("s_waitcnt vmcnt(0)" ::: "memory");
        }
    }
    __syncthreads();
}

namespace pg8 {
#define PG8_LAS __attribute__((address_space(3)))
constexpr int BM = 256, BK = 64, HALF = 128, HTB = HALF * BK * 2  , STAGE_BYTES = 8 * HTB, NXCD = 8, WGM = 8;

__host__ __device__ __forceinline__ int lds_byte(int r, int c) { const int st = (r >> 4) * 2 + (c >> 5), rr = r & 15, cc = c & 31, ob = rr * 64 + cc * 2; return st * 1024 + (ob ^ (((ob >> 9) & 1) << 5)); }
__host__ __device__ __forceinline__ void stage_rc(int b, int& R, int& C) { const int st = b / 1024, sb = b % 1024, swz = sb ^ (((sb >> 9) & 1) << 5); R = (st >> 1) * 16 + swz / 64; C = (st & 1) * 32 + (swz % 64) / 2; }
__host__ __device__ __forceinline__ int perm32(int rho) { const int n = rho >> 4, i = rho & 15; return 8 * (i >> 2) + 4 * n + (i & 3); }

struct Unit { int pm, pn; };
struct Gemm { const bf16_t* A; const bf16_t* Bt; int lda, ldb, K; int pad; const int* ridx = nullptr; };

struct StaticOrder {
    int nM, nN, nwg, G, c, rep; bool skipctx;
    __host__ __device__ void init(int M, int N, int G_, int c_) { nM = M / BM; nN = N / BM; nwg = nM * nN; G = G_; c = c_; rep = 1; skipctx = false; }
    __host__ __device__ bool next(int i, Unit& u) const {
        const long L = (long)(i / rep) * G + c; if (L >= nwg) return false;
        int wgid = (int)L; { const int q = nwg / NXCD, r = nwg % NXCD, xcd = wgid % NXCD, off = wgid / NXCD; wgid = (xcd < r ? xcd * (q + 1) : r * (q + 1) + (xcd - r) * q) + off; }
        const int nig = WGM * nN, gid = wgid / nig, fm = gid * WGM, gsz = (nM - fm) < WGM ? (nM - fm) : WGM;
        u.pm = fm + ((wgid % nig) % gsz); u.pn = (wgid % nig) / gsz; if (skipctx) u.pm = (u.pm >> 3) * 9 + 1 + (u.pm & 7); return true;
    }
    __device__ __forceinline__ void a_ready(const Unit&) const {}
    __device__ __forceinline__ void done(const Unit&) const {}
};
typedef int pg8_v8i __attribute__((ext_vector_type(8)));
#ifdef PROBE_CLK
#define PG8_PROBE_NOW() (__builtin_amdgcn_s_memtime() / 20ull)
#else
#define PG8_PROBE_NOW() __builtin_amdgcn_s_memrealtime()
#endif
#ifndef PG8_DMAMMA
#define PG8_DMAMMA 0
#endif
#ifndef PG8_BUF
#define PG8_BUF 0
#endif
__device__ __forceinline__ __amdgpu_buffer_rsrc_t pg8_rsrc(const void* p) {
    const unsigned long long v = (unsigned long long)(size_t)p; const unsigned lo = __builtin_amdgcn_readfirstlane((unsigned)v), hi = __builtin_amdgcn_readfirstlane((unsigned)(v >> 32));
    return __builtin_amdgcn_make_buffer_rsrc((void*)(size_t)(((unsigned long long)hi << 32) | lo), 0, -1, 0x00020000);
}
template <class Epi, class Sched, bool STAMP, bool GATHER, bool FP8, bool PRB>
__device__ __forceinline__ void gemm_phase_x(PG8_LAS unsigned char* lds, const Gemm g, const Sched& S, const Epi& E, unsigned long long* stamps, unsigned long long& pk, unsigned long long& pe);
template <class Epi, class Sched, bool STAMP = false, bool GATHER = false, bool FP8 = false>
__device__ __forceinline__ void gemm_phase(PG8_LAS unsigned char* lds, const Gemm g, const Sched& S, const Epi& E, unsigned long long* stamps) { unsigned long long a_ = 0, b_ = 0; gemm_phase_x<Epi, Sched, STAMP, GATHER, FP8, false>(lds, g, S, E, stamps, a_, b_); }
template <class Epi, class Sched, bool STAMP, bool GATHER, bool FP8, bool PRB>
__device__ __forceinline__ void gemm_phase_x(PG8_LAS unsigned char* lds, const Gemm g, const Sched& S, const Epi& E, unsigned long long* stamps, unsigned long long& pk, unsigned long long& pe) {
    unsigned long long pt_ = 0;
    const int tid = opaque_v((int)threadIdx.x), wid = __builtin_amdgcn_readfirstlane(tid >> 6), lane = tid & 63, wr = wid >> 2, wc = wid & 3, fr = lane & 15, fq = lane >> 4;
    const int K = g.K, nt = K / BK;
    const int wscale = g.pad;
    int ts_lo = 0, ts_hi = 0, nts = 0; const unsigned long long rt_entry = STAMP ? (unsigned long long)wall_clock64() : 0ull;
#define PG8_STAMP() do { if (STAMP && wid == 0 && nts < 64) { const unsigned long long _c = (unsigned long long)clock64(); \
        ts_lo = (lane == nts) ? (int)(unsigned)_c : ts_lo; ts_hi = (lane == nts) ? (int)(unsigned)(_c >> 32) : ts_hi; ++nts; } } while (0)
    PG8_STAMP();
    unsigned voffA[2], voffB[2];
#pragma unroll
    for (int i = 0; i < 2; ++i) { int R, C; stage_rc(tid * 16 + i * 8192, R, C); const int Rb = Epi::PERM ? ((R & ~31) + perm32(R & 31)) : R;
        voffA[i] = GATHER ? (unsigned)C * 2u : (unsigned)(R * g.lda + C) * 2u; voffB[i] = (unsigned)(Rb * g.ldb + C) * 2u; }
    unsigned vs[2][2];
#define PG8_LDRAW(pm_) do { if (wid < 4) __builtin_amdgcn_global_load_lds((const unsigned*)(g.ridx + ((pm_) * BM + wid * 64 + lane)), (PG8_LAS unsigned*)(lds + STAGE_BYTES + wid * 256), 4, 0, 0); } while (0)
#define PG8_CONV(vo) do { _Pragma("unroll") for (int _h = 0; _h < 2; ++_h) _Pragma("unroll") for (int _i = 0; _i < 2; ++_i) { int _R, _C; stage_rc(tid * 16 + _i * 8192, _R, _C); \
        int _v = *(const PG8_LAS int*)(lds + STAGE_BYTES + (_h * HALF + _R) * 4); _v = _v < 0 ? 0 : _v; (vo)[_h][_i] = (unsigned)_v * (unsigned)(g.lda * 2) + voffA[_i]; } } while (0)
    const size_t kstep = (size_t)(BK * 2);
    const size_t hstepA = (size_t)HALF * g.lda * 2, hstepB = (size_t)HALF * g.ldb * 2;
    const size_t tstepA = GATHER ? 0 : 2 * hstepA, tstepB = 2 * hstepB;
    const unsigned ldsw = (unsigned)wid * 1024u;
    const int aoff = lds_byte(wr * 64 + fr, fq * 8), boff = lds_byte(wc * 32 + fr, fq * 8);
#define PG8_SA(b, h) (((b) * 2 + (h)) * HTB)
#define PG8_SB(b, h) ((4 + (b) * 2 + (h)) * HTB)
#if PG8_BUF
    const __amdgpu_buffer_rsrc_t rsA = pg8_rsrc(g.A), rsB = pg8_rsrc(g.Bt);
#define PG8_STAGE_R(rs, base0, bufoff, gbase, voff) do { const int _so = __builtin_amdgcn_readfirstlane((int)(unsigned)((const char*)(gbase) - (const char*)(base0))); _Pragma("unroll") for (int _i = 0; _i < 2; ++_i) \
        __builtin_amdgcn_raw_ptr_buffer_load_lds(rs, (PG8_LAS void*)(lds + (bufoff) + ldsw + _i * 8192), 16, (int)(voff)[_i], _so, 0, 0); } while (0)
#define PG8_STAGE(bufoff, gbase, voff) PG8_STAGE_R(rsB, g.Bt, bufoff, gbase, voff)
#define PG8_STAGEA(bufoff, base, half, vsel) do { if constexpr (GATHER) PG8_STAGE_R(rsA, g.A, bufoff, base, vsel[half]); else PG8_STAGE_R(rsA, g.A, bufoff, (base) + (half) * hstepA, voffA); } while (0)
#else
#define PG8_STAGE(bufoff, gbase, voff) do { _Pragma("unroll") for (int _i = 0; _i < 2; ++_i) \
        __builtin_amdgcn_global_load_lds((const unsigned*)((const char*)(gbase) + (voff)[_i]), (PG8_LAS unsigned*)(lds + (bufoff) + ldsw + _i * 8192), 16, 0, 0); } while (0)
#define PG8_STAGEA(bufoff, base, half, vsel) do { if constexpr (GATHER) PG8_STAGE(bufoff, base, vsel[half]); else PG8_STAGE(bufoff, (base) + (half) * hstepA, voffA); } while (0)
#endif
#define PG8_LDA(dst, b, h) do { if constexpr (FP8) { _Pragma("unroll") for (int m = 0; m < 4; ++m) { const u32x4 lo_ = *(const PG8_LAS u32x4*)(lds + PG8_SA(b, h) + aoff + m * 2048), hi_ = *(const PG8_LAS u32x4*)(lds + PG8_SA(b, h) + aoff + m * 2048 + 1024); \
        dst##8[m] = __builtin_bit_cast(pg8_v8i, __builtin_shufflevector(lo_, hi_, 0, 1, 2, 3, 4, 5, 6, 7)); } } \
    else { _Pragma("unroll") for (int m = 0; m < 4; ++m) _Pragma("unroll") for (int k = 0; k < 2; ++k) dst[m][k] = *(const PG8_LAS bf16x8*)(lds + PG8_SA(b, h) + aoff + m * 2048 + k * 1024); } } while (0)
#define PG8_LDB(dst, b, h) do { if constexpr (FP8) { _Pragma("unroll") for (int n = 0; n < 2; ++n) { const u32x4 lo_ = *(const PG8_LAS u32x4*)(lds + PG8_SB(b, h) + boff + n * 2048), hi_ = *(const PG8_LAS u32x4*)(lds + PG8_SB(b, h) + boff + n * 2048 + 1024); \
        dst##8[n] = __builtin_bit_cast(pg8_v8i, __builtin_shufflevector(lo_, hi_, 0, 1, 2, 3, 4, 5, 6, 7)); } } \
    else { _Pragma("unroll") for (int n = 0; n < 2; ++n) _Pragma("unroll") for (int k = 0; k < 2; ++k) dst[n][k] = *(const PG8_LAS bf16x8*)(lds + PG8_SB(b, h) + boff + n * 2048 + k * 1024); } } while (0)
#define PG8_MMA(ai, bj, At, Bt) do { __builtin_amdgcn_s_setprio(1); _Pragma("unroll") for (int m = 0; m < 4; ++m) _Pragma("unroll") for (int n = 0; n < 2; ++n) _Pragma("unroll") for (int k = 0; k < 2; ++k) \
        acc[ai][bj][m][n] = __builtin_amdgcn_mfma_f32_16x16x32_bf16(Bt[n][k], At[m][k], acc[ai][bj][m][n], 0, 0, 0); __builtin_amdgcn_s_setprio(0); } while (0)
#define PG8_MMA8(ai, bj, At, Bt) do { __builtin_amdgcn_s_setprio(1); _Pragma("unroll") for (int m = 0; m < 4; ++m) _Pragma("unroll") for (int n = 0; n < 2; ++n) \
        acc[ai][bj][m][n] = __builtin_amdgcn_mfma_scale_f32_16x16x128_f8f6f4(Bt##8[n], At##8[m], acc[ai][bj][m][n], 0, 0, 0, wscale, 0, 0x7f7f7f7f); \
        __builtin_amdgcn_s_setprio(0); } while (0)
#define PG8_MMX(ai, bj, At, Bt) do { if constexpr (FP8) PG8_MMA8(ai, bj, At, Bt); else PG8_MMA(ai, bj, At, Bt); } while (0)
#define PG8_PIECE(bufoff, gbase, voff, i) __builtin_amdgcn_global_load_lds((const unsigned*)((const char*)(gbase) + (voff)[i]), (PG8_LAS unsigned*)(lds + (bufoff) + ldsw + (i) * 8192), 16, 0, 0)
#define PG8_PIECEB(bufoff, gbase, i) PG8_PIECE(bufoff, gbase, voffB, i)
#define PG8_PIECEA(bufoff, base, half, i) do { if constexpr (GATHER) PG8_PIECE(bufoff, base, vs[half], i); else PG8_PIECE(bufoff, (base) + (half) * hstepA, voffA, i); } while (0)
#define PG8_MF8(ai, bj, At, Bt, m, n) acc[ai][bj][m][n] = __builtin_amdgcn_mfma_scale_f32_16x16x128_f8f6f4(Bt##8[n], At##8[m], acc[ai][bj][m][n], 0, 0, 0, wscale, 0, 0x7f7f7f7f)
#define PG8_MF16(ai, bj, At, Bt, m, n) do { acc[ai][bj][m][n] = __builtin_amdgcn_mfma_f32_16x16x32_bf16(Bt[n][0], At[m][0], acc[ai][bj][m][n], 0, 0, 0); acc[ai][bj][m][n] = __builtin_amdgcn_mfma_f32_16x16x32_bf16(Bt[n][1], At[m][1], acc[ai][bj][m][n], 0, 0, 0); } while (0)
#define PG8_MF(ai, bj, At, Bt, m, n) do { if constexpr (FP8) PG8_MF8(ai, bj, At, Bt, m, n); else PG8_MF16(ai, bj, At, Bt, m, n); } while (0)
#define PG8_MMXS(ai, bj, At, Bt, S0, S1) do { __builtin_amdgcn_s_setprio(1); PG8_MF(ai, bj, At, Bt, 0, 0); PG8_MF(ai, bj, At, Bt, 0, 1); PG8_SCHED; S0; PG8_SCHED; \
        PG8_MF(ai, bj, At, Bt, 1, 0); PG8_MF(ai, bj, At, Bt, 1, 1); PG8_MF(ai, bj, At, Bt, 2, 0); PG8_SCHED; S1; PG8_SCHED; PG8_MF(ai, bj, At, Bt, 2, 1); PG8_MF(ai, bj, At, Bt, 3, 0); PG8_MF(ai, bj, At, Bt, 3, 1); \
        __builtin_amdgcn_s_setprio(0); } while (0)
#define PG8_WAIT_V(n) asm volatile("s_waitcnt vmcnt(" #n ")" ::: "memory")
#define PG8_WAIT_L(n) asm volatile("s_waitcnt lgkmcnt(" #n ")" ::: "memory")
#define PG8_BAR __builtin_amdgcn_s_barrier()
#define PG8_SCHED __builtin_amdgcn_sched_barrier(0)
    Unit cur, nxt; int ui = 0;
    if (!S.next(0, cur)) return;
    f32x4 acc[2][2][4][2];
#pragma unroll
    for (int a = 0; a < 2; ++a)
#pragma unroll
        for (int b = 0; b < 2; ++b)
#pragma unroll
            for (int m = 0; m < 4; ++m)
#pragma unroll
                for (int n = 0; n < 2; ++n) acc[a][b][m][n] = (f32x4){0.f, 0.f, 0.f, 0.f};
    bf16x8 At[4][2], B0[2][2], B1[2][2]; pg8_v8i At8[4], B08[2], B18[2];
    const char* cA = (const char*)g.A + (size_t)cur.pm * tstepA; const char* cB = (const char*)g.Bt + (size_t)cur.pn * tstepB;
    S.a_ready(cur);
    if constexpr (GATHER) { PG8_LDRAW(cur.pm); asm volatile("s_waitcnt vmcnt(0)" ::: "memory"); __builtin_amdgcn_s_barrier(); asm volatile("" ::: "memory"); PG8_CONV(vs); asm volatile("s_waitcnt lgkmcnt(0)" ::: "memory"); __builtin_amdgcn_s_barrier(); }
    PG8_STAGE(PG8_SB(0, 0), cB, voffB); PG8_STAGEA(PG8_SA(0, 0), cA, 0, vs); PG8_STAGE(PG8_SB(0, 1), cB + hstepB, voffB); PG8_STAGEA(PG8_SA(0, 1), cA, 1, vs);
    if (wr == 1) PG8_BAR;
    PG8_WAIT_V(4); PG8_BAR;
    PG8_STAGE(PG8_SB(1, 0), cB + kstep, voffB); PG8_STAGEA(PG8_SA(1, 0), cA + kstep, 0, vs); PG8_STAGE(PG8_SB(1, 1), cB + hstepB + kstep, voffB);
    PG8_WAIT_V(6); PG8_BAR;
    PG8_STAMP();
    for (;;) {
        if constexpr (PRB) { if (wid == 0) pt_ = PG8_PROBE_NOW(); }
        const bool has_next = S.next(ui + 1, nxt);
        if constexpr (GATHER) { if (has_next) PG8_LDRAW(nxt.pm); }
        const char* nA = has_next ? (const char*)g.A + (size_t)nxt.pm * tstepA : cA; const char* nB = has_next ? (const char*)g.Bt + (size_t)nxt.pn * tstepB : cB;
#pragma unroll 1
        for (int t = 0; t < nt; t += 2) {
            const bool last = (t == nt - 2);
            const char* a1 = cA + (size_t)(t + 1) * kstep;
            const char* a2 = last ? nA : cA + (size_t)(t + 2) * kstep; const char* b2 = last ? nB : cB + (size_t)(t + 2) * kstep;
            const char* a3 = a2 + kstep; const char* b3 = b2 + kstep;
            if (last && has_next) S.a_ready(nxt);
#if PG8_DMAMMA
            PG8_LDB(B0, 0, 0); PG8_SCHED; PG8_LDA(At, 0, 0);
            PG8_WAIT_L(8); PG8_BAR; PG8_WAIT_L(0); PG8_MMXS(0, 0, At, B0, PG8_PIECEA(PG8_SA(1, 1), a1, 1, 0), PG8_PIECEA(PG8_SA(1, 1), a1, 1, 1)); PG8_BAR; PG8_SCHED;
            PG8_LDB(B1, 0, 1);
            if constexpr (GATHER) { if (last && has_next) { PG8_CONV(vs); asm volatile("" : "+v"(vs[0][0]), "+v"(vs[0][1]), "+v"(vs[1][0]), "+v"(vs[1][1])); } }
            PG8_BAR; PG8_WAIT_L(0); PG8_MMXS(0, 1, At, B1, PG8_PIECEB(PG8_SB(0, 0), b2, 0), PG8_PIECEB(PG8_SB(0, 0), b2, 1)); PG8_BAR;
            PG8_LDA(At, 0, 1);
            PG8_BAR; PG8_WAIT_L(0); PG8_MMXS(1, 0, At, B0, PG8_PIECEA(PG8_SA(0, 0), a2, 0, 0), PG8_PIECEA(PG8_SA(0, 0), a2, 0, 1)); PG8_BAR; PG8_SCHED;
            PG8_WAIT_V(4); PG8_BAR; PG8_MMXS(1, 1, At, B1, PG8_PIECEB(PG8_SB(0, 1), b2 + hstepB, 0), PG8_PIECEB(PG8_SB(0, 1), b2 + hstepB, 1)); PG8_BAR;
            PG8_LDB(B0, 1, 0); PG8_SCHED; PG8_LDA(At, 1, 0);
            PG8_WAIT_L(8); PG8_BAR; PG8_WAIT_L(0); PG8_MMXS(0, 0, At, B0, PG8_PIECEA(PG8_SA(0, 1), a2, 1, 0), PG8_PIECEA(PG8_SA(0, 1), a2, 1, 1)); PG8_BAR; PG8_SCHED;
            PG8_LDB(B1, 1, 1);
            PG8_BAR; PG8_WAIT_L(0); PG8_MMXS(0, 1, At, B1, PG8_PIECEB(PG8_SB(1, 0), b3, 0), PG8_PIECEB(PG8_SB(1, 0), b3, 1)); PG8_BAR;
            PG8_LDA(At, 1, 1);
            PG8_BAR; PG8_WAIT_L(0); PG8_MMXS(1, 0, At, B0, PG8_PIECEA(PG8_SA(1, 0), a3, 0, 0), PG8_PIECEA(PG8_SA(1, 0), a3, 0, 1)); PG8_BAR; PG8_SCHED;
            PG8_WAIT_V(4); PG8_BAR; PG8_MMXS(1, 1, At, B1, PG8_PIECEB(PG8_SB(1, 1), b3 + hstepB, 0), PG8_PIECEB(PG8_SB(1, 1), b3 + hstepB, 1)); PG8_BAR;
#else
            PG8_LDB(B0, 0, 0); PG8_SCHED; PG8_LDA(At, 0, 0); PG8_STAGEA(PG8_SA(1, 1), a1, 1, vs);
            if constexpr (GATHER) { if (last && has_next) { PG8_CONV(vs); asm volatile("" : "+v"(vs[0][0]), "+v"(vs[0][1]), "+v"(vs[1][0]), "+v"(vs[1][1])); } }
            PG8_WAIT_L(8); PG8_BAR; PG8_WAIT_L(0); PG8_MMX(0, 0, At, B0); PG8_BAR; PG8_SCHED;
            PG8_LDB(B1, 0, 1); PG8_STAGE(PG8_SB(0, 0), b2, voffB);
            PG8_BAR; PG8_WAIT_L(0); PG8_MMX(0, 1, At, B1); PG8_BAR;
            PG8_LDA(At, 0, 1); PG8_STAGEA(PG8_SA(0, 0), a2, 0, vs);
            PG8_BAR; PG8_WAIT_L(0); PG8_MMX(1, 0, At, B0); PG8_BAR; PG8_SCHED;
            PG8_STAGE(PG8_SB(0, 1), b2 + hstepB, voffB);
            PG8_WAIT_V(6); PG8_BAR; PG8_MMX(1, 1, At, B1); PG8_BAR;
            PG8_LDB(B0, 1, 0); PG8_SCHED; PG8_LDA(At, 1, 0); PG8_STAGEA(PG8_SA(0, 1), a2, 1, vs);
            PG8_WAIT_L(8); PG8_BAR; PG8_WAIT_L(0); PG8_MMX(0, 0, At, B0); PG8_BAR; PG8_SCHED;
            PG8_LDB(B1, 1, 1); PG8_STAGE(PG8_SB(1, 0), b3, voffB);
            PG8_BAR; PG8_WAIT_L(0); PG8_MMX(0, 1, At, B1); PG8_BAR;
            PG8_LDA(At, 1, 1); PG8_STAGEA(PG8_SA(1, 0), a3, 0, vs);
            PG8_BAR; PG8_WAIT_L(0); PG8_MMX(1, 0, At, B0); PG8_BAR; PG8_SCHED;
            PG8_STAGE(PG8_SB(1, 1), b3 + hstepB, voffB);
            PG8_WAIT_V(6); PG8_BAR; PG8_MMX(1, 1, At, B1); PG8_BAR;
#endif
        }
        PG8_STAMP();
        if constexpr (PRB) { if (wid == 0) { const unsigned long long n_ = PG8_PROBE_NOW(); pk += n_ - pt_; pt_ = n_; } }
        if constexpr (!Epi::AFTER_DRAIN) { E(acc, cur, wr, wc, fr, fq); S.done(cur); }
        if constexpr (PRB) { if (wid == 0) { const unsigned long long n_ = PG8_PROBE_NOW(); pe += n_ - pt_; } }
        PG8_STAMP();
        if (!has_next) break;
#pragma unroll
        for (int a = 0; a < 2; ++a)
#pragma unroll
            for (int b = 0; b < 2; ++b)
#pragma unroll
                for (int m = 0; m < 4; ++m)
#pragma unroll
                    for (int n = 0; n < 2; ++n) acc[a][b][m][n] = (f32x4){0.f, 0.f, 0.f, 0.f};
        cur = nxt; cA = nA; cB = nB; ++ui;
    }
    PG8_WAIT_V(0);
    if (wr == 0) PG8_BAR;
    PG8_BAR;
    if constexpr (Epi::AFTER_DRAIN) { E.fused(acc, cur, wr, wc, fr, fq, lds, wid, lane); S.done(cur); }
    PG8_STAMP();
    if (STAMP && wid == 0) { stamps[lane] = lane < nts ? (((unsigned long long)(unsigned)ts_hi << 32) | (unsigned)ts_lo) : 0ull;
        if (lane == 62) stamps[62] = rt_entry; if (lane == 63) stamps[63] = (unsigned long long)wall_clock64(); }
#undef PG8_STAMP
#undef PG8_SA
#undef PG8_SB
#undef PG8_STAGE
#undef PG8_STAGEA
#undef PG8_LDRAW
#undef PG8_CONV
#undef PG8_LDA
#undef PG8_LDB
#undef PG8_MMA
#undef PG8_MMA8
#undef PG8_MMX
#undef PG8_WAIT_V
#undef PG8_WAIT_L
#undef PG8_BAR
#undef PG8_SCHED
}
}
namespace pg8 {
struct MoeOrder {
    int NT, G, c, nunits, rep;
    __device__ void init(int NT_, int G_, int c_) { NT = NT_; G = G_; c = c_; nunits = NPANEL * NT_; rep = 1; }
    __device__ bool next(int i, Unit& u) const {
        const long L0 = (long)(i / rep) * G + c; if (L0 >= nunits) return false;
        int pr, pnl;
        if (G == 256) { const int x = c & 7, jj = c >> 3, PX = 32 / NT; pr = (i / rep) * (256 / NT) + x * PX + jj / NT; pnl = jj % NT; }
        else { pr = (int)L0 / NT; pnl = (int)L0 % NT; }
        int pm, e;
        if (pr < 512) { e = pr >> 5; pm = (pr & 31) * 16 + e; } else { pm = pr; e = (pr - 512) >> 2; }
        u.pm = pm; u.pn = e * NT + pnl; return true;
    }
    __device__ __forceinline__ void a_ready(const Unit&) const {}
    __device__ __forceinline__ void done(const Unit&) const {}
};

__device__ __forceinline__ u32x4 pack8(const f32x4 a, const f32x4 b) { u32x4 w; w.x = cvt_pk_bf16(a[0], a[1]); w.y = cvt_pk_bf16(a[2], a[3]); w.z = cvt_pk_bf16(b[0], b[1]); w.w = cvt_pk_bf16(b[2], b[3]); return w; }

struct EpiStore {
    static constexpr bool PERM = true, AFTER_DRAIN = false;
    bf16_t* O; int ldc; int pnmask;
    __device__ __forceinline__ void operator()(const f32x4 (&acc)[2][2][4][2], const Unit& u, int wr, int wc, int fr, int fq) const {
        const int row0 = u.pm * BM + wr * 64 + fr, col0 = (u.pn & pnmask) * BM + wc * 32 + 8 * fq;
#pragma unroll
        for (int ai = 0; ai < 2; ++ai)
#pragma unroll
            for (int m = 0; m < 4; ++m) { const int row = row0 + ai * HALF + m * 16; bf16_t* rowp = O + (size_t)row * ldc + col0;
#pragma unroll
                for (int bj = 0; bj < 2; ++bj) *(u32x4*)(rowp + bj * HALF) = pack8(acc[ai][bj][m][0], acc[ai][bj][m][1]);
                __builtin_amdgcn_sched_barrier(0); }
    }
};
struct EpiStoreF8 {
    static constexpr bool PERM = true, AFTER_DRAIN = false;
    unsigned char* O; int ldc; int pnmask;
    __device__ __forceinline__ void operator()(const f32x4 (&acc)[2][2][4][2], const Unit& u, int wr, int wc, int fr, int fq) const {
        const int row0 = u.pm * BM + wr * 64 + fr, col0 = (u.pn & pnmask) * BM + wc * 32 + 8 * fq;
#pragma unroll
        for (int ai = 0; ai < 2; ++ai)
#pragma unroll
            for (int m = 0; m < 4; ++m) { const int row = row0 + ai * HALF + m * 16; unsigned char* rowp = O + (size_t)row * ldc + col0;
#pragma unroll
                for (int bj = 0; bj < 2; ++bj) { const f32x4 a = acc[ai][bj][m][0], b = acc[ai][bj][m][1]; u32x2 w; w.x = cvt4_fp8(a[0], a[1], a[2], a[3]); w.y = cvt4_fp8(b[0], b[1], b[2], b[3]); *(u32x2*)(rowp + bj * HALF) = w; }
                __builtin_amdgcn_sched_barrier(0); }
    }
};
struct EpiUq {
    static constexpr bool PERM = true, AFTER_DRAIN = false;
    bf16_t* O; const float* rcos; const float* rsin;
    __device__ __forceinline__ void operator()(const f32x4 (&acc)[2][2][4][2], const Unit& u, int wr, int wc, int fr, int fq) const {
        const int row0 = u.pm * BM + wr * 64 + fr, col0 = u.pn * BM + wc * 32 + 8 * fq;
        const int bsmp = u.pm / 9, ptile = u.pm - bsmp * 9; const bool latent = ptile != 0;
        int j0[2]; bool inr[2];
#pragma unroll
        for (int bj = 0; bj < 2; ++bj) { const int c = col0 + bj * HALF, hd = c / 192, off = c - hd * 192; inr[bj] = latent && off >= 128; j0[bj] = (off - 128) >> 1; }
#pragma unroll
        for (int ai = 0; ai < 2; ++ai)
#pragma unroll
            for (int m = 0; m < 4; ++m) { const int row = row0 + ai * HALF + m * 16; bf16_t* rowp = O + (size_t)row * 1536 + col0;
                const int t = row - bsmp * TPS - CTXL, trow = (t >> 6) & 31, tcol = t & 63;
#pragma unroll
                for (int bj = 0; bj < 2; ++bj) { f32x4 a = acc[ai][bj][m][0], b = acc[ai][bj][m][1];
                    if (inr[bj]) { const int pos = j0[bj] < 16 ? trow : tcol, ti = pos * 16 + (j0[bj] & 15);
                        const f32x4 cs = *(const f32x4*)(rcos + ti), sn = *(const f32x4*)(rsin + ti);
                        const f32x4 a2 = {a[0] * cs[0] - a[1] * sn[0], a[0] * sn[0] + a[1] * cs[0], a[2] * cs[1] - a[3] * sn[1], a[2] * sn[1] + a[3] * cs[1]};
                        const f32x4 b2 = {b[0] * cs[2] - b[1] * sn[2], b[0] * sn[2] + b[1] * cs[2], b[2] * cs[3] - b[3] * sn[3], b[2] * sn[3] + b[3] * cs[3]};
                        a = a2; b = b2; }
                    *(u32x4*)(rowp + bj * HALF) = pack8(a, b); } }
    }
};
struct EpiSwiGlu {
    static constexpr bool PERM = true, AFTER_DRAIN = false;
    unsigned char* O;
    __device__ __forceinline__ void operator()(const f32x4 (&acc)[2][2][4][2], const Unit& u, int wr, int wc, int fr, int fq) const {
        const int row0 = u.pm * BM + wr * 64 + fr, col0 = (u.pn & 7) * HALF + wc * 32 + 8 * fq;
#pragma unroll
        for (int ai = 0; ai < 2; ++ai)
#pragma unroll
            for (int m = 0; m < 4; ++m) { unsigned char* rowp = O + (size_t)(row0 + ai * HALF + m * 16) * LDACT + col0; f32x4 r[2];
#pragma unroll
                for (int n = 0; n < 2; ++n) { const f32x4 g = acc[ai][0][m][n], up = acc[ai][1][m][n];
#pragma unroll
                    for (int j = 0; j < 4; ++j) r[n][j] = g[j] * __builtin_amdgcn_rcpf(1.0f + __builtin_amdgcn_exp2f(-1.4426950408889634f * g[j])) * up[j]; }
                u32x2 w; w.x = cvt4_fp8(r[0][0], r[0][1], r[0][2], r[0][3]); w.y = cvt4_fp8(r[1][0], r[1][1], r[1][2], r[1][3]);
                *(u32x2*)rowp = w; __builtin_amdgcn_sched_barrier(0); }
    }
};
struct EpiDown {
    static constexpr bool PERM = true, AFTER_DRAIN = false;
    bf16_t* O; const float* gv;
    __device__ __forceinline__ void operator()(const f32x4 (&acc)[2][2][4][2], const Unit& u, int wr, int wc, int fr, int fq) const {
        const int row0 = u.pm * BM + wr * 64 + fr, col0 = (u.pn & 3) * BM + wc * 32 + 8 * fq;
#pragma unroll
        for (int ai = 0; ai < 2; ++ai)
#pragma unroll
            for (int m = 0; m < 4; ++m) { const int row = row0 + ai * HALF + m * 16; const float s = gv[row]; bf16_t* rowp = O + (size_t)row * D + col0;
#pragma unroll
                for (int bj = 0; bj < 2; ++bj) *(u32x4*)(rowp + bj * HALF) = pack8(acc[ai][bj][m][0] * s, acc[ai][bj][m][1] * s); }
    }
};
}
namespace att {
constexpr int NW = 8, QBLK = 32, KVBLK = 64, DV = 128;
constexpr float THR = 8.f;
#ifndef ATT_QKPIPE_GQA
#define ATT_QKPIPE_GQA 0
#endif
#ifndef ATT_QKPIPE_MLA
#define ATT_QKPIPE_MLA 0
#endif
#ifndef MLA_QREG
#define MLA_QREG 4
#endif
#define SBAR() __builtin_amdgcn_sched_barrier(0)
__device__ __forceinline__ int crow(int r, int hi) { return (r & 3) + 8 * (r >> 2) + 4 * hi; }
__device__ __forceinline__ unsigned cvtpk(float lo, float hi) { unsigned r; asm volatile("v_cvt_pk_bf16_f32 %0, %1, %2" : "=v"(r) : "v"(lo), "v"(hi)); return r; }

template <int DQK> struct Cfg {
    static constexpr float SCALE = DQK == 128 ? 0.088388347648318440f : 0.072168783648703220f;
    static constexpr float C = SCALE * 1.4426950408889634f;
    static constexpr int ROWB = DQK * 2;
    static constexpr int SHM_K = KVBLK * DQK * 2, SHM_V = KVBLK * DV * 2;
    static constexpr int QREG = DQK == 128 ? 8 : MLA_QREG;
    static constexpr int SHM_ATTN = 2 * SHM_V + 2 * SHM_K + NW * 64 * 4 + NW * (DQK / 16 - QREG) * 1024;
};
#define KSWZ(row, colB) ((row) * ROWB + ((colB) ^ ((((colB) < 256) ? ((row) & 15) : ((row) & 7)) << 4)))

template <int DQK>
__device__ __forceinline__ void partialSM(f32x16& p0, f32x16& p1, float& m_reg, float& mn, float& alpha) {
  constexpr float C = Cfg<DQK>::C, SCALE = Cfg<DQK>::SCALE;
  float pmax = p0[0];
#pragma unroll
  for (int r = 1; r < 16; ++r) pmax = fmaxf(pmax, p0[r]);
#pragma unroll
  for (int r = 0; r < 16; ++r) pmax = fmaxf(pmax, p1[r]);
  { auto rr = __builtin_amdgcn_permlane32_swap(__float_as_uint(pmax), __float_as_uint(pmax), false, false);
    pmax = fmaxf(__uint_as_float(rr[0]), __uint_as_float(rr[1])); }
  if (__builtin_expect(__all(pmax - m_reg <= THR / SCALE), 1)) { mn = m_reg; alpha = 1.f; }
  else { mn = fmaxf(m_reg, pmax); alpha = __builtin_amdgcn_exp2f((m_reg - mn) * C); m_reg = mn; }
  float mnC = -mn * C;
#pragma unroll
  for (int r = 0; r < 16; ++r) p0[r] = fmaf(p0[r], C, mnC);
#pragma unroll
  for (int r = 0; r < 16; ++r) p1[r] = fmaf(p1[r], C, mnC);
#pragma unroll
  for (int r = 0; r < 16; ++r) p0[r] = __builtin_amdgcn_exp2f(p0[r]);
}
__device__ __forceinline__ void finishSM(f32x16& p0, f32x16& p1, float alpha, float& l_reg, bf16x8& pa0, bf16x8& pa1, bf16x8& pa2, bf16x8& pa3) {
#pragma unroll
  for (int r = 0; r < 16; ++r) p1[r] = __builtin_amdgcn_exp2f(p1[r]);
  float ps = 0;
#pragma unroll
  for (int r = 0; r < 16; ++r) ps += p0[r];
#pragma unroll
  for (int r = 0; r < 16; ++r) ps += p1[r];
  { auto rr = __builtin_amdgcn_permlane32_swap(__float_as_uint(ps), __float_as_uint(ps), false, false);
    ps = __uint_as_float(rr[0]) + __uint_as_float(rr[1]); }
  l_reg = l_reg * alpha + ps;
#define PK4(P, BASE, OUT) do { unsigned a0 = cvtpk(P[BASE + 0], P[BASE + 1]), a1 = cvtpk(P[BASE + 2], P[BASE + 3]);   \
    unsigned b0 = cvtpk(P[BASE + 4], P[BASE + 5]), b1 = cvtpk(P[BASE + 6], P[BASE + 7]);                              \
    auto r0 = __builtin_amdgcn_permlane32_swap(a0, b0, false, false); auto r1 = __builtin_amdgcn_permlane32_swap(a1, b1, false, false); \
    u32x4 w = {r0[0], r1[0], r0[1], r1[1]}; OUT = *reinterpret_cast<bf16x8*>(&w); } while (0)
  PK4(p0, 0, pa0); PK4(p0, 8, pa1); PK4(p1, 0, pa2); PK4(p1, 8, pa3);
#undef PK4
}
template <int DQK, int QREG>
__device__ __forceinline__ void qkt_plain(f32x16& p0, f32x16& p1, const char* Ks, const bf16x8* qr, const char* qx, int r32, int hi) {
  constexpr int ROWB = Cfg<DQK>::ROWB;
  p0 = f32x16{}; p1 = f32x16{};
#pragma unroll
  for (int d0 = 0; d0 < DQK / 16; ++d0) { int cb = (d0 * 16 + hi * 8) * 2;
    bf16x8 b0 = *reinterpret_cast<const bf16x8*>(Ks + KSWZ(r32, cb));
    bf16x8 b1 = *reinterpret_cast<const bf16x8*>(Ks + KSWZ(32 + r32, cb));
    bf16x8 q; if (d0 < QREG) q = qr[d0]; else q = *reinterpret_cast<const bf16x8*>(qx + (d0 - QREG) * 1024);
    p0 = __builtin_amdgcn_mfma_f32_32x32x16_bf16(b0, q, p0, 0, 0, 0);
    p1 = __builtin_amdgcn_mfma_f32_32x32x16_bf16(b1, q, p1, 0, 0, 0); }
}
template <int DQK, int QREG, int D0>
__device__ __forceinline__ void qk_issue(bf16x8 (&kl)[3], bf16x8 (&kh)[3], bf16x8 (&qf)[3], int kb, int s4, int s3, int hi16, int qxa) {
  constexpr int ROWB = Cfg<DQK>::ROWB;
  const int ad = kb + ((D0 * 32 + hi16) ^ (D0 < 8 ? s4 : s3));
  asm volatile("ds_read_b128 %0, %1" : "=v"(kl[D0 % 3]) : "v"(ad) : "memory");
  asm volatile("ds_read_b128 %0, %1 offset:%2" : "=v"(kh[D0 % 3]) : "v"(ad), "n"(32 * ROWB) : "memory");
  if constexpr (D0 >= QREG) asm volatile("ds_read_b128 %0, %1 offset:%2" : "=v"(qf[D0 % 3]) : "v"(qxa), "n"((D0 - QREG) * 1024) : "memory");
}
template <int DQK, int QREG, int D0>
__device__ __forceinline__ void qk_steps(f32x16& p0, f32x16& p1, bf16x8 (&kl)[3], bf16x8 (&kh)[3], bf16x8 (&qf)[3], const bf16x8* qr, int kb, int s4, int s3, int hi16, int qxa) {
  constexpr int ND = DQK / 16;
  if constexpr (D0 < ND) {
    constexpr int R1 = D0 + 1 < ND ? 2 + (D0 + 1 >= QREG ? 1 : 0) : 0, R2 = D0 + 2 < ND ? 2 + (D0 + 2 >= QREG ? 1 : 0) : 0;
    if constexpr (D0 >= QREG) asm volatile("s_waitcnt lgkmcnt(%3)" : "+v"(kl[D0 % 3]), "+v"(kh[D0 % 3]), "+v"(qf[D0 % 3]) : "n"(R1 + R2));
    else asm volatile("s_waitcnt lgkmcnt(%2)" : "+v"(kl[D0 % 3]), "+v"(kh[D0 % 3]) : "n"(R1 + R2));
    bf16x8 q; if constexpr (D0 < QREG) q = qr[D0]; else q = qf[D0 % 3];
    if constexpr (D0 == 0) { p0 = __builtin_amdgcn_mfma_f32_32x32x16_bf16(kl[0], q, f32x16{}, 0, 0, 0); p1 = __builtin_amdgcn_mfma_f32_32x32x16_bf16(kh[0], q, f32x16{}, 0, 0, 0); }
    else { p0 = __builtin_amdgcn_mfma_f32_32x32x16_bf16(kl[D0 % 3], q, p0, 0, 0, 0); p1 = __builtin_amdgcn_mfma_f32_32x32x16_bf16(kh[D0 % 3], q, p1, 0, 0, 0); }
    if constexpr (D0 + 3 < ND) qk_issue<DQK, QREG, D0 + 3>(kl, kh, qf, kb, s4, s3, hi16, qxa);
    qk_steps<DQK, QREG, D0 + 1>(p0, p1, kl, kh, qf, qr, kb, s4, s3, hi16, qxa);
  }
}
template <int DQK, int QREG>
__device__ __forceinline__ void qkt(f32x16& p0, f32x16& p1, const char* Ks, const bf16x8* qr, const char* qx, int r32, int hi) {
  constexpr int ROWB = Cfg<DQK>::ROWB;
  if constexpr ((DQK == 128 && !ATT_QKPIPE_GQA) || (DQK == 192 && !ATT_QKPIPE_MLA)) { qkt_plain<DQK, QREG>(p0, p1, Ks, qr, qx, r32, hi); return; }
  const int kb = (int)(unsigned)(uintptr_t)Ks + r32 * ROWB, s4 = (r32 & 15) << 4, s3 = (r32 & 7) << 4, hi16 = hi * 16, qxa = (int)(unsigned)(uintptr_t)qx;
  bf16x8 kl[3], kh[3], qf[3];
  qk_issue<DQK, QREG, 0>(kl, kh, qf, kb, s4, s3, hi16, qxa); qk_issue<DQK, QREG, 1>(kl, kh, qf, kb, s4, s3, hi16, qxa); qk_issue<DQK, QREG, 2>(kl, kh, qf, kb, s4, s3, hi16, qxa);
  qk_steps<DQK, QREG, 0>(p0, p1, kl, kh, qf, qr, kb, s4, s3, hi16, qxa);
}
__device__ __forceinline__ int v_st(int k, int c) { const int kk = (k & ~0xC) | ((k & 4) << 1) | ((k & 8) >> 1); return ((kk >> 3) * 4 + (c >> 5)) * 512 + ((kk & 7) * 32 + (c & 31)) * 2; }
__device__ __forceinline__ int v_rd_base(int lane) { return ((lane & 3) << 3) | (((lane >> 2) & 3) << 6) | (((lane >> 4) & 1) << 5) | (((lane >> 5) & 1) << 8); }
constexpr int v_rd_off(int d0, int ks, int half) { return d0 * 512 + ks * 4096 + half * 2048; }
template <int OFF> __device__ __forceinline__ s16x4 tr_read(int vb) {
  s16x4 r; asm volatile("ds_read_b64_tr_b16 %0, %1 offset:%2" : "=&v"(r) : "v"(vb), "i"(OFF) : "memory"); return r;
}
template <int D0> __device__ __forceinline__ void pv_one(f32x16& od, int vb, bf16x8 pa0, bf16x8 pa1, bf16x8 pa2, bf16x8 pa3) {
  const s16x4 l0 = tr_read<v_rd_off(D0, 0, 0)>(vb), h0 = tr_read<v_rd_off(D0, 0, 1)>(vb), l1 = tr_read<v_rd_off(D0, 1, 0)>(vb), h1 = tr_read<v_rd_off(D0, 1, 1)>(vb);
  const s16x4 l2 = tr_read<v_rd_off(D0, 2, 0)>(vb), h2 = tr_read<v_rd_off(D0, 2, 1)>(vb), l3 = tr_read<v_rd_off(D0, 3, 0)>(vb), h3 = tr_read<v_rd_off(D0, 3, 1)>(vb);
  asm volatile("s_waitcnt lgkmcnt(0)" ::: "memory"); SBAR();
#define PK(L, H) (bf16x8){L[0], L[1], L[2], L[3], H[0], H[1], H[2], H[3]}
  od = __builtin_amdgcn_mfma_f32_32x32x16_bf16(pa0, PK(l0, h0), od, 0, 0, 0);
  od = __builtin_amdgcn_mfma_f32_32x32x16_bf16(pa1, PK(l1, h1), od, 0, 0, 0);
  od = __builtin_amdgcn_mfma_f32_32x32x16_bf16(pa2, PK(l2, h2), od, 0, 0, 0);
  od = __builtin_amdgcn_mfma_f32_32x32x16_bf16(pa3, PK(l3, h3), od, 0, 0, 0);
#undef PK
}
__device__ __forceinline__ void pv_d0(f32x16* o, int vb, bf16x8 pa0, bf16x8 pa1, bf16x8 pa2, bf16x8 pa3) {
  pv_one<0>(o[0], vb, pa0, pa1, pa2, pa3); pv_one<1>(o[1], vb, pa0, pa1, pa2, pa3); pv_one<2>(o[2], vb, pa0, pa1, pa2, pa3); pv_one<3>(o[3], vb, pa0, pa1, pa2, pa3);
}

template <int DQK, int SDEPTH, int ldq, int ldk, int ldkr, int ldv, int ldo>
__device__ __forceinline__ void attn_body(const bf16_t* __restrict__ Qb, const bf16_t* __restrict__ Kh, const bf16_t* __restrict__ Kr,
                                          const bf16_t* __restrict__ Vh, unsigned char* __restrict__ Ob, int seq, char* lds, int qt0, const float* __restrict__ rt, const float* __restrict__ qg) {
  constexpr int ROWB = Cfg<DQK>::ROWB, SHM_K = Cfg<DQK>::SHM_K, SHM_V = Cfg<DQK>::SHM_V;
  constexpr bool X = DQK == 192; constexpr int QREG = Cfg<DQK>::QREG, QLDS = DQK / 16 - QREG;
  const int tid = opaque_v((int)threadIdx.x), wid = tid >> 6, lane = tid & 63, r32 = lane & 31, hi = lane >> 5;
  char* V_lds = lds; char* K_lds = lds + 2 * SHM_V;
  float* ws = (float*)(lds + 2 * SHM_V + 2 * SHM_K) + wid * 64; float* li_l = ws; float* al_l = ws + 32;
  float m_reg = -1e30f, l_reg = 0; f32x16 o[4] = {}; bf16x8 qr[QREG];
  const bf16_t* Qw = Qb + (long)(wid * QBLK + r32) * ldq + hi * 8;
  char* qx = lds + 2 * SHM_V + 2 * SHM_K + NW * 64 * 4 + wid * (QLDS * 1024) + lane * 16;
#pragma unroll
  for (int d0 = 0; d0 < QREG; ++d0) qr[d0] = *reinterpret_cast<const bf16x8*>(Qw + d0 * 16);
  if constexpr (X) {
#pragma unroll
    for (int d0 = QREG; d0 < 8; ++d0) *reinterpret_cast<bf16x8*>(qx + (d0 - QREG) * 1024) = *reinterpret_cast<const bf16x8*>(Qw + d0 * 16);
  }
  if constexpr (!X) {
    float ss = 0.f;
#pragma unroll
    for (int d0 = 0; d0 < 8; ++d0) { const u32x4 w = *reinterpret_cast<const u32x4*>(&qr[d0]);
#pragma unroll
      for (int q = 0; q < 4; ++q) { const float x0 = __uint_as_float(w[q] << 16), x1 = __uint_as_float(w[q] & 0xffff0000u); ss += x0 * x0 + x1 * x1; } }
    ss += __shfl_xor(ss, 32);
    const float rstd = 1.0f / sqrtf(ss * (1.0f / 128.0f) + 1e-6f);
    const int t = qt0 >= 0 ? qt0 + wid * QBLK + r32 : 0;
#pragma unroll
    for (int d0 = 0; d0 < 8; ++d0) { u32x4 w = *reinterpret_cast<const u32x4*>(&qr[d0]);
      const f32x4 g0 = *reinterpret_cast<const f32x4*>(qg + d0 * 16 + hi * 8), g1 = *reinterpret_cast<const f32x4*>(qg + d0 * 16 + hi * 8 + 4);
      const int pos = d0 < 4 ? (t >> 6) : (t & 63), ti = pos * 32 + (d0 & 3) * 8 + hi * 4; const f32x4 cs = *reinterpret_cast<const f32x4*>(rt + ti), sn = *reinterpret_cast<const f32x4*>(rt + 2048 + ti);
      const float gg[8] = {g0[0], g0[1], g0[2], g0[3], g1[0], g1[1], g1[2], g1[3]};
#pragma unroll
      for (int q = 0; q < 4; ++q) { const float x0 = __uint_as_float(w[q] << 16) * rstd * gg[2 * q], x1 = __uint_as_float(w[q] & 0xffff0000u) * rstd * gg[2 * q + 1]; w[q] = cvtpk(x0 * cs[q] - x1 * sn[q], x0 * sn[q] + x1 * cs[q]); }
      qr[d0] = *reinterpret_cast<const bf16x8*>(&w); }
  }
  if constexpr (X) {
#pragma unroll
    for (int d0 = 8; d0 < 12; ++d0) {
      u32x4 w = *reinterpret_cast<const u32x4*>(Qw + d0 * 16);
      { const int t = qt0 >= 0 ? qt0 + wid * QBLK + r32 : 0, j0 = (d0 - 8) * 8 + hi * 4, pos = d0 < 10 ? (t >> 6) : (t & 63), ti = pos * 16 + (j0 & 15);
        const f32x4 cs = *reinterpret_cast<const f32x4*>(rt + ti), sn = *reinterpret_cast<const f32x4*>(rt + 1024 + ti);
#pragma unroll
        for (int q = 0; q < 4; ++q) { const float x0 = __uint_as_float(w[q] << 16), x1 = __uint_as_float(w[q] & 0xffff0000u); w[q] = cvtpk(x0 * cs[q] - x1 * sn[q], x0 * sn[q] + x1 * cs[q]); } }
      *reinterpret_cast<u32x4*>(qx + (d0 - QREG) * 1024) = w; }
  }
  const int sr = tid >> 4, sc = (tid & 15) * 8, vst0 = v_st(sr, sc), vst1 = v_st(32 + sr, sc);
  const int xr = tid >> 3, xc = (tid & 7) * 8;
  const int vb0 = (int)(uintptr_t)V_lds + v_rd_base(lane);
  struct { bf16x8 vs0, vs1, ks0, ks1, kx; } sr_[SDEPTH];
#define LD8(p) (*reinterpret_cast<const bf16x8*>(p))
#define SLOAD(i, k0) do { sr_[i].vs0 = LD8(&Vh[(long)((k0) + sr) * ldv + sc]); sr_[i].vs1 = LD8(&Vh[(long)((k0) + 32 + sr) * ldv + sc]); \
    sr_[i].ks0 = LD8(&Kh[(long)((k0) + sr) * ldk + sc]); sr_[i].ks1 = LD8(&Kh[(long)((k0) + 32 + sr) * ldk + sc]); \
    if constexpr (X) sr_[i].kx = LD8(&Kr[(long)((k0) + xr) * ldkr + xc]); } while (0)
#define SWRITE(b, i) do { *(bf16x8*)(V_lds + (b) * SHM_V + vst0) = sr_[i].vs0;          \
    *(bf16x8*)(V_lds + (b) * SHM_V + vst1) = sr_[i].vs1; int kc = sc * 2;               \
    *(bf16x8*)(K_lds + (b) * SHM_K + KSWZ(sr, kc)) = sr_[i].ks0;                       \
    *(bf16x8*)(K_lds + (b) * SHM_K + KSWZ(32 + sr, kc)) = sr_[i].ks1;                  \
    if constexpr (X) { int kx_ = 256 + xc * 2; *(bf16x8*)(K_lds + (b) * SHM_K + KSWZ(xr, kx_)) = sr_[i].kx; } } while (0)
#define SWAIT() do { if constexpr (SDEPTH == 2) { if constexpr (X) asm volatile("s_waitcnt vmcnt(5)" ::: "memory"); else asm volatile("s_waitcnt vmcnt(4)" ::: "memory"); } else asm volatile("s_waitcnt vmcnt(0)" ::: "memory"); } while (0)
#define RESC(a) do { if (__any((a) < 1.f)) { if (hi == 0) al_l[r32] = (a); asm volatile("s_waitcnt lgkmcnt(0)" ::: "memory"); \
    _Pragma("unroll") for (int d = 0; d < 4; ++d) _Pragma("unroll") for (int r = 0; r < 16; ++r) o[d][r] *= al_l[crow(r, hi)]; } } while (0)
  f32x16 pA0, pA1, pB0, pB1; float mnA, mnB, alA, alB; bf16x8 pa0, pa1, pa2, pa3; const int NT = seq / KVBLK;
  constexpr int SE = 0, SO = SDEPTH - 1;
  SLOAD(SE, 0); asm volatile("s_waitcnt vmcnt(0)" ::: "memory"); SWRITE(0, SE); __syncthreads();
  qkt<DQK, QREG>(pA0, pA1, K_lds, qr, qx, r32, hi); partialSM<DQK>(pA0, pA1, m_reg, mnA, alA);
  SLOAD(SO, KVBLK); if constexpr (SDEPTH == 2) { if (2 < NT) SLOAD(SE, 2 * KVBLK); }
  SWAIT(); SWRITE(1, SO); __syncthreads();
  for (int j = 1; j + 1 < NT; j += 2) {
    SBAR(); qkt<DQK, QREG>(pB0, pB1, K_lds + SHM_K, qr, qx, r32, hi);
    finishSM(pA0, pA1, alA, l_reg, pa0, pa1, pa2, pa3); SBAR();
    SLOAD(SO, (j + SDEPTH) * KVBLK); SBAR();
    pv_d0(o, vb0, pa0, pa1, pa2, pa3); partialSM<DQK>(pB0, pB1, m_reg, mnB, alB);
    __syncthreads(); SWAIT(); SWRITE(0, SE);
    RESC(alB); __syncthreads();
    SBAR(); qkt<DQK, QREG>(pA0, pA1, K_lds, qr, qx, r32, hi);
    finishSM(pB0, pB1, alB, l_reg, pa0, pa1, pa2, pa3); SBAR();
    if (SDEPTH == 1 || j + 3 < NT) SLOAD(SE, (j + 1 + SDEPTH) * KVBLK); SBAR();
    pv_d0(o, vb0 + (int)SHM_V, pa0, pa1, pa2, pa3); partialSM<DQK>(pA0, pA1, m_reg, mnA, alA);
    __syncthreads(); SWAIT(); SWRITE(1, SO);
    RESC(alA); __syncthreads();
  }
  SBAR(); qkt<DQK, QREG>(pB0, pB1, K_lds + SHM_K, qr, qx, r32, hi);
  finishSM(pA0, pA1, alA, l_reg, pa0, pa1, pa2, pa3); SBAR();
  pv_d0(o, vb0, pa0, pa1, pa2, pa3); partialSM<DQK>(pB0, pB1, m_reg, mnB, alB);
  __syncthreads(); RESC(alB);
  finishSM(pB0, pB1, alB, l_reg, pa0, pa1, pa2, pa3); SBAR();
  pv_d0(o, vb0 + (int)SHM_V, pa0, pa1, pa2, pa3);
  if (hi == 0) li_l[r32] = l_reg; asm volatile("s_waitcnt lgkmcnt(0)" ::: "memory");
  float rli[16];
#pragma unroll
  for (int r = 0; r < 16; ++r) rli[r] = __builtin_amdgcn_rcpf(li_l[crow(r, hi)]);
  unsigned char* Ow = Ob + (long)(wid * QBLK) * ldo;
#pragma unroll
  for (int r = 0; r < 16; ++r) { int orow = crow(r, hi);
#pragma unroll
    for (int d0 = 0; d0 < 4; ++d0) { const float ov = __builtin_fminf(__builtin_fmaxf(o[d0][r] * rli[r] * AO_SCALE, -448.f), 448.f); Ow[(long)orow * ldo + d0 * 32 + r32] = (unsigned char)(__builtin_amdgcn_cvt_pk_fp8_f32(ov, 0.f, 0, false) & 0xff); } }
#undef LD8
#undef SLOAD
#undef SWRITE
#undef SWAIT
#undef RESC
}
#undef KSWZ
}
#ifndef A2_RS_GQA
#define A2_RS_GQA 0
#endif
#ifndef A2_SPREAD
#define A2_SPREAD 0
#endif
#ifndef A2_SHADOW_GQA
#define A2_SHADOW_GQA 0
#endif
#ifndef A2_SHADOW_MLA
#define A2_SHADOW_MLA 0
#endif
#ifndef A2_KSWZ4
#define A2_KSWZ4 1
#endif
#ifndef A2_OST
#define A2_OST 0
#endif
#ifndef A2_PKSM
#define A2_PKSM 0
#endif
#ifndef A2_BUF
#define A2_BUF 1
#endif
#ifndef A2_RS_MLA
#define A2_RS_MLA 0
#endif
namespace att2 {
#if defined(PROBE_SEL) && PROBE_SEL >= 50 && PROBE_SEL <= 59
#define A2_T(n) do { if (wid == 0) { const unsigned long long t_ = __builtin_amdgcn_s_memrealtime(); if ((n) == PROBE_SEL - 49) pacc += t_ - a2_t; a2_t = t_; } } while (0)
#define A2_TDECL unsigned long long a2_t = 0ull;
#if PROBE_SEL == 54
#define A2_TQ() do { __builtin_amdgcn_sched_barrier(0); if (wid == 0) { pacc += __builtin_amdgcn_s_memrealtime() - a2_t; } } while (0)
#else
#define A2_TQ() do { } while (0)
#endif
#if PROBE_SEL >= 56
#define A2_TX(n) A2_T(n)
#define A2_T3() A2_T(9)
#else
#define A2_TX(n) do { } while (0)
#define A2_T3() A2_T(3)
#endif
#else
#define A2_TX(n) do { } while (0)
#define A2_T3() do { } while (0)
#define A2_TQ() do { } while (0)
#define A2_T(n) do { } while (0)
#define A2_TDECL
#endif
using att::Cfg; using att::crow; using att::cvtpk; using att::v_rd_base; using att::pv_d0;
typedef LAS char LASc; typedef LAS bf16x8 LASv;
constexpr int NW = 8, QBLK = 32, KVBLK = 64;
constexpr float THR = 8.f;
#define KSWZ2(row, colB) ((row) * ROWB + ((colB) ^ (((row) & 7) << 4)))
#define A2_BAR() do { asm volatile("" ::: "memory"); __builtin_amdgcn_sched_barrier(0); __builtin_amdgcn_s_barrier(); __builtin_amdgcn_sched_barrier(0); asm volatile("" ::: "memory"); } while (0)

template <int DQK>
__device__ __forceinline__ void qk_tile(f32x16& p0, f32x16& p1, const LASc* Ks, const bf16x8* qr, int r32, int hi) {
  constexpr int ROWB = Cfg<DQK>::ROWB;
  const int kb = (int)(unsigned)(size_t)Ks + r32 * ROWB, s3 = (r32 & 7) << 4, s4 = A2_KSWZ4 ? (r32 & 15) << 4 : s3, hi16 = hi * 16;
  bf16x8 kl[3], kh[3], qf[3];
  att::qk_issue<DQK, DQK / 16, 0>(kl, kh, qf, kb, s4, s3, hi16, 0); att::qk_issue<DQK, DQK / 16, 1>(kl, kh, qf, kb, s4, s3, hi16, 0); att::qk_issue<DQK, DQK / 16, 2>(kl, kh, qf, kb, s4, s3, hi16, 0);
  att::qk_steps<DQK, DQK / 16, 0>(p0, p1, kl, kh, qf, qr, kb, s4, s3, hi16, 0);
}
template <int DQK, class HOOK>
__device__ __forceinline__ void softmax_tile(f32x16& p0, f32x16& p1, float& m_reg, float& l_reg, float& alpha, bf16x8& pa0, bf16x8& pa1, bf16x8& pa2, bf16x8& pa3, HOOK&& hook) {
  constexpr float C = Cfg<DQK>::C, SCALE = Cfg<DQK>::SCALE;
  float pmax = p0[0];
#pragma unroll
  for (int r = 1; r < 16; ++r) pmax = fmaxf(pmax, p0[r]);
#pragma unroll
  for (int r = 0; r < 16; ++r) pmax = fmaxf(pmax, p1[r]);
  { auto rr = __builtin_amdgcn_permlane32_swap(__float_as_uint(pmax), __float_as_uint(pmax), false, false);
    pmax = fmaxf(__uint_as_float(rr[0]), __uint_as_float(rr[1])); }
  float mn;
  if (__builtin_expect(__all(pmax - m_reg <= THR / SCALE), 1)) { mn = m_reg; alpha = 1.f; }
  else { mn = fmaxf(m_reg, pmax); alpha = __builtin_amdgcn_exp2f((m_reg - mn) * C); m_reg = mn; }
  const float mnC = -mn * C;
#if A2_PKSM
  const f32x2 Cv = {C, C}, Mv = {mnC, mnC}; f32x2 ps2 = {0.f, 0.f};
#pragma unroll
  for (int r = 0; r < 16; r += 2) { f32x2 t = {p0[r], p0[r + 1]}; t = __builtin_elementwise_fma(t, Cv, Mv); p0[r] = __builtin_amdgcn_exp2f(t[0]); p0[r + 1] = __builtin_amdgcn_exp2f(t[1]); }
#pragma unroll
  for (int r = 0; r < 16; r += 2) { f32x2 t = {p1[r], p1[r + 1]}; t = __builtin_elementwise_fma(t, Cv, Mv); p1[r] = __builtin_amdgcn_exp2f(t[0]); p1[r + 1] = __builtin_amdgcn_exp2f(t[1]); }
#pragma unroll
  for (int r = 0; r < 16; r += 2) { const f32x2 t = {p0[r], p0[r + 1]}; ps2 += t; }
#pragma unroll
  for (int r = 0; r < 16; r += 2) { const f32x2 t = {p1[r], p1[r + 1]}; ps2 += t; }
  float ps = ps2[0] + ps2[1];
#else
  hook(0);
#pragma unroll
  for (int r = 0; r < 8; ++r) p0[r] = __builtin_amdgcn_exp2f(fmaf(p0[r], C, mnC));
  hook(1);
#pragma unroll
  for (int r = 8; r < 16; ++r) p0[r] = __builtin_amdgcn_exp2f(fmaf(p0[r], C, mnC));
  hook(2);
#pragma unroll
  for (int r = 0; r < 8; ++r) p1[r] = __builtin_amdgcn_exp2f(fmaf(p1[r], C, mnC));
  hook(3);
#pragma unroll
  for (int r = 8; r < 16; ++r) p1[r] = __builtin_amdgcn_exp2f(fmaf(p1[r], C, mnC));
  hook(4);
  float ps = 0;
#pragma unroll
  for (int r = 0; r < 16; ++r) ps += p0[r];
#pragma unroll
  for (int r = 0; r < 16; ++r) ps += p1[r];
#endif
  { auto rr = __builtin_amdgcn_permlane32_swap(__float_as_uint(ps), __float_as_uint(ps), false, false);
    ps = __uint_as_float(rr[0]) + __uint_as_float(rr[1]); }
  l_reg = l_reg * alpha + ps;
#define PK4(P, BASE, OUT) do { unsigned a0 = cvtpk(P[BASE + 0], P[BASE + 1]), a1 = cvtpk(P[BASE + 2], P[BASE + 3]);   \
    unsigned b0 = cvtpk(P[BASE + 4], P[BASE + 5]), b1 = cvtpk(P[BASE + 6], P[BASE + 7]);                              \
    auto r0 = __builtin_amdgcn_permlane32_swap(a0, b0, false, false); auto r1 = __builtin_amdgcn_permlane32_swap(a1, b1, false, false); \
    u32x4 w = {r0[0], r1[0], r0[1], r1[1]}; OUT = *reinterpret_cast<bf16x8*>(&w); } while (0)
  PK4(p0, 0, pa0); PK4(p0, 8, pa1); PK4(p1, 0, pa2); PK4(p1, 8, pa3);
#undef PK4
}

struct VFrag { s16x4 l0, h0, l1, h1, l2, h2, l3, h3; };
template <int D0> __device__ __forceinline__ void pv_reads(VFrag& f, int vb) {
  using att::tr_read; using att::v_rd_off;
  f.l0 = tr_read<v_rd_off(D0, 0, 0)>(vb); f.h0 = tr_read<v_rd_off(D0, 0, 1)>(vb); f.l1 = tr_read<v_rd_off(D0, 1, 0)>(vb); f.h1 = tr_read<v_rd_off(D0, 1, 1)>(vb);
  f.l2 = tr_read<v_rd_off(D0, 2, 0)>(vb); f.h2 = tr_read<v_rd_off(D0, 2, 1)>(vb); f.l3 = tr_read<v_rd_off(D0, 3, 0)>(vb); f.h3 = tr_read<v_rd_off(D0, 3, 1)>(vb);
}
__device__ __forceinline__ void pv_mma(f32x16& od, const VFrag& f, bf16x8 pa0, bf16x8 pa1, bf16x8 pa2, bf16x8 pa3) {
#define PK(L, H) (bf16x8){L[0], L[1], L[2], L[3], H[0], H[1], H[2], H[3]}
  od = __builtin_amdgcn_mfma_f32_32x32x16_bf16(pa0, PK(f.l0, f.h0), od, 0, 0, 0);
  od = __builtin_amdgcn_mfma_f32_32x32x16_bf16(pa1, PK(f.l1, f.h1), od, 0, 0, 0);
  od = __builtin_amdgcn_mfma_f32_32x32x16_bf16(pa2, PK(f.l2, f.h2), od, 0, 0, 0);
  od = __builtin_amdgcn_mfma_f32_32x32x16_bf16(pa3, PK(f.l3, f.h3), od, 0, 0, 0);
#undef PK
}
__device__ __forceinline__ void pv_pipe(f32x16* o, int vb, bf16x8 pa0, bf16x8 pa1, bf16x8 pa2, bf16x8 pa3) {
  VFrag fa, fb;
  pv_reads<0>(fa, vb); pv_reads<1>(fb, vb);
  asm volatile("s_waitcnt lgkmcnt(8)" ::: "memory"); __builtin_amdgcn_sched_barrier(0); pv_mma(o[0], fa, pa0, pa1, pa2, pa3); __builtin_amdgcn_sched_barrier(0);
  pv_reads<2>(fa, vb);
  asm volatile("s_waitcnt lgkmcnt(8)" ::: "memory"); __builtin_amdgcn_sched_barrier(0); pv_mma(o[1], fb, pa0, pa1, pa2, pa3); __builtin_amdgcn_sched_barrier(0);
  pv_reads<3>(fb, vb);
  asm volatile("s_waitcnt lgkmcnt(8)" ::: "memory"); __builtin_amdgcn_sched_barrier(0); pv_mma(o[2], fa, pa0, pa1, pa2, pa3); __builtin_amdgcn_sched_barrier(0);
  asm volatile("s_waitcnt lgkmcnt(0)" ::: "memory"); __builtin_amdgcn_sched_barrier(0); pv_mma(o[3], fb, pa0, pa1, pa2, pa3);
}

#if A2_NOSGB
#define A2_SGB4(nv) do { } while (0)
#else
#define A2_SGB4(nv) do { _Pragma("unroll") for (int g_ = 0; g_ < 4; ++g_) { __builtin_amdgcn_sched_group_barrier(0x008, 1, 0); __builtin_amdgcn_sched_group_barrier(0x002, (nv), 0); } } while (0)
#endif
#define A2_SGB4X() do { _Pragma("unroll") for (int g_ = 0; g_ < 4; ++g_) { __builtin_amdgcn_sched_group_barrier(0x008, 1, 0); __builtin_amdgcn_sched_group_barrier(0x002, 2, 0); __builtin_amdgcn_sched_group_barrier(0x400, 2, 0); } } while (0)
template <int DQK, bool PV>
__device__ __forceinline__ void pv_pipe_s1(f32x16* o, int vb, bf16x8 pa0, bf16x8 pa1, bf16x8 pa2, bf16x8 pa3, f32x16& p0, f32x16& p1, float& m_reg, float& alpha, float& mnC) {
  constexpr float C = Cfg<DQK>::C, SCALE = Cfg<DQK>::SCALE;
  VFrag fa, fb;
  if constexpr (PV) { pv_reads<0>(fa, vb); pv_reads<1>(fb, vb); asm volatile("s_waitcnt lgkmcnt(8)" ::: "memory"); }
  __builtin_amdgcn_sched_barrier(0);
  if constexpr (PV) pv_mma(o[0], fa, pa0, pa1, pa2, pa3);
  float ma = fmaxf(p0[0], p0[1]), mb = fmaxf(p1[0], p1[1]);
#pragma unroll
  for (int r = 2; r < 16; r += 2) { ma = fmaxf(fmaxf(ma, p0[r]), p0[r + 1]); mb = fmaxf(fmaxf(mb, p1[r]), p1[r + 1]); }
  if constexpr (PV) A2_SGB4(4);
  __builtin_amdgcn_sched_barrier(0);
  if constexpr (PV) { pv_reads<2>(fa, vb); asm volatile("s_waitcnt lgkmcnt(8)" ::: "memory"); }
  __builtin_amdgcn_sched_barrier(0);
  if constexpr (PV) pv_mma(o[1], fb, pa0, pa1, pa2, pa3);
  { float pmax = fmaxf(ma, mb);
    auto rr = __builtin_amdgcn_permlane32_swap(__float_as_uint(pmax), __float_as_uint(pmax), false, false);
    pmax = fmaxf(__uint_as_float(rr[0]), __uint_as_float(rr[1]));
    const bool keep = __all(pmax - m_reg <= THR / SCALE);
    const float mn = keep ? m_reg : fmaxf(m_reg, pmax);
    alpha = __builtin_amdgcn_exp2f((m_reg - mn) * C); m_reg = mn; mnC = -mn * C; }
  if constexpr (PV) A2_SGB4(3);
  __builtin_amdgcn_sched_barrier(0);
  if constexpr (PV) { pv_reads<3>(fb, vb); asm volatile("s_waitcnt lgkmcnt(8)" ::: "memory"); }
  __builtin_amdgcn_sched_barrier(0);
  if constexpr (PV) pv_mma(o[2], fa, pa0, pa1, pa2, pa3);
#pragma unroll
  for (int r = 0; r < 8; ++r) p0[r] = __builtin_amdgcn_exp2f(fmaf(p0[r], C, mnC));
  if constexpr (PV) A2_SGB4X();
  __builtin_amdgcn_sched_barrier(0);
  if constexpr (PV) asm volatile("s_waitcnt lgkmcnt(0)" ::: "memory");
  __builtin_amdgcn_sched_barrier(0);
  if constexpr (PV) pv_mma(o[3], fb, pa0, pa1, pa2, pa3);
#pragma unroll
  for (int r = 8; r < 16; ++r) p0[r] = __builtin_amdgcn_exp2f(fmaf(p0[r], C, mnC));
  if constexpr (PV) A2_SGB4X();
  __builtin_amdgcn_sched_barrier(0);
}
template <int DQK>
__device__ __forceinline__ void softmax_p2(f32x16& p0, f32x16& p1, float mnC, float alpha, float& l_reg, bf16x8& pa0, bf16x8& pa1, bf16x8& pa2, bf16x8& pa3) {
  constexpr float C = Cfg<DQK>::C;
#pragma unroll
  for (int r = 0; r < 16; ++r) p1[r] = __builtin_amdgcn_exp2f(fmaf(p1[r], C, mnC));
  float ps = 0;
#pragma unroll
  for (int r = 0; r < 16; ++r) ps += p0[r];
#pragma unroll
  for (int r = 0; r < 16; ++r) ps += p1[r];
  { auto rr = __builtin_amdgcn_permlane32_swap(__float_as_uint(ps), __float_as_uint(ps), false, false);
    ps = __uint_as_float(rr[0]) + __uint_as_float(rr[1]); }
  l_reg = l_reg * alpha + ps;
#define PK4(P, BASE, OUT) do { unsigned a0 = cvtpk(P[BASE + 0], P[BASE + 1]), a1 = cvtpk(P[BASE + 2], P[BASE + 3]);   \
    unsigned b0 = cvtpk(P[BASE + 4], P[BASE + 5]), b1 = cvtpk(P[BASE + 6], P[BASE + 7]);                              \
    auto r0 = __builtin_amdgcn_permlane32_swap(a0, b0, false, false); auto r1 = __builtin_amdgcn_permlane32_swap(a1, b1, false, false); \
    u32x4 w = {r0[0], r1[0], r0[1], r1[1]}; OUT = *reinterpret_cast<bf16x8*>(&w); } while (0)
  PK4(p0, 0, pa0); PK4(p0, 8, pa1); PK4(p1, 0, pa2); PK4(p1, 8, pa3);
#undef PK4
}

template <int DQK, int ldq, int ldk, int ldkr, int ldv, int ldo>
__device__ __forceinline__ void attn_body2(const bf16_t* __restrict__ Qb, const bf16_t* __restrict__ Kh, const bf16_t* __restrict__ Kr, const bf16_t* __restrict__ Vh,
                                           unsigned char* __restrict__ Ob, int seq, LAS unsigned char* lds, int qt0, const float* __restrict__ rt, const float* __restrict__ qg, unsigned long long& pacc) {
  constexpr int ROWB = Cfg<DQK>::ROWB, SHM_K = Cfg<DQK>::SHM_K, SHM_V = Cfg<DQK>::SHM_V, NKI = SHM_K / 8192, NVI = SHM_V / 8192, NDMA = NKI + NVI, NQ = DQK / 16;
  constexpr bool X = DQK == 192;
  constexpr bool A2_SHADOW_ = X ? (A2_SHADOW_MLA != 0) : (A2_SHADOW_GQA != 0);
  constexpr bool A2_REGSTAGE = X ? (A2_RS_MLA != 0) : (A2_RS_GQA != 0);
  constexpr int NSK = A2_REGSTAGE ? 3 : 4, NSV = A2_REGSTAGE ? 3 : (X ? 3 : 4);
  constexpr int NW_K = (NSK - 3) * NDMA, NW_V = (NSV - 3) * NDMA + NKI, NWAIT_M = NW_K < NW_V ? NW_K : NW_V, NWAIT_V = NWAIT_M + NDMA;
  static_assert(A2_REGSTAGE || (NSK >= 4 && NSV >= 3), "ring depths");
  static_assert(NSK == NSV || NSK == NSV + 1, "ring depths");
  constexpr int K_OFF = 0, V_OFF = NSK * SHM_K, WS_OFF = V_OFF + NSV * SHM_V;
  const int tid = opaque_v((int)threadIdx.x), wid = __builtin_amdgcn_readfirstlane(tid >> 6), lane = tid & 63, r32 = lane & 31, hi = lane >> 5, grp = wid >> 2;
  LAS float* ws = (LAS float*)(lds + WS_OFF) + wid * 64; LAS float* li_l = ws; LAS float* al_l = ws + 32;
  const char* srcK[NKI]; int stepK[NKI];
#pragma unroll
  for (int i = 0; i < NKI; ++i) { const int P = i * 8192 + wid * 1024 + lane * 16, row = P / ROWB, cbs = P - row * ROWB, cb = cbs ^ (((A2_KSWZ4 && cbs < 256) ? (row & 15) : (row & 7)) << 4);
    if (X && cb >= 256) { srcK[i] = (const char*)Kr + (size_t)row * (ldkr * 2) + (cb - 256); stepK[i] = KVBLK * ldkr * 2; }
    else { srcK[i] = (const char*)Kh + (size_t)row * (ldk * 2) + cb; stepK[i] = KVBLK * ldk * 2; } }
  const char* srcV[NVI];
#pragma unroll
  for (int i = 0; i < NVI; ++i) { const int P = i * 8192 + wid * 1024 + lane * 16, sub = P >> 9, kkh = sub >> 2, cblk = sub & 3, win = P & 511, kkl = win >> 6, cl = (win & 63) >> 1;
    const int kk = kkh * 8 + kkl, k = (kk & ~0xC) | ((kk & 4) << 1) | ((kk & 8) >> 1), c = cblk * 32 + cl;
    srcV[i] = (const char*)Vh + (size_t)k * (ldv * 2) + c * 2; }
#if A2_BUF
  unsigned long long b0_ = (unsigned long long)(size_t)Kh; { const unsigned long long v_ = (unsigned long long)(size_t)Vh, r_ = X ? (unsigned long long)(size_t)Kr : b0_; b0_ = b0_ < v_ ? b0_ : v_; b0_ = b0_ < r_ ? b0_ : r_; }
  const unsigned b0lo = __builtin_amdgcn_readfirstlane((unsigned)b0_), b0hi = __builtin_amdgcn_readfirstlane((unsigned)(b0_ >> 32));
  const char* B0 = (const char*)(size_t)(((unsigned long long)b0hi << 32) | b0lo);
  const __amdgpu_buffer_rsrc_t rsrc = __builtin_amdgcn_make_buffer_rsrc((void*)B0, 0, -1, 0x00020000);
  unsigned offK[NKI], offV[NVI];
#pragma unroll
  for (int i = 0; i < NKI; ++i) offK[i] = (unsigned)(srcK[i] - B0);
#pragma unroll
  for (int i = 0; i < NVI; ++i) offV[i] = (unsigned)(srcV[i] - B0);
#define A2_ISSUE_K(t, st) do { _Pragma("unroll") for (int _i = 0; _i < NKI; ++_i) \
    __builtin_amdgcn_raw_ptr_buffer_load_lds(rsrc, (LAS void*)(lds + K_OFF + (st) * SHM_K + _i * 8192 + wid * 1024), 16, (int)(offK[_i] + __umul24((unsigned)(t), (unsigned)stepK[_i])), 0, 0, 0); } while (0)
#define A2_ISSUE_V(t, st) do { _Pragma("unroll") for (int _i = 0; _i < NVI; ++_i) \
    __builtin_amdgcn_raw_ptr_buffer_load_lds(rsrc, (LAS void*)(lds + V_OFF + (st) * SHM_V + _i * 8192 + wid * 1024), 16, (int)offV[_i], (int)((t) * (KVBLK * ldv * 2)), 0, 0); } while (0)
#else
#define A2_ISSUE_K(t, st) do { _Pragma("unroll") for (int _i = 0; _i < NKI; ++_i) \
    __builtin_amdgcn_global_load_lds((const unsigned*)(srcK[_i] + (size_t)(t) * stepK[_i]), (LAS unsigned*)(lds + K_OFF + (st) * SHM_K + _i * 8192 + wid * 1024), 16, 0, 0); } while (0)
#define A2_ISSUE_V(t, st) do { _Pragma("unroll") for (int _i = 0; _i < NVI; ++_i) \
    __builtin_amdgcn_global_load_lds((const unsigned*)(srcV[_i] + (size_t)(t) * (KVBLK * ldv * 2)), (LAS unsigned*)(lds + V_OFF + (st) * SHM_V + _i * 8192 + wid * 1024), 16, 0, 0); } while (0)
#endif
  u32x4 rgK[NKI], rgV[NVI];
#define A2_LOAD_K(t) do { _Pragma("unroll") for (int _i = 0; _i < NKI; ++_i) rgK[_i] = *(const u32x4*)(srcK[_i] + (size_t)(t) * stepK[_i]); } while (0)
#define A2_LOAD_V(t) do { _Pragma("unroll") for (int _i = 0; _i < NVI; ++_i) rgV[_i] = *(const u32x4*)(srcV[_i] + (size_t)(t) * (KVBLK * ldv * 2)); } while (0)
#define A2_WRITE_K(st) do { _Pragma("unroll") for (int _i = 0; _i < NKI; ++_i) *(LAS u32x4*)(lds + K_OFF + (st) * SHM_K + _i * 8192 + wid * 1024 + lane * 16) = rgK[_i]; } while (0)
#define A2_WRITE_V(st) do { _Pragma("unroll") for (int _i = 0; _i < NVI; ++_i) *(LAS u32x4*)(lds + V_OFF + (st) * SHM_V + _i * 8192 + wid * 1024 + lane * 16) = rgV[_i]; } while (0)
  const int NT = seq / KVBLK; A2_TDECL
  asm volatile("s_waitcnt vmcnt(0) lgkmcnt(0)" ::: "memory"); A2_BAR();
  if constexpr (A2_REGSTAGE) {
    A2_LOAD_K(0); A2_LOAD_V(0); A2_WRITE_K(0); A2_WRITE_V(0);
    A2_LOAD_K(NT > 1 ? 1 : 0); A2_WRITE_K(1);
    A2_LOAD_K(NT > 2 ? 2 : NT - 1); A2_LOAD_V(NT > 1 ? 1 : 0);
  } else {
#pragma unroll
  for (int t = 0; t < NSV - 2; ++t) A2_ISSUE_V(t < NT ? t : NT - 1, t);
#pragma unroll
  for (int t = 0; t < NSK - 1; ++t) A2_ISSUE_K(t < NT ? t : NT - 1, t);
  }
  float m_reg = -1e30f, l_reg = 0; f32x16 o[4] = {}; bf16x8 qr[NQ];
  const bf16_t* Qw = Qb + (long)(wid * QBLK + r32) * ldq + hi * 8;
#pragma unroll
  for (int d0 = 0; d0 < NQ; ++d0) qr[d0] = *reinterpret_cast<const bf16x8*>(Qw + d0 * 16);
  if constexpr (!X) {
    float ss = 0.f;
#pragma unroll
    for (int d0 = 0; d0 < 8; ++d0) { const u32x4 w = *reinterpret_cast<const u32x4*>(&qr[d0]);
#pragma unroll
      for (int q = 0; q < 4; ++q) { const float x0 = __uint_as_float(w[q] << 16), x1 = __uint_as_float(w[q] & 0xffff0000u); ss += x0 * x0 + x1 * x1; } }
    ss += __shfl_xor(ss, 32);
    const float rstd = 1.0f / sqrtf(ss * (1.0f / 128.0f) + 1e-6f);
    const int t = qt0 >= 0 ? qt0 + wid * QBLK + r32 : 0;
#pragma unroll
    for (int d0 = 0; d0 < 8; ++d0) { u32x4 w = *reinterpret_cast<const u32x4*>(&qr[d0]);
      const f32x4 g0 = *reinterpret_cast<const f32x4*>(qg + d0 * 16 + hi * 8), g1 = *reinterpret_cast<const f32x4*>(qg + d0 * 16 + hi * 8 + 4);
      const int pos = d0 < 4 ? (t >> 6) : (t & 63), ti = pos * 32 + (d0 & 3) * 8 + hi * 4; const f32x4 cs = *reinterpret_cast<const f32x4*>(rt + ti), sn = *reinterpret_cast<const f32x4*>(rt + 2048 + ti);
      const float gg[8] = {g0[0], g0[1], g0[2], g0[3], g1[0], g1[1], g1[2], g1[3]};
#pragma unroll
      for (int q = 0; q < 4; ++q) { const float x0 = __uint_as_float(w[q] << 16) * rstd * gg[2 * q], x1 = __uint_as_float(w[q] & 0xffff0000u) * rstd * gg[2 * q + 1]; w[q] = cvtpk(x0 * cs[q] - x1 * sn[q], x0 * sn[q] + x1 * cs[q]); }
      qr[d0] = *reinterpret_cast<const bf16x8*>(&w); }
  } else {
    { const int t = qt0 >= 0 ? qt0 + wid * QBLK + r32 : 0;
#pragma unroll
      for (int d0 = 8; d0 < 12; ++d0) { u32x4 w = *reinterpret_cast<const u32x4*>(&qr[d0]);
        const int j0 = (d0 - 8) * 8 + hi * 4, pos = d0 < 10 ? (t >> 6) : (t & 63), ti = pos * 16 + (j0 & 15);
        const f32x4 cs = *reinterpret_cast<const f32x4*>(rt + ti), sn = *reinterpret_cast<const f32x4*>(rt + 1024 + ti);
#pragma unroll
        for (int q = 0; q < 4; ++q) { const float x0 = __uint_as_float(w[q] << 16), x1 = __uint_as_float(w[q] & 0xffff0000u); w[q] = cvtpk(x0 * cs[q] - x1 * sn[q], x0 * sn[q] + x1 * cs[q]); }
        qr[d0] = *reinterpret_cast<const bf16x8*>(&w); } }
  }
  asm volatile("s_waitcnt vmcnt(0) lgkmcnt(0)" ::: "memory"); A2_BAR();
  if (grp == 1) A2_BAR();
  const int vb0 = (int)(unsigned)(size_t)(lds + V_OFF) + v_rd_base(lane);
  f32x16 s0, s1; bf16x8 pa0, pa1, pa2, pa3; float alpha, mnC_ = 0.f;
  if constexpr (A2_SHADOW_) { pa0 = (bf16x8){}; pa1 = pa0; pa2 = pa0; pa3 = pa0; }
  int kst = 0, kis = NSK - 1, vst = NSV - 1, vis = NSV - 2;
#pragma unroll 1
  for (int i = 0; i < NT; ++i) {
    A2_T(0);
    __builtin_amdgcn_s_setprio(1);
    qk_tile<DQK>(s0, s1, (const LASc*)(lds + K_OFF + kst * SHM_K), qr, r32, hi);
    A2_TQ();
    if constexpr (A2_SHADOW_) { pv_pipe_s1<DQK, true>(o, vb0 + (i > 0 ? vst : 0) * SHM_V, pa0, pa1, pa2, pa3, s0, s1, m_reg, alpha, mnC_); }
    else { if (i > 0) pv_pipe(o, vb0 + vst * SHM_V, pa0, pa1, pa2, pa3); }
    __builtin_amdgcn_s_setprio(0);
    A2_T(1);
    if constexpr (!A2_REGSTAGE) asm volatile("s_waitcnt vmcnt(%0)" :: "n"(NWAIT_M) : "memory");
    A2_BAR();
    A2_T(2);
    const int tv_ = i + NSV - 2 < NT ? i + NSV - 2 : NT - 1, tk_ = i + NSK - 1 < NT ? i + NSK - 1 : NT - 1;
    if constexpr (A2_SHADOW_) softmax_p2<DQK>(s0, s1, mnC_, alpha, l_reg, pa0, pa1, pa2, pa3);
    else
    softmax_tile<DQK>(s0, s1, m_reg, l_reg, alpha, pa0, pa1, pa2, pa3, [&](const int k) {
      if constexpr (!A2_REGSTAGE && A2_SPREAD) {
        __builtin_amdgcn_sched_barrier(0);
        if (k < NVI) __builtin_amdgcn_global_load_lds((const unsigned*)(srcV[k] + (size_t)tv_ * (KVBLK * ldv * 2)), (LAS unsigned*)(lds + V_OFF + vis * SHM_V + k * 8192 + wid * 1024), 16, 0, 0);
        else if (k - NVI < NKI) __builtin_amdgcn_global_load_lds((const unsigned*)(srcK[k - NVI] + (size_t)tk_ * stepK[k - NVI]), (LAS unsigned*)(lds + K_OFF + kis * SHM_K + (k - NVI) * 8192 + wid * 1024), 16, 0, 0);
        __builtin_amdgcn_sched_barrier(0);
      } });
    A2_TX(7);
    if (__any(alpha < 1.f)) { if (hi == 0) al_l[r32] = alpha; asm volatile("s_waitcnt lgkmcnt(0)" ::: "memory");
#pragma unroll
      for (int d = 0; d < 4; ++d)
#pragma unroll
        for (int r = 0; r < 16; ++r) o[d][r] *= al_l[crow(r, hi)]; }
    __builtin_amdgcn_sched_barrier(0);
    A2_TX(8);
    if constexpr (A2_REGSTAGE) {
      A2_WRITE_V(vis); A2_WRITE_K(kis);
      __builtin_amdgcn_sched_barrier(0);
      { const int tv = i + 2 < NT ? i + 2 : NT - 1, tk = i + 3 < NT ? i + 3 : NT - 1; A2_LOAD_V(tv); A2_LOAD_K(tk); }
      A2_T3();
      asm volatile("s_waitcnt lgkmcnt(0)" ::: "memory"); A2_BAR();
    } else {
    if constexpr (!A2_SPREAD) { A2_ISSUE_V(tv_, vis); A2_ISSUE_K(tk_, kis); }
    A2_T3();
    asm volatile("s_waitcnt vmcnt(%0)" :: "n"(NWAIT_V) : "memory"); A2_BAR();
    }
    A2_T(4);
    kst = kst == NSK - 1 ? 0 : kst + 1; kis = kis == NSK - 1 ? 0 : kis + 1; vst = vst == NSV - 1 ? 0 : vst + 1; vis = vis == NSV - 1 ? 0 : vis + 1;
  }
  if (grp == 0) A2_BAR();
  pv_pipe(o, vb0 + vst * SHM_V, pa0, pa1, pa2, pa3);
  if (hi == 0) li_l[r32] = l_reg; asm volatile("s_waitcnt lgkmcnt(0)" ::: "memory");
  float rli[16];
#pragma unroll
  for (int r = 0; r < 16; ++r) rli[r] = __builtin_amdgcn_rcpf(li_l[crow(r, hi)]);
  unsigned char* Ow = Ob + (long)(wid * QBLK) * ldo;
#if A2_OST
  { const int kfree = kst == 0 ? NSK - 1 : kst - 1, vfree = vst == 0 ? NSV - 1 : vst - 1;
    LAS unsigned char* stg = grp == 0 ? lds + K_OFF + kfree * SHM_K + wid * 4096 : lds + V_OFF + vfree * SHM_V + (wid - 4) * 4096;
#pragma unroll
    for (int r = 0; r < 16; ++r) { const int orow = crow(r, hi); float f[4];
#pragma unroll
      for (int d0 = 0; d0 < 4; ++d0) f[d0] = __builtin_fminf(__builtin_fmaxf(o[d0][r] * rli[r] * AO_SCALE, -448.f), 448.f);
      unsigned w = (unsigned)__builtin_amdgcn_cvt_pk_fp8_f32(f[0], f[1], 0, false); w = (unsigned)__builtin_amdgcn_cvt_pk_fp8_f32(f[2], f[3], (int)w, true);
      *(LAS unsigned*)(stg + orow * 128 + 4 * r32) = w; }
    asm volatile("s_waitcnt lgkmcnt(0)" ::: "memory");
#pragma unroll
    for (int k = 0; k < 4; ++k) { const int orow = (lane >> 3) + 8 * k; const u32x4 v = *(const LAS u32x4*)(stg + orow * 128 + (lane & 7) * 16); *(u32x4*)(Ow + (long)orow * ldo + (lane & 7) * 16) = v; }
  }
#else
#pragma unroll
  for (int r = 0; r < 16; ++r) { const int orow = crow(r, hi);
#pragma unroll
    for (int d0 = 0; d0 < 4; ++d0) { const float ov = __builtin_fminf(__builtin_fmaxf(o[d0][r] * rli[r] * AO_SCALE, -448.f), 448.f); Ow[(long)orow * ldo + d0 * 32 + r32] = (unsigned char)(__builtin_amdgcn_cvt_pk_fp8_f32(ov, 0.f, 0, false) & 0xff); } }
#endif
#undef A2_ISSUE_K
#undef A2_ISSUE_V
#undef A2_LOAD_K
#undef A2_LOAD_V
#undef A2_WRITE_K
#undef A2_WRITE_V
}
#undef KSWZ2
#undef A2_BAR
}
#ifndef TOPK_DYN
#define TOPK_DYN 1
#endif
#ifndef AO_PERM
#define AO_PERM (ATT_V2 && A2_OST)
#endif
#ifndef PERM_OY
#define PERM_OY 1
#endif
#ifndef PERM_HK
#define PERM_HK 1
#endif
#ifndef LN2_LDSV
#define LN2_LDSV 1
#endif
#ifndef LN2_SKIP
#define LN2_SKIP 1
#endif
#ifndef LN2_NEB
#define LN2_NEB 2
#endif
#ifndef LN_RECOMP
#define LN_RECOMP 1
#endif
struct Frame {
    LAS unsigned char* lds;
    int tid, lane, wave, vcu, G, gw, ngw;
    float* out;
    unsigned char* ws;
};
enum { I_X = 0, I_C, I_CTX, I_CCTX, I_ADAW, I_ADAB, I_LMG, I_LMB, I_LFG, I_LFB, I_RW, I_WG, I_WU, I_WDN, I_GQKV, I_GQG, I_GKG, I_GWO, I_MDQ, I_MQG, I_MUQ, I_MDKV, I_MKVG, I_MUKV, I_MWO };

__device__ __forceinline__ u32x2 pack4(const f32x4 v) { u32x2 w; w.x = cvt_pk_bf16(v[0], v[1]); w.y = cvt_pk_bf16(v[2], v[3]); return w; }
__device__ __forceinline__ f32x4 unpack4(const u32x2 w) { return (f32x4){__uint_as_float(w.x << 16), __uint_as_float(w.x & 0xffff0000u), __uint_as_float(w.y << 16), __uint_as_float(w.y & 0xffff0000u)}; }
__device__ __forceinline__ float silu_f(float x) { return x / (1.0f + __expf(-x)); }

__device__ __forceinline__ void transpose_item(const float* W, int N, const float* g, bf16_t* dst, int ldd, int row_off, int il, LAS float* scr, int item, int lane) {
    const int nblk = N / 32, kb = item / nblk, nb = item % nblk, k0 = 64 * kb, n0 = 32 * nb;
#pragma unroll 8
    for (int i = 0; i < 32; ++i) { const int kk = 2 * i + (lane >> 5); float v = __builtin_nontemporal_load(&W[(size_t)(k0 + kk) * N + n0 + (lane & 31)]); if (g) v *= g[k0 + kk]; scr[kk * 33 + (lane & 31)] = v; }
    LDS_WAIT(); asm volatile("" ::: "memory");
    const int c = lane & 7;
#pragma unroll
    for (int j = 0; j < 4; ++j) { const int n = (lane >> 3) + 8 * j; const LAS float* s = scr + (8 * c) * 33 + n;
        u32x4 o; o.x = cvt_pk_bf16(s[0 * 33], s[1 * 33]); o.y = cvt_pk_bf16(s[2 * 33], s[3 * 33]); o.z = cvt_pk_bf16(s[4 * 33], s[5 * 33]); o.w = cvt_pk_bf16(s[6 * 33], s[7 * 33]);
        const int nn = n0 + n, dr = row_off + (il ? ((nn >> 7) << 8) + (nn & 127) : nn);
        *(u32x4*)(dst + (size_t)dr * ldd + k0 + 8 * c) = o; }
    LDS_WAIT(); asm volatile("" ::: "memory");
}

__device__ __forceinline__ int perm_hk(int c) { const int ch = c >> 2, e = c & 3, L = ch & 63, j = ch >> 6; return 16 * L + 4 * j + e; }
__device__ __forceinline__ int perm_oy(int c) { const int ch = c >> 2, e = c & 3, L = ch & 63, j = ch >> 6; return 8 * (L + 64 * (j >> 1)) + 4 * (j & 1) + e; }
__device__ __forceinline__ void transpose_item_fp8(const float* W, int N, float scale, unsigned char* dst, int ldd, int row_off, int il, LAS float* scr, int item, int lane, const float* g = nullptr, int kp = 0) {
    const int nblk = N / 32, kb = item / nblk, nb = item % nblk, k0 = 64 * kb, n0 = 32 * nb;
    { f32x4 wv[8];
#pragma unroll
      for (int i = 0; i < 8; ++i) { const int kk = 8 * i + (lane >> 3), ks = kp == 1 ? 4 * (4 * kb + (kk >> 4)) + (kk & 3) + 256 * ((kk >> 2) & 3) : kp == 2 ? ((k0 + kk) & ~127) + 32 * (kk & 3) + (((k0 + kk) & 127) >> 2) : k0 + kk;      wv[i] = __builtin_nontemporal_load((const f32x4*)&W[(size_t)ks * N + n0 + 4 * (lane & 7)]); }
#pragma unroll
      for (int i = 0; i < 8; ++i) { const int kk = 8 * i + (lane >> 3); float sc = scale; if (g) sc *= g[k0 + kk]; LAS float* d = scr + kk * 33 + 4 * (lane & 7);
        d[0] = wv[i][0] * sc; d[1] = wv[i][1] * sc; d[2] = wv[i][2] * sc; d[3] = wv[i][3] * sc; } }
    LDS_WAIT(); asm volatile("" ::: "memory");
    const int n = lane >> 1, kh = (lane & 1) * 32; const LAS float* s = scr + kh * 33 + n;
    u32x4 o0, o1;
#pragma unroll
    for (int q = 0; q < 4; ++q) { o0[q] = cvt4_fp8(s[(4 * q + 0) * 33], s[(4 * q + 1) * 33], s[(4 * q + 2) * 33], s[(4 * q + 3) * 33]); o1[q] = cvt4_fp8(s[(16 + 4 * q + 0) * 33], s[(16 + 4 * q + 1) * 33], s[(16 + 4 * q + 2) * 33], s[(16 + 4 * q + 3) * 33]); }
    const int nn = n0 + n, dr = row_off + (il == 3 ? perm_hk(nn) : il == 2 ? perm_oy(nn) : il ? ((nn >> 7) << 8) + (nn & 127) : nn);
    u32x4* dp = (u32x4*)(dst + (size_t)dr * ldd + k0 + kh); dp[0] = o0; dp[1] = o1;
    LDS_WAIT(); asm volatile("" ::: "memory");
}

__device__ __forceinline__ void phase_p0a(Frame& F) {
    LAS float* scr = (LAS float*)(F.lds + F.wave * 9216);
    constexpr int I_QKV = 16 * 48, I_WO = 16 * 32, I_DQ = 16 * 24, I_DKV = 16 * 10, I_UQ = 12 * 48, I_UKV = 4 * 64;
    constexpr int PERJ = I_QKV + I_WO + I_DQ + I_DKV + I_UQ + I_UKV + I_WO;
    for (int it = F.gw; it < 2 * PERJ; it += F.ngw) {
        const int j = it / PERJ; int r = it - j * PERJ;
        if (r < I_QKV) { transpose_item_fp8(in_ptr(I_GQKV) + (size_t)j * 1024 * 1536, 1536, WP_SCALE, (unsigned char*)(F.ws + WS_WQKV) + (size_t)j * 1536 * 1024, 1024, 0, 0, scr, r, F.lane, nullptr, PERM_HK ? 1 : 0); continue; } r -= I_QKV;
        if (r < I_WO) { transpose_item_fp8(in_ptr(I_GWO) + (size_t)j * 1024 * 1024, 1024, WO_SCALE, (unsigned char*)(F.ws + WS_WOG) + (size_t)j * 1024 * 1024, 1024, 0, O8F ? 3 : PERM_OY ? 2 : 0, scr, r, F.lane, nullptr, AO_PERM ? 2 : 0); continue; } r -= I_WO;
        if (r < I_DQ) { transpose_item_fp8(in_ptr(I_MDQ) + (size_t)j * 1024 * 768, 768, WP_SCALE, (unsigned char*)(F.ws + WS_WD) + (size_t)j * 1280 * 1024, 1024, 0, 0, scr, r, F.lane, nullptr, PERM_HK ? 1 : 0); continue; } r -= I_DQ;
        if (r < I_DKV) { transpose_item_fp8(in_ptr(I_MDKV) + (size_t)j * 1024 * 320, 320, WP_SCALE, (unsigned char*)(F.ws + WS_WD) + (size_t)j * 1280 * 1024, 1024, 768, 0, scr, r, F.lane, nullptr, PERM_HK ? 1 : 0); continue; } r -= I_DKV;
        if (r < I_UQ) { transpose_item_fp8(in_ptr(I_MUQ) + (size_t)j * 768 * 1536, 1536, WP_SCALE, (unsigned char*)(F.ws + WS_WUQ) + (size_t)j * 1536 * 768, 768, 0, 0, scr, r, F.lane, in_ptr(I_MQG) + j * 768); continue; } r -= I_UQ;
        if (r < I_UKV) { transpose_item(in_ptr(I_MUKV) + (size_t)j * 256 * 2048, 2048, in_ptr(I_MKVG) + j * 256, (bf16_t*)(F.ws + WS_WUKV) + (size_t)j * 2048 * 256, 256, 0, 0, scr, r, F.lane); continue; } r -= I_UKV;
        transpose_item_fp8(in_ptr(I_MWO) + (size_t)j * 1024 * 1024, 1024, WO_SCALE, (unsigned char*)(F.ws + WS_WOM) + (size_t)j * 1024 * 1024, 1024, 0, O8F ? 3 : PERM_OY ? 2 : 0, scr, r, F.lane, nullptr, AO_PERM ? 2 : 0);
    }
    for (int i = blockIdx.x * NTHR + F.tid; i < 2 * 12288; i += F.G * NTHR) { const int j = i / 12288, q = i - j * 12288;
        *((u32x4*)((unsigned char*)(F.ws + WS_WD) + (size_t)j * 1280 * 1024 + (size_t)1088 * 1024) + q) = (u32x4){0u, 0u, 0u, 0u}; }
    { int* idn = (int*)(F.ws + WS_GVAL); for (int i = blockIdx.x * NTHR + F.tid; i < NSLOT; i += F.G * NTHR) idn[i] = i; }
    { float* rwt = (float*)(F.ws + WS_RWT); const float* rw = in_ptr(I_RW); for (int i = blockIdx.x * NTHR + F.tid; i < NL * NE * D; i += F.G * NTHR) { const int li = i >> 14, e = (i >> 10) & 15, k = i & 1023; rwt[i] = rw[((size_t)li * D + k) * NE + e]; } }
    { float* rt = (float*)(F.ws + WS_ROPE); const int i = blockIdx.x * NTHR + F.tid;
        if (i < 2048) { const int pos = i >> 5, m = i & 31; const float fr = powf(10000.0f, -(float)(2 * m) / 64.0f), a = (float)pos * fr; rt[i] = cosf(a); rt[2048 + i] = sinf(a); }
        else if (i < 3072) { const int q = i - 2048, pos = q >> 4, m = q & 15; const float fr = powf(10000.0f, -(float)(2 * m) / 32.0f), a = (float)pos * fr; rt[4096 + q] = cosf(a); rt[5120 + q] = sinf(a); } }
    { float* modp = (float*)(F.ws + WS_R + R_MODP); LAS float* s = (LAS float*)(F.lds + F.wave * 9216);
        for (int it = F.gw; it < NL * 96 * MOD_KC; it += F.ngw) {
            const int kc = it % MOD_KC, cg = (it / MOD_KC) % 96, li = it / (MOD_KC * 96);
            for (int q = F.lane; q < 33 * 64; q += 64) { const int b = q >> 6, kk = q & 63; const float cv = b < 32 ? in_ptr(I_C)[b * D + kc * 64 + kk] : in_ptr(I_CCTX)[kc * 64 + kk]; s[kk * 36 + b] = silu_f(cv); }
            LDS_WAIT(); asm volatile("" ::: "memory");
            float acc[33];
#pragma unroll
            for (int b = 0; b < 33; ++b) acc[b] = 0.f;
            const float* wp = in_ptr(I_ADAW) + ((size_t)li * D + kc * 64) * MODSZ + cg * 64 + F.lane;
#pragma unroll 1
            for (int k8 = 0; k8 < 64; k8 += 16) { float wv[16];
#pragma unroll
                for (int q = 0; q < 16; ++q) wv[q] = __builtin_nontemporal_load(&wp[(size_t)(k8 + q) * MODSZ]);
#pragma unroll
                for (int q = 0; q < 16; ++q) { const int kk = k8 + q; const float w = wv[q];
#pragma unroll
                    for (int b4 = 0; b4 < 8; ++b4) { const f32x4 sv = *(const LAS f32x4*)(s + kk * 36 + b4 * 4); acc[b4 * 4 + 0] += sv[0] * w; acc[b4 * 4 + 1] += sv[1] * w; acc[b4 * 4 + 2] += sv[2] * w; acc[b4 * 4 + 3] += sv[3] * w; }
                    acc[32] += s[kk * 36 + 32] * w; } }
            float* op = modp + ((size_t)(kc * NL + li) * 33) * MODSZ + cg * 64 + F.lane;
#pragma unroll
            for (int b = 0; b < 33; ++b) op[(size_t)b * MODSZ] = acc[b];
            LDS_WAIT(); asm volatile("" ::: "memory");
        } }
}
__device__ __forceinline__ void phase_p0b(Frame& F) {
    const float* modp = (const float*)(F.ws + WS_R + R_MODP); float* mod = (float*)(F.ws + WS_MOD);
    for (int i = blockIdx.x * NTHR + F.tid; i < NL * 33 * MODSZ; i += F.G * NTHR) { const int n = i % MODSZ, li = i / (33 * MODSZ); float a = in_ptr(I_ADAB)[li * MODSZ + n];
#pragma unroll
        for (int kc = 0; kc < MOD_KC; ++kc) a += modp[(size_t)kc * NL * 33 * MODSZ + i];
        mod[i] = a; }
}
__device__ __forceinline__ const float* xrow_in(const float* xl, const float* xc, int b, int p) { return p < CTXL ? xc + ((size_t)b * CTXL + p) * D : xl + ((size_t)b * SEQ + (p - CTXL)) * D; }

__device__ __forceinline__ void phase_p0c(Frame& F) {
    const float* mod = (const float*)(F.ws + WS_MOD); unsigned char* H8 = (unsigned char*)(F.ws + WS_H);
    for (int r2 = F.gw * 2; r2 < T; r2 += F.ngw * 2) {
        f32x4 xa[2][4];
#pragma unroll
        for (int i = 0; i < 2; ++i) { const int r = r2 + i, b = r / TPS, p = r - b * TPS; const f32x4* xr = (const f32x4*)xrow_in(in_ptr(I_X), in_ptr(I_CTX), b, p) + F.lane;
#pragma unroll
            for (int j = 0; j < 4; ++j) xa[i][j] = __builtin_nontemporal_load(&xr[64 * j]); }
#pragma unroll
        for (int i = 0; i < 2; ++i) { const int r = r2 + i, b = r / TPS, p = r - b * TPS; const float* mv = mod + (size_t)(p < CTXL ? 32 : b) * MODSZ; unsigned* hr = (unsigned*)(H8 + (size_t)r * D) + F.lane; u32x4 hw;
#pragma unroll
            for (int j = 0; j < 4; ++j) { const f32x4 sh = *((const f32x4*)mv + F.lane + 64 * j), sc = *((const f32x4*)(mv + D) + F.lane + 64 * j); const f32x4 hv = xa[i][j] * (1.0f + sc) + sh; hw[j] = cvt4_fp8(hv[0], hv[1], hv[2], hv[3]); if (!PERM_HK) hr[64 * j] = hw[j]; }
            if (PERM_HK) *((u32x4*)(H8 + (size_t)r * D) + F.lane) = hw; } }
}

__device__ __forceinline__ void phase_qknorm(Frame& F, int j, bf16_t* dry) {
    bf16_t* QKV = (bf16_t*)(F.ws + WS_R + R_QKV); const ptrdiff_t dofs = dry ? dry - QKV : 0; const float* rt = (const float*)(F.ws + WS_ROPE);
    const float* kg = in_ptr(I_GKG) + j * 128;
    const int l16 = F.lane & 15, hd = (F.lane >> 4) & 1, rsel = F.lane >> 5;
    const f32x4 gk0 = *(const f32x4*)(kg + l16 * 8), gk1 = *(const f32x4*)(kg + l16 * 8 + 4);
    constexpr int KB = 3;
    for (int r2 = F.gw; r2 < T / 2; r2 += KB * F.ngw) {
        u32x4 w[KB]; f32x4 cs[KB], sn[KB]; u32x4* ptr[KB]; bool ok[KB];
#pragma unroll
        for (int u = 0; u < KB; ++u) { const int rr = r2 + u * F.ngw; ok[u] = rr < T / 2; const int r = 2 * (ok[u] ? rr : r2) + rsel; const int b = r / TPS, p = r - b * TPS; const int t = p >= CTXL ? p - CTXL : 0, trow = t >> 6, tcol = t & 63;
            const int j0 = l16 * 4, pos = j0 < 32 ? trow : tcol, ti = pos * 32 + (j0 & 31);
            cs[u] = *(const f32x4*)(rt + ti); sn[u] = *(const f32x4*)(rt + 2048 + ti);
            ptr[u] = (u32x4*)(QKV + (size_t)r * 1536 + 1024 + hd * 128 + l16 * 8); w[u] = *ptr[u]; }
#pragma unroll
        for (int u = 0; u < KB; ++u) {
            f32x4 a = {__uint_as_float(w[u].x << 16), __uint_as_float(w[u].x & 0xffff0000u), __uint_as_float(w[u].y << 16), __uint_as_float(w[u].y & 0xffff0000u)};
            f32x4 c = {__uint_as_float(w[u].z << 16), __uint_as_float(w[u].z & 0xffff0000u), __uint_as_float(w[u].w << 16), __uint_as_float(w[u].w & 0xffff0000u)};
            float ss = (a[0] * a[0] + a[1] * a[1]) + (a[2] * a[2] + a[3] * a[3]) + (c[0] * c[0] + c[1] * c[1]) + (c[2] * c[2] + c[3] * c[3]);
            ss += __shfl_xor(ss, 1); ss += __shfl_xor(ss, 2); ss += __shfl_xor(ss, 4); ss += __shfl_xor(ss, 8);
            const float rstd = 1.0f / sqrtf(ss * (1.0f / 128.0f) + LN_EPS);
            a = a * rstd * gk0; c = c * rstd * gk1;
            const f32x4 a2 = {a[0] * cs[u][0] - a[1] * sn[u][0], a[0] * sn[u][0] + a[1] * cs[u][0], a[2] * cs[u][1] - a[3] * sn[u][1], a[2] * sn[u][1] + a[3] * cs[u][1]};
            const f32x4 c2 = {c[0] * cs[u][2] - c[1] * sn[u][2], c[0] * sn[u][2] + c[1] * cs[u][2], c[2] * cs[u][3] - c[3] * sn[u][3], c[2] * sn[u][3] + c[3] * cs[u][3]};
            u32x4 o; o.x = cvt_pk_bf16(a2[0], a2[1]); o.y = cvt_pk_bf16(a2[2], a2[3]); o.z = cvt_pk_bf16(c2[0], c2[1]); o.w = cvt_pk_bf16(c2[2], c2[3]);
            if (ok[u]) *(u32x4*)((bf16_t*)ptr[u] + dofs) = o; }
    }
}
__device__ __forceinline__ void phase_mla_stats(Frame& F, bf16_t* dry) {
    bf16_t* CQ = (bf16_t*)(F.ws + WS_R + R_CQ); unsigned char* CQ8 = (unsigned char*)(F.ws + WS_CQ8); bf16_t* KR = (bf16_t*)(F.ws + WS_KR); const ptrdiff_t dofs = dry ? dry - CQ : 0; const float* rt = (const float*)(F.ws + WS_ROPE) + 4096;
    for (int r4 = F.gw * 4; r4 < T; r4 += F.ngw * 4) {
        u32x4 w0a[4], w1a[4], wka[4];
#pragma unroll
        for (int i = 0; i < 4; ++i) { const bf16_t* row = CQ + (size_t)(r4 + i) * 1280; w0a[i] = *(const u32x4*)(row + F.lane * 8); w1a[i] = *(const u32x4*)(row + 512 + F.lane * 8); wka[i] = *(const u32x4*)(row + 1024 + (F.lane & 7) * 8); }
#pragma unroll
        for (int i = 0; i < 4; ++i) { const int r = r4 + i; const int b = r / TPS, p = r - b * TPS; const int t = p >= CTXL ? p - CTXL : 0, trow = t >> 6, tcol = t & 63;
        bf16_t* row = CQ + (size_t)r * 1280; const u32x4 w0 = w0a[i], w1 = w1a[i];
        float s0 = 0.f, s1 = 0.f;
#pragma unroll
        for (int q = 0; q < 4; ++q) { const float a = __uint_as_float(w0[q] << 16), c = __uint_as_float(w0[q] & 0xffff0000u); s0 += a * a + c * c; const float a1 = __uint_as_float(w1[q] << 16), c1 = __uint_as_float(w1[q] & 0xffff0000u); s1 += a1 * a1 + c1 * c1; }
        const float sq = wave_sum(s0 + (F.lane < 32 ? s1 : 0.f)), skv = wave_sum(F.lane >= 32 ? s1 : 0.f);
        const float rq = 1.0f / sqrtf(sq * (1.0f / 768.0f) + LN_EPS), rkv = 1.0f / sqrtf(skv * (1.0f / 256.0f) + LN_EPS);
        { unsigned char* c8 = CQ8 + (size_t)r * 768; u32x2 q0; q0.x = cvt4_fp8(__uint_as_float(w0[0] << 16) * rq, __uint_as_float(w0[0] & 0xffff0000u) * rq, __uint_as_float(w0[1] << 16) * rq, __uint_as_float(w0[1] & 0xffff0000u) * rq);
          q0.y = cvt4_fp8(__uint_as_float(w0[2] << 16) * rq, __uint_as_float(w0[2] & 0xffff0000u) * rq, __uint_as_float(w0[3] << 16) * rq, __uint_as_float(w0[3] & 0xffff0000u) * rq); *(u32x2*)(c8 + F.lane * 8) = q0;
          if (F.lane < 32) { u32x2 q1; q1.x = cvt4_fp8(__uint_as_float(w1[0] << 16) * rq, __uint_as_float(w1[0] & 0xffff0000u) * rq, __uint_as_float(w1[1] << 16) * rq, __uint_as_float(w1[1] & 0xffff0000u) * rq);
            q1.y = cvt4_fp8(__uint_as_float(w1[2] << 16) * rq, __uint_as_float(w1[2] & 0xffff0000u) * rq, __uint_as_float(w1[3] << 16) * rq, __uint_as_float(w1[3] & 0xffff0000u) * rq); *(u32x2*)(c8 + 512 + F.lane * 8) = q1; }
          else { u32x4 o1;
#pragma unroll
            for (int q = 0; q < 4; ++q) o1[q] = cvt_pk_bf16(__uint_as_float(w1[q] << 16) * rkv, __uint_as_float(w1[q] & 0xffff0000u) * rkv);
            *(u32x4*)(row + dofs + 512 + F.lane * 8) = o1; } }
        if (F.lane < 8) { const u32x4 w = wka[i]; u32x4 o = w;
            { const int j0 = F.lane * 4, pos = j0 < 16 ? trow : tcol, ti = pos * 16 + (j0 & 15); const f32x4 cs = *(const f32x4*)(rt + ti), sn = *(const f32x4*)(rt + 1024 + ti);
#pragma unroll
                for (int q = 0; q < 4; ++q) { const float x0 = __uint_as_float(w[q] << 16), x1 = __uint_as_float(w[q] & 0xffff0000u); o[q] = cvt_pk_bf16(x0 * cs[q] - x1 * sn[q], x0 * sn[q] + x1 * cs[q]); } }
            *(u32x4*)(KR + (size_t)r * 64 + F.lane * 8) = o; } } }
}

__device__ __forceinline__ float lane_xor32_sum(float a) { auto rr = __builtin_amdgcn_permlane32_swap(__float_as_uint(a), __float_as_uint(a), false, false); return __uint_as_float(rr[0]) + __uint_as_float(rr[1]); }
__device__ __forceinline__ float lane_xor32_max(float a) { auto rr = __builtin_amdgcn_permlane32_swap(__float_as_uint(a), __float_as_uint(a), false, false); return fmaxf(__uint_as_float(rr[0]), __uint_as_float(rr[1])); }
__device__ __forceinline__ float lane_xor4(float v) {
    const int a = __builtin_amdgcn_update_dpp(0, __builtin_bit_cast(int, v), 0x114, 0xf, 0xA, false);
    return __builtin_bit_cast(float, __builtin_amdgcn_update_dpp(a, __builtin_bit_cast(int, v), 0x104, 0xf, 0x5, false));
}
__device__ __forceinline__ void ln1_reduce16(float (&acc)[16], int lane, float& lg_e) {
#pragma unroll
    for (int e = 0; e < 8; ++e) { auto rr = __builtin_amdgcn_permlane32_swap(__float_as_uint(acc[e]), __float_as_uint(acc[e + 8]), false, false); acc[e] = __uint_as_float(rr[0]) + __uint_as_float(rr[1]); }
#pragma unroll
    for (int e = 0; e < 4; ++e) { const bool up = (lane & 16) != 0; const float send = up ? acc[e] : acc[e + 4], keep = up ? acc[e + 4] : acc[e]; acc[e] = keep + lane_xor16(send); }
#pragma unroll
    for (int e = 0; e < 2; ++e) { const bool up = (lane & 8) != 0; const float send = up ? acc[e] : acc[e + 2], keep = up ? acc[e + 2] : acc[e]; acc[e] = keep + DPP_MOV(send, 0x128); }
    { const bool up = (lane & 2) != 0; const float send = up ? acc[0] : acc[1], keep = up ? acc[1] : acc[0]; acc[0] = keep + DPP_MOV(send, 0x4E); }
    float v = acc[0]; v += DPP_MOV(v, 0xB1); v += lane_xor4(v); lg_e = v;
}
__device__ __forceinline__ void phase_ln1(Frame& F, int li, const float* xin_l, const float* xin_c, const bf16_t* O, float* xdry, bool skipctx) {
    LAS float* Wt = (LAS float*)F.lds;
    { const f32x4* rwt = (const f32x4*)((const float*)(F.ws + WS_RWT) + (size_t)li * NE * D); for (int i = F.tid; i < D * NE / 4; i += NTHR) *((LAS f32x4*)Wt + i) = rwt[i]; }
    __syncthreads();
    const float* mod = (const float*)(F.ws + WS_MOD) + (size_t)li * 33 * MODSZ; unsigned char* H8 = (unsigned char*)(F.ws + WS_H); float* AFF = (float*)(F.ws + WS_AFF); int* INV = (int*)(F.ws + WS_INV);
    f32x4 lg[4], lb[4], g1[4], sh2[4], sc2[4];
    { const float* pg = in_ptr(I_LMG) + li * D; const float* pb = in_ptr(I_LMB) + li * D;
#pragma unroll
      for (int j = 0; j < 4; ++j) { lg[j] = *((const f32x4*)pg + F.lane + 64 * j); lb[j] = *((const f32x4*)pb + F.lane + 64 * j); } }
#pragma unroll 1
    for (int rp_ = 0; rp_ < REP_LN1; ++rp_) { float* xd = rp_ + 1 < REP_LN1 ? xdry : nullptr; float* Xl = xd ? xd + (size_t)NB * CTXL * D : F.out; float* Xc = xd ? xd : (float*)(F.ws + WS_XC);
    for (int wv = F.gw; wv < 2048; wv += F.ngw) { const int b = wv >> 6, w = wv & 63;
#pragma unroll 1
        for (int seg = skipctx ? 1 : 0; seg < 2; ++seg) { const float* mv = mod + (size_t)(seg == 0 ? 32 : b) * MODSZ;
#pragma unroll
            for (int j = 0; j < 4; ++j) { g1[j] = *((const f32x4*)(mv + 2 * D) + F.lane + 64 * j); sh2[j] = *((const f32x4*)(mv + 3 * D) + F.lane + 64 * j); sc2[j] = *((const f32x4*)(mv + 4 * D) + F.lane + 64 * j); }
            const int np = seg == 0 ? 2 : 16, p0 = seg == 0 ? 4 * w : CTXL + 32 * w;
            const float* xin = seg == 0 ? xin_c + (size_t)b * CTXL * D : xin_l + ((size_t)b * SEQ - CTXL) * D;
            float* xout = seg == 0 ? Xc + (size_t)b * CTXL * D : Xl + ((size_t)b * SEQ - CTXL) * D;
            f32x4 nx[2][4]; u32x2 no[2][4];
#define LN1_FETCH(pp) do { _Pragma("unroll") for (int q = 0; q < 2; ++q) { const f32x4* xr = (const f32x4*)(xin + (size_t)((pp) + q) * D) + F.lane; const u32x2* orow = (const u32x2*)(O + ((size_t)b * TPS + (pp) + q) * D) + F.lane; \
                _Pragma("unroll") for (int j = 0; j < 4; ++j) { nx[q][j] = __builtin_nontemporal_load(&xr[64 * j]); if (!PERM_OY && !O8F) no[q][j] = __builtin_nontemporal_load(&orow[64 * j]); } \
                if (O8F) { const u32x4 w0 = __builtin_nontemporal_load((const u32x4*)((const unsigned char*)O + ((size_t)b * TPS + (pp) + q) * D) + F.lane); \
                    no[q][0] = (u32x2){w0[0], 0u}; no[q][1] = (u32x2){w0[1], 0u}; no[q][2] = (u32x2){w0[2], 0u}; no[q][3] = (u32x2){w0[3], 0u}; } \
                else if (PERM_OY) { const u32x4* o4 = (const u32x4*)(O + ((size_t)b * TPS + (pp) + q) * D) + F.lane; const u32x4 w0 = __builtin_nontemporal_load(&o4[0]), w1 = __builtin_nontemporal_load(&o4[64]); \
                    no[q][0] = (u32x2){w0[0], w0[1]}; no[q][1] = (u32x2){w0[2], w0[3]}; no[q][2] = (u32x2){w1[0], w1[1]}; no[q][3] = (u32x2){w1[2], w1[3]}; } } } while (0)
            LN1_FETCH(p0);
#pragma unroll 1
            for (int k = 0; k < np; ++k) { const int pA = p0 + 2 * k; const size_t rA = (size_t)b * TPS + pA;
                f32x4 v[2][4]; float s[2] = {0.f, 0.f};
#pragma unroll
                for (int q = 0; q < 2; ++q)
#pragma unroll
                    for (int j = 0; j < 4; ++j) { v[q][j] = nx[q][j] * ALPHA + g1[j] * (O8F ? unpack4_fp8(no[q][j].x) * (1.0f / O8_SCALE) : unpack4(no[q][j])); s[q] += (v[q][j][0] + v[q][j][1]) + (v[q][j][2] + v[q][j][3]); }
                __builtin_amdgcn_sched_barrier(0);
                if (k + 1 < np) LN1_FETCH(pA + 2);
                __builtin_amdgcn_sched_barrier(0);
                float s2[2] = {0.f, 0.f};
#pragma unroll
                for (int q = 0; q < 2; ++q) { const float mean = wave_sum(s[q]) * (1.0f / D);
#pragma unroll
                    for (int j = 0; j < 4; ++j) { v[q][j] = v[q][j] - mean; s2[q] += (v[q][j][0] * v[q][j][0] + v[q][j][1] * v[q][j][1]) + (v[q][j][2] * v[q][j][2] + v[q][j][3] * v[q][j][3]); } }
#pragma unroll
                for (int q = 0; q < 2; ++q) { const float rstd = 1.0f / sqrtf(wave_sum(s2[q]) * (1.0f / D) + LN_EPS);
                    f32x4* xw = (f32x4*)(xout + (size_t)(pA + q) * D) + F.lane; unsigned* hr = (unsigned*)(H8 + (rA + q) * D) + F.lane; u32x4 hw;
#pragma unroll
                    for (int j = 0; j < 4; ++j) { v[q][j] = v[q][j] * rstd * lg[j] + lb[j]; if (!LN_RECOMP) __builtin_nontemporal_store(v[q][j], &xw[64 * j]); v[q][j] = v[q][j] * (1.0f + sc2[j]) + sh2[j]; hw[j] = cvt4_fp8(v[q][j][0], v[q][j][1], v[q][j][2], v[q][j][3]); if (!PERM_HK) hr[64 * j] = hw[j]; }
                    if (PERM_HK) *((u32x4*)(H8 + (rA + q) * D) + F.lane) = hw; }
                f32x2 hp[4][4];
#pragma unroll
                for (int j = 0; j < 4; ++j)
#pragma unroll
                    for (int c = 0; c < 4; ++c) hp[j][c] = (f32x2){v[0][j][c], v[1][j][c]};
                __builtin_amdgcn_sched_barrier(0);
                float accA[16], accB[16];
#pragma unroll
                for (int e = 0; e < 16; ++e) { f32x2 a2 = {0.f, 0.f};
#pragma unroll
                    for (int j = 0; j < 4; ++j) { const f32x4 wq = *(const LAS f32x4*)(Wt + e * D + 4 * F.lane + 256 * j);
#pragma unroll
                        for (int c = 0; c < 4; ++c) a2 = __builtin_elementwise_fma(hp[j][c], (f32x2){wq[c], wq[c]}, a2); }
                    accA[e] = a2[0]; accB[e] = a2[1]; if (e & 1) __builtin_amdgcn_sched_barrier(0); }
                float lgA, lgB; ln1_reduce16(accA, F.lane, lgA); ln1_reduce16(accB, F.lane, lgB);
#pragma unroll
                for (int q = 0; q < 2; ++q) { const float lg_e = q ? lgB : lgA;
                    float mx = lg_e; mx = fmaxf(mx, DPP_MOV(mx, 0x4E)); mx = fmaxf(mx, DPP_MOV(mx, 0x128)); mx = fmaxf(mx, lane_xor16(mx)); mx = lane_xor32_max(mx);
                    const float ex = __expf(lg_e - mx); float se = ex; se += DPP_MOV(se, 0x4E); se += DPP_MOV(se, 0x128); se += lane_xor16(se); se = lane_xor32_sum(se);
                    const int eidx = ((F.lane >> 5) << 3) | (((F.lane >> 4) & 1) << 2) | (((F.lane >> 3) & 1) << 1) | ((F.lane >> 1) & 1);
                    if ((F.lane & 5) == 0) { AFF[(rA + q) * NE + eidx] = ex / se; INV[(rA + q) * NE + eidx] = -1; } }
            } } } }
}

__device__ __forceinline__ void topk_item(Frame& F, LAS unsigned* keys, LAS unsigned* hist, int e, int row0  , int n, int cap, int slot0) {
    const float* AFF = (const float*)(F.ws + WS_AFF); int* INV = (int*)(F.ws + WS_INV); int* STOK = (int*)(F.ws + WS_STOK);
    const int nk = n >> 6;
    for (int k0 = 0; k0 < nk; k0 += 16) { float av[16];
#pragma unroll
        for (int u = 0; u < 16; ++u) { const int k = k0 + u < nk ? k0 + u : nk - 1; av[u] = AFF[(size_t)(row0 + F.lane + 64 * k) * NE + e]; }
#pragma unroll
        for (int u = 0; u < 16; ++u) if (k0 + u < nk) keys[F.lane + 64 * (k0 + u)] = __float_as_uint(av[u]); }
    LDS_WAIT(); asm volatile("" ::: "memory");
    unsigned prefix = 0u, mask = 0u; int krem = cap;
#pragma unroll 1
    for (int pass = 0; pass < 4; ++pass) { const int shift = 24 - 8 * pass;
        *(LAS u32x4*)(hist + 4 * F.lane) = (u32x4){0u, 0u, 0u, 0u};
        LDS_WAIT(); asm volatile("" ::: "memory");
#pragma unroll 4
        for (int k = 0; k < nk; ++k) { const unsigned key = keys[F.lane + 64 * k]; if ((key & mask) == prefix) __hip_atomic_fetch_add(hist + ((key >> shift) & 255u), 1u, __ATOMIC_RELAXED, __HIP_MEMORY_SCOPE_WORKGROUP); }
        LDS_WAIT(); asm volatile("" ::: "memory");
        const u32x4 c = *(const LAS u32x4*)(hist + 4 * F.lane);
        const int s = (int)(c[0] + c[1] + c[2] + c[3]);
        int suf = s;
#pragma unroll
        for (int o = 1; o < 64; o <<= 1) { const int t = __shfl_down(suf, o); if (F.lane + o < 64) suf += t; }
        int cum = suf - s;
        int fbin = -1, fk = 0;
#pragma unroll
        for (int q = 3; q >= 0; --q) { const int cq = (int)c[q]; if (fbin < 0 && cum < krem && cum + cq >= krem) { fbin = 4 * F.lane + q; fk = krem - cum; } cum += cq; }
        const unsigned long long bal = __ballot(fbin >= 0); const int src = bal ? __ffsll((long long)bal) - 1 : 0;
        const int bin = __shfl(fbin, src), nkk = __shfl(fk, src);
        prefix |= (unsigned)bin << shift; mask |= 0xffu << shift; krem = nkk;
        asm volatile("" ::: "memory");
    }
    int nsel = 0, neq = 0;
    const unsigned long long lt = (1ull << F.lane) - 1ull;
#pragma unroll 2
    for (int k = 0; k < nk; ++k) { const unsigned key = keys[F.lane + 64 * k]; const bool gt = key > prefix, eq = key == prefix;
        const unsigned long long be = __ballot(eq); const int eqb = neq + __popcll(be & lt); const bool sel = gt || (eq && eqb < krem);
        const unsigned long long bs = __ballot(sel); const int pos = nsel + __popcll(bs & lt);
        if (sel && pos < cap) { const int row = row0 + F.lane + 64 * k, slot = slot0 + pos; STOK[slot] = row; INV[(size_t)row * NE + e] = slot; }
        nsel += __popcll(bs); neq += __popcll(be); }
    LDS_WAIT(); asm volatile("" ::: "memory");
}
__device__ __forceinline__ void phase_topk_conv(Frame& F, int li, bool skipctx) {
    LAS unsigned* hist = (LAS unsigned*)(F.lds + 8 * 9216 + F.wave * 1024);
#if TOPK_DYN
    LAS unsigned* ctr = (LAS unsigned*)(F.lds + MISC_OFF + 64);
    if (F.tid == 0) *ctr = 0u;
    __syncthreads();
#endif
    if (F.wave < 4 && !(skipctx && F.wave >= 2)) for (int it = F.vcu * 2 + (F.wave & 1); it < 512; it += F.G * 2) { const int set = F.wave >> 1, b = (it >> 4) & 31, e = it & 15; LAS unsigned* keys = (LAS unsigned*)(F.lds + F.wave * 9216);
        if (set == 0) topk_item(F, keys, hist, e, b * TPS + CTXL, SEQ, CAPL, (b * NE + e) * CAPL);
        else topk_item(F, keys, hist, e, b * TPS, CTXL, CAPC, NSLOT_L + (e * 4 + (b >> 3)) * 256 + (b & 7) * CAPC); }
    LAS float* scr = (LAS float*)(F.lds + F.wave * 9216);
#if TOPK_DYN
    for (;;) { unsigned k_ = 0; if (F.lane == 0) k_ = __hip_atomic_fetch_add(ctr, 1u, __ATOMIC_RELAXED, __HIP_MEMORY_SCOPE_WORKGROUP); k_ = __builtin_amdgcn_readfirstlane(k_);
        const int it = F.vcu * NWAVES + (int)(k_ & 7u) + (int)(k_ >> 3) * F.ngw; if (it >= 3 * NE * 512) break;
#else
    for (int it = F.gw; it < 3 * NE * 512; it += F.ngw) {
#endif
        const int which = it / (NE * 512), rem = it - which * (NE * 512), e = rem >> 9, item = rem & 511;
        const size_t eoff = ((size_t)li * NE + e) * D * FF;
        if (which == 0) transpose_item_fp8(in_ptr(I_WG) + eoff, FF, WGU_SCALE, (unsigned char*)(F.ws + WS_WGU) + (size_t)e * 2048 * D, D, 0, 1, scr, item, F.lane, nullptr, PERM_HK ? 1 : 0);
        else if (which == 1) transpose_item_fp8(in_ptr(I_WU) + eoff, FF, WGU_SCALE, (unsigned char*)(F.ws + WS_WGU) + (size_t)e * 2048 * D, D, 128, 1, scr, item, F.lane, nullptr, PERM_HK ? 1 : 0);
        else transpose_item_fp8(in_ptr(I_WDN) + eoff, D, WDN_SCALE, (unsigned char*)(F.ws + WS_WDN) + (size_t)e * D * FF, FF, 0, Y8F ? 3 : PERM_OY ? 2 : 0, scr, item, F.lane); }
}
__device__ __forceinline__ void phase_gather(Frame& F) {
    const bf16_t* H = (const bf16_t*)(F.ws + WS_H); bf16_t* XS = (bf16_t*)(F.ws + WS_R + R_XS); const int* STOK = (const int*)(F.ws + WS_STOK);
    for (int s0 = F.gw * 4; s0 < NSLOT; s0 += F.ngw * 4) { u32x4 v[4][2];
#pragma unroll
        for (int q = 0; q < 4; ++q) { int row = STOK[s0 + q]; row = row < 0 ? 0 : (row >= T ? T - 1 : row); const u32x4* src = (const u32x4*)(H + (size_t)row * D) + F.lane; v[q][0] = src[0]; v[q][1] = src[64]; }
#pragma unroll
        for (int q = 0; q < 4; ++q) { u32x4* dst = (u32x4*)(XS + (size_t)(s0 + q) * D) + F.lane; dst[0] = v[q][0]; dst[64] = v[q][1]; } }
}
template <bool LV, class FN> __device__ __forceinline__ f32x4 ln2_vec(LAS float* VL, int idx4, FN&& fn) { if constexpr (LV) return *((const LAS f32x4*)VL + idx4); else return fn(); }
template <bool LV>
__device__ __forceinline__ void phase_ln2_t(Frame& F, int li, float* xdry, bool skipctx, const float* xin_l, const float* xin_c, const bf16_t* O) {
    const float* mod = (const float*)(F.ws + WS_MOD) + (size_t)li * 33 * MODSZ; const float* modn = mod + (size_t)33 * MODSZ; const bool has_next = li + 1 < NL;
    unsigned char* H8 = (unsigned char*)(F.ws + WS_H); const int* INV = (const int*)(F.ws + WS_INV); const float* AFF = (const float*)(F.ws + WS_AFF); const bf16_t* Y = (const bf16_t*)(F.ws + WS_R + R_XS);
    float* Xl = F.out; float* Xc = (float*)(F.ws + WS_XC); float* Xdl = xdry ? xdry + (size_t)NB * CTXL * D : Xl; float* Xdc = xdry ? xdry : Xc;
#if LN2_LDSV
    LAS float* VL = (LAS float*)F.lds; const int b_wg = (F.vcu * NWAVES) >> 6; constexpr bool ldsv_ok = LV;
    if constexpr (ldsv_ok) { for (int i = F.tid; i < 12 * 256; i += NTHR) { const int id = i >> 8, c4 = i & 255; const float* src;
            if (id == 0) src = in_ptr(I_LMG) + li * D; else if (id == 1) src = in_ptr(I_LMB) + li * D; else if (id == 2) src = in_ptr(I_LFG) + li * D; else if (id == 3) src = in_ptr(I_LFB) + li * D;
            else { const int s_ = (id - 4) >> 2, k_ = (id - 4) & 3; const float* mcur = mod + (size_t)(s_ == 0 ? 32 : b_wg) * MODSZ; const float* mnx = modn + (size_t)(s_ == 0 ? 32 : b_wg) * MODSZ;
                src = k_ == 0 ? mcur + 2 * D : k_ == 1 ? mcur + 5 * D : k_ == 2 ? mnx : mnx + D; if (k_ >= 2 && !has_next) src = mcur; }
            *((LAS f32x4*)VL + i) = *((const f32x4*)src + c4); }
        __syncthreads(); }
#define LN2_VEC(id, j, memexpr) ln2_vec<ldsv_ok>(VL, (id) * 256 + F.lane + 64 * (j), [&]() { return (memexpr); })
#else
#define LN2_VEC(id, j, memexpr) (memexpr)
#endif
#if LN2_NEB > 2 || LN2_LDSV
    const float* pg_ = in_ptr(I_LFG) + li * D; const float* pb_ = in_ptr(I_LFB) + li * D;
#define LN2_LG(j) LN2_VEC(2, j, *((const f32x4*)pg_ + F.lane + 64 * (j)))
#define LN2_LB(j) LN2_VEC(3, j, *((const f32x4*)pb_ + F.lane + 64 * (j)))
#define LN2_G2(j) LN2_VEC(5 + 4 * seg, j, *((const f32x4*)(mv + 5 * D) + F.lane + 64 * (j)))
#else
    f32x4 lg[4], lb[4], g2[4];
    { const float* pg = in_ptr(I_LFG) + li * D; const float* pb = in_ptr(I_LFB) + li * D;
#pragma unroll
      for (int j = 0; j < 4; ++j) { lg[j] = *((const f32x4*)pg + F.lane + 64 * j); lb[j] = *((const f32x4*)pb + F.lane + 64 * j); } }
#define LN2_LG(j) lg[j]
#define LN2_LB(j) lb[j]
#define LN2_G2(j) g2[j]
#endif
    for (int wv = F.gw; wv < 2048; wv += F.ngw) { const int b = wv >> 6, w = wv & 63;
#pragma unroll 1
        for (int seg = skipctx ? 1 : 0; seg < 2; ++seg) { const float* mv = mod + (size_t)(seg == 0 ? 32 : b) * MODSZ; const float* mn = modn + (size_t)(seg == 0 ? 32 : b) * MODSZ;
#if LN2_NEB <= 2 && !LN2_LDSV
#pragma unroll
            for (int j = 0; j < 4; ++j) g2[j] = *((const f32x4*)(mv + 5 * D) + F.lane + 64 * j);
#endif
            const int np = seg == 0 ? 2 : 16, p0 = seg == 0 ? 4 * w : CTXL + 32 * w;
            const float* xio = LN_RECOMP ? (seg == 0 ? xin_c + (size_t)b * CTXL * D : xin_l + ((size_t)b * SEQ - CTXL) * D) : (seg == 0 ? Xc + (size_t)b * CTXL * D : Xl + ((size_t)b * SEQ - CTXL) * D);
            float* xo2 = seg == 0 ? Xdc + (size_t)b * CTXL * D : Xdl + ((size_t)b * SEQ - CTXL) * D;
            const int* iab = (F.lane & 32) ? (const int*)AFF : INV; const int iao = ((F.lane >> 4) & 1) * NE + (F.lane & 15);
            int nia = iab[((size_t)b * TPS + p0) * NE + iao];
#pragma unroll 1
            for (int k = 0; k < np; ++k) { const int pA = p0 + 2 * k; const size_t rA = (size_t)b * TPS + pA;
                f32x4 xv[2][4], f[2][4];
                const int mia = nia; nia = iab[(k + 1 < np ? rA + 2 : rA) * NE + iao];
#pragma unroll
                for (int q = 0; q < 2; ++q) { const f32x4* xr = (const f32x4*)(xio + (size_t)(pA + q) * D) + F.lane;
#pragma unroll
                    for (int j = 0; j < 4; ++j) { xv[q][j] = __builtin_nontemporal_load(&xr[64 * j]); f[q][j] = (f32x4){0.f, 0.f, 0.f, 0.f}; } }
                if constexpr (LN_RECOMP != 0) {
                    u32x2 ov[2][4]; float s1[2] = {0.f, 0.f}, s1b[2] = {0.f, 0.f};
#pragma unroll
                    for (int q = 0; q < 2; ++q) { const u32x2* orow = (const u32x2*)(O + (rA + q) * D) + F.lane;
                        if (O8F) { const u32x4 w0 = __builtin_nontemporal_load((const u32x4*)((const unsigned char*)O + (rA + q) * D) + F.lane);
                            ov[q][0] = (u32x2){w0[0], 0u}; ov[q][1] = (u32x2){w0[1], 0u}; ov[q][2] = (u32x2){w0[2], 0u}; ov[q][3] = (u32x2){w0[3], 0u}; }
                        else if (PERM_OY) { const u32x4* o4 = (const u32x4*)(O + (rA + q) * D) + F.lane; const u32x4 w0 = __builtin_nontemporal_load(&o4[0]), w1 = __builtin_nontemporal_load(&o4[64]);
                            ov[q][0] = (u32x2){w0[0], w0[1]}; ov[q][1] = (u32x2){w0[2], w0[3]}; ov[q][2] = (u32x2){w1[0], w1[1]}; ov[q][3] = (u32x2){w1[2], w1[3]}; }
                        else {
#pragma unroll
                        for (int j = 0; j < 4; ++j) ov[q][j] = __builtin_nontemporal_load(&orow[64 * j]); } }
#pragma unroll
                    for (int j = 0; j < 4; ++j) { const f32x4 g1j = LN2_VEC(4 + 4 * seg, j, *((const f32x4*)(mv + 2 * D) + F.lane + 64 * j));
#pragma unroll
                        for (int q = 0; q < 2; ++q) { xv[q][j] = xv[q][j] * ALPHA + g1j * (O8F ? unpack4_fp8(ov[q][j].x) * (1.0f / O8_SCALE) : unpack4(ov[q][j])); s1[q] += (xv[q][j][0] + xv[q][j][1]) + (xv[q][j][2] + xv[q][j][3]); } }
#pragma unroll
                    for (int q = 0; q < 2; ++q) { const float mean = wave_sum(s1[q]) * (1.0f / D);
#pragma unroll
                        for (int j = 0; j < 4; ++j) { xv[q][j] = xv[q][j] - mean; s1b[q] += (xv[q][j][0] * xv[q][j][0] + xv[q][j][1] * xv[q][j][1]) + (xv[q][j][2] * xv[q][j][2] + xv[q][j][3] * xv[q][j][3]); } }
                    float rs1[2];
#pragma unroll
                    for (int q = 0; q < 2; ++q) rs1[q] = 1.0f / sqrtf(wave_sum(s1b[q]) * (1.0f / D) + LN_EPS);
#pragma unroll
                    for (int j = 0; j < 4; ++j) { const f32x4 mg = LN2_VEC(0, j, *((const f32x4*)(in_ptr(I_LMG) + li * D) + F.lane + 64 * j)), mb = LN2_VEC(1, j, *((const f32x4*)(in_ptr(I_LMB) + li * D) + F.lane + 64 * j));
#pragma unroll
                        for (int q = 0; q < 2; ++q) xv[q][j] = xv[q][j] * rs1[q] * mg + mb; }
                }
                unsigned msk[2];
                { const unsigned long long bal_ = __ballot(F.lane < 32 && mia >= 0); msk[0] = (unsigned)bal_ & 0xffffu; msk[1] = (unsigned)(bal_ >> 16) & 0xffffu; }
                while (msk[0] | msk[1]) {
                    int sl[2][LN2_NEB]; float gt[2][LN2_NEB]; bool hs[2][LN2_NEB];
#pragma unroll
                    for (int q = 0; q < 2; ++q)
#pragma unroll
                        for (int i = 0; i < LN2_NEB; ++i) { const bool has = msk[q] != 0u; const int e = has ? __builtin_ctz(msk[q]) : 0; msk[q] &= msk[q] - 1u;
                            const int s_ = __builtin_amdgcn_readlane(mia, 16 * q + e); const float g_ = __uint_as_float((unsigned)__builtin_amdgcn_readlane(mia, 32 + 16 * q + e));
                            sl[q][i] = has ? s_ : 0; gt[q][i] = has ? (Y8F ? g_ * (1.0f / Y8_SCALE) : g_) : 0.f; hs[q][i] = has; }
                    u32x2 yv[2][LN2_NEB][4];
#pragma unroll
                    for (int q = 0; q < 2; ++q)
#pragma unroll
                        for (int i = 0; i < LN2_NEB; ++i) { const u32x2* yr = (const u32x2*)(Y + (size_t)sl[q][i] * D) + F.lane;
#if LN2_SKIP
                            if (hs[q][i]) {
                            if (Y8F) { const u32x4 w0 = __builtin_nontemporal_load((const u32x4*)((const unsigned char*)Y + (size_t)sl[q][i] * D) + F.lane);
                                yv[q][i][0] = (u32x2){w0[0], 0u}; yv[q][i][1] = (u32x2){w0[1], 0u}; yv[q][i][2] = (u32x2){w0[2], 0u}; yv[q][i][3] = (u32x2){w0[3], 0u}; }
                            else if (PERM_OY) { const u32x4* y4 = (const u32x4*)(Y + (size_t)sl[q][i] * D) + F.lane; const u32x4 w0 = __builtin_nontemporal_load(&y4[0]), w1 = __builtin_nontemporal_load(&y4[64]);
                                yv[q][i][0] = (u32x2){w0[0], w0[1]}; yv[q][i][1] = (u32x2){w0[2], w0[3]}; yv[q][i][2] = (u32x2){w1[0], w1[1]}; yv[q][i][3] = (u32x2){w1[2], w1[3]}; }
                            else {
#pragma unroll
                            for (int j = 0; j < 4; ++j) yv[q][i][j] = __builtin_nontemporal_load(&yr[64 * j]); } }
                            else {
#pragma unroll
                            for (int j = 0; j < 4; ++j) yv[q][i][j] = (u32x2){0u, 0u}; }
#else
#pragma unroll
                            for (int j = 0; j < 4; ++j) yv[q][i][j] = __builtin_nontemporal_load(&yr[64 * j]);
#endif
                        }
#pragma unroll
                    for (int q = 0; q < 2; ++q)
#pragma unroll
                        for (int i = 0; i < LN2_NEB; ++i)
#pragma unroll
                            for (int j = 0; j < 4; ++j) f[q][j] += (Y8F ? unpack4_fp8(yv[q][i][j].x) : unpack4(yv[q][i][j])) * gt[q][i];
                }
                f32x4 v[2][4]; float s[2] = {0.f, 0.f}, s2[2] = {0.f, 0.f};
#pragma unroll
                for (int q = 0; q < 2; ++q)
#pragma unroll
                    for (int j = 0; j < 4; ++j) { v[q][j] = xv[q][j] * ALPHA + LN2_G2(j) * f[q][j]; s[q] += (v[q][j][0] + v[q][j][1]) + (v[q][j][2] + v[q][j][3]); }
#pragma unroll
                for (int q = 0; q < 2; ++q) { const float mean = wave_sum(s[q]) * (1.0f / D);
#pragma unroll
                    for (int j = 0; j < 4; ++j) { v[q][j] = v[q][j] - mean; s2[q] += (v[q][j][0] * v[q][j][0] + v[q][j][1] * v[q][j][1]) + (v[q][j][2] * v[q][j][2] + v[q][j][3] * v[q][j][3]); } }
#pragma unroll
                for (int q = 0; q < 2; ++q) { const float rstd = 1.0f / sqrtf(wave_sum(s2[q]) * (1.0f / D) + LN_EPS);
                    f32x4* xw = (f32x4*)(xo2 + (size_t)(pA + q) * D) + F.lane; unsigned* hr = (unsigned*)(H8 + (rA + q) * D) + F.lane;
                    u32x4 hw = {0u, 0u, 0u, 0u};
#pragma unroll
                    for (int j = 0; j < 4; ++j) { v[q][j] = v[q][j] * rstd * LN2_LG(j) + LN2_LB(j); __builtin_nontemporal_store(v[q][j], &xw[64 * j]); if (has_next) { const f32x4 sh1 = LN2_VEC(6 + 4 * seg, j, *((const f32x4*)mn + F.lane + 64 * j)), sc1 = LN2_VEC(7 + 4 * seg, j, *((const f32x4*)(mn + D) + F.lane + 64 * j)); const f32x4 hv = v[q][j] * (1.0f + sc1) + sh1; hw[j] = cvt4_fp8(hv[0], hv[1], hv[2], hv[3]); if (!PERM_HK) hr[64 * j] = hw[j]; } }
                    if (PERM_HK && has_next) *((u32x4*)(H8 + (rA + q) * D) + F.lane) = hw; }
            } } }
}
__device__ __forceinline__ void phase_ln2(Frame& F, int li, float* xdry, bool skipctx, const float* xin_l, const float* xin_c, const bf16_t* O) {
#if LN2_LDSV
    if (F.G == 256) phase_ln2_t<true>(F, li, xdry, skipctx, xin_l, xin_c, O); else
#endif
    phase_ln2_t<false>(F, li, xdry, skipctx, xin_l, xin_c, O);
}
#ifndef ATT_V2
#define ATT_V2 0
#endif
template <int DQK, int SD>
__device__ __forceinline__ void phase_attn(Frame& F, int jg, bool skipctx, unsigned long long& pacc) {
    char* lds = (char*)F.lds;
    for (int u = F.vcu; u < (skipctx ? 2048 : 2048 + 256); u += F.G) {
        int b, h, prow, seq;
        if (u < 2048) { b = u >> 6; h = (u >> 3) & 7; prow = CTXL + (u & 7) * 256; seq = TPS; } else { const int q = u - 2048; b = q >> 3; h = q & 7; prow = 0; seq = CTXL; }
        const size_t row0 = (size_t)b * TPS;
        if constexpr (DQK == 128) {
            const bf16_t* QKV = (const bf16_t*)(F.ws + WS_R + R_QKV); unsigned char* AO = (unsigned char*)(F.ws + WS_R + R_AOG);
            const bf16_t* K = QKV + row0 * 1536 + 1024 + (h >> 2) * 128;
#if ATT_V2
            att2::attn_body2<128, 1536, 1536, 64, 1536, D>(QKV + (row0 + prow) * 1536 + h * 128, K, nullptr, K + 256, AO + (row0 + prow) * D + h * 128, seq, F.lds, prow - CTXL, (const float*)(F.ws + WS_ROPE), in_ptr(I_GQG) + jg * 128, pacc);
#else
            att::attn_body<128, SD, 1536, 1536, 64, 1536, D>(QKV + (row0 + prow) * 1536 + h * 128, K, nullptr, K + 256, AO + (row0 + prow) * D + h * 128, seq, lds, prow - CTXL, (const float*)(F.ws + WS_ROPE), in_ptr(I_GQG) + jg * 128);
#endif
        } else {
            const bf16_t* Q = (const bf16_t*)(F.ws + WS_R + R_Q); const bf16_t* KV = (const bf16_t*)(F.ws + WS_R + R_KV); const bf16_t* KR = (const bf16_t*)(F.ws + WS_KR); unsigned char* AO = (unsigned char*)(F.ws + WS_R + R_AOM);
            const bf16_t* K = KV + row0 * 2048 + h * 256;
#if ATT_V2
            att2::attn_body2<192, 1536, 2048, 64, 2048, D>(Q + (row0 + prow) * 1536 + h * 192, K, KR + row0 * 64, K + 128, AO + (row0 + prow) * D + h * 128, seq, F.lds, prow - CTXL, (const float*)(F.ws + WS_ROPE) + 4096, nullptr, pacc);
#else
            att::attn_body<192, SD, 1536, 2048, 64, 2048, D>(Q + (row0 + prow) * 1536 + h * 192, K, KR + row0 * 64, K + 128, AO + (row0 + prow) * D + h * 128, seq, lds, prow - CTXL, (const float*)(F.ws + WS_ROPE) + 4096, nullptr);
#endif
        }
        __syncthreads();
    }
}

#ifndef REP_DENSE
#define REP_DENSE 1
#endif
#ifndef REP_MOE
#define REP_MOE 1
#endif
#ifndef REP_ATTN
#define REP_ATTN 1
#endif
#ifndef REP_THIN
#define REP_THIN 1
#endif
#ifndef REP_LN1
#define REP_LN1 1
#endif
#ifndef REP_LN2
#define REP_LN2 1
#endif
#ifndef REP_QK
#define REP_QK 1
#endif
#ifndef REP_BAR
#define REP_BAR 1
#endif
#ifndef REP_ATTN_M
#define REP_ATTN_M REP_ATTN
#endif
#ifndef REP_ATTN_G
#define REP_ATTN_G REP_ATTN
#endif
#ifndef EN_ALL
#define EN_ALL 1
#endif
#ifndef EN_ATTN_MLA
#define EN_ATTN_MLA 1
#endif
#ifndef EN_ATTN_GQA
#define EN_ATTN_GQA 1
#endif
#ifndef ATT_SD_GQA
#define ATT_SD_GQA 1
#endif
#ifndef EN_UQ
#define EN_UQ 1
#endif
#ifndef EN_UKV
#define EN_UKV 1
#endif
#ifndef EN_P0A
#define EN_P0A EN_ALL
#endif
#ifndef EN_P0B
#define EN_P0B EN_ALL
#endif
#ifndef EN_P0C
#define EN_P0C EN_ALL
#endif
#ifndef EN_PROJ
#define EN_PROJ EN_ALL
#endif
#ifndef EN_THIN1
#define EN_THIN1 EN_ALL
#endif
#ifndef EN_UQKV
#define EN_UQKV EN_ALL
#endif
#ifndef EN_ATTN
#define EN_ATTN EN_ALL
#endif
#ifndef EN_OPROJ
#define EN_OPROJ EN_ALL
#endif
#ifndef EN_LN1
#define EN_LN1 EN_ALL
#endif
#ifndef EN_TOPK
#define EN_TOPK EN_ALL
#endif
#ifndef EN_GATHER
#define EN_GATHER 0
#endif
#ifndef EN_GU
#define EN_GU EN_ALL
#endif
#ifndef EN_DN
#define EN_DN EN_ALL
#endif
#ifndef EN_LN2
#define EN_LN2 EN_ALL
#endif
constexpr int NPH = 3 + NL * 11;
struct Args { const float* in[25]; float* out; unsigned char* ws; int ph_lo, ph_hi; };
__global__ void __launch_bounds__(NTHR, 2) mk_fwd(Args args) {
    extern __shared__ __attribute__((aligned(16))) unsigned char lds_raw[];
    Frame F;
    F.lds = (LAS unsigned char*)lds_raw;
    F.tid = threadIdx.x; F.lane = F.tid & 63; F.wave = __builtin_amdgcn_readfirstlane(F.tid >> 6);
    F.G = gridDim.x; { const int bx = blockIdx.x; F.vcu = (F.G % 8 == 0) ? (bx % 8) * (F.G / 8) + bx / 8 : bx; }
    F.gw = F.vcu * NWAVES + F.wave; F.ngw = F.G * NWAVES;
    F.out = args.out; F.ws = args.ws;
    volatile LAS unsigned* MISC = (volatile LAS unsigned*)(F.lds + MISC_OFF);
    if (F.tid < 4) MISC[F.tid] = 0u;
    __syncthreads();
    const int lo = args.ph_lo, hi = args.ph_hi;
    XcdBarrier bar; bar.bar = (unsigned*)(F.ws + WS_CTL) + CW_BAR; bar.x = 0; bar.st = MISC;
    if (hi - lo > 1) bar = xcd_barrier_post((unsigned*)(F.ws + WS_CTL) + CW_BAR, MISC);
#define IN(k) (lo <= (k) && (k) < hi)
#ifdef PROBE_SEL
#ifndef PROBE_WG
#define PROBE_WG 0
#endif
    unsigned long long pr_acc = 0ull, pr_t0 = 0ull; const bool pr_on = (int)blockIdx.x == PROBE_WG && F.wave == 0;
#define PSTART(g) do { if ((g) == PROBE_SEL && pr_on) pr_t0 = __builtin_amdgcn_s_memrealtime(); } while (0)
#define PEND(g) do { if ((g) == PROBE_SEL && pr_on) pr_acc += __builtin_amdgcn_s_memrealtime() - pr_t0; } while (0)
#else
#define PSTART(g) do { } while (0)
#define PEND(g) do { } while (0)
#endif
#define SEAM(k) do { if ((k) + 1 < hi) { PSTART(11); for (int rb_ = 0; rb_ < REP_BAR; ++rb_) xcd_barrier(bar); PEND(11); } } while (0)
#define SEAMG(k, g) do { if ((k) + 1 < hi) { PSTART(11); PSTART(20 + (g)); for (int rb_ = 0; rb_ < REP_BAR; ++rb_) xcd_barrier(bar); PEND(11); PEND(20 + (g)); } } while (0)
#define PB() do { F.lane = opaque_v(F.lane); F.tid = opaque_v(F.tid); F.gw = opaque_s(F.gw); F.wave = opaque_s(F.wave); F.vcu = opaque_s(F.vcu); } while (0)

#if EN_P0A
    if (IN(0)) { PB(); PSTART(0); _Pragma("unroll 1") for (int rep_ = 0; rep_ < REP_THIN; ++rep_) { phase_p0a(F); __syncthreads(); } PEND(0); SEAMG(0, 0); }
#endif
#if EN_P0B
    if (IN(1)) { PB(); PSTART(0); _Pragma("unroll 1") for (int rep_ = 0; rep_ < REP_THIN; ++rep_) { phase_p0b(F); __syncthreads(); } PEND(0); SEAMG(1, 0); }
#endif
#if EN_P0C
    if (IN(2)) { PB(); PSTART(0); _Pragma("unroll 1") for (int rep_ = 0; rep_ < REP_THIN; ++rep_) { phase_p0c(F); __syncthreads(); } PEND(0); SEAMG(2, 0); }
#endif

#pragma unroll 1
    for (int li = 0; li < NL; ++li) {
        const int pb = 3 + li * 11, j = li >> 1; const bool mla = (li & 1) != 0, lastl = li == NL - 1;
#if EN_PROJ
        if (IN(pb + 0)) { PB(); PSTART(1);
            const int N = mla ? 1280 : 1536;
            pg8::Gemm g{(const bf16_t*)(F.ws + WS_H), (const bf16_t*)(mla ? F.ws + WS_WD + (size_t)j * 1280 * 1024 : F.ws + WS_WQKV + (size_t)j * 1536 * 1024), D / 2, D / 2, D / 2, 0x7a7a7a7a  , (const int*)(F.ws + WS_GVAL)  };
            pg8::StaticOrder S; S.init(T, N, F.G, (int)blockIdx.x); S.rep = REP_DENSE;
            pg8::EpiStore E{(bf16_t*)(F.ws + WS_R), N, 0xffff};
            pg8::gemm_phase<pg8::EpiStore, pg8::StaticOrder, false, true, true>(F.lds, g, S, E, nullptr);
            PEND(1); SEAMG(pb + 0, 1);
        }
#endif
#if EN_THIN1
        if (IN(pb + 1)) { PB(); PSTART(2); _Pragma("unroll 1") for (int rp_ = 0; rp_ < REP_QK; ++rp_) { bf16_t* dry_ = rp_ + 1 < REP_QK ? (bf16_t*)(F.ws + WS_R + 396 * MiB) : nullptr; if (mla) phase_mla_stats(F, dry_); else phase_qknorm(F, j, dry_); __syncthreads(); } PEND(2); SEAMG(pb + 1, 2); }
#endif
#if EN_UQKV
        if (mla && IN(pb + 2)) { PB(); PSTART(3);
#if EN_UQ
            { pg8::Gemm g{(const bf16_t*)(F.ws + WS_CQ8), (const bf16_t*)(F.ws + WS_WUQ + (size_t)j * 1536 * 768), 384, 384, 384, 0x7a7a7a7a  , (const int*)(F.ws + WS_GVAL)  };
              pg8::StaticOrder S; S.init(lastl ? NB * SEQ : T, 1536, F.G, (int)blockIdx.x); S.rep = REP_DENSE; S.skipctx = lastl;
              pg8::EpiStore E{(bf16_t*)(F.ws + WS_R + R_Q), 1536, 0xffff};
              pg8::gemm_phase<pg8::EpiStore, pg8::StaticOrder, false, true, true>(F.lds, g, S, E, nullptr); }
#endif
#if EN_UKV
            { pg8::Gemm g{(const bf16_t*)(F.ws + WS_R + R_CQ) + 768, (const bf16_t*)(F.ws + WS_WUKV) + (size_t)j * 2048 * 256, 1280, 256, 256, 0};
              pg8::StaticOrder S; S.init(T, 2048, F.G, (int)blockIdx.x); S.rep = REP_DENSE;
              pg8::EpiStore E{(bf16_t*)(F.ws + WS_R + R_KV), 2048, 0xffff};
              pg8::gemm_phase<pg8::EpiStore, pg8::StaticOrder>(F.lds, g, S, E, nullptr); }
#endif
            PEND(3); SEAMG(pb + 2, 3);
        }
#endif
#if EN_ATTN
        if (IN(pb + 3)) { PB(); PSTART(4); unsigned long long pa_ = 0ull;
#if EN_ATTN_MLA
            _Pragma("unroll 1") for (int rep_ = 0; rep_ < REP_ATTN_M; ++rep_) { if (mla) phase_attn<192, ATT_SD_MLA>(F, j, lastl, pa_); __syncthreads(); }
#endif
#if EN_ATTN_GQA
            _Pragma("unroll 1") for (int rep_ = 0; rep_ < REP_ATTN_G; ++rep_) { if (!mla) phase_attn<128, ATT_SD_GQA>(F, j, lastl, pa_); __syncthreads(); }
#endif
#if defined(PROBE_SEL) && PROBE_SEL >= 50 && PROBE_SEL <= 59
            if (pr_on) pr_acc += pa_;
#endif
            PEND(4); SEAMG(pb + 3, 4); }
#endif
#if EN_OPROJ
        if (IN(pb + 4)) { PB(); PSTART(5);
            pg8::Gemm g{(const bf16_t*)(F.ws + WS_R + (mla ? R_AOM : R_AOG)), (const bf16_t*)(F.ws + (mla ? WS_WOM : WS_WOG) + (size_t)j * 1024 * 1024), D / 2, D / 2, D / 2, O8F ? 0x7a7a7a7a   : 0x75757575  , (const int*)(F.ws + WS_GVAL)  };
            pg8::StaticOrder S; S.init(lastl ? NB * SEQ : T, D, F.G, (int)blockIdx.x); S.rep = REP_DENSE; S.skipctx = lastl;
#if O8F
            pg8::EpiStoreF8 E{(unsigned char*)(F.ws + WS_R + R_O2), D, 0xffff};
            pg8::gemm_phase<pg8::EpiStoreF8, pg8::StaticOrder, false, true, true>(F.lds, g, S, E, nullptr);
#else
            pg8::EpiStore E{(bf16_t*)(F.ws + WS_R + (LN_RECOMP ? R_O2 : (mla ? R_OM : R_OG))), D, 0xffff};
            pg8::gemm_phase<pg8::EpiStore, pg8::StaticOrder, false, true, true>(F.lds, g, S, E, nullptr);
#endif
            PEND(5); SEAMG(pb + 4, 5);
        }
#endif
#if EN_LN1
        if (IN(pb + 5)) { PB(); PSTART(6); phase_ln1(F, li, li == 0 ? in_ptr(I_X) : F.out, li == 0 ? in_ptr(I_CTX) : (const float*)(F.ws + WS_XC), (const bf16_t*)(F.ws + WS_R + (LN_RECOMP ? R_O2 : (mla ? R_OM : R_OG))), (float*)(F.ws + WS_R + 396 * MiB), lastl); PEND(6); SEAMG(pb + 5, 6); }
#endif
#if EN_TOPK
        if (IN(pb + 6)) { PB(); PSTART(7); _Pragma("unroll 1") for (int rep_ = 0; rep_ < REP_THIN; ++rep_) { phase_topk_conv(F, li, lastl); __syncthreads(); } PEND(7); SEAMG(pb + 6, 7); }
#endif
#if EN_GATHER
        if (IN(pb + 7)) { PB(); PSTART(12); _Pragma("unroll 1") for (int rep_ = 0; rep_ < REP_THIN; ++rep_) { phase_gather(F); __syncthreads(); } PEND(12); SEAMG(pb + 7, 12); }
#endif
#if EN_GU
        if (IN(pb + 8)) { PB(); PSTART(8);
            pg8::Gemm g{(const bf16_t*)(F.ws + WS_H), (const bf16_t*)(F.ws + WS_WGU), D / 2, D / 2, D / 2, 0x7a7a7a7a  , (const int*)(F.ws + WS_STOK)};
            pg8::MoeOrder S; S.init(8, F.G, (int)blockIdx.x); S.rep = REP_MOE; if (lastl) S.nunits = 512 * 8;
            pg8::EpiSwiGlu E{(unsigned char*)(F.ws + WS_R + R_ACT2)};
#if defined(PROBE_SEL) && (PROBE_SEL == 40 || PROBE_SEL == 41)
            { unsigned long long qk_ = 0, qe_ = 0; pg8::gemm_phase_x<pg8::EpiSwiGlu, pg8::MoeOrder, false, true, true, true>(F.lds, g, S, E, nullptr, qk_, qe_); if (pr_on) pr_acc += (PROBE_SEL == 40 ? qk_ : qe_); }
#else
            pg8::gemm_phase<pg8::EpiSwiGlu, pg8::MoeOrder, false, true, true>(F.lds, g, S, E, nullptr);
#endif
            PEND(8); SEAMG(pb + 8, 8);
        }
#endif
#if EN_DN
        if (IN(pb + 9)) { PB(); PSTART(9);
            pg8::Gemm g{(const bf16_t*)(F.ws + WS_R + R_ACT2), (const bf16_t*)(F.ws + WS_WDN), LDACT / 2, FF / 2, FF / 2, Y8F ? 0x7c7c7c7c   : 0x79797979  , (const int*)(F.ws + WS_GVAL)  };
            pg8::MoeOrder S; S.init(4, F.G, (int)blockIdx.x); S.rep = REP_MOE; if (lastl) S.nunits = 512 * 4;
#if Y8F
            pg8::EpiStoreF8 E{(unsigned char*)(F.ws + WS_R + R_XS), D, 3};
            pg8::gemm_phase<pg8::EpiStoreF8, pg8::MoeOrder, false, true, true>(F.lds, g, S, E, nullptr);
#else
            pg8::EpiStore E{(bf16_t*)(F.ws + WS_R + R_XS), D, 3};
#if defined(PROBE_SEL) && (PROBE_SEL == 42 || PROBE_SEL == 43)
            { unsigned long long qk_ = 0, qe_ = 0; pg8::gemm_phase_x<pg8::EpiStore, pg8::MoeOrder, false, true, true, true>(F.lds, g, S, E, nullptr, qk_, qe_); if (pr_on) pr_acc += (PROBE_SEL == 42 ? qk_ : qe_); }
#else
            pg8::gemm_phase<pg8::EpiStore, pg8::MoeOrder, false, true, true>(F.lds, g, S, E, nullptr);
#endif
#endif
            PEND(9); SEAMG(pb + 9, 9);
        }
#endif
#if EN_LN2
        if (IN(pb + 10)) { PB(); PSTART(10); _Pragma("unroll 1") for (int rp_ = 0; rp_ < REP_LN2; ++rp_) { phase_ln2(F, li, rp_ + 1 < REP_LN2 ? (float*)(F.ws + WS_R + 288 * MiB) : nullptr, lastl, li == 0 ? in_ptr(I_X) : F.out, li == 0 ? in_ptr(I_CTX) : (const float*)(F.ws + WS_XC), (const bf16_t*)(F.ws + WS_R + R_O2)); __syncthreads(); } PEND(10); SEAMG(pb + 10, 10); }
#endif
    }
#ifdef PROBE_SEL
    if (pr_on) { const unsigned long long tgt = __builtin_amdgcn_s_memrealtime() + pr_acc; while (__builtin_amdgcn_s_memrealtime() < tgt) __builtin_amdgcn_s_sleep(64); }
#endif
#undef IN
#undef SEAM
}

extern "C" void kernel_launch(void* const* d_in, const int* in_sizes, int n_in, void* d_out, int out_size, void* d_ws, size_t ws_size, hipStream_t stream) {
    static int grid = 0;
    if (grid == 0) {
        if (n_in != 25 || out_size != NB * SEQ * D || ws_size < WS_END) { fprintf(stderr, "kernel_launch: shape/workspace mismatch (n_in %d out %d ws %zu need %zu); nothing launched\n", n_in, out_size, ws_size, (size_t)WS_END); grid = -1; return; }
        int dev = 0, cus = 0, per_cu = 0;
        if (hipGetDevice(&dev) != hipSuccess || hipDeviceGetAttribute(&cus, hipDeviceAttributeMultiprocessorCount, dev) != hipSuccess) { grid = -1; return; }
        if (hipFuncSetAttribute((const void*)mk_fwd, hipFuncAttributeMaxDynamicSharedMemorySize, LDS_BYTES) != hipSuccess) { fprintf(stderr, "kernel_launch: hipFuncSetAttribute failed\n"); grid = -1; return; }
        if (hipOccupancyMaxActiveBlocksPerMultiprocessor(&per_cu, (const void*)mk_fwd, NTHR, LDS_BYTES) != hipSuccess || per_cu < 1) { fprintf(stderr, "kernel_launch: occupancy query says %d\n", per_cu); (void)hipGetLastError(); grid = -1; return; }
        grid = cus < 256 ? cus : 256;
    }
    if (grid < 0) return;
    (void)hipMemsetAsync((char*)d_ws + WS_CTL, 0, CTL_ZERO_BYTES, stream);
    Args a{};
    for (int i = 0; i < 25; ++i) a.in[i] = (const float*)d_in[i];
    a.out = (float*)d_out; a.ws = (unsigned char*)d_ws;
#if MK_ONE_LAUNCH
    a.ph_lo = 0; a.ph_hi = NPH;
    hipLaunchKernelGGL(mk_fwd, dim3(grid), dim3(NTHR), LDS_BYTES, stream, a);
#else
    for (int p = 0; p < NPH; ++p) {
        if (p >= 3 && ((p - 3) % 11) == 2 && (((p - 3) / 11) & 1) == 0) continue;
        a.ph_lo = p; a.ph_hi = p + 1;
        hipLaunchKernelGGL(mk_fwd, dim3(grid), dim3(NTHR), LDS_BYTES, stream, a);
    }
#endif
    const hipError_t le = hipPeekAtLastError();
    if (le != hipSuccess) fprintf(stderr, "kernel_launch: launch failed: %s\n", hipGetErrorName(le));
}
```
